# Optimizing an MI355X kernel written in HIP

```python
import jax
import jax.numpy as jnp
from jax import lax
import numpy as np

D_MODEL = 1024
BATCH = 4
SEQ = 4096
DEPTH = 4

N_MIXERS = 3
DN_ALPHA = (2.0 * DEPTH) ** 0.25
DN_BETA = (8.0 * DEPTH) ** -0.25
LN_EPS = 1e-5
RMS_EPS = 1e-6

MLA_HEADS = 8
MLA_Q_RANK = 384
MLA_KV_RANK = 256
MLA_NOPE = 128
MLA_ROPE = 64
MLA_V = 128
ROPE_THETA = 10000.0
Q_BLOCK = 128
MLA_IN = MLA_Q_RANK + MLA_KV_RANK + MLA_ROPE

POOL_WINDOWS = (2, 4, 8, 16)
POOL_GROUPS = len(POOL_WINDOWS)
POOL_GROUP_DIM = D_MODEL // POOL_GROUPS

MLSTM_HEADS = 4
MLSTM_QK = D_MODEL // (2 * MLSTM_HEADS)
MLSTM_V = D_MODEL // MLSTM_HEADS
MLSTM_CONV = 5
MLSTM_CHUNK = 64
MLSTM_IN = 2 * MLSTM_HEADS * MLSTM_QK + 2 * MLSTM_HEADS * MLSTM_V + 4 * MLSTM_HEADS

D_FF = 2816
N_EXPERTS = 8
TOP_K = 2
D_FF_EXPERT = 3584

N_MLA = (DEPTH + 2) // 3
N_POOL = (DEPTH + 1) // 3
N_MLSTM = DEPTH // 3
N_DENSE = (DEPTH + 1) // 2
N_MOE = DEPTH // 2

kernel_name = "hybrid_mla_pool_mlstm_moe_encoder"


def _layernorm(x, g, b):
    xf = x.astype(jnp.float32)
    mu = jnp.mean(xf, axis=-1, keepdims=True)
    var = jnp.mean(jnp.square(xf - mu), axis=-1, keepdims=True)
    y = (xf - mu) * lax.rsqrt(var + LN_EPS)
    return (y * g + b).astype(x.dtype)


def _rmsnorm(x, g):
    xf = x.astype(jnp.float32)
    y = xf * lax.rsqrt(jnp.mean(jnp.square(xf), axis=-1, keepdims=True) + RMS_EPS)
    return (y * g).astype(x.dtype)


def _rope(x, cos, sin):
    half = x.shape[-1] // 2
    xf = x.astype(jnp.float32)
    x1, x2 = xf[..., :half], xf[..., half:]
    out = jnp.concatenate([x1 * cos - x2 * sin, x2 * cos + x1 * sin], axis=-1)
    return out.astype(x.dtype)


def _mla(x, positions, w_dqkv, q_norm, w_uq, kv_norm, w_ukv, w_o):
    B, S, _ = x.shape
    H = MLA_HEADS
    lat = x @ w_dqkv
    cq = lat[..., :MLA_Q_RANK]
    ckv = lat[..., MLA_Q_RANK:MLA_Q_RANK + MLA_KV_RANK]
    kr = lat[..., MLA_Q_RANK + MLA_KV_RANK:]
    q = (_rmsnorm(cq, q_norm) @ w_uq).reshape(B, S, H, MLA_NOPE + MLA_ROPE)
    qn, qr = q[..., :MLA_NOPE], q[..., MLA_NOPE:]
    kv = (_rmsnorm(ckv, kv_norm) @ w_ukv).reshape(B, S, H, MLA_NOPE + MLA_V)
    kn, v = kv[..., :MLA_NOPE], kv[..., MLA_NOPE:]
    inv_freq = ROPE_THETA ** (-jnp.arange(0, MLA_ROPE, 2, dtype=jnp.float32) / MLA_ROPE)
    ang = positions.astype(jnp.float32)[..., None] * inv_freq
    cos, sin = jnp.cos(ang), jnp.sin(ang)
    qr = _rope(qr, cos[:, :, None, :], sin[:, :, None, :])
    kr = _rope(kr, cos, sin)
    scale = (MLA_NOPE + MLA_ROPE) ** -0.5
    nb = S // Q_BLOCK
    qn_b = qn.reshape(B, nb, Q_BLOCK, H, MLA_NOPE).transpose(1, 0, 2, 3, 4)
    qr_b = qr.reshape(B, nb, Q_BLOCK, H, MLA_ROPE).transpose(1, 0, 2, 3, 4)

    def attend(blk):
        qn_i, qr_i = blk
        s = (jnp.einsum('bqhd,bkhd->bhqk', qn_i, kn)
             + jnp.einsum('bqhr,bkr->bhqk', qr_i, kr))
        p = jax.nn.softmax(s.astype(jnp.float32) * scale, axis=-1).astype(v.dtype)
        return jnp.einsum('bhqk,bkhd->bqhd', p, v)

    o = lax.map(attend, (qn_b, qr_b))
    o = o.transpose(1, 0, 2, 3, 4).reshape(B, S, H * MLA_V)
    return o @ w_o


def _pool_mixer(x, w_grp, scale):
    B, S, D = x.shape
    xf = x.astype(jnp.float32)
    cs = jnp.concatenate([jnp.zeros((B, 1, D), jnp.float32), jnp.cumsum(xf, axis=1)], axis=1)
    t = jnp.arange(S)
    outs = []
    for g, w in enumerate(POOL_WINDOWS):
        lo = jnp.clip(t - w // 2, 0, S)
        hi = jnp.clip(t + w - w // 2, 0, S)
        sl = slice(g * POOL_GROUP_DIM, (g + 1) * POOL_GROUP_DIM)
        csg = cs[:, :, sl]
        mean = (csg[:, hi] - csg[:, lo]) / (hi - lo).astype(jnp.float32)[None, :, None]
        outs.append(mean - xf[:, :, sl])
    z = jnp.stack(outs, axis=2).astype(x.dtype)
    y = jnp.einsum('bsgc,gcd->bsgd', z, w_grp).reshape(B, S, D)
    return y * scale


def _mlstm_chunk(carry, inp):
    C, n, m = carry
    q, k, v, li, lf = inp
    L = q.shape[-2]
    causal_in_chunk = jnp.tril(jnp.ones((L, L), dtype=bool))
    b = jnp.cumsum(lf, axis=-1)
    Dm = b[..., :, None] - b[..., None, :] + li[..., None, :]
    Dm = jnp.where(causal_in_chunk, Dm, -jnp.inf)
    g = b + m[..., None]
    m_t = jnp.maximum(g, jnp.max(Dm, axis=-1))
    Dw = jnp.exp(Dm - m_t[..., None])
    gw = jnp.exp(g - m_t)
    s = jnp.einsum('...td,...sd->...ts', q, k) * Dw
    num = gw[..., None] * jnp.einsum('...td,...dv->...tv', q, C) + jnp.einsum('...ts,...sv->...tv', s, v)
    den = gw * jnp.einsum('...td,...d->...t', q, n) + jnp.sum(s, axis=-1)
    h = num / jnp.maximum(jnp.abs(den), jnp.exp(-m_t))[..., None]
    bL = b[..., -1]
    a = bL[..., None] - b + li
    m_new = jnp.maximum(bL + m, jnp.max(a, axis=-1))
    aw = jnp.exp(a - m_new[..., None])
    cw = jnp.exp(bL + m - m_new)
    C_new = cw[..., None, None] * C + jnp.einsum('...sd,...sv->...dv', k * aw[..., None], v)
    n_new = cw[..., None] * n + jnp.einsum('...s,...sd->...d', aw, k)
    return (C_new, n_new, m_new), h


def _mlstm_mixer(x, w_in, conv_w, b_gate, norm_g, w_out):
    B, S, D = x.shape
    H, DK, DV, L = MLSTM_HEADS, MLSTM_QK, MLSTM_V, MLSTM_CHUNK
    NC = S // L
    proj = x @ w_in
    n_qk = 2 * H * DK
    qk = proj[..., :n_qk]
    v = proj[..., n_qk:n_qk + H * DV]
    o = proj[..., n_qk + H * DV:n_qk + 2 * H * DV]
    gates = proj[..., n_qk + 2 * H * DV:]
    qk = jax.nn.silu(lax.conv_general_dilated(
        qk, conv_w[:, None, :], window_strides=(1,),
        padding=[(MLSTM_CONV // 2, MLSTM_CONV // 2)],
        dimension_numbers=('NWC', 'WIO', 'NWC'), feature_group_count=n_qk))
    q = qk[..., :H * DK].reshape(B, S, H, DK).astype(jnp.float32)
    k = qk[..., H * DK:].reshape(B, S, H, DK).astype(jnp.float32) * (DK ** -0.5)
    v = v.reshape(B, S, H, DV).astype(jnp.float32)
    gates = (gates + b_gate).astype(jnp.float32).reshape(B, S, 2, 2, H)
    li = gates[:, :, 0]
    lf = jax.nn.log_sigmoid(gates[:, :, 1])

    def two_dir(a):
        return jnp.stack([a, jnp.flip(a, axis=1)], axis=0)

    def gate_dir(a):
        return jnp.stack([a[:, :, 0], jnp.flip(a[:, :, 1], axis=1)], axis=0)

    def to_chunks(a):
        return a.reshape(2, B, NC, L, H, a.shape[-1]).transpose(2, 0, 1, 4, 3, 5)

    qc = to_chunks(two_dir(q))
    kc = to_chunks(two_dir(k))
    vc = to_chunks(two_dir(v))
    lic = to_chunks(gate_dir(li)[..., None])[..., 0]
    lfc = to_chunks(gate_dir(lf)[..., None])[..., 0]
    init = (jnp.zeros((2, B, H, DK, DV), jnp.float32),
            jnp.zeros((2, B, H, DK), jnp.float32),
            jnp.zeros((2, B, H), jnp.float32))
    _, hs = lax.scan(_mlstm_chunk, init, (qc, kc, vc, lic, lfc))
    hs = hs.transpose(1, 2, 0, 4, 3, 5).reshape(2, B, S, H, DV)
    h = hs[0] + jnp.flip(hs[1], axis=1)
    mu = jnp.mean(h, axis=-1, keepdims=True)
    var = jnp.mean(jnp.square(h - mu), axis=-1, keepdims=True)
    hn = ((h - mu) * lax.rsqrt(var + LN_EPS)).reshape(B, S, D) * norm_g
    y = (hn * jax.nn.sigmoid(o.astype(jnp.float32))).astype(x.dtype)
    return y @ w_out


def _swiglu(x, w_gate, w_up, w_down):
    return (jax.nn.silu(x @ w_gate) * (x @ w_up)) @ w_down


def _moe(x, w_router, w_gate, w_up, w_down):
    B, S, D = x.shape
    xt = x.reshape(B * S, D)
    logits = (xt @ w_router).astype(jnp.float32)
    top_v, top_i = lax.top_k(logits, TOP_K)
    top_w = jax.nn.softmax(top_v, axis=-1)
    combine = jnp.sum(jax.nn.one_hot(top_i, N_EXPERTS, dtype=jnp.float32) * top_w[..., None], axis=1)
    y = jnp.zeros_like(xt)
    for e in range(N_EXPERTS):
        y = y + combine[:, e:e + 1].astype(x.dtype) * _swiglu(xt, w_gate[e], w_up[e], w_down[e])
    return y.reshape(B, S, D)


def setup_inputs(seed: int = 0) -> dict:
    key = jax.random.key(seed)
    ks = iter(jax.random.split(key, 32))
    f32 = jnp.float32

    def nrm(shape, fan_in, scale=1.0):
        return jax.random.normal(next(ks), shape, f32) * (scale * fan_in ** -0.5)

    def gain(shape):
        return 1.0 + 0.02 * jax.random.normal(next(ks), shape, f32)

    x = jax.random.normal(next(ks), (BATCH, SEQ, D_MODEL), f32)
    offset = jax.random.randint(next(ks), (BATCH, 1), 0, 1024, dtype=jnp.int32)
    positions = jnp.arange(SEQ, dtype=jnp.int32)[None, :] + offset

    H = MLA_HEADS
    mla_w_dqkv = nrm((N_MLA, D_MODEL, MLA_IN), D_MODEL)
    mla_q_norm = gain((N_MLA, MLA_Q_RANK))
    mla_w_uq = nrm((N_MLA, MLA_Q_RANK, H * (MLA_NOPE + MLA_ROPE)), MLA_Q_RANK)
    mla_kv_norm = gain((N_MLA, MLA_KV_RANK))
    mla_w_ukv = nrm((N_MLA, MLA_KV_RANK, H * (MLA_NOPE + MLA_V)), MLA_KV_RANK)
    mla_w_o = nrm((N_MLA, H * MLA_V, D_MODEL), H * MLA_V, DN_BETA)

    pool_w = nrm((N_POOL, POOL_GROUPS, POOL_GROUP_DIM, POOL_GROUP_DIM), POOL_GROUP_DIM, DN_BETA)
    pool_scale = gain((N_POOL, D_MODEL))

    HM = MLSTM_HEADS
    mlstm_w_in = nrm((N_MLSTM, D_MODEL, MLSTM_IN), D_MODEL)
    mlstm_conv = nrm((N_MLSTM, MLSTM_CONV, 2 * HM * MLSTM_QK), MLSTM_CONV)
    b_i = 0.1 * jax.random.normal(next(ks), (N_MLSTM, 2 * HM), f32)
    b_f = 3.0 + 3.0 * jax.random.uniform(next(ks), (N_MLSTM, 2 * HM), f32)
    mlstm_b_gate = jnp.concatenate([b_i, b_f], axis=-1)
    mlstm_norm = gain((N_MLSTM, D_MODEL))
    mlstm_w_out = nrm((N_MLSTM, HM * MLSTM_V, D_MODEL), HM * MLSTM_V, DN_BETA)

    ffn_w_gate = nrm((N_DENSE, D_MODEL, D_FF), D_MODEL)
    ffn_w_up = nrm((N_DENSE, D_MODEL, D_FF), D_MODEL)
    ffn_w_down = nrm((N_DENSE, D_FF, D_MODEL), D_FF, DN_BETA)

    moe_router = nrm((N_MOE, D_MODEL, N_EXPERTS), D_MODEL)
    moe_w_gate = nrm((N_MOE, N_EXPERTS, D_MODEL, D_FF_EXPERT), D_MODEL)
    moe_w_up = nrm((N_MOE, N_EXPERTS, D_MODEL, D_FF_EXPERT), D_MODEL)
    moe_w_down = nrm((N_MOE, N_EXPERTS, D_FF_EXPERT, D_MODEL), D_FF_EXPERT, DN_BETA)

    ln_g = gain((DEPTH, 2, D_MODEL))
    ln_b = 0.02 * jax.random.normal(next(ks), (DEPTH, 2, D_MODEL), f32)

    return {
        "x": x, "positions": positions,
        "mla_w_dqkv": mla_w_dqkv, "mla_q_norm": mla_q_norm, "mla_w_uq": mla_w_uq,
        "mla_kv_norm": mla_kv_norm, "mla_w_ukv": mla_w_ukv, "mla_w_o": mla_w_o,
        "pool_w": pool_w, "pool_scale": pool_scale,
        "mlstm_w_in": mlstm_w_in, "mlstm_conv": mlstm_conv, "mlstm_b_gate": mlstm_b_gate,
        "mlstm_norm": mlstm_norm, "mlstm_w_out": mlstm_w_out,
        "ffn_w_gate": ffn_w_gate, "ffn_w_up": ffn_w_up, "ffn_w_down": ffn_w_down,
        "moe_router": moe_router, "moe_w_gate": moe_w_gate, "moe_w_up": moe_w_up,
        "moe_w_down": moe_w_down,
        "ln_g": ln_g, "ln_b": ln_b,
    }


def reference(x, positions, mla_w_dqkv, mla_q_norm, mla_w_uq, mla_kv_norm, mla_w_ukv, mla_w_o,
              pool_w, pool_scale, mlstm_w_in, mlstm_conv, mlstm_b_gate, mlstm_norm, mlstm_w_out,
              ffn_w_gate, ffn_w_up, ffn_w_down, moe_router, moe_w_gate, moe_w_up, moe_w_down,
              ln_g, ln_b):
    for i in range(DEPTH):
        j = i // N_MIXERS
        if i % N_MIXERS == 0:
            y = _mla(x, positions, mla_w_dqkv[j], mla_q_norm[j], mla_w_uq[j],
                     mla_kv_norm[j], mla_w_ukv[j], mla_w_o[j])
        elif i % N_MIXERS == 1:
            y = _pool_mixer(x, pool_w[j], pool_scale[j])
        else:
            y = _mlstm_mixer(x, mlstm_w_in[j], mlstm_conv[j], mlstm_b_gate[j],
                             mlstm_norm[j], mlstm_w_out[j])
        x = _layernorm(DN_ALPHA * x + y, ln_g[i, 0], ln_b[i, 0])
        c = i // 2
        if i % 2 == 0:
            y = _swiglu(x, ffn_w_gate[c], ffn_w_up[c], ffn_w_down[c])
        else:
            y = _moe(x, moe_router[c], moe_w_gate[c], moe_w_up[c], moe_w_down[c])
        x = _layernorm(DN_ALPHA * x + y, ln_g[i, 1], ln_b[i, 1])
    return x
```

```cpp
#include <hip/hip_runtime.h>
#include <cstdio>
#include <cstdint>

#define LAS __attribute__((address_space(3)))
#define GAS __attribute__((address_space(1)))
typedef unsigned short bf16_t;
typedef short bf16x8 __attribute__((ext_vector_type(8)));
typedef short s16x4 __attribute__((ext_vector_type(4)));
typedef float f32x4 __attribute__((ext_vector_type(4)));
typedef float f32x2 __attribute__((ext_vector_type(2)));
typedef float f32x16 __attribute__((ext_vector_type(16)));
typedef unsigned u32x4 __attribute__((ext_vector_type(4)));
typedef unsigned u32x2 __attribute__((ext_vector_type(2)));
typedef GAS unsigned gu32;

constexpr int BATCH = 4, SEQ = 4096, T = BATCH * SEQ, D = 1024;
constexpr float DN_ALPHA = 1.6817928305074290f;
constexpr float LN_EPS = 1e-5f, RMS_EPS = 1e-6f;
constexpr int MLA_H = 8, MLA_QR = 384, MLA_KVR = 256, MLA_NOPE = 128, MLA_ROPE = 64, MLA_V = 128, MLA_IN = 704, MLA_INP = 768;
constexpr int MLA_QW = MLA_H * (MLA_NOPE + MLA_ROPE);
constexpr int MLA_KVW = MLA_H * (MLA_NOPE + MLA_V);
constexpr int ML_H = 4, ML_DK = 128, ML_DV = 256, ML_IN = 3088, ML_INP = 3072;
constexpr int DFF = 2816, NEXP = 8, DFFE = 3584;
constexpr int MOE_MAXT = 136;
constexpr int NWAVES = 8, NTHR = 512;

constexpr size_t MiB = 1u << 20;
constexpr size_t WS_CTL = 0, CTL_ZERO_BYTES = 1 * MiB;
constexpr size_t WS_META = 1 * MiB;
constexpr size_t MT_CNTW = 0;
constexpr size_t MT_MOE = 16384;
constexpr size_t MT_TOKE = 32768;
constexpr size_t MT_TOKW = MT_TOKE + (size_t)T * 8;
constexpr size_t MT_RANK = MT_TOKW + (size_t)T * 8;
constexpr size_t MT_ROWTOK = MT_RANK + (size_t)T * 8;
constexpr size_t MT_GATES = 1 * MiB;
constexpr size_t MT_GVEC = 2 * MiB;
constexpr size_t MT_ROPE = 4 * MiB;
static_assert(MT_ROWTOK + (size_t)MOE_MAXT * 256 * 4 <= MT_GATES, "meta map");
constexpr size_t WS_W = 17 * MiB;
constexpr size_t W_DQKV = 0;
constexpr size_t W_UQ = W_DQKV + 2 * (size_t)MLA_INP * D * 2;
constexpr size_t W_UKV = W_UQ + 2 * (size_t)MLA_QW * MLA_QR * 2;
constexpr size_t W_O = W_UKV + 2 * (size_t)MLA_KVW * MLA_KVR * 2;
constexpr size_t W_POOL = W_O + 2 * (size_t)D * D * 2;
constexpr size_t W_IN = W_POOL + 4 * (size_t)256 * 256 * 2;
constexpr size_t W_OUT = W_IN + (size_t)ML_INP * D * 2;
constexpr size_t W_GU = W_OUT + (size_t)D * D * 2;
constexpr size_t W_DN = W_GU + 2 * (size_t)2 * DFF * D * 2;
constexpr size_t W_END = W_DN + 2 * (size_t)D * DFF * 2;
static_assert(W_END <= 55 * MiB, "weights map");
constexpr size_t WS_WMOE = 72 * MiB;
constexpr size_t WM_GU = 0, WM_DN = (size_t)NEXP * 2 * DFFE * D * 2;
static_assert(WM_DN + (size_t)NEXP * D * DFFE * 2 == 168 * MiB, "moe weights map");
constexpr size_t WS_X = 240 * MiB;
constexpr size_t WS_XB = 304 * MiB;
constexpr size_t WS_Y = 336 * MiB;
constexpr size_t WS_SCR = 400 * MiB;
constexpr size_t WS_END = 834 * MiB;
constexpr size_t SC_LAT = 0, SC_CQN = 48 * MiB, SC_CKVN = 60 * MiB, SC_KR = 68 * MiB, SC_Q = 70 * MiB, SC_KV = 118 * MiB, SC_O = 182 * MiB;
constexpr size_t SC_H = 0;
constexpr size_t SC_Z = 0;
constexpr size_t SC_XP = 0, SC_HM = 68 * MiB, SC_Y2 = 306 * MiB;
static_assert(SC_Y2 + (size_t)2 * T * D * 4 == 434 * MiB, "moe scratch");
constexpr size_t SC_PROJ = 0, SC_QKC = 96 * MiB, SC_HS = 128 * MiB, SC_YM = 256 * MiB;

constexpr int LDS_MAIN = 131072;
constexpr int LDS_MISC = LDS_MAIN;
constexpr int LDS_BYTES = 147456;

#define RLX_AGENT __ATOMIC_RELAXED, __HIP_MEMORY_SCOPE_AGENT
__device__ __forceinline__ unsigned cvt_pk_bf16(float lo, float hi) { unsigned r; asm volatile("v_cvt_pk_bf16_f32 %0, %1, %2" : "=v"(r) : "v"(lo), "v"(hi)); return r; }
__device__ __forceinline__ float bf2f(unsigned short b) { return __builtin_bit_cast(float, (unsigned)b << 16); }
__device__ __forceinline__ float bflo(unsigned w) { return __builtin_bit_cast(float, w << 16); }
__device__ __forceinline__ float bfhi(unsigned w) { return __builtin_bit_cast(float, w & 0xffff0000u); }
__device__ __forceinline__ float wave_sum(float v) {
#pragma unroll
    for (int o = 32; o >= 1; o >>= 1) v += __shfl_xor(v, o);
    return v;
}
__device__ __forceinline__ float fast_exp(float x) { return __builtin_amdgcn_exp2f(x * 1.4426950408889634f); }
__device__ __forceinline__ float fast_rcp(float x) { return __builtin_amdgcn_rcpf(x); }
__device__ __forceinline__ float silu_f(float x) { return x * fast_rcp(1.0f + fast_exp(-x)); }
__device__ __forceinline__ float sigmoid_f(float x) { return fast_rcp(1.0f + fast_exp(-x)); }

namespace pg8 {
constexpr int BM = 256, BK = 64, HALF = 128, HTB = HALF * BK * 2, STAGE_BYTES = 8 * HTB, NXCD = 8, WGM = 8;
__host__ __device__ __forceinline__ int lds_byte(int r, int c) { const int st = (r >> 4) * 2 + (c >> 5), rr = r & 15, cc = c & 31, ob = rr * 64 + cc * 2; return st * 1024 + (ob ^ (((ob >> 9) & 1) << 5)); }
__host__ __device__ __forceinline__ void stage_rc(int b, int& R, int& C) { const int st = b / 1024, sb = b % 1024, swz = sb ^ (((sb >> 9) & 1) << 5); R = (st >> 1) * 16 + swz / 64; C = (st & 1) * 32 + (swz % 64) / 2; }
__host__ __device__ __forceinline__ int perm32(int rho) { const int n = rho >> 4, i = rho & 15; return 8 * (i >> 2) + 4 * n + (i & 3); }

struct Unit { int pm, pn, e, nv; };
struct Gemm { const bf16_t* A; const bf16_t* Bt; int lda, ldb, K; };

struct DenseOrder {
    int nM, nN, nwg, G, c;
    __device__ __forceinline__ void init(int M, int N, int G_, int c_) { nM = M / BM; nN = N / BM; nwg = nM * nN; G = G_; c = c_; }
    __device__ __forceinline__ bool next(int i, Unit& u) const {
        const long L = (long)i * G + c; if (L >= nwg) return false;
        int wgid = (int)L; { const int q = nwg / NXCD, r = nwg % NXCD, xcd = wgid % NXCD, off = wgid / NXCD; wgid = (xcd < r ? xcd * (q + 1) : r * (q + 1) + (xcd - r) * q) + off; }
        const int nig = WGM * nN, gid = wgid / nig, fm = gid * WGM, gsz = (nM - fm) < WGM ? (nM - fm) : WGM;
        u.pm = fm + ((wgid % nig) % gsz); u.pn = (wgid % nig) / gsz; u.e = 0; u.nv = 256; return true;
    }
    __device__ __forceinline__ const char* a_tile(const Unit& u, const Gemm& g) const { return (const char*)g.A + (size_t)u.pm * BM * g.lda * 2; }
    __device__ __forceinline__ const char* b_tile(const Unit& u, const Gemm& g) const { return (const char*)g.Bt + (size_t)u.pn * BM * g.ldb * 2; }
};
struct PoolOrder : DenseOrder {
    __device__ __forceinline__ const char* a_tile(const Unit& u, const Gemm& g) const { return (const char*)g.A + ((size_t)u.pm * BM * g.lda + (size_t)u.pn * 256) * 2; }
    __device__ __forceinline__ const char* b_tile(const Unit& u, const Gemm& g) const { return (const char*)g.Bt + (size_t)u.pn * 256 * 256 * 2; }
};
struct MoeOrder {
    const LAS int* tab; int ntiles, nN, Nexp, G, c;
    __device__ __forceinline__ void build_table(const int* meta, LAS int* tabw, int Nexp_, int G_, int c_) {
        const int tid = threadIdx.x;
        if (tid < MOE_MAXT) {
            int e = 0;
#pragma unroll
            for (int k = 1; k < 8; ++k) e += (tid >= meta[8 + k]) ? 1 : 0;
            const int rem = meta[e] - (tid - meta[8 + e]) * 256;
            tabw[2 * tid] = e; tabw[2 * tid + 1] = rem < 256 ? rem : 256;
        }
        ntiles = __builtin_amdgcn_readfirstlane(meta[16]);
        __syncthreads();
        tab = tabw; Nexp = Nexp_; nN = Nexp_ / BM; G = G_; c = c_;
    }
    __device__ __forceinline__ bool next(int i, Unit& u) const {
        const long L = (long)i * G + c; if (L >= (long)ntiles * nN) return false;
        const int rt = (int)(L / nN); u.pn = (int)(L % nN); u.pm = rt;
        u.e = __builtin_amdgcn_readfirstlane(tab[2 * rt]); u.nv = __builtin_amdgcn_readfirstlane(tab[2 * rt + 1]); return true;
    }
    __device__ __forceinline__ const char* a_tile(const Unit& u, const Gemm& g) const { return (const char*)g.A + (size_t)u.pm * BM * g.lda * 2; }
    __device__ __forceinline__ const char* b_tile(const Unit& u, const Gemm& g) const { return (const char*)g.Bt + ((size_t)u.e * Nexp + (size_t)u.pn * BM) * g.ldb * 2; }
};

struct EpiF32 {
    static constexpr bool PERM = false;
    float* C; int ldc;
    __device__ __forceinline__ void operator()(const f32x4 (&acc)[2][2][4][2], const Unit& u, int wr, int wc, int fr, int fq) const {
        const int row0 = u.pm * BM + wr * 64 + fr, col0 = u.pn * BM + wc * 32 + 4 * fq;
#pragma unroll
        for (int ai = 0; ai < 2; ++ai)
#pragma unroll
            for (int m = 0; m < 4; ++m) { float* rowp = C + (size_t)(row0 + ai * HALF + m * 16) * ldc + col0;
#pragma unroll
                for (int bj = 0; bj < 2; ++bj)
#pragma unroll
                    for (int n = 0; n < 2; ++n) *(f32x4*)(rowp + bj * HALF + n * 16) = acc[ai][bj][m][n]; }
    }
};
struct EpiF32Scatter {
    static constexpr bool PERM = false;
    float* C; const int* rowtok;
    __device__ __forceinline__ void operator()(const f32x4 (&acc)[2][2][4][2], const Unit& u, int wr, int wc, int fr, int fq) const {
        const int col0 = u.pn * BM + wc * 32 + 4 * fq;
#pragma unroll
        for (int ai = 0; ai < 2; ++ai)
#pragma unroll
            for (int m = 0; m < 4; ++m) { const int rl = ai * HALF + wr * 64 + m * 16 + fr;
                if (rl < u.nv) { const int dst = rowtok[u.pm * BM + rl]; float* rowp = C + (size_t)dst * D + col0;
#pragma unroll
                    for (int bj = 0; bj < 2; ++bj)
#pragma unroll
                        for (int n = 0; n < 2; ++n) *(f32x4*)(rowp + bj * HALF + n * 16) = acc[ai][bj][m][n]; } }
    }
};
struct EpiBf16 {
    static constexpr bool PERM = true;
    bf16_t* O; int ldc;
    __device__ __forceinline__ void operator()(const f32x4 (&acc)[2][2][4][2], const Unit& u, int wr, int wc, int fr, int fq) const {
        const int row0 = u.pm * BM + wr * 64 + fr, col0 = u.pn * BM + wc * 32 + 8 * fq;
#pragma unroll
        for (int ai = 0; ai < 2; ++ai)
#pragma unroll
            for (int m = 0; m < 4; ++m) { bf16_t* rowp = O + (size_t)(row0 + ai * HALF + m * 16) * ldc + col0;
#pragma unroll
                for (int bj = 0; bj < 2; ++bj) { const f32x4 v0 = acc[ai][bj][m][0], v1 = acc[ai][bj][m][1];
                    u32x4 w; w.x = cvt_pk_bf16(v0[0], v0[1]); w.y = cvt_pk_bf16(v0[2], v0[3]); w.z = cvt_pk_bf16(v1[0], v1[1]); w.w = cvt_pk_bf16(v1[2], v1[3]);
                    *(u32x4*)(rowp + bj * HALF) = w; } }
    }
};
struct EpiSwiGLU {
    static constexpr bool PERM = true;
    bf16_t* O; int ldc;
    __device__ __forceinline__ void operator()(const f32x4 (&acc)[2][2][4][2], const Unit& u, int wr, int wc, int fr, int fq) const {
        const int row0 = u.pm * BM + wr * 64 + fr, col0 = u.pn * HALF + wc * 32 + 8 * fq;
#pragma unroll
        for (int ai = 0; ai < 2; ++ai)
#pragma unroll
            for (int m = 0; m < 4; ++m) { bf16_t* rowp = O + (size_t)(row0 + ai * HALF + m * 16) * ldc + col0;
                float h[8];
#pragma unroll
                for (int n = 0; n < 2; ++n)
#pragma unroll
                    for (int i = 0; i < 4; ++i) h[n * 4 + i] = silu_f(acc[ai][0][m][n][i]) * acc[ai][1][m][n][i];
                u32x4 w; w.x = cvt_pk_bf16(h[0], h[1]); w.y = cvt_pk_bf16(h[2], h[3]); w.z = cvt_pk_bf16(h[4], h[5]); w.w = cvt_pk_bf16(h[6], h[7]);
                *(u32x4*)rowp = w; }
    }
};

template <class Epi, class Sched, bool ALIGN_EPI = true>
__device__ __forceinline__ void gemm_phase(LAS unsigned char* lds, const Gemm g, const Sched& S, const Epi& E) {
    const int tid = threadIdx.x, wid = __builtin_amdgcn_readfirstlane(tid >> 6), lane = tid & 63, wr = wid >> 2, wc = wid & 3, fr = lane & 15, fq = lane >> 4;
    int K = g.K; asm volatile("" : "+s"(K));
    const int nt = K / BK;
    unsigned voffA[2], voffB[2];
#pragma unroll
    for (int i = 0; i < 2; ++i) { int R, C; stage_rc(tid * 16 + i * 8192, R, C); const int Rb = Epi::PERM ? ((R & ~31) + perm32(R & 31)) : R;
        voffA[i] = (unsigned)(R * g.lda + C) * 2u; voffB[i] = (unsigned)(Rb * g.ldb + C) * 2u; }
    const size_t kstep = (size_t)(BK * 2);
    const size_t hstepA = (size_t)HALF * g.lda * 2, hstepB = (size_t)HALF * g.ldb * 2;
    const unsigned ldsw = (unsigned)wid * 1024u;
    const int aoff = lds_byte(wr * 64 + fr, fq * 8), boff = lds_byte(wc * 32 + fr, fq * 8);
#define PG8_SA(b, h) (((b) * 2 + (h)) * HTB)
#define PG8_SB(b, h) ((4 + (b) * 2 + (h)) * HTB)
#define PG8_STAGE(bufoff, gbase, voff) do { _Pragma("unroll") for (int _i = 0; _i < 2; ++_i) \
        __builtin_amdgcn_global_load_lds((const unsigned*)((const char*)(gbase) + (voff)[_i]), (LAS unsigned*)(lds + (bufoff) + ldsw + _i * 8192), 16, 0, 0); } while (0)
#define PG8_LDA(dst, b, h) do { _Pragma("unroll") for (int m = 0; m < 4; ++m) _Pragma("unroll") for (int k = 0; k < 2; ++k) dst[m][k] = *(const LAS bf16x8*)(lds + PG8_SA(b, h) + aoff + m * 2048 + k * 1024); } while (0)
#define PG8_LDB(dst, b, h) do { _Pragma("unroll") for (int n = 0; n < 2; ++n) _Pragma("unroll") for (int k = 0; k < 2; ++k) dst[n][k] = *(const LAS bf16x8*)(lds + PG8_SB(b, h) + boff + n * 2048 + k * 1024); } while (0)
#define PG8_MMA(ai, bj, At, Bt) do { __builtin_amdgcn_s_setprio(1); _Pragma("unroll") for (int m = 0; m < 4; ++m) _Pragma("unroll") for (int n = 0; n < 2; ++n) _Pragma("unroll") for (int k = 0; k < 2; ++k) \
        acc[ai][bj][m][n] = __builtin_amdgcn_mfma_f32_16x16x32_bf16(Bt[n][k], At[m][k], acc[ai][bj][m][n], 0, 0, 0); __builtin_amdgcn_s_setprio(0); } while (0)
#define PG8_WAIT_V(n) asm volatile("s_waitcnt vmcnt(" #n ")" ::: "memory")
#define PG8_WAIT_L(n) asm volatile("s_waitcnt lgkmcnt(" #n ")" ::: "memory")
#define PG8_BAR __builtin_amdgcn_s_barrier()
#define PG8_SCHED __builtin_amdgcn_sched_barrier(0)
    Unit cur, nxt; int ui = 0;
    if (!S.next(0, cur)) return;
    f32x4 acc[2][2][4][2];
#pragma unroll
    for (int a = 0; a < 2; ++a)
#pragma unroll
        for (int b = 0; b < 2; ++b)
#pragma unroll
            for (int m = 0; m < 4; ++m)
#pragma unroll
                for (int n = 0; n < 2; ++n) acc[a][b][m][n] = (f32x4){0.f, 0.f, 0.f, 0.f};
    bf16x8 At[4][2], B0[2][2], B1[2][2];
    const char* cA = S.a_tile(cur, g); const char* cB = S.b_tile(cur, g);
    PG8_STAGE(PG8_SB(0, 0), cB, voffB); PG8_STAGE(PG8_SB(0, 1), cB + hstepB, voffB); PG8_STAGE(PG8_SA(0, 0), cA, voffA); PG8_STAGE(PG8_SA(0, 1), cA + hstepA, voffA);
    if (wr == 1) PG8_BAR;
    PG8_WAIT_V(2); PG8_BAR;
    PG8_STAGE(PG8_SB(1, 0), cB + kstep, voffB); PG8_STAGE(PG8_SA(1, 0), cA + kstep, voffA); PG8_STAGE(PG8_SB(1, 1), cB + hstepB + kstep, voffB);
    PG8_WAIT_V(6); PG8_BAR;
    for (;;) {
        const bool has_next = S.next(ui + 1, nxt);
        const char* nA = has_next ? S.a_tile(nxt, g) : cA; const char* nB = has_next ? S.b_tile(nxt, g) : cB;
        for (int t = 0; t < nt; t += 2) {
            const bool last = (t == nt - 2);
            const char* a1 = cA + (size_t)(t + 1) * kstep;
            const char* a2 = last ? nA : cA + (size_t)(t + 2) * kstep; const char* b2 = last ? nB : cB + (size_t)(t + 2) * kstep;
            const char* a3 = a2 + kstep; const char* b3 = b2 + kstep;
            PG8_LDB(B0, 0, 0); PG8_LDB(B1, 0, 1); PG8_SCHED; PG8_LDA(At, 0, 0); PG8_STAGE(PG8_SA(1, 1), a1 + hstepA, voffA);
            PG8_WAIT_V(8); PG8_WAIT_L(0); PG8_BAR; PG8_MMA(0, 0, At, B0); PG8_MMA(0, 1, At, B1); PG8_BAR; PG8_SCHED;
            PG8_LDA(At, 0, 1); PG8_STAGE(PG8_SB(0, 0), b2, voffB); PG8_STAGE(PG8_SB(0, 1), b2 + hstepB, voffB); PG8_STAGE(PG8_SA(0, 0), a2, voffA);
            PG8_WAIT_V(8); PG8_WAIT_L(0); PG8_BAR; PG8_MMA(1, 0, At, B0); PG8_MMA(1, 1, At, B1); PG8_BAR; PG8_SCHED;
            PG8_LDB(B0, 1, 0); PG8_LDB(B1, 1, 1); PG8_SCHED; PG8_LDA(At, 1, 0); PG8_STAGE(PG8_SA(0, 1), a2 + hstepA, voffA);
            PG8_WAIT_V(8); PG8_WAIT_L(0); PG8_BAR; PG8_MMA(0, 0, At, B0); PG8_MMA(0, 1, At, B1); PG8_BAR; PG8_SCHED;
            PG8_LDA(At, 1, 1); PG8_STAGE(PG8_SB(1, 0), b3, voffB); PG8_STAGE(PG8_SB(1, 1), b3 + hstepB, voffB); PG8_STAGE(PG8_SA(1, 0), a3, voffA);
            PG8_WAIT_V(8); PG8_WAIT_L(0); PG8_BAR; PG8_MMA(1, 0, At, B0); PG8_MMA(1, 1, At, B1); PG8_BAR; PG8_SCHED;
        }
        if constexpr (ALIGN_EPI) { if (wr == 0) PG8_BAR; }
        E(acc, cur, wr, wc, fr, fq);
        if (!has_next) break;
#pragma unroll
        for (int a = 0; a < 2; ++a)
#pragma unroll
            for (int b = 0; b < 2; ++b)
#pragma unroll
                for (int m = 0; m < 4; ++m)
#pragma unroll
                    for (int n = 0; n < 2; ++n) acc[a][b][m][n] = (f32x4){0.f, 0.f, 0.f, 0.f};
        cur = nxt; cA = nA; cB = nB; ++ui;
        if constexpr (ALIGN_EPI) { if (wr == 1) PG8_BAR; }
    }
    PG8_WAIT_V(0);
    if constexpr (!ALIGN_EPI) { if (wr == 0) PG8_BAR; }
    PG8_BAR;
#undef PG8_SA
#undef PG8_SB
#undef PG8_STAGE
#undef PG8_LDA
#undef PG8_LDB
#undef PG8_MMA
#undef PG8_WAIT_V
#undef PG8_WAIT_L
#undef PG8_BAR
#undef PG8_SCHED
}
}

#ifndef ATT_SDEPTH
#define ATT_SDEPTH 1
#endif
namespace att {
constexpr int NW = 8, QBLK = 32, KVBLK = 64;
constexpr float SCALE = 0.07216878364870322f;
constexpr float THR = 8.f;
constexpr int LDQ = MLA_QW, LDK = MLA_KVW, LDKR = MLA_ROPE, LDO = D;
constexpr int SHM_V = KVBLK * 128 * 2, SHM_K = KVBLK * 128 * 2, SHM_KR = KVBLK * 64 * 2;
constexpr int OFF_V = 0, OFF_K = 2 * SHM_V, OFF_KR = OFF_K + 2 * SHM_K, OFF_WS = OFF_KR + 2 * SHM_KR, OFF_QR = OFF_WS + NW * 64 * 4, SHM_ATTN = OFF_QR + NW * 4096;
#define KSWZ(row, colB) ((row) * 256 + ((colB) ^ (((row) & 7) << 4)))
#define KRSWZ(row, colB) ((row) * 128 + ((colB) ^ ((((row) >> 1) & 7) << 4)))
#define SBAR() __builtin_amdgcn_sched_barrier(0)
__device__ __forceinline__ int crow(int r, int hi) { return (r & 3) + 8 * (r >> 2) + 4 * hi; }

__device__ __forceinline__ void partialSM(f32x16& p0, f32x16& p1, float& m_reg, float& mn, float& alpha) {
  constexpr float C = SCALE * 1.4426950408889634f;
  float pmax = p0[0];
#pragma unroll
  for (int r = 1; r < 16; ++r) pmax = fmaxf(pmax, p0[r]);
#pragma unroll
  for (int r = 0; r < 16; ++r) pmax = fmaxf(pmax, p1[r]);
  { auto rr = __builtin_amdgcn_permlane32_swap(__float_as_uint(pmax), __float_as_uint(pmax), false, false);
    pmax = fmaxf(__uint_as_float(rr[0]), __uint_as_float(rr[1])); }
  if (__builtin_expect(__all(pmax - m_reg <= THR / SCALE), 1)) { mn = m_reg; alpha = 1.f; }
  else { mn = fmaxf(m_reg, pmax); alpha = __builtin_amdgcn_exp2f((m_reg - mn) * C); m_reg = mn; }
  float mnC = -mn * C;
#pragma unroll
  for (int r = 0; r < 16; ++r) p0[r] = fmaf(p0[r], C, mnC);
#pragma unroll
  for (int r = 0; r < 16; ++r) p1[r] = fmaf(p1[r], C, mnC);
#pragma unroll
  for (int r = 0; r < 16; ++r) p0[r] = __builtin_amdgcn_exp2f(p0[r]);
}
__device__ __forceinline__ void finishSM(f32x16& p0, f32x16& p1, float alpha, float& l_reg, bf16x8& pa0, bf16x8& pa1, bf16x8& pa2, bf16x8& pa3) {
#pragma unroll
  for (int r = 0; r < 16; ++r) p1[r] = __builtin_amdgcn_exp2f(p1[r]);
  float ps = 0;
#pragma unroll
  for (int r = 0; r < 16; ++r) ps += p0[r];
#pragma unroll
  for (int r = 0; r < 16; ++r) ps += p1[r];
  { auto rr = __builtin_amdgcn_permlane32_swap(__float_as_uint(ps), __float_as_uint(ps), false, false);
    ps = __uint_as_float(rr[0]) + __uint_as_float(rr[1]); }
  l_reg = l_reg * alpha + ps;
#define PK4(P, BASE, OUT) do { unsigned a0 = cvt_pk_bf16(P[BASE + 0], P[BASE + 1]), a1 = cvt_pk_bf16(P[BASE + 2], P[BASE + 3]);   \
    unsigned b0 = cvt_pk_bf16(P[BASE + 4], P[BASE + 5]), b1 = cvt_pk_bf16(P[BASE + 6], P[BASE + 7]);                              \
    auto r0 = __builtin_amdgcn_permlane32_swap(a0, b0, false, false); auto r1 = __builtin_amdgcn_permlane32_swap(a1, b1, false, false); \
    u32x4 w = {r0[0], r1[0], r0[1], r1[1]}; OUT = __builtin_bit_cast(bf16x8, w); } while (0)
  PK4(p0, 0, pa0); PK4(p0, 8, pa1); PK4(p1, 0, pa2); PK4(p1, 8, pa3);
}
__device__ __forceinline__ void qkt(f32x16& p0, f32x16& p1, const char* Ks, const char* Krs, const bf16x8* qr, const char* qrl, int r32, int hi) {
  p0 = f32x16{}; p1 = f32x16{};
#pragma unroll
  for (int d0 = 0; d0 < 8; ++d0) { const int cb = (d0 * 16 + hi * 8) * 2;
    bf16x8 b0 = *reinterpret_cast<const bf16x8*>(Ks + KSWZ(r32, cb));
    bf16x8 b1 = *reinterpret_cast<const bf16x8*>(Ks + KSWZ(32 + r32, cb));
    p0 = __builtin_amdgcn_mfma_f32_32x32x16_bf16(b0, qr[d0], p0, 0, 0, 0);
    p1 = __builtin_amdgcn_mfma_f32_32x32x16_bf16(b1, qr[d0], p1, 0, 0, 0); }
#pragma unroll
  for (int d0 = 0; d0 < 4; ++d0) { const int cb = (d0 * 16 + hi * 8) * 2;
    bf16x8 b0 = *reinterpret_cast<const bf16x8*>(Krs + KRSWZ(r32, cb));
    bf16x8 b1 = *reinterpret_cast<const bf16x8*>(Krs + KRSWZ(32 + r32, cb));
    const bf16x8 qq = *reinterpret_cast<const bf16x8*>(qrl + d0 * 1024);
    p0 = __builtin_amdgcn_mfma_f32_32x32x16_bf16(b0, qq, p0, 0, 0, 0);
    p1 = __builtin_amdgcn_mfma_f32_32x32x16_bf16(b1, qq, p1, 0, 0, 0); }
}
__device__ __forceinline__ int v_st(int k, int c) { const int kk = (k & ~0xC) | ((k & 4) << 1) | ((k & 8) >> 1); return ((kk >> 3) * 4 + (c >> 5)) * 512 + ((kk & 7) * 32 + (c & 31)) * 2; }
__device__ __forceinline__ int v_rd_base(int lane) { return ((lane & 3) << 3) | (((lane >> 2) & 3) << 6) | (((lane >> 4) & 1) << 5) | (((lane >> 5) & 1) << 8); }
constexpr int v_rd_off(int d0, int ks, int half) { return d0 * 512 + ks * 4096 + half * 2048; }
template <int OFF> __device__ __forceinline__ s16x4 tr_read(int vb) {
  s16x4 r; asm volatile("ds_read_b64_tr_b16 %0, %1 offset:%2" : "=&v"(r) : "v"(vb), "i"(OFF) : "memory"); return r;
}
#define PKV(L, H) (bf16x8){L[0], L[1], L[2], L[3], H[0], H[1], H[2], H[3]}
template <int D0> __device__ __forceinline__ void pv_one(f32x16& od, int vb, bf16x8 pa0, bf16x8 pa1, bf16x8 pa2, bf16x8 pa3) {
  const s16x4 l0 = tr_read<v_rd_off(D0, 0, 0)>(vb), h0 = tr_read<v_rd_off(D0, 0, 1)>(vb), l1 = tr_read<v_rd_off(D0, 1, 0)>(vb), h1 = tr_read<v_rd_off(D0, 1, 1)>(vb);
  const s16x4 l2 = tr_read<v_rd_off(D0, 2, 0)>(vb), h2 = tr_read<v_rd_off(D0, 2, 1)>(vb), l3 = tr_read<v_rd_off(D0, 3, 0)>(vb), h3 = tr_read<v_rd_off(D0, 3, 1)>(vb);
  asm volatile("s_waitcnt lgkmcnt(0)" ::: "memory"); SBAR();
  od = __builtin_amdgcn_mfma_f32_32x32x16_bf16(pa0, PKV(l0, h0), od, 0, 0, 0);
  od = __builtin_amdgcn_mfma_f32_32x32x16_bf16(pa1, PKV(l1, h1), od, 0, 0, 0);
  od = __builtin_amdgcn_mfma_f32_32x32x16_bf16(pa2, PKV(l2, h2), od, 0, 0, 0);
  od = __builtin_amdgcn_mfma_f32_32x32x16_bf16(pa3, PKV(l3, h3), od, 0, 0, 0);
}
__device__ __forceinline__ void pv_d0(f32x16* o, int vb, bf16x8 pa0, bf16x8 pa1, bf16x8 pa2, bf16x8 pa3) {
  pv_one<0>(o[0], vb, pa0, pa1, pa2, pa3); pv_one<1>(o[1], vb, pa0, pa1, pa2, pa3); pv_one<2>(o[2], vb, pa0, pa1, pa2, pa3); pv_one<3>(o[3], vb, pa0, pa1, pa2, pa3);
}

__device__ __forceinline__ void attn_body(const bf16_t* __restrict__ Qb, const float* __restrict__ cs, const bf16_t* __restrict__ Kn, const bf16_t* __restrict__ Vh,
                                          const bf16_t* __restrict__ Kr, bf16_t* __restrict__ Ob, int seq, char* lds) {
  int tid = threadIdx.x; asm volatile("" : "+v"(tid));
  const int wid = tid >> 6, lane = tid & 63, r32 = lane & 31, hi = lane >> 5;
  char* V_lds = lds + OFF_V; char* K_lds = lds + OFF_K; char* KR_lds = lds + OFF_KR;
  float* ws = (float*)(lds + OFF_WS) + wid * 64; float* li_l = ws; float* al_l = ws + 32;
  float m_reg = -1e30f, l_reg = 0; f32x16 o[4] = {}; bf16x8 qr[8];
  char* qrl = lds + OFF_QR + wid * 4096 + lane * 16;
  { const int qrow = wid * QBLK + r32;
    const unsigned qoff = (unsigned)(qrow * LDQ + hi * 8) * 2u;
    const char* Qc = (const char*)Qb;
    bf16x8 qro[4];
#pragma unroll
    for (int d0 = 0; d0 < 8; ++d0) qr[d0] = *reinterpret_cast<const bf16x8*>(Qc + qoff + d0 * 32);
#pragma unroll
    for (int d0 = 0; d0 < 4; ++d0) qro[d0] = *reinterpret_cast<const bf16x8*>(Qc + qoff + 256 + d0 * 32);
    const char* csc = (const char*)cs; const unsigned csoff = (unsigned)qrow * 256u;
#pragma unroll
    for (int a = 0; a < 2; ++a) {
      const int i0 = a * 16 + hi * 8;
      bf16x8 x1 = qro[a], x2 = qro[2 + a], y1, y2;
#pragma unroll
      for (int j = 0; j < 8; ++j) {
        const f32x2 c_s = *reinterpret_cast<const f32x2*>(csc + csoff + 8 * (i0 + j));
        const float f1 = bf2f((unsigned short)x1[j]), f2 = bf2f((unsigned short)x2[j]);
        const float g1 = f1 * c_s.x - f2 * c_s.y, g2 = f2 * c_s.x + f1 * c_s.y;
        const unsigned pk = cvt_pk_bf16(g1, g2);
        y1[j] = (short)(pk & 0xffffu); y2[j] = (short)(pk >> 16);
      }
      *reinterpret_cast<bf16x8*>(qrl + a * 1024) = y1; *reinterpret_cast<bf16x8*>(qrl + (2 + a) * 1024) = y2;
    }
  }
  const int sr = tid >> 4, sc = (tid & 15) * 8, vst0 = v_st(sr, sc), vst1 = v_st(32 + sr, sc);
  const int krr = tid >> 3, krc = (tid & 7) * 8;
  const int vb0 = (int)(uintptr_t)V_lds + v_rd_base(lane);
  constexpr int SDEPTH = ATT_SDEPTH;
  struct { bf16x8 vs0, vs1, ks0, ks1, kr0; } sr_[SDEPTH];
  const unsigned vo0 = (unsigned)(sr * LDK + sc) * 2u, vo1 = (unsigned)((32 + sr) * LDK + sc) * 2u, kro = (unsigned)(krr * LDKR + krc) * 2u;
#define SLOAD(i, k0) do { const char* vt_ = (const char*)Vh + (size_t)(k0) * (LDK * 2); const char* kt_ = (const char*)Kn + (size_t)(k0) * (LDK * 2); const char* krt_ = (const char*)Kr + (size_t)(k0) * (LDKR * 2); \
    sr_[i].vs0 = *reinterpret_cast<const bf16x8*>(vt_ + vo0); sr_[i].vs1 = *reinterpret_cast<const bf16x8*>(vt_ + vo1); \
    sr_[i].ks0 = *reinterpret_cast<const bf16x8*>(kt_ + vo0); sr_[i].ks1 = *reinterpret_cast<const bf16x8*>(kt_ + vo1); \
    sr_[i].kr0 = *reinterpret_cast<const bf16x8*>(krt_ + kro); } while (0)
#define SWRITE(b, i) do { *(bf16x8*)(V_lds + (b) * SHM_V + vst0) = sr_[i].vs0;          \
    *(bf16x8*)(V_lds + (b) * SHM_V + vst1) = sr_[i].vs1; const int kc = sc * 2;               \
    *(bf16x8*)(K_lds + (b) * SHM_K + KSWZ(sr, kc)) = sr_[i].ks0;                       \
    *(bf16x8*)(K_lds + (b) * SHM_K + KSWZ(32 + sr, kc)) = sr_[i].ks1;                  \
    *(bf16x8*)(KR_lds + (b) * SHM_KR + KRSWZ(krr, krc * 2)) = sr_[i].kr0; } while (0)
#define SWAIT() do { if constexpr (SDEPTH == 2) asm volatile("s_waitcnt vmcnt(5)" ::: "memory"); else asm volatile("s_waitcnt vmcnt(0)" ::: "memory"); } while (0)
#define RESC(a) do { if (__any((a) < 1.f)) { if (hi == 0) al_l[r32] = (a); asm volatile("s_waitcnt lgkmcnt(0)" ::: "memory"); \
    _Pragma("unroll") for (int d = 0; d < 4; ++d) _Pragma("unroll") for (int r = 0; r < 16; ++r) o[d][r] *= al_l[crow(r, hi)]; } } while (0)
  f32x16 pA0, pA1, pB0, pB1; float mnA, mnB, alA, alB; bf16x8 pa0, pa1, pa2, pa3; const int NT = seq / KVBLK;
  constexpr int SE = 0, SO = SDEPTH - 1;
  SLOAD(SE, 0); asm volatile("s_waitcnt vmcnt(0)" ::: "memory"); SWRITE(0, SE); __syncthreads();
  qkt(pA0, pA1, K_lds, KR_lds, qr, qrl, r32, hi); partialSM(pA0, pA1, m_reg, mnA, alA);
  SLOAD(SO, KVBLK); if constexpr (SDEPTH == 2) { if (2 < NT) SLOAD(SE, 2 * KVBLK); }
  SWAIT(); SWRITE(1, SO); __syncthreads();
  for (int j = 1; j + 1 < NT; j += 2) {
    SBAR(); qkt(pB0, pB1, K_lds + SHM_K, KR_lds + SHM_KR, qr, qrl, r32, hi);
    finishSM(pA0, pA1, alA, l_reg, pa0, pa1, pa2, pa3); SBAR();
    SLOAD(SO, (j + SDEPTH) * KVBLK); SBAR();
    pv_d0(o, vb0, pa0, pa1, pa2, pa3); partialSM(pB0, pB1, m_reg, mnB, alB);
    __syncthreads(); SWAIT(); SWRITE(0, SE);
    RESC(alB); __syncthreads();
    SBAR(); qkt(pA0, pA1, K_lds, KR_lds, qr, qrl, r32, hi);
    finishSM(pB0, pB1, alB, l_reg, pa0, pa1, pa2, pa3); SBAR();
    if (SDEPTH == 1 || j + 3 < NT) SLOAD(SE, (j + 1 + SDEPTH) * KVBLK); SBAR();
    pv_d0(o, vb0 + SHM_V, pa0, pa1, pa2, pa3); partialSM(pA0, pA1, m_reg, mnA, alA);
    __syncthreads(); SWAIT(); SWRITE(1, SO);
    RESC(alA); __syncthreads();
  }
  SBAR(); qkt(pB0, pB1, K_lds + SHM_K, KR_lds + SHM_KR, qr, qrl, r32, hi);
  finishSM(pA0, pA1, alA, l_reg, pa0, pa1, pa2, pa3); SBAR();
  pv_d0(o, vb0, pa0, pa1, pa2, pa3); partialSM(pB0, pB1, m_reg, mnB, alB);
  __syncthreads(); RESC(alB);
  finishSM(pB0, pB1, alB, l_reg, pa0, pa1, pa2, pa3); SBAR();
  pv_d0(o, vb0 + SHM_V, pa0, pa1, pa2, pa3);
  if (hi == 0) li_l[r32] = l_reg; asm volatile("s_waitcnt lgkmcnt(0)" ::: "memory");
  float rli[16];
#pragma unroll
  for (int r = 0; r < 16; ++r) rli[r] = __builtin_amdgcn_rcpf(li_l[crow(r, hi)]);
  __syncthreads();
  int tid2 = threadIdx.x; asm volatile("" : "+v"(tid2));
  const int wid2 = tid2 >> 6, lane2 = tid2 & 63;
  char* ot = lds + wid2 * (32 * 272);
#pragma unroll
  for (int r = 0; r < 16; ++r) { const int orow = crow(r, lane2 >> 5);
#pragma unroll
    for (int d0 = 0; d0 < 4; ++d0) *(bf16_t*)(ot + orow * 272 + (d0 * 32 + (lane2 & 31)) * 2) = (bf16_t)(cvt_pk_bf16(o[d0][r] * rli[r], 0.f) & 0xffffu); }
  asm volatile("s_waitcnt lgkmcnt(0)" ::: "memory");
  char* Oc = (char*)Ob;
#pragma unroll
  for (int i = 0; i < 8; ++i) { const int id = lane2 + 64 * i, row = id >> 4, ch = id & 15;
    const u32x4 v = *(const u32x4*)(ot + row * 272 + ch * 16);
    *(u32x4*)(Oc + (unsigned)((wid2 * QBLK + row) * LDO + ch * 8) * 2u) = v; }
  __syncthreads();
#undef SLOAD
#undef SWRITE
#undef SWAIT
#undef RESC
}
}

namespace mls {
constexpr int OFF_Q = 0, OFF_K = 16384, OFF_VA = 32768, OFF_VB = 49152, OFF_C = 57344, OFF_N = 65536, OFF_VEC = 73728, LDS_NEED = 73728 + 1024;
__device__ __forceinline__ unsigned off_b(unsigned row, unsigned ch) { return 256u * row + 16u * (ch ^ (((row & 3) << 2) | ((row >> 2) & 3))); }
__device__ __forceinline__ unsigned off_vb(unsigned row, unsigned ch) { return 1024u * (row >> 3) + 512u * (ch >> 2) + 64u * (row & 7) + 16u * ((ch & 3) ^ ((row >> 2) & 3)); }
__device__ __forceinline__ s16x4 trr(unsigned addr) { s16x4 r; asm volatile("ds_read_b64_tr_b16 %0, %1" : "=&v"(r) : "v"(addr) : "memory"); return r; }

struct Tensors { const bf16_t* qkc; const bf16_t* proj; const float* gvec; float* hs; };

__device__ __forceinline__ void scan_unit(const Tensors& Tn, int unit, char* lds) {
  int tid = threadIdx.x; asm volatile("" : "+v"(tid));
  const int wid = __builtin_amdgcn_readfirstlane(tid >> 6), lane = tid & 63, r32 = lane & 31, hi = lane >> 5;
  const int chain = unit >> 3, vs = unit & 7, dir = chain >> 4, bb = (chain >> 2) & 3, hd = chain & 3;
  const unsigned lbase = (unsigned)(uintptr_t)lds;
  float* vec = (float*)(lds + OFF_VEC);
  unsigned qko[2];
#pragma unroll
  for (int i = 0; i < 2; ++i) { const int idx = tid + 512 * i, row = idx >> 4, ch = idx & 15; qko[i] = (unsigned)(((dir ? 63 - row : row) * 1024 + ch * 8) * 2); }
  const int vrow = (tid & 255) >> 2, vch = tid & 3;
  const unsigned vo = (unsigned)(((dir ? 63 - vrow : vrow) * ML_INP + vch * 8) * 2), awo = (unsigned)vrow * 4u;
  const char* gvb = (const char*)Tn.gvec + (size_t)chain * SEQ * 4;
  const unsigned veo = (unsigned)((tid >> 6) * 32 * SEQ + (tid & 63)) * 4u;
  const char* awsrc = gvb + (size_t)3 * 32 * SEQ * 4;
  bf16x8 sq[2], sk[2], sv; float sawl = 0.f, svec = 0.f;
#define TB(c) ((size_t)bb * SEQ + (dir ? (SEQ - 64 * ((c) + 1)) : 64 * (c)))
#define MLOAD(c) do { const size_t tb_ = TB(c); \
    const char* qb_ = (const char*)Tn.qkc + (tb_ * 1024 + hd * 128) * 2; const char* kb_ = qb_ + 1024; \
    const char* vb_ = (const char*)Tn.proj + (tb_ * ML_INP + 1024 + hd * 256 + vs * 32) * 2; \
    _Pragma("unroll") for (int i = 0; i < 2; ++i) { sq[i] = *reinterpret_cast<const bf16x8*>(qb_ + qko[i]); sk[i] = *reinterpret_cast<const bf16x8*>(kb_ + qko[i]); } \
    sv = *reinterpret_cast<const bf16x8*>(vb_ + vo); sawl = *reinterpret_cast<const float*>(awsrc + (size_t)(c) * 256 + awo); \
    if (tid < 192) svec = *reinterpret_cast<const float*>(gvb + (size_t)(c) * 256 + veo); } while (0)
#define MWRITE() do { \
    _Pragma("unroll") for (int i = 0; i < 2; ++i) { const int idx = tid + 512 * i, row = idx >> 4, ch = idx & 15; \
      *(bf16x8*)(lds + OFF_Q + off_b(row, ch)) = sq[i]; *(bf16x8*)(lds + OFF_K + off_b(row, ch)) = sk[i]; } \
    if (tid < 256) { *(bf16x8*)(lds + OFF_VA + att::v_st(vrow, vch * 8)) = sv; \
      float f[8]; _Pragma("unroll") for (int j = 0; j < 8; ++j) f[j] = bf2f((unsigned short)sv[j]) * sawl; \
      u32x4 w; w.x = cvt_pk_bf16(f[0], f[1]); w.y = cvt_pk_bf16(f[2], f[3]); w.z = cvt_pk_bf16(f[4], f[5]); w.w = cvt_pk_bf16(f[6], f[7]); \
      *(u32x4*)(lds + OFF_VB + off_vb(vrow, vch)) = w; } \
    else { const unsigned a = cvt_pk_bf16(sawl, sawl); u32x4 w = {a, a, a, a}; *(u32x4*)(lds + OFF_VB + off_vb(vrow, 4 + vch)) = w; } \
    if (tid < 192) vec[tid] = svec; } while (0)

  f32x16 Cst = {}, Nst = {};
  float m = 0.f;
  const int blk = wid - 2;
  MLOAD(0);
  asm volatile("s_waitcnt vmcnt(0)" ::: "memory");
  MWRITE();
  if (wid >= 2 && wid < 6) {
#pragma unroll
    for (int g = 0; g < 4; ++g) { const unsigned a = off_b(r32, 4 * blk + g) + 8 * hi; *(u32x2*)(lds + OFF_C + a) = (u32x2){0u, 0u}; *(u32x2*)(lds + OFF_N + a) = (u32x2){0u, 0u}; }
  }
  __syncthreads();
  const bf16x8 ones = {(short)0x3F80, (short)0x3F80, (short)0x3F80, (short)0x3F80, (short)0x3F80, (short)0x3F80, (short)0x3F80, (short)0x3F80};
  const int th = wid & 1;
  const unsigned hso = (unsigned)(((dir ? 63 - 32 * th - 4 * hi : 32 * th + 4 * hi) * D + hd * 256 + vs * 32 + r32) * 4);
  const int hstep = dir ? -(D * 4) : (D * 4);
  for (int c = 0; c < 64; ++c) {
    if (c + 1 < 64) MLOAD(c + 1);
    const float pm63 = vec[128 + 63], bL = vec[63];
    const float Mx = fmaxf(m, pm63);
    if (wid < 2) {
      int ln_ = lane; asm volatile("" : "+v"(ln_));
      const int r32 = ln_ & 31, hi = ln_ >> 5;
      f32x16 qc = {}, qn = {}, p0 = {}, p1 = {};
      {
        bf16x8 qf[8];
#pragma unroll
        for (int ks = 0; ks < 8; ++ks) qf[ks] = *(const bf16x8*)(lds + OFF_Q + off_b(32 * th + r32, 2 * ks + hi));
#pragma unroll
        for (int ks = 0; ks < 8; ++ks) {
          const bf16x8 cf = *(const bf16x8*)(lds + OFF_C + off_b(r32, 2 * ks + hi));
          const bf16x8 nf = *(const bf16x8*)(lds + OFF_N + off_b(r32, 2 * ks + hi));
          qc = __builtin_amdgcn_mfma_f32_32x32x16_bf16(qf[ks], cf, qc, 0, 0, 0);
          qn = __builtin_amdgcn_mfma_f32_32x32x16_bf16(qf[ks], nf, qn, 0, 0, 0);
        }
#pragma unroll
        for (int ks = 0; ks < 8; ++ks) {
          const bf16x8 k0 = *(const bf16x8*)(lds + OFF_K + off_b(r32, 2 * ks + hi));
          const bf16x8 k1 = *(const bf16x8*)(lds + OFF_K + off_b(32 + r32, 2 * ks + hi));
          p0 = __builtin_amdgcn_mfma_f32_32x32x16_bf16(k0, qf[ks], p0, 0, 0, 0);
          p1 = __builtin_amdgcn_mfma_f32_32x32x16_bf16(k1, qf[ks], p1, 0, 0, 0);
        }
      }
      const int t = 32 * th + r32;
      const float Mt = fmaxf(m, vec[128 + t]);
#pragma unroll
      for (int r = 0; r < 16; ++r) { const int s0 = att::crow(r, hi), s1 = 32 + s0;
        const float w0 = (s0 <= t) ? fast_exp(vec[64 + s0] - Mt) : 0.f, w1 = (s1 <= t) ? fast_exp(vec[64 + s1] - Mt) : 0.f;
        p0[r] *= w0; p1[r] *= w1; }
      bf16x8 pa0, pa1, pa2, pa3;
      PK4(p0, 0, pa0); PK4(p0, 8, pa1); PK4(p1, 0, pa2); PK4(p1, 8, pa3);
      f32x16 pv = {}, pd = {};
      att::pv_one<0>(pv, (int)(lbase + OFF_VA) + att::v_rd_base(ln_), pa0, pa1, pa2, pa3);
      pd = __builtin_amdgcn_mfma_f32_32x32x16_bf16(pa0, ones, pd, 0, 0, 0);
      pd = __builtin_amdgcn_mfma_f32_32x32x16_bf16(pa1, ones, pd, 0, 0, 0);
      pd = __builtin_amdgcn_mfma_f32_32x32x16_bf16(pa2, ones, pd, 0, 0, 0);
      pd = __builtin_amdgcn_mfma_f32_32x32x16_bf16(pa3, ones, pd, 0, 0, 0);
      char* hsb = (char*)Tn.hs + ((size_t)dir * T + TB(c)) * (D * 4);
#pragma unroll
      for (int r = 0; r < 16; ++r) { const int rr = (r & 3) + 8 * (r >> 2), tr_ = 32 * th + 4 * hi + rr;
        const float Mr = fmaxf(m, vec[128 + tr_]), gw = fast_exp(m - Mr), en = fast_exp(-(vec[tr_] + Mr));
        const float num = gw * qc[r] + pv[r], den = gw * qn[r] + pd[r];
        const float h = num * fast_rcp(fmaxf(fabsf(den), en));
        *(float*)(hsb + (unsigned)((int)hso + rr * hstep)) = h; }
    } else if (wid < 6) {
      int ln_ = lane; asm volatile("" : "+v"(ln_));
      const int hi = ln_ >> 5;
      f32x16 kv = {}, kn = {};
#pragma unroll
      for (int ks = 0; ks < 4; ++ks) {
        const unsigned hb = (ln_ >> 4) & 1, q = (ln_ & 15) >> 2, p = ln_ & 3;
        const unsigned row0 = 16 * ks + 8 * hi + q;
        const s16x4 ka = trr(lbase + OFF_K + off_b(row0, 4 * blk + 2 * hb + (p >> 1)) + 8 * (p & 1));
        const s16x4 kb = trr(lbase + OFF_K + off_b(row0 + 4, 4 * blk + 2 * hb + (p >> 1)) + 8 * (p & 1));
        const s16x4 va = trr(lbase + OFF_VB + off_vb(row0, 2 * hb + (p >> 1)) + 8 * (p & 1));
        const s16x4 vb_ = trr(lbase + OFF_VB + off_vb(row0 + 4, 2 * hb + (p >> 1)) + 8 * (p & 1));
        const s16x4 aa = trr(lbase + OFF_VB + off_vb(row0, 4 + 2 * hb + (p >> 1)) + 8 * (p & 1));
        const s16x4 ab = trr(lbase + OFF_VB + off_vb(row0 + 4, 4 + 2 * hb + (p >> 1)) + 8 * (p & 1));
        asm volatile("s_waitcnt lgkmcnt(0)" ::: "memory"); __builtin_amdgcn_sched_barrier(0);
        const bf16x8 kf = PKV(ka, kb), vf = PKV(va, vb_), af = PKV(aa, ab);
        kv = __builtin_amdgcn_mfma_f32_32x32x16_bf16(kf, vf, kv, 0, 0, 0);
        kn = __builtin_amdgcn_mfma_f32_32x32x16_bf16(kf, af, kn, 0, 0, 0);
      }
      const float cw = fast_exp(m - Mx), sc = fast_exp(pm63 - Mx);
#pragma unroll
      for (int r = 0; r < 16; ++r) { Cst[r] = cw * Cst[r] + sc * kv[r]; Nst[r] = cw * Nst[r] + sc * kn[r]; }
    }
    m = bL + Mx;
    __syncthreads();
    if (c + 1 < 64) {
      asm volatile("s_waitcnt vmcnt(0)" ::: "memory");
      MWRITE();
      if (wid >= 2 && wid < 6) {
#pragma unroll
        for (int g = 0; g < 4; ++g) { const unsigned a = off_b(r32, 4 * blk + g) + 8 * hi;
          *(u32x2*)(lds + OFF_C + a) = (u32x2){cvt_pk_bf16(Cst[4 * g], Cst[4 * g + 1]), cvt_pk_bf16(Cst[4 * g + 2], Cst[4 * g + 3])};
          *(u32x2*)(lds + OFF_N + a) = (u32x2){cvt_pk_bf16(Nst[4 * g], Nst[4 * g + 1]), cvt_pk_bf16(Nst[4 * g + 2], Nst[4 * g + 3])}; }
      }
    }
    __syncthreads();
  }
#undef TB
#undef MLOAD
#undef MWRITE
}
}

#define XB_TMO      128
#define XB_XCNT(j)  (256  + 64 * (j))
#define XB_XSUB(j)  (1280 + 64 * (j))
#define XB_XGEN(j)  (2304 + 64 * (j))
#define XB_TOP      3328
#define XB_TOPGEN   3392
#define XCD_BAR_WORDS 3456
#define XB_SPIN_CAP (1u << 18)
__device__ __forceinline__ unsigned xb_ld(unsigned* p)              { return __hip_atomic_load(p, __ATOMIC_RELAXED, __HIP_MEMORY_SCOPE_AGENT); }
__device__ __forceinline__ unsigned xb_add(unsigned* p, unsigned v) { return __hip_atomic_fetch_add(p, v, __ATOMIC_RELAXED, __HIP_MEMORY_SCOPE_AGENT); }
__device__ __forceinline__ unsigned xb_xcc_id() { return (unsigned)__builtin_amdgcn_s_getreg((3 << 11) | 20) & 0xFu; }
#define XB_SPIN(cond, bar) do { unsigned _sp = 0; while (cond) { __builtin_amdgcn_s_sleep(1); \
    if ((++_sp & 255u) == 0u) { if (xb_ld(&(bar)[XB_TMO])) break; if (_sp > XB_SPIN_CAP) { atomicAdd(&(bar)[XB_TMO], 1u); break; } } } } while (0)
struct XcdBarrier { unsigned* bar; unsigned x; volatile LAS unsigned* st; };
__device__ __forceinline__ XcdBarrier xcd_barrier_post(unsigned* bar, volatile LAS unsigned* st) {
    XcdBarrier b; b.bar = bar; b.x = xb_xcc_id(); b.st = st;
    if (threadIdx.x == 0) (void)xb_add(&bar[XB_XCNT(b.x)], 1u);
    return b;
}
__device__ __forceinline__ void xcd_barrier_complete(unsigned* bar, unsigned x, unsigned& nloc, unsigned& nx) {
    const unsigned G = gridDim.x * gridDim.y * gridDim.z;
    unsigned sum, cnt, mine, sp = 0u;
    for (;;) {
        sum = 0u; cnt = 0u; mine = 0u;
#pragma unroll
        for (unsigned j = 0; j < 16; ++j) { const unsigned c = xb_ld(&bar[XB_XCNT(j)]); sum += c; cnt += (c > 0u) ? 1u : 0u; mine = (j == x) ? c : mine; }
        if (sum == G) break;
        __builtin_amdgcn_s_sleep(1);
        if ((++sp & 255u) == 0u) { if (xb_ld(&bar[XB_TMO])) break; if (sp > XB_SPIN_CAP) { atomicAdd(&bar[XB_TMO], 1u); break; } }
    }
    nloc = mine > 0u ? mine : 1u; nx = cnt > 0u ? cnt : 1u;
}
__device__ __forceinline__ void xcd_barrier(const XcdBarrier& b) {
    asm volatile("s_waitcnt vmcnt(0)" ::: "memory");
    __syncthreads();
    if (threadIdx.x == 0) {
        unsigned* bar = b.bar;
        __builtin_amdgcn_s_waitcnt(0);
        unsigned nloc = b.st[0], nx = b.st[1];
        if (nloc == 0u) { xcd_barrier_complete(bar, b.x, nloc, nx); b.st[0] = nloc; b.st[1] = nx; }
        const unsigned old = xb_add(&bar[XB_XSUB(b.x)], 1u);
        const unsigned gen = old / nloc;
        if (old + 1u == (gen + 1u) * nloc) {
            __builtin_amdgcn_fence(__ATOMIC_RELEASE, "agent");
            asm volatile("s_waitcnt vmcnt(0)" ::: "memory");
            const unsigned og = xb_add(&bar[XB_TOP], 1u);
            const unsigned tg = og / nx;
            if (og + 1u == (tg + 1u) * nx) xb_add(&bar[XB_TOPGEN], 1u);
            else XB_SPIN(xb_ld(&bar[XB_TOPGEN]) == tg, bar);
            __builtin_amdgcn_fence(__ATOMIC_ACQUIRE, "agent");
            xb_add(&bar[XB_XGEN(b.x)], 1u);
            asm volatile("s_waitcnt vmcnt(0)" ::: "memory");
        } else {
            XB_SPIN(xb_ld(&bar[XB_XGEN(b.x)]) == gen, bar);
            __builtin_amdgcn_fence(__ATOMIC_ACQUIRE, "agent");
            asm volatile("s_waitcnt vmcnt(0)" ::: "memory");
        }
    }
    __syncthreads();
}

struct Args { const float* in[24]; float* out; unsigned char* ws; int ph_lo, ph_hi; };
constexpr int NPH = 38;
struct Frame {
    char* lds; int tid, lane, wave, G, bid;
    unsigned char* ws;
};

struct CvtJob { const float* src; bf16_t* dst; int K, N, sld; int grp, gstride, goff; const float* sk; const float* sn; };
__device__ __forceinline__ void cvt_tiles(const Frame& F, const CvtJob& j, int& rot) {
    float* tile = (float*)F.lds;
    const int tk = j.K / 64, tn = j.N / 64, nt = tk * tn;
    int start = F.bid - (rot % F.G); if (start < 0) start += F.G;
    for (int it = start; it < nt; it += F.G) {
        const int k0 = (it / tn) * 64, n0 = (it % tn) * 64;
        __syncthreads();
#pragma unroll
        for (int i = 0; i < 8; ++i) { const int k = i * 8 + (F.tid >> 6), n = F.tid & 63;
            float v = j.src[(size_t)(k0 + k) * j.sld + n0 + n];
            if (j.sk) v *= j.sk[k0 + k];
            if (j.sn) v *= j.sn[n0 + n];
            tile[k * 65 + n] = v; }
        __syncthreads();
        { const int n = F.tid >> 3, kc = F.tid & 7; float f[8];
#pragma unroll
          for (int q = 0; q < 8; ++q) f[q] = tile[(kc * 8 + q) * 65 + n];
          u32x4 w; w.x = cvt_pk_bf16(f[0], f[1]); w.y = cvt_pk_bf16(f[2], f[3]); w.z = cvt_pk_bf16(f[4], f[5]); w.w = cvt_pk_bf16(f[6], f[7]);
          const int nn = n0 + n, drow = (nn / j.grp) * j.gstride + j.goff + (nn % j.grp);
          *(u32x4*)(j.dst + (size_t)drow * j.K + k0 + kc * 8) = w; }
    }
    rot += nt;
}
__device__ __forceinline__ CvtJob mkjob(const float* src, bf16_t* dst, int K, int N, int sld) { CvtJob j; j.src = src; j.dst = dst; j.K = K; j.N = N; j.sld = sld; j.grp = N; j.gstride = 0; j.goff = 0; j.sk = nullptr; j.sn = nullptr; return j; }

__device__ __forceinline__ void phase_convert_small(const Frame& F, const Args& a) {
    bf16_t* W = (bf16_t*)(F.ws + WS_W); int rot = 0;
    for (int j = 0; j < 2; ++j) {
        { CvtJob c = mkjob(a.in[2] + (size_t)j * D * MLA_IN, (bf16_t*)((char*)W + W_DQKV) + (size_t)j * MLA_INP * D, D, MLA_IN, MLA_IN); cvt_tiles(F, c, rot); }
        { CvtJob c = mkjob(a.in[4] + (size_t)j * MLA_QR * MLA_QW, (bf16_t*)((char*)W + W_UQ) + (size_t)j * MLA_QW * MLA_QR, MLA_QR, MLA_QW, MLA_QW); c.sk = a.in[3] + j * MLA_QR; cvt_tiles(F, c, rot); }
        { CvtJob c = mkjob(a.in[6] + (size_t)j * MLA_KVR * MLA_KVW, (bf16_t*)((char*)W + W_UKV) + (size_t)j * MLA_KVW * MLA_KVR, MLA_KVR, MLA_KVW, MLA_KVW); c.sk = a.in[5] + j * MLA_KVR; cvt_tiles(F, c, rot); }
        { CvtJob c = mkjob(a.in[7] + (size_t)j * D * D, (bf16_t*)((char*)W + W_O) + (size_t)j * D * D, D, D, D); cvt_tiles(F, c, rot); }
        { bf16_t* z = (bf16_t*)((char*)W + W_DQKV) + (size_t)j * MLA_INP * D + (size_t)MLA_IN * D;
          for (int i = F.bid * NTHR + F.tid; i < (MLA_INP - MLA_IN) * D / 8; i += F.G * NTHR) *(u32x4*)(z + (size_t)i * 8) = (u32x4){0u, 0u, 0u, 0u}; }
    }
    for (int g = 0; g < 4; ++g) { CvtJob c = mkjob(a.in[8] + (size_t)g * 256 * 256, (bf16_t*)((char*)W + W_POOL) + (size_t)g * 256 * 256, 256, 256, 256); c.sn = a.in[9] + g * 256; cvt_tiles(F, c, rot); }
    { CvtJob c = mkjob(a.in[10], (bf16_t*)((char*)W + W_IN), D, ML_INP, ML_IN); cvt_tiles(F, c, rot); }
    { CvtJob c = mkjob(a.in[14], (bf16_t*)((char*)W + W_OUT), D, D, D); cvt_tiles(F, c, rot); }
    for (int j = 0; j < 2; ++j) {
        { CvtJob c = mkjob(a.in[15] + (size_t)j * D * DFF, (bf16_t*)((char*)W + W_GU) + (size_t)j * 2 * DFF * D, D, DFF, DFF); c.grp = 128; c.gstride = 256; c.goff = 0; cvt_tiles(F, c, rot); }
        { CvtJob c = mkjob(a.in[16] + (size_t)j * D * DFF, (bf16_t*)((char*)W + W_GU) + (size_t)j * 2 * DFF * D, D, DFF, DFF); c.grp = 128; c.gstride = 256; c.goff = 128; cvt_tiles(F, c, rot); }
        { CvtJob c = mkjob(a.in[17] + (size_t)j * DFF * D, (bf16_t*)((char*)W + W_DN) + (size_t)j * D * DFF, DFF, D, D); cvt_tiles(F, c, rot); }
    }
    { const float* x = a.in[0]; bf16_t* xb = (bf16_t*)(F.ws + WS_XB);
      for (size_t i = (size_t)F.bid * NTHR + F.tid; i < (size_t)T * D / 8; i += (size_t)F.G * NTHR) {
          const f32x4 v0 = *(const f32x4*)(x + i * 8), v1 = *(const f32x4*)(x + i * 8 + 4);
          u32x4 w; w.x = cvt_pk_bf16(v0[0], v0[1]); w.y = cvt_pk_bf16(v0[2], v0[3]); w.z = cvt_pk_bf16(v1[0], v1[1]); w.w = cvt_pk_bf16(v1[2], v1[3]);
          *(u32x4*)(xb + i * 8) = w; } }
}
__device__ __forceinline__ void phase_convert_moe(const Frame& F, const Args& a, int c) {
    bf16_t* GU = (bf16_t*)(F.ws + WS_WMOE + WM_GU); bf16_t* DN = (bf16_t*)(F.ws + WS_WMOE + WM_DN); int rot = 0;
    for (int e = 0; e < NEXP; ++e) {
        const size_t eo = ((size_t)c * NEXP + e) * (size_t)D * DFFE;
        { CvtJob j = mkjob(a.in[19] + eo, GU + (size_t)e * 2 * DFFE * D, D, DFFE, DFFE); j.grp = 128; j.gstride = 256; j.goff = 0; cvt_tiles(F, j, rot); }
        { CvtJob j = mkjob(a.in[20] + eo, GU + (size_t)e * 2 * DFFE * D, D, DFFE, DFFE); j.grp = 128; j.gstride = 256; j.goff = 128; cvt_tiles(F, j, rot); }
        { CvtJob j = mkjob(a.in[21] + eo, DN + (size_t)e * D * DFFE, DFFE, D, D); cvt_tiles(F, j, rot); }
    }
}

template <int MODE>
__device__ __forceinline__ void phase_ln(const Frame& F, const float* xin, const float* y, float* xout, bf16_t* xb, const float* g, const float* b,
                                         const float* wproj  , const float* bgate) {
    constexpr bool MOE_IN = MODE & 1, ROUTER = (MODE & 2) != 0, GATES = (MODE & 4) != 0, FINAL = (MODE & 8) != 0;
    constexpr int NP = ROUTER ? 8 : (GATES ? 16 : 0); constexpr int NPA = NP ? NP : 4;
    float* wl = (float*)F.lds;
    int* sel = (int*)(F.lds + 65536);
    const int* toke = (const int*)(F.ws + WS_META + MT_TOKE); const float* tokw = (const float*)(F.ws + WS_META + MT_TOKW);
    if constexpr (NP != 0) {
        for (int i = F.tid; i < 1024 * NPA; i += NTHR) { const int c = i / NPA, p = i % NPA; wl[i] = ROUTER ? wproj[c * 8 + p] : wproj[(size_t)c * ML_IN + ML_INP + p]; }
        __syncthreads();
    }
    f32x4 gg[4], bb[4];
#pragma unroll
    for (int j = 0; j < 4; ++j) { gg[j] = *(const f32x4*)(g + F.lane * 4 + 256 * j); bb[j] = *(const f32x4*)(b + F.lane * 4 + 256 * j); }
    for (int blk = F.bid; blk < T / 64; blk += F.G) {
        for (int rr = 0; rr < 8; ++rr) {
            const int row = blk * 64 + F.wave * 8 + rr;
            f32x4 v[4]; float w1 = 0.f, w2 = 0.f;
            if (MOE_IN) { w1 = tokw[row * 2]; w2 = tokw[row * 2 + 1]; }
#pragma unroll
            for (int j = 0; j < 4; ++j) { const int c = F.lane * 4 + 256 * j;
                const f32x4 xv = *(const f32x4*)(xin + (size_t)row * D + c);
                f32x4 yv;
                if (MOE_IN) { const f32x4 ya = *(const f32x4*)(y + (size_t)(2 * row) * D + c), yb = *(const f32x4*)(y + (size_t)(2 * row + 1) * D + c); yv = ya * w1 + yb * w2; }
                else yv = *(const f32x4*)(y + (size_t)row * D + c);
                v[j] = xv * DN_ALPHA + yv; }
            float s = 0.f;
#pragma unroll
            for (int j = 0; j < 4; ++j) s += (v[j][0] + v[j][1]) + (v[j][2] + v[j][3]);
            const float mu = wave_sum(s) * (1.0f / 1024.0f);
            float q = 0.f;
#pragma unroll
            for (int j = 0; j < 4; ++j) { const f32x4 d = v[j] - mu; q += (d[0] * d[0] + d[1] * d[1]) + (d[2] * d[2] + d[3] * d[3]); }
            const float rstd = 1.0f / sqrtf(wave_sum(q) * (1.0f / 1024.0f) + LN_EPS);
#pragma unroll
            for (int j = 0; j < 4; ++j) { const int c = F.lane * 4 + 256 * j;
                v[j] = (v[j] - mu) * rstd * gg[j] + bb[j];
                *(f32x4*)(xout + (size_t)row * D + c) = v[j];
                if (!FINAL) { u32x2 w; w.x = cvt_pk_bf16(v[j][0], v[j][1]); w.y = cvt_pk_bf16(v[j][2], v[j][3]); *(u32x2*)(xb + (size_t)row * D + c) = w; } }
            if constexpr (NP != 0) {
                float pr[NPA];
#pragma unroll
                for (int p = 0; p < NP; ++p) pr[p] = 0.f;
#pragma unroll
                for (int j = 0; j < 4; ++j)
#pragma unroll
                    for (int i = 0; i < 4; ++i) { const int c = F.lane * 4 + 256 * j + i;
#pragma unroll
                        for (int p4 = 0; p4 < NPA / 4; ++p4) { const f32x4 wv = *(const f32x4*)(wl + c * NPA + p4 * 4);
                            pr[p4 * 4 + 0] += v[j][i] * wv[0]; pr[p4 * 4 + 1] += v[j][i] * wv[1]; pr[p4 * 4 + 2] += v[j][i] * wv[2]; pr[p4 * 4 + 3] += v[j][i] * wv[3]; } }
#pragma unroll
                for (int p = 0; p < NP; ++p) pr[p] = wave_sum(pr[p]);
                if constexpr (ROUTER) {
                    int e1 = 0; float v1 = pr[0];
#pragma unroll
                    for (int p = 1; p < 8; ++p) if (pr[p] > v1) { v1 = pr[p]; e1 = p; }
                    int e2 = -1; float v2 = -3.0e38f;
#pragma unroll
                    for (int p = 0; p < 8; ++p) if (p != e1 && pr[p] > v2) { v2 = pr[p]; e2 = p; }
                    const float ww2 = 1.0f / (1.0f + expf(v1 - v2)), ww1 = 1.0f - ww2;
                    if (F.lane == 0) { int* te = (int*)(F.ws + WS_META + MT_TOKE); float* tw = (float*)(F.ws + WS_META + MT_TOKW);
                        te[row * 2] = e1; te[row * 2 + 1] = e2; tw[row * 2] = ww1; tw[row * 2 + 1] = ww2;
                        sel[F.wave * 16 + rr * 2] = e1; sel[F.wave * 16 + rr * 2 + 1] = e2; }
                }
                if constexpr (GATES) { if (F.lane < 16) { float gv = 0.f;
#pragma unroll
                        for (int p = 0; p < 16; ++p) gv = (F.lane == p) ? pr[p] : gv;
                        ((float*)(F.ws + WS_META + MT_GATES))[(size_t)row * 16 + F.lane] = gv + bgate[F.lane]; } }
            }
        }
        if constexpr (ROUTER) {
            __syncthreads();
            if (F.tid < 128) { const int e = sel[F.tid]; int rk = 0; for (int p = 0; p < F.tid; ++p) rk += (sel[p] == e) ? 1 : 0;
                const int row = blk * 64 + (F.tid >> 4) * 8 + ((F.tid & 15) >> 1);
                ((int*)(F.ws + WS_META + MT_RANK))[row * 2 + (F.tid & 1)] = rk; }
            if (F.tid >= 128 && F.tid < 136) { const int e = F.tid - 128; int cn = 0; for (int p = 0; p < 128; ++p) cn += (sel[p] == e) ? 1 : 0;
                ((int*)(F.ws + WS_META + MT_CNTW))[blk * 8 + e] = cn; }
            __syncthreads();
        }
    }
    (void)toke;
}

__device__ __forceinline__ void phase_moe_permute(const Frame& F) {
    int* cl = (int*)F.lds;
    int* tot = cl + 2048; int* toff = cl + 2056; int* base = cl + 2072;
    const int* cntw = (const int*)(F.ws + WS_META + MT_CNTW);
    for (int i = F.tid; i < 2048; i += NTHR) cl[i] = cntw[i];
    __syncthreads();
    if (F.tid < 8) { int s = 0; for (int w = 0; w < 256; ++w) s += cl[w * 8 + F.tid]; tot[F.tid] = s; }
    __syncthreads();
    if (F.tid == 0) { int o = 0; for (int e = 0; e < 8; ++e) { toff[e] = o; o += (tot[e] + 255) >> 8; } toff[8] = o;
        if (F.bid == 0) { int* meta = (int*)(F.ws + WS_META + MT_MOE); for (int e = 0; e < 8; ++e) meta[e] = tot[e]; for (int e = 0; e < 9; ++e) meta[8 + e] = toff[e]; } }
    __syncthreads();
    const int* toke = (const int*)(F.ws + WS_META + MT_TOKE); const int* rank = (const int*)(F.ws + WS_META + MT_RANK);
    int* rowtok = (int*)(F.ws + WS_META + MT_ROWTOK);
    const bf16_t* xb = (const bf16_t*)(F.ws + WS_XB); bf16_t* xp = (bf16_t*)(F.ws + WS_SCR + SC_XP);
    for (int blk = F.bid; blk < T / 64; blk += F.G) {
        __syncthreads();
        if (F.tid < 8) { int s = 0; for (int w = 0; w < blk; ++w) s += cl[w * 8 + F.tid]; base[F.tid] = toff[F.tid] * 256 + s; }
        __syncthreads();
        for (int pp = F.wave; pp < 128; pp += NWAVES) {
            const int tok = blk * 64 + (pp >> 1), k = pp & 1, e = toke[tok * 2 + k], row = base[e] + rank[tok * 2 + k];
            const u32x4 v0 = *(const u32x4*)(xb + (size_t)tok * D + F.lane * 8), v1 = *(const u32x4*)(xb + (size_t)tok * D + 512 + F.lane * 8);
            *(u32x4*)(xp + (size_t)row * D + F.lane * 8) = v0; *(u32x4*)(xp + (size_t)row * D + 512 + F.lane * 8) = v1;
            if (F.lane == 0) rowtok[row] = tok * 2 + k;
        }
    }
}

__device__ __forceinline__ void phase_mla_rows(const Frame& F, const int* positions) {
    const float* lat = (const float*)(F.ws + WS_SCR + SC_LAT);
    bf16_t* cqn = (bf16_t*)(F.ws + WS_SCR + SC_CQN); bf16_t* ckvn = (bf16_t*)(F.ws + WS_SCR + SC_CKVN); bf16_t* kr = (bf16_t*)(F.ws + WS_SCR + SC_KR);
    float* rope = (float*)(F.ws + WS_META + MT_ROPE);
    for (int row = F.bid * NWAVES + F.wave; row < T; row += F.G * NWAVES) {
        const float* lr = lat + (size_t)row * MLA_INP;
        float cq[6], ck[4]; float s1 = 0.f, s2 = 0.f;
#pragma unroll
        for (int j = 0; j < 6; ++j) { cq[j] = lr[F.lane + 64 * j]; s1 += cq[j] * cq[j]; }
#pragma unroll
        for (int j = 0; j < 4; ++j) { ck[j] = lr[MLA_QR + F.lane + 64 * j]; s2 += ck[j] * ck[j]; }
        const float r1 = 1.0f / sqrtf(wave_sum(s1) * (1.0f / MLA_QR) + RMS_EPS), r2 = 1.0f / sqrtf(wave_sum(s2) * (1.0f / MLA_KVR) + RMS_EPS);
#pragma unroll
        for (int j = 0; j < 6; ++j) cqn[(size_t)row * MLA_QR + F.lane + 64 * j] = (bf16_t)(cvt_pk_bf16(cq[j] * r1, 0.f) & 0xffffu);
#pragma unroll
        for (int j = 0; j < 4; ++j) ckvn[(size_t)row * MLA_KVR + F.lane + 64 * j] = (bf16_t)(cvt_pk_bf16(ck[j] * r2, 0.f) & 0xffffu);
        const float kx = lr[MLA_QR + MLA_KVR + F.lane];
        const float ko = __shfl_xor(kx, 32);
        const int i = F.lane & 31;
        const float invf = exp2f(-(float)i * (13.287712379549449f / 32.0f));
        const float ang = (float)positions[row] * invf;
        const double rev = (double)ang * 0.15915494309189535;
        const float fr = (float)(rev - floor(rev));
        const float sn = __builtin_amdgcn_sinf(fr), cs = __builtin_amdgcn_cosf(fr);
        const float out = (F.lane < 32) ? (kx * cs - ko * sn) : (kx * cs + ko * sn);
        kr[(size_t)row * MLA_ROPE + F.lane] = (bf16_t)(cvt_pk_bf16(out, 0.f) & 0xffffu);
        if (F.lane < 32) *(f32x2*)(rope + (size_t)row * 64 + 2 * i) = (f32x2){cs, sn};
    }
}

__device__ __forceinline__ void phase_pool_z(const Frame& F) {
    const float* x = (const float*)(F.ws + WS_X); bf16_t* z = (bf16_t*)(F.ws + WS_SCR + SC_Z);
    const int c = F.tid * 2, half = 1 << (c >> 8);
    for (int blk = F.bid; blk < T / 64; blk += F.G) {
        const int b0 = (blk * 64) / SEQ * SEQ, t0 = blk * 64 - b0;
        f32x2 sum = {0.f, 0.f};
        for (int s = t0 - half; s < t0 + half; ++s) if (s >= 0 && s < SEQ) { const f32x2 v = *(const f32x2*)(x + (size_t)(b0 + s) * D + c); sum += v; }
        for (int t = t0; t < t0 + 64; ++t) {
            const int lo = t - half < 0 ? 0 : t - half, hi = t + half > SEQ ? SEQ : t + half;
            const f32x2 xv = *(const f32x2*)(x + (size_t)(b0 + t) * D + c);
            const float inv = 1.0f / (float)(hi - lo);
            const f32x2 zz = sum * inv - xv;
            *(unsigned*)(z + (size_t)(b0 + t) * D + c) = cvt_pk_bf16(zz[0], zz[1]);
            if (t + half < SEQ) { const f32x2 v = *(const f32x2*)(x + (size_t)(b0 + t + half) * D + c); sum += v; }
            if (t - half >= 0) { const f32x2 v = *(const f32x2*)(x + (size_t)(b0 + t - half) * D + c); sum -= v; }
        }
    }
}

__device__ __forceinline__ void phase_mlstm_prep(const Frame& F, const float* convw) {
    const bf16_t* proj = (const bf16_t*)(F.ws + WS_SCR + SC_PROJ); bf16_t* qkc = (bf16_t*)(F.ws + WS_SCR + SC_QKC);
    const int c = F.tid * 2;
    float w0[5], w1[5];
#pragma unroll
    for (int j = 0; j < 5; ++j) { w0[j] = convw[j * 1024 + c]; w1[j] = convw[j * 1024 + c + 1]; }
    const float ksc = (c >= 512) ? 0.08838834764831845f : 1.0f;
    for (int blk = F.bid; blk < T / 64; blk += F.G) {
        const int b0 = (blk * 64) / SEQ * SEQ, t0 = blk * 64 - b0;
        float a0[5], a1[5];
#pragma unroll
        for (int j = 0; j < 4; ++j) { const int s = t0 - 2 + j; unsigned w = 0u; if (s >= 0 && s < SEQ) w = *(const unsigned*)(proj + (size_t)(b0 + s) * ML_INP + c); a0[j + 1] = bflo(w); a1[j + 1] = bfhi(w); }
        for (int t = t0; t < t0 + 64; ++t) {
#pragma unroll
            for (int j = 0; j < 4; ++j) { a0[j] = a0[j + 1]; a1[j] = a1[j + 1]; }
            { const int s = t + 2; unsigned w = 0u; if (s < SEQ) w = *(const unsigned*)(proj + (size_t)(b0 + s) * ML_INP + c); a0[4] = bflo(w); a1[4] = bfhi(w); }
            float r0 = 0.f, r1 = 0.f;
#pragma unroll
            for (int j = 0; j < 5; ++j) { r0 += a0[j] * w0[j]; r1 += a1[j] * w1[j]; }
            r0 = silu_f(r0) * ksc; r1 = silu_f(r1) * ksc;
            *(unsigned*)(qkc + (size_t)(b0 + t) * D + c) = cvt_pk_bf16(r0, r1);
        }
    }
    const float* gates = (const float*)(F.ws + WS_META + MT_GATES);
    float* gb = (float*)(F.ws + WS_META + MT_GVEC); float* gu = gb + 32 * SEQ; float* gpm = gu + 32 * SEQ; float* gawl = gpm + 32 * SEQ;
    for (int wg = F.bid * NWAVES + F.wave; wg < 32 * 64; wg += F.G * NWAVES) {
        const int chain = wg >> 6, cch = wg & 63, dir = chain >> 4, bb = (chain >> 2) & 3, hd = chain & 3;
        const int pos = cch * 64 + F.lane, tok = dir ? (SEQ - 1 - pos) : pos;
        const size_t row = (size_t)bb * SEQ + tok;
        const float li = gates[row * 16 + dir * 4 + hd], f = gates[row * 16 + 8 + dir * 4 + hd];
        const float lf = fminf(f, 0.f) - log1pf(expf(-fabsf(f)));
        float bsum = lf;
#pragma unroll
        for (int o = 1; o < 64; o <<= 1) { const float n = __shfl_up(bsum, o); if (F.lane >= o) bsum += n; }
        const float u = li - bsum;
        float pm = u;
#pragma unroll
        for (int o = 1; o < 64; o <<= 1) { const float n = __shfl_up(pm, o); if (F.lane >= o) pm = fmaxf(pm, n); }
        const float pm63 = __shfl(pm, 63);
        const size_t o_ = (size_t)chain * SEQ + pos;
        gb[o_] = bsum; gu[o_] = u; gpm[o_] = pm; gawl[o_] = expf(u - pm63);
    }
}

__device__ __forceinline__ void phase_mlstm_combine(const Frame& F, const float* norm_g) {
    const float* hs = (const float*)(F.ws + WS_SCR + SC_HS); const bf16_t* proj = (const bf16_t*)(F.ws + WS_SCR + SC_PROJ); bf16_t* ym = (bf16_t*)(F.ws + WS_SCR + SC_YM);
    for (int row = F.bid * NWAVES + F.wave; row < T; row += F.G * NWAVES) {
#pragma unroll
        for (int hd = 0; hd < 4; ++hd) { const int c = hd * 256 + F.lane * 4;
            const f32x4 h = *(const f32x4*)(hs + (size_t)row * D + c) + *(const f32x4*)(hs + (size_t)T * D + (size_t)row * D + c);
            const float mu = wave_sum((h[0] + h[1]) + (h[2] + h[3])) * (1.0f / 256.0f);
            const f32x4 d = h - mu;
            const float rstd = 1.0f / sqrtf(wave_sum((d[0] * d[0] + d[1] * d[1]) + (d[2] * d[2] + d[3] * d[3])) * (1.0f / 256.0f) + LN_EPS);
            const f32x4 gn = *(const f32x4*)(norm_g + c);
            const u32x2 ow = *(const u32x2*)(proj + (size_t)row * ML_INP + 2048 + c);
            const float o0 = bflo(ow.x), o1 = bfhi(ow.x), o2 = bflo(ow.y), o3 = bfhi(ow.y);
            const float y0 = d[0] * rstd * gn[0] * sigmoid_f(o0), y1 = d[1] * rstd * gn[1] * sigmoid_f(o1), y2 = d[2] * rstd * gn[2] * sigmoid_f(o2), y3 = d[3] * rstd * gn[3] * sigmoid_f(o3);
            *(u32x2*)(ym + (size_t)row * D + c) = (u32x2){cvt_pk_bf16(y0, y1), cvt_pk_bf16(y2, y3)}; }
    }
}

__global__ void __launch_bounds__(NTHR, 2) fwd_kernel(Args args) {
    extern __shared__ __attribute__((aligned(16))) unsigned char lds_raw[];
    Frame F;
    F.lds = (char*)lds_raw; F.tid = threadIdx.x; F.lane = F.tid & 63; F.wave = __builtin_amdgcn_readfirstlane(F.tid >> 6); F.G = gridDim.x; F.bid = blockIdx.x; F.ws = args.ws;
    LAS unsigned char* ldsl = (LAS unsigned char*)lds_raw;
    volatile LAS unsigned* MISC = (volatile LAS unsigned*)(ldsl + LDS_MISC);
    if (F.tid < 64) MISC[F.tid] = 0u;
    __syncthreads();
    const int lo = args.ph_lo, hi = args.ph_hi;
    XcdBarrier bar; bar.bar = (unsigned*)(args.ws + WS_CTL) + 4096; bar.x = 0; bar.st = nullptr;
    if (hi - lo > 1) bar = xcd_barrier_post((unsigned*)(args.ws + WS_CTL) + 4096, MISC + 8);
#ifndef EN_MASK
#define EN_MASK 0xffffffffu
#endif
#define EN(b) ((EN_MASK >> (b)) & 1u)
#define IN(k) (lo <= (k) && (k) < hi)
#define SEAM(k) do { if (IN(k) && IN((k) + 1)) xcd_barrier(bar); } while (0)
    int ph = 0;
#define PTRS unsigned char* ws = args.ws; asm volatile("" : "+s"(ws)); F.ws = ws; unsigned char* scr = ws + WS_SCR; bf16_t* Wb = (bf16_t*)(ws + WS_W); \
    float* X = (float*)(ws + WS_X); bf16_t* XB = (bf16_t*)(ws + WS_XB); float* Y = (float*)(ws + WS_Y); const float* lng = args.in[22]; const float* lnb = args.in[23]; \
    (void)scr; (void)Wb; (void)X; (void)XB; (void)Y; (void)lng; (void)lnb;

    if (EN(0) && IN(ph)) { PTRS phase_convert_small(F, args); }
    SEAM(ph); ++ph;
    if (EN(0) && IN(ph)) { PTRS phase_convert_moe(F, args, 0); }
    SEAM(ph); ++ph;

#define GEMM_DENSE(EPI, Aptr, lda_, Bptr, ldb_, K_, Mrows, Ncols, epi) do { \
        pg8::Gemm g{(const bf16_t*)(Aptr), (const bf16_t*)(Bptr), (lda_), (ldb_), (K_)}; pg8::DenseOrder S; S.init((Mrows), (Ncols), F.G, F.bid); \
        pg8::gemm_phase<EPI, pg8::DenseOrder, true>(ldsl, g, S, epi); } while (0)

#define MLA_PHASES(j, xres, lnidx, LNMODE, wproj_) do { \
    if (EN(11) && IN(ph)) { PTRS  pg8::EpiF32 E{(float*)(scr + SC_LAT), MLA_INP}; GEMM_DENSE(pg8::EpiF32, XB, D, (char*)Wb + W_DQKV + (size_t)(j) * MLA_INP * D * 2, D, D, T, MLA_INP, E); } \
    SEAM(ph); ++ph; \
    if (EN(2) && IN(ph)) { PTRS phase_mla_rows(F, (const int*)args.in[1]); } \
    SEAM(ph); ++ph; \
    if (EN(12) && IN(ph)) { PTRS  { pg8::EpiBf16 E{(bf16_t*)(scr + SC_Q), MLA_QW}; GEMM_DENSE(pg8::EpiBf16, scr + SC_CQN, MLA_QR, (char*)Wb + W_UQ + (size_t)(j) * MLA_QW * MLA_QR * 2, MLA_QR, MLA_QR, T, MLA_QW, E); } \
                  { pg8::EpiBf16 E{(bf16_t*)(scr + SC_KV), MLA_KVW}; GEMM_DENSE(pg8::EpiBf16, scr + SC_CKVN, MLA_KVR, (char*)Wb + W_UKV + (size_t)(j) * MLA_KVW * MLA_KVR * 2, MLA_KVR, MLA_KVR, T, MLA_KVW, E); } } \
    SEAM(ph); ++ph; \
    if (EN(3) && IN(ph)) { PTRS  const int x8 = F.bid & 7, jj = F.bid >> 3, per = F.G >> 3; \
        for (int lu = jj; lu < 64; lu += per) { const int bh = x8 * 4 + (lu >> 4), qb = lu & 15, b_ = bh >> 3, h_ = bh & 7; const size_t r0 = (size_t)b_ * SEQ + (size_t)qb * 256; \
            att::attn_body((const bf16_t*)(scr + SC_Q) + r0 * MLA_QW + h_ * 192, (const float*)(ws + WS_META + MT_ROPE) + r0 * 64, \
                           (const bf16_t*)(scr + SC_KV) + (size_t)b_ * SEQ * MLA_KVW + h_ * 256, (const bf16_t*)(scr + SC_KV) + (size_t)b_ * SEQ * MLA_KVW + h_ * 256 + 128, \
                           (const bf16_t*)(scr + SC_KR) + (size_t)b_ * SEQ * MLA_ROPE, (bf16_t*)(scr + SC_O) + r0 * D + h_ * 128, SEQ, F.lds); } } \
    SEAM(ph); ++ph; \
    if (EN(13) && IN(ph)) { PTRS  pg8::EpiF32 E{Y, D}; GEMM_DENSE(pg8::EpiF32, scr + SC_O, D, (char*)Wb + W_O + (size_t)(j) * D * D * 2, D, D, T, D, E); } \
    SEAM(ph); ++ph; \
    if (EN(4) && IN(ph)) { PTRS phase_ln<LNMODE>(F, xres, Y, X, XB, lng + (lnidx) * D, lnb + (lnidx) * D, wproj_, nullptr); } \
    SEAM(ph); ++ph; } while (0)

#define DENSE_PHASES(c, lnidx, LNMODE) do { \
    if (EN(14) && IN(ph)) { PTRS  pg8::EpiSwiGLU E{(bf16_t*)(scr + SC_H), DFF}; GEMM_DENSE(pg8::EpiSwiGLU, XB, D, (char*)Wb + W_GU + (size_t)(c) * 2 * DFF * D * 2, D, D, T, 2 * DFF, E); } \
    SEAM(ph); ++ph; \
    if (EN(15) && IN(ph)) { PTRS  pg8::EpiF32 E{Y, D}; GEMM_DENSE(pg8::EpiF32, scr + SC_H, DFF, (char*)Wb + W_DN + (size_t)(c) * D * DFF * 2, DFF, DFF, T, D, E); } \
    SEAM(ph); ++ph; \
    if (EN(4) && IN(ph)) { PTRS phase_ln<LNMODE>(F, X, Y, X, XB, lng + (lnidx) * D, lnb + (lnidx) * D, nullptr, nullptr); } \
    SEAM(ph); ++ph; } while (0)

#define MOE_PHASES(c, lnidx, LNMODE, xout_, wproj_, bgate_) do { \
    if (EN(6) && IN(ph)) { PTRS phase_moe_permute(F); } \
    SEAM(ph); ++ph; \
    if (EN(7) && IN(ph)) { PTRS  pg8::Gemm g{(const bf16_t*)(scr + SC_XP), (const bf16_t*)(ws + WS_WMOE + WM_GU), D, D, D}; pg8::MoeOrder S; S.build_table((const int*)(ws + WS_META + MT_MOE), (LAS int*)(ldsl + LDS_MISC + 1024), 2 * DFFE, F.G, F.bid); \
        pg8::EpiSwiGLU E{(bf16_t*)(scr + SC_HM), DFFE}; pg8::gemm_phase<pg8::EpiSwiGLU, pg8::MoeOrder, true>(ldsl, g, S, E); } \
    SEAM(ph); ++ph; \
    if (EN(7) && IN(ph)) { PTRS  pg8::Gemm g{(const bf16_t*)(scr + SC_HM), (const bf16_t*)(ws + WS_WMOE + WM_DN), DFFE, DFFE, DFFE}; pg8::MoeOrder S; S.build_table((const int*)(ws + WS_META + MT_MOE), (LAS int*)(ldsl + LDS_MISC + 1024), D, F.G, F.bid); \
        pg8::EpiF32Scatter E{(float*)(scr + SC_Y2), (const int*)(ws + WS_META + MT_ROWTOK)}; pg8::gemm_phase<pg8::EpiF32Scatter, pg8::MoeOrder, true>(ldsl, g, S, E); } \
    SEAM(ph); ++ph; \
    if (EN(4) && IN(ph)) { PTRS phase_ln<LNMODE>(F, X, (const float*)(scr + SC_Y2), xout_, XB, lng + (lnidx) * D, lnb + (lnidx) * D, wproj_, bgate_); } \
    SEAM(ph); ++ph; } while (0)

    MLA_PHASES(0, args.in[0], 0, 0, nullptr);
    DENSE_PHASES(0, 1, 0);
    if (EN(5) && IN(ph)) { PTRS phase_pool_z(F); }
    SEAM(ph); ++ph;
    if (EN(16) && IN(ph)) { PTRS  pg8::Gemm g{(const bf16_t*)(scr + SC_Z), (const bf16_t*)((char*)Wb + W_POOL), D, 256, 256}; pg8::PoolOrder S; S.init(T, D, F.G, F.bid);
        pg8::EpiF32 E{Y, D}; pg8::gemm_phase<pg8::EpiF32, pg8::PoolOrder, true>(ldsl, g, S, E); }
    SEAM(ph); ++ph;
    if (EN(4) && IN(ph)) { PTRS phase_ln<2>(F, X, Y, X, XB, lng + 2 * D, lnb + 2 * D, args.in[18], nullptr); }
    SEAM(ph); ++ph;
    MOE_PHASES(0, 3, 1 | 4, X, args.in[10], args.in[12]);
    if (EN(0) && IN(ph)) { PTRS phase_convert_moe(F, args, 1); }
    SEAM(ph); ++ph;
    if (EN(17) && IN(ph)) { PTRS  pg8::EpiBf16 E{(bf16_t*)(scr + SC_PROJ), ML_INP}; GEMM_DENSE(pg8::EpiBf16, XB, D, (char*)Wb + W_IN, D, D, T, ML_INP, E); }
    SEAM(ph); ++ph;
    if (EN(8) && IN(ph)) { PTRS phase_mlstm_prep(F, args.in[11]); }
    SEAM(ph); ++ph;
    if (EN(9) && IN(ph)) { PTRS  mls::Tensors Tn; Tn.qkc = (const bf16_t*)(scr + SC_QKC); Tn.proj = (const bf16_t*)(scr + SC_PROJ);
        Tn.gvec = (const float*)(ws + WS_META + MT_GVEC); Tn.hs = (float*)(scr + SC_HS);
        for (int u = F.bid; u < 256; u += F.G) mls::scan_unit(Tn, u, F.lds); }
    SEAM(ph); ++ph;
    if (EN(10) && IN(ph)) { PTRS phase_mlstm_combine(F, args.in[13]); }
    SEAM(ph); ++ph;
    if (EN(18) && IN(ph)) { PTRS  pg8::EpiF32 E{Y, D}; GEMM_DENSE(pg8::EpiF32, scr + SC_YM, D, (char*)Wb + W_OUT, D, D, T, D, E); }
    SEAM(ph); ++ph;
    if (EN(4) && IN(ph)) { PTRS phase_ln<0>(F, X, Y, X, XB, lng + 4 * D, lnb + 4 * D, nullptr, nullptr); }
    SEAM(ph); ++ph;
    DENSE_PHASES(1, 5, 0);
    MLA_PHASES(1, X, 6, 2, args.in[18] + (size_t)D * NEXP);
    MOE_PHASES(1, 7, 1 | 8, args.out, nullptr, nullptr);
#undef IN
#undef SEAM
}

extern "C" void kernel_launch(void* const* d_in, const int* in_sizes, int n_in, void* d_out, int out_size, void* d_ws, size_t ws_size, hipStream_t stream) {
    static int grid = 0;
    if (grid == 0) {
        if (n_in != 24 || in_sizes[0] != T * D || out_size != T * D || ws_size < WS_END) {
            fprintf(stderr, "kernel_launch: shape mismatch: n_in %d in0 %d out %d ws %zu (need %zu)\n", n_in, n_in > 0 ? in_sizes[0] : -1, out_size, ws_size, (size_t)WS_END); grid = -1; return; }
        int dev = 0, cus = 0, per_cu = 0;
        if (hipGetDevice(&dev) != hipSuccess || hipDeviceGetAttribute(&cus, hipDeviceAttributeMultiprocessorCount, dev) != hipSuccess) { grid = -1; return; }
        if (hipFuncSetAttribute((const void*)fwd_kernel, hipFuncAttributeMaxDynamicSharedMemorySize, LDS_BYTES) != hipSuccess) { fprintf(stderr, "kernel_launch: hipFuncSetAttribute failed\n"); grid = -1; return; }
        if (hipOccupancyMaxActiveBlocksPerMultiprocessor(&per_cu, (const void*)fwd_kernel, NTHR, LDS_BYTES) != hipSuccess || per_cu < 1)
            fprintf(stderr, "kernel_launch: occupancy query reports %d blocks per CU\n", per_cu);
        (void)hipGetLastError();
        grid = cus;
    }
    if (grid < 0) return;
    if (hipMemsetAsync((char*)d_ws + WS_CTL, 0, CTL_ZERO_BYTES, stream) != hipSuccess) { fprintf(stderr, "kernel_launch: memset failed\n"); return; }
    Args a{};
    for (int i = 0; i < 24; ++i) a.in[i] = (const float*)d_in[i];
    a.out = (float*)d_out; a.ws = (unsigned char*)d_ws;
#ifndef MK_ONE_LAUNCH
#define MK_ONE_LAUNCH 0
#endif
    if (MK_ONE_LAUNCH) { a.ph_lo = 0; a.ph_hi = NPH; hipLaunchKernelGGL(fwd_kernel, dim3(grid), dim3(NTHR), LDS_BYTES, stream, a); }
    else for (int p = 0; p < NPH; ++p) { a.ph_lo = p; a.ph_hi = p + 1; hipLaunchKernelGGL(fwd_kernel, dim3(grid), dim3(NTHR), LDS_BYTES, stream, a); }
    const hipError_t le = hipPeekAtLastError();
    if (le != hipSuccess) fprintf(stderr, "kernel_launch: launch failed: %s\n", hipGetErrorName(le));
}
```

```cpp
#include <hip/hip_runtime.h>
#include <cstdio>
#include <cstdint>

#define LAS __attribute__((address_space(3)))
#define GAS __attribute__((address_space(1)))
typedef unsigned short bf16_t;
typedef short bf16x8 __attribute__((ext_vector_type(8)));
typedef short s16x4 __attribute__((ext_vector_type(4)));
typedef float f32x4 __attribute__((ext_vector_type(4)));
typedef float f32x2 __attribute__((ext_vector_type(2)));
typedef float f32x16 __attribute__((ext_vector_type(16)));
typedef unsigned u32x4 __attribute__((ext_vector_type(4)));
typedef unsigned u32x2 __attribute__((ext_vector_type(2)));
typedef GAS unsigned gu32;

constexpr int BATCH = 4, SEQ = 4096, T = BATCH * SEQ, D = 1024;
constexpr float DN_ALPHA = 1.6817928305074290f;
constexpr float LN_EPS = 1e-5f, RMS_EPS = 1e-6f;
constexpr int MLA_H = 8, MLA_QR = 384, MLA_KVR = 256, MLA_NOPE = 128, MLA_ROPE = 64, MLA_V = 128, MLA_IN = 704, MLA_INP = 768;
constexpr int MLA_QW = MLA_H * (MLA_NOPE + MLA_ROPE);
constexpr int MLA_KVW = MLA_H * (MLA_NOPE + MLA_V);
constexpr int ML_H = 4, ML_DK = 128, ML_DV = 256, ML_IN = 3088, ML_INP = 3072;
constexpr int DFF = 2816, NEXP = 8, DFFE = 3584;
constexpr int MOE_MAXT = 136;
constexpr int NWAVES = 8, NTHR = 512;

constexpr size_t MiB = 1u << 20;
constexpr size_t WS_CTL = 0, CTL_ZERO_BYTES = 1 * MiB;
constexpr size_t WS_META = 1 * MiB;
constexpr size_t MT_CNTW = 0;
constexpr size_t MT_MOE = 16384;
constexpr size_t MT_TOKE = 32768;
constexpr size_t MT_TOKW = MT_TOKE + (size_t)T * 8;
constexpr size_t MT_RANK = MT_TOKW + (size_t)T * 8;
constexpr size_t MT_ROWTOK = MT_RANK + (size_t)T * 8;
constexpr size_t MT_GATES = 1 * MiB;
constexpr size_t MT_GVEC = 2 * MiB;
constexpr size_t MT_ROPE = 4 * MiB;
static_assert(MT_ROWTOK + (size_t)MOE_MAXT * 256 * 4 <= MT_GATES, "meta map");
constexpr size_t WS_W = 17 * MiB;
constexpr size_t W_DQKV = 0;
constexpr size_t W_UQ = W_DQKV + 2 * (size_t)MLA_INP * D * 2;
constexpr size_t W_UKV = W_UQ + 2 * (size_t)MLA_QW * MLA_QR * 2;
constexpr size_t W_O = W_UKV + 2 * (size_t)MLA_KVW * MLA_KVR * 2;
constexpr size_t W_POOL = W_O + 2 * (size_t)D * D * 2;
constexpr size_t W_IN = W_POOL + 4 * (size_t)256 * 256 * 2;
constexpr size_t W_OUT = W_IN + (size_t)ML_INP * D * 2;
constexpr size_t W_GU = W_OUT + (size_t)D * D * 2;
constexpr size_t W_DN = W_GU + 2 * (size_t)2 * DFF * D * 2;
constexpr size_t W_END = W_DN + 2 * (size_t)D * DFF * 2;
static_assert(W_END <= 55 * MiB, "weights map");
constexpr size_t WS_WMOE = 72 * MiB;
constexpr size_t WM_GU = 0, WM_DN = (size_t)NEXP * 2 * DFFE * D * 2;
static_assert(WM_DN + (size_t)NEXP * D * DFFE * 2 == 168 * MiB, "moe weights map");
constexpr size_t WS_X = 240 * MiB;
constexpr size_t WS_XB = 304 * MiB;
constexpr size_t WS_Y = 336 * MiB;
constexpr size_t WS_SCR = 400 * MiB;
constexpr size_t WS_END = 834 * MiB;
constexpr size_t SC_LAT = 0, SC_CQN = 48 * MiB, SC_CKVN = 60 * MiB, SC_KR = 68 * MiB, SC_Q = 70 * MiB, SC_KV = 118 * MiB, SC_O = 182 * MiB;
constexpr size_t SC_H = 0;
constexpr size_t SC_Z = 0;
constexpr size_t SC_XP = 0, SC_HM = 68 * MiB, SC_Y2 = 306 * MiB;
static_assert(SC_Y2 + (size_t)2 * T * D * 4 == 434 * MiB, "moe scratch");
constexpr size_t SC_PROJ = 0, SC_QKC = 96 * MiB, SC_HS = 128 * MiB, SC_YM = 256 * MiB;

constexpr int LDS_MAIN = 131072;
constexpr int LDS_MISC = LDS_MAIN;
constexpr int LDS_BYTES = 147456;

#define RLX_AGENT __ATOMIC_RELAXED, __HIP_MEMORY_SCOPE_AGENT
__device__ __forceinline__ unsigned cvt_pk_bf16(float lo, float hi) { unsigned r; asm volatile("v_cvt_pk_bf16_f32 %0, %1, %2" : "=v"(r) : "v"(lo), "v"(hi)); return r; }
__device__ __forceinline__ float bf2f(unsigned short b) { return __builtin_bit_cast(float, (unsigned)b << 16); }
__device__ __forceinline__ float bflo(unsigned w) { return __builtin_bit_cast(float, w << 16); }
__device__ __forceinline__ float bfhi(unsigned w) { return __builtin_bit_cast(float, w & 0xffff0000u); }
__device__ __forceinline__ float wave_sum(float v) {
#pragma unroll
    for (int o = 32; o >= 1; o >>= 1) v += __shfl_xor(v, o);
    return v;
}
__device__ __forceinline__ float fast_exp(float x) { return __builtin_amdgcn_exp2f(x * 1.4426950408889634f); }
__device__ __forceinline__ float fast_rcp(float x) { return __builtin_amdgcn_rcpf(x); }
__device__ __forceinline__ float silu_f(float x) { return x * fast_rcp(1.0f + fast_exp(-x)); }
__device__ __forceinline__ float sigmoid_f(float x) { return fast_rcp(1.0f + fast_exp(-x)); }

namespace pg8 {
constexpr int BM = 256, BK = 64, HALF = 128, HTB = HALF * BK * 2, STAGE_BYTES = 8 * HTB, NXCD = 8, WGM = 8;
__host__ __device__ __forceinline__ int lds_byte(int r, int c) { const int st = (r >> 4) * 2 + (c >> 5), rr = r & 15, cc = c & 31, ob = rr * 64 + cc * 2; return st * 1024 + (ob ^ (((ob >> 9) & 1) << 5)); }
__host__ __device__ __forceinline__ void stage_rc(int b, int& R, int& C) { const int st = b / 1024, sb = b % 1024, swz = sb ^ (((sb >> 9) & 1) << 5); R = (st >> 1) * 16 + swz / 64; C = (st & 1) * 32 + (swz % 64) / 2; }
__host__ __device__ __forceinline__ int perm32(int rho) { const int n = rho >> 4, i = rho & 15; return 8 * (i >> 2) + 4 * n + (i & 3); }

struct Unit { int pm, pn, e, nv; };
struct Gemm { const bf16_t* A; const bf16_t* Bt; int lda, ldb, K; };

struct DenseOrder {
    int nM, nN, nwg, G, c;
    __device__ __forceinline__ void init(int M, int N, int G_, int c_) { nM = M / BM; nN = N / BM; nwg = nM * nN; G = G_; c = c_; }
    __device__ __forceinline__ bool next(int i, Unit& u) const {
        const long L = (long)i * G + c; if (L >= nwg) return false;
        int wgid = (int)L; { const int q = nwg / NXCD, r = nwg % NXCD, xcd = wgid % NXCD, off = wgid / NXCD; wgid = (xcd < r ? xcd * (q + 1) : r * (q + 1) + (xcd - r) * q) + off; }
        const int nig = WGM * nN, gid = wgid / nig, fm = gid * WGM, gsz = (nM - fm) < WGM ? (nM - fm) : WGM;
        u.pm = fm + ((wgid % nig) % gsz); u.pn = (wgid % nig) / gsz; u.e = 0; u.nv = 256; return true;
    }
    __device__ __forceinline__ const char* a_tile(const Unit& u, const Gemm& g) const { return (const char*)g.A + (size_t)u.pm * BM * g.lda * 2; }
    __device__ __forceinline__ const char* b_tile(const Unit& u, const Gemm& g) const { return (const char*)g.Bt + (size_t)u.pn * BM * g.ldb * 2; }
};
struct PoolOrder : DenseOrder {
    __device__ __forceinline__ const char* a_tile(const Unit& u, const Gemm& g) const { return (const char*)g.A + ((size_t)u.pm * BM * g.lda + (size_t)u.pn * 256) * 2; }
    __device__ __forceinline__ const char* b_tile(const Unit& u, const Gemm& g) const { return (const char*)g.Bt + (size_t)u.pn * 256 * 256 * 2; }
};
struct MoeOrder {
    const LAS int* tab; int ntiles, nN, Nexp, G, c;
    __device__ __forceinline__ void build_table(const int* meta, LAS int* tabw, int Nexp_, int G_, int c_) {
        const int tid = threadIdx.x;
        if (tid < MOE_MAXT) {
            int e = 0;
#pragma unroll
            for (int k = 1; k < 8; ++k) e += (tid >= meta[8 + k]) ? 1 : 0;
            const int rem = meta[e] - (tid - meta[8 + e]) * 256;
            tabw[2 * tid] = e; tabw[2 * tid + 1] = rem < 256 ? rem : 256;
        }
        ntiles = __builtin_amdgcn_readfirstlane(meta[16]);
        __syncthreads();
        tab = tabw; Nexp = Nexp_; nN = Nexp_ / BM; G = G_; c = c_;
    }
    __device__ __forceinline__ bool next(int i, Unit& u) const {
        const long L = (long)i * G + c; if (L >= (long)ntiles * nN) return false;
        const int rt = (int)(L / nN); u.pn = (int)(L % nN); u.pm = rt;
        u.e = __builtin_amdgcn_readfirstlane(tab[2 * rt]); u.nv = __builtin_amdgcn_readfirstlane(tab[2 * rt + 1]); return true;
    }
    __device__ __forceinline__ const char* a_tile(const Unit& u, const Gemm& g) const { return (const char*)g.A + (size_t)u.pm * BM * g.lda * 2; }
    __device__ __forceinline__ const char* b_tile(const Unit& u, const Gemm& g) const { return (const char*)g.Bt + ((size_t)u.e * Nexp + (size_t)u.pn * BM) * g.ldb * 2; }
};

struct EpiF32 {
    static constexpr bool PERM = false;
    float* C; int ldc;
    __device__ __forceinline__ void operator()(const f32x4 (&acc)[2][2][4][2], const Unit& u, int wr, int wc, int fr, int fq) const {
        const int row0 = u.pm * BM + wr * 64 + fr, col0 = u.pn * BM + wc * 32 + 4 * fq;
#pragma unroll
        for (int ai = 0; ai < 2; ++ai)
#pragma unroll
            for (int m = 0; m < 4; ++m) { float* rowp = C + (size_t)(row0 + ai * HALF + m * 16) * ldc + col0;
#pragma unroll
                for (int bj = 0; bj < 2; ++bj)
#pragma unroll
                    for (int n = 0; n < 2; ++n) *(f32x4*)(rowp + bj * HALF + n * 16) = acc[ai][bj][m][n]; }
    }
};
struct EpiF32Scatter {
    static constexpr bool PERM = false;
    float* C; const int* rowtok;
    __device__ __forceinline__ void operator()(const f32x4 (&acc)[2][2][4][2], const Unit& u, int wr, int wc, int fr, int fq) const {
        const int col0 = u.pn * BM + wc * 32 + 4 * fq;
#pragma unroll
        for (int ai = 0; ai < 2; ++ai)
#pragma unroll
            for (int m = 0; m < 4; ++m) { const int rl = ai * HALF + wr * 64 + m * 16 + fr;
                if (rl < u.nv) { const int dst = rowtok[u.pm * BM + rl]; float* rowp = C + (size_t)dst * D + col0;
#pragma unroll
                    for (int bj = 0; bj < 2; ++bj)
#pragma unroll
                        for (int n = 0; n < 2; ++n) *(f32x4*)(rowp + bj * HALF + n * 16) = acc[ai][bj][m][n]; } }
    }
};
struct EpiBf16 {
    static constexpr bool PERM = true;
    bf16_t* O; int ldc;
    __device__ __forceinline__ void operator()(const f32x4 (&acc)[2][2][4][2], const Unit& u, int wr, int wc, int fr, int fq) const {
        const int row0 = u.pm * BM + wr * 64 + fr, col0 = u.pn * BM + wc * 32 + 8 * fq;
#pragma unroll
        for (int ai = 0; ai < 2; ++ai)
#pragma unroll
            for (int m = 0; m < 4; ++m) { bf16_t* rowp = O + (size_t)(row0 + ai * HALF + m * 16) * ldc + col0;
#pragma unroll
                for (int bj = 0; bj < 2; ++bj) { const f32x4 v0 = acc[ai][bj][m][0], v1 = acc[ai][bj][m][1];
                    u32x4 w; w.x = cvt_pk_bf16(v0[0], v0[1]); w.y = cvt_pk_bf16(v0[2], v0[3]); w.z = cvt_pk_bf16(v1[0], v1[1]); w.w = cvt_pk_bf16(v1[2], v1[3]);
                    *(u32x4*)(rowp + bj * HALF) = w; } }
    }
};
struct EpiSwiGLU {
    static constexpr bool PERM = true;
    bf16_t* O; int ldc;
    __device__ __forceinline__ void operator()(const f32x4 (&acc)[2][2][4][2], const Unit& u, int wr, int wc, int fr, int fq) const {
        const int row0 = u.pm * BM + wr * 64 + fr, col0 = u.pn * HALF + wc * 32 + 8 * fq;
#pragma unroll
        for (int ai = 0; ai < 2; ++ai)
#pragma unroll
            for (int m = 0; m < 4; ++m) { bf16_t* rowp = O + (size_t)(row0 + ai * HALF + m * 16) * ldc + col0;
                float h[8];
#pragma unroll
                for (int n = 0; n < 2; ++n)
#pragma unroll
                    for (int i = 0; i < 4; ++i) h[n * 4 + i] = silu_f(acc[ai][0][m][n][i]) * acc[ai][1][m][n][i];
                u32x4 w; w.x = cvt_pk_bf16(h[0], h[1]); w.y = cvt_pk_bf16(h[2], h[3]); w.z = cvt_pk_bf16(h[4], h[5]); w.w = cvt_pk_bf16(h[6], h[7]);
                *(u32x4*)rowp = w; }
    }
};

template <class Epi, class Sched, bool ALIGN_EPI = true>
__device__ __forceinline__ void gemm_phase(LAS unsigned char* lds, const Gemm g, const Sched& S, const Epi& E) {
    const int tid = threadIdx.x, wid = __builtin_amdgcn_readfirstlane(tid >> 6), lane = tid & 63, wr = wid >> 2, wc = wid & 3, fr = lane & 15, fq = lane >> 4;
    int K = g.K; asm volatile("" : "+s"(K));
    const int nt = K / BK;
    unsigned voffA[2], voffB[2];
#pragma unroll
    for (int i = 0; i < 2; ++i) { int R, C; stage_rc(tid * 16 + i * 8192, R, C); const int Rb = Epi::PERM ? ((R & ~31) + perm32(R & 31)) : R;
        voffA[i] = (unsigned)(R * g.lda + C) * 2u; voffB[i] = (unsigned)(Rb * g.ldb + C) * 2u; }
    const size_t kstep = (size_t)(BK * 2);
    const size_t hstepA = (size_t)HALF * g.lda * 2, hstepB = (size_t)HALF * g.ldb * 2;
    const unsigned ldsw = (unsigned)wid * 1024u;
    const int aoff = lds_byte(wr * 64 + fr, fq * 8), boff = lds_byte(wc * 32 + fr, fq * 8);
#define PG8_SA(b, h) (((b) * 2 + (h)) * HTB)
#define PG8_SB(b, h) ((4 + (b) * 2 + (h)) * HTB)
#define PG8_STAGE(bufoff, gbase, voff) do { _Pragma("unroll") for (int _i = 0; _i < 2; ++_i) \
        __builtin_amdgcn_global_load_lds((const unsigned*)((const char*)(gbase) + (voff)[_i]), (LAS unsigned*)(lds + (bufoff) + ldsw + _i * 8192), 16, 0, 0); } while (0)
#define PG8_LDA(dst, b, h) do { _Pragma("unroll") for (int m = 0; m < 4; ++m) _Pragma("unroll") for (int k = 0; k < 2; ++k) dst[m][k] = *(const LAS bf16x8*)(lds + PG8_SA(b, h) + aoff + m * 2048 + k * 1024); } while (0)
#define PG8_LDB(dst, b, h) do { _Pragma("unroll") for (int n = 0; n < 2; ++n) _Pragma("unroll") for (int k = 0; k < 2; ++k) dst[n][k] = *(const LAS bf16x8*)(lds + PG8_SB(b, h) + boff + n * 2048 + k * 1024); } while (0)
#define PG8_MMA(ai, bj, At, Bt) do { __builtin_amdgcn_s_setprio(1); _Pragma("unroll") for (int m = 0; m < 4; ++m) _Pragma("unroll") for (int n = 0; n < 2; ++n) _Pragma("unroll") for (int k = 0; k < 2; ++k) \
        acc[ai][bj][m][n] = __builtin_amdgcn_mfma_f32_16x16x32_bf16(Bt[n][k], At[m][k], acc[ai][bj][m][n], 0, 0, 0); __builtin_amdgcn_s_setprio(0); } while (0)
#define PG8_WAIT_V(n) asm volatile("s_waitcnt vmcnt(" #n ")" ::: "memory")
#define PG8_WAIT_L(n) asm volatile("s_waitcnt lgkmcnt(" #n ")" ::: "memory")
#define PG8_BAR __builtin_amdgcn_s_barrier()
#define PG8_SCHED __builtin_amdgcn_sched_barrier(0)
    Unit cur, nxt; int ui = 0;
    if (!S.next(0, cur)) return;
    f32x4 acc[2][2][4][2];
#pragma unroll
    for (int a = 0; a < 2; ++a)
#pragma unroll
        for (int b = 0; b < 2; ++b)
#pragma unroll
            for (int m = 0; m < 4; ++m)
#pragma unroll
                for (int n = 0; n < 2; ++n) acc[a][b][m][n] = (f32x4){0.f, 0.f, 0.f, 0.f};
    bf16x8 At[4][2], B0[2][2], B1[2][2];
    const char* cA = S.a_tile(cur, g); const char* cB = S.b_tile(cur, g);
    PG8_STAGE(PG8_SB(0, 0), cB, voffB); PG8_STAGE(PG8_SB(0, 1), cB + hstepB, voffB); PG8_STAGE(PG8_SA(0, 0), cA, voffA); PG8_STAGE(PG8_SA(0, 1), cA + hstepA, voffA);
    if (wr == 1) PG8_BAR;
    PG8_WAIT_V(2); PG8_BAR;
    PG8_STAGE(PG8_SB(1, 0), cB + kstep, voffB); PG8_STAGE(PG8_SA(1, 0), cA + kstep, voffA); PG8_STAGE(PG8_SB(1, 1), cB + hstepB + kstep, voffB);
    PG8_WAIT_V(6); PG8_BAR;
    for (;;) {
        const bool has_next = S.next(ui + 1, nxt);
        const char* nA = has_next ? S.a_tile(nxt, g) : cA; const char* nB = has_next ? S.b_tile(nxt, g) : cB;
        for (int t = 0; t < nt; t += 2) {
            const bool last = (t == nt - 2);
            const char* a1 = cA + (size_t)(t + 1) * kstep;
            const char* a2 = last ? nA : cA + (size_t)(t + 2) * kstep; const char* b2 = last ? nB : cB + (size_t)(t + 2) * kstep;
            const char* a3 = a2 + kstep; const char* b3 = b2 + kstep;
            PG8_LDB(B0, 0, 0); PG8_LDB(B1, 0, 1); PG8_SCHED; PG8_LDA(At, 0, 0); PG8_STAGE(PG8_SA(1, 1), a1 + hstepA, voffA);
            PG8_WAIT_V(8); PG8_WAIT_L(0); PG8_BAR; PG8_MMA(0, 0, At, B0); PG8_MMA(0, 1, At, B1); PG8_BAR; PG8_SCHED;
            PG8_LDA(At, 0, 1); PG8_STAGE(PG8_SB(0, 0), b2, voffB); PG8_STAGE(PG8_SB(0, 1), b2 + hstepB, voffB); PG8_STAGE(PG8_SA(0, 0), a2, voffA);
            PG8_WAIT_V(8); PG8_WAIT_L(0); PG8_BAR; PG8_MMA(1, 0, At, B0); PG8_MMA(1, 1, At, B1); PG8_BAR; PG8_SCHED;
            PG8_LDB(B0, 1, 0); PG8_LDB(B1, 1, 1); PG8_SCHED; PG8_LDA(At, 1, 0); PG8_STAGE(PG8_SA(0, 1), a2 + hstepA, voffA);
            PG8_WAIT_V(8); PG8_WAIT_L(0); PG8_BAR; PG8_MMA(0, 0, At, B0); PG8_MMA(0, 1, At, B1); PG8_BAR; PG8_SCHED;
            PG8_LDA(At, 1, 1); PG8_STAGE(PG8_SB(1, 0), b3, voffB); PG8_STAGE(PG8_SB(1, 1), b3 + hstepB, voffB); PG8_STAGE(PG8_SA(1, 0), a3, voffA);
            PG8_WAIT_V(8); PG8_WAIT_L(0); PG8_BAR; PG8_MMA(1, 0, At, B0); PG8_MMA(1, 1, At, B1); PG8_BAR; PG8_SCHED;
        }
        if constexpr (ALIGN_EPI) { if (wr == 0) PG8_BAR; }
        E(acc, cur, wr, wc, fr, fq);
        if (!has_next) break;
#pragma unroll
        for (int a = 0; a < 2; ++a)
#pragma unroll
            for (int b = 0; b < 2; ++b)
#pragma unroll
                for (int m = 0; m < 4; ++m)
#pragma unroll
                    for (int n = 0; n < 2; ++n) acc[a][b][m][n] = (f32x4){0.f, 0.f, 0.f, 0.f};
        cur = nxt; cA = nA; cB = nB; ++ui;
        if constexpr (ALIGN_EPI) { if (wr == 1) PG8_BAR; }
    }
    PG8_WAIT_V(0);
    if constexpr (!ALIGN_EPI) { if (wr == 0) PG8_BAR; }
    PG8_BAR;
#undef PG8_SA
#undef PG8_SB
#undef PG8_STAGE
#undef PG8_LDA
#undef PG8_LDB
#undef PG8_MMA
#undef PG8_WAIT_V
#undef PG8_WAIT_L
#undef PG8_BAR
#undef PG8_SCHED
}
}

#ifndef ATT_SDEPTH
#define ATT_SDEPTH 1
#endif
namespace att {
constexpr int NW = 8, QBLK = 32, KVBLK = 64;
constexpr float SCALE = 0.07216878364870322f;
constexpr float THR = 8.f;
constexpr int LDQ = MLA_QW, LDK = MLA_KVW, LDKR = MLA_ROPE, LDO = D;
constexpr int SHM_V = KVBLK * 128 * 2, SHM_K = KVBLK * 128 * 2, SHM_KR = KVBLK * 64 * 2;
constexpr int OFF_V = 0, OFF_K = 2 * SHM_V, OFF_KR = OFF_K + 2 * SHM_K, OFF_WS = OFF_KR + 2 * SHM_KR, OFF_QR = OFF_WS + NW * 64 * 4, SHM_ATTN = OFF_QR + NW * 4096;
#define KSWZ(row, colB) ((row) * 256 + ((colB) ^ (((row) & 7) << 4)))
#define KRSWZ(row, colB) ((row) * 128 + ((colB) ^ ((((row) >> 1) & 7) << 4)))
#define SBAR() __builtin_amdgcn_sched_barrier(0)
__device__ __forceinline__ int crow(int r, int hi) { return (r & 3) + 8 * (r >> 2) + 4 * hi; }

__device__ __forceinline__ void partialSM(f32x16& p0, f32x16& p1, float& m_reg, float& mn, float& alpha) {
  constexpr float C = SCALE * 1.4426950408889634f;
  float pmax = p0[0];
#pragma unroll
  for (int r = 1; r < 16; ++r) pmax = fmaxf(pmax, p0[r]);
#pragma unroll
  for (int r = 0; r < 16; ++r) pmax = fmaxf(pmax, p1[r]);
  { auto rr = __builtin_amdgcn_permlane32_swap(__float_as_uint(pmax), __float_as_uint(pmax), false, false);
    pmax = fmaxf(__uint_as_float(rr[0]), __uint_as_float(rr[1])); }
  if (__builtin_expect(__all(pmax - m_reg <= THR / SCALE), 1)) { mn = m_reg; alpha = 1.f; }
  else { mn = fmaxf(m_reg, pmax); alpha = __builtin_amdgcn_exp2f((m_reg - mn) * C); m_reg = mn; }
  float mnC = -mn * C;
#pragma unroll
  for (int r = 0; r < 16; ++r) p0[r] = fmaf(p0[r], C, mnC);
#pragma unroll
  for (int r = 0; r < 16; ++r) p1[r] = fmaf(p1[r], C, mnC);
#pragma unroll
  for (int r = 0; r < 16; ++r) p0[r] = __builtin_amdgcn_exp2f(p0[r]);
}
__device__ __forceinline__ void finishSM(f32x16& p0, f32x16& p1, float alpha, float& l_reg, bf16x8& pa0, bf16x8& pa1, bf16x8& pa2, bf16x8& pa3) {
#pragma unroll
  for (int r = 0; r < 16; ++r) p1[r] = __builtin_amdgcn_exp2f(p1[r]);
  float ps = 0;
#pragma unroll
  for (int r = 0; r < 16; ++r) ps += p0[r];
#pragma unroll
  for (int r = 0; r < 16; ++r) ps += p1[r];
  { auto rr = __builtin_amdgcn_permlane32_swap(__float_as_uint(ps), __float_as_uint(ps), false, false);
    ps = __uint_as_float(rr[0]) + __uint_as_float(rr[1]); }
  l_reg = l_reg * alpha + ps;
#define PK4(P, BASE, OUT) do { unsigned a0 = cvt_pk_bf16(P[BASE + 0], P[BASE + 1]), a1 = cvt_pk_bf16(P[BASE + 2], P[BASE + 3]);   \
    unsigned b0 = cvt_pk_bf16(P[BASE + 4], P[BASE + 5]), b1 = cvt_pk_bf16(P[BASE + 6], P[BASE + 7]);                              \
    auto r0 = __builtin_amdgcn_permlane32_swap(a0, b0, false, false); auto r1 = __builtin_amdgcn_permlane32_swap(a1, b1, false, false); \
    u32x4 w = {r0[0], r1[0], r0[1], r1[1]}; OUT = __builtin_bit_cast(bf16x8, w); } while (0)
  PK4(p0, 0, pa0); PK4(p0, 8, pa1); PK4(p1, 0, pa2); PK4(p1, 8, pa3);
}
__device__ __forceinline__ void qkt(f32x16& p0, f32x16& p1, const char* Ks, const char* Krs, const bf16x8* qr, const char* qrl, int r32, int hi) {
  p0 = f32x16{}; p1 = f32x16{};
#pragma unroll
  for (int d0 = 0; d0 < 8; ++d0) { const int cb = (d0 * 16 + hi * 8) * 2;
    bf16x8 b0 = *reinterpret_cast<const bf16x8*>(Ks + KSWZ(r32, cb));
    bf16x8 b1 = *reinterpret_cast<const bf16x8*>(Ks + KSWZ(32 + r32, cb));
    p0 = __builtin_amdgcn_mfma_f32_32x32x16_bf16(b0, qr[d0], p0, 0, 0, 0);
    p1 = __builtin_amdgcn_mfma_f32_32x32x16_bf16(b1, qr[d0], p1, 0, 0, 0); }
#pragma unroll
  for (int d0 = 0; d0 < 4; ++d0) { const int cb = (d0 * 16 + hi * 8) * 2;
    bf16x8 b0 = *reinterpret_cast<const bf16x8*>(Krs + KRSWZ(r32, cb));
    bf16x8 b1 = *reinterpret_cast<const bf16x8*>(Krs + KRSWZ(32 + r32, cb));
    const bf16x8 qq = *reinterpret_cast<const bf16x8*>(qrl + d0 * 1024);
    p0 = __builtin_amdgcn_mfma_f32_32x32x16_bf16(b0, qq, p0, 0, 0, 0);
    p1 = __builtin_amdgcn_mfma_f32_32x32x16_bf16(b1, qq, p1, 0, 0, 0); }
}
__device__ __forceinline__ int v_st(int k, int c) { const int kk = (k & ~0xC) | ((k & 4) << 1) | ((k & 8) >> 1); return ((kk >> 3) * 4 + (c >> 5)) * 512 + ((kk & 7) * 32 + (c & 31)) * 2; }
__device__ __forceinline__ int v_rd_base(int lane) { return ((lane & 3) << 3) | (((lane >> 2) & 3) << 6) | (((lane >> 4) & 1) << 5) | (((lane >> 5) & 1) << 8); }
constexpr int v_rd_off(int d0, int ks, int half) { return d0 * 512 + ks * 4096 + half * 2048; }
template <int OFF> __device__ __forceinline__ s16x4 tr_read(int vb) {
  s16x4 r; asm volatile("ds_read_b64_tr_b16 %0, %1 offset:%2" : "=&v"(r) : "v"(vb), "i"(OFF) : "memory"); return r;
}
#define PKV(L, H) (bf16x8){L[0], L[1], L[2], L[3], H[0], H[1], H[2], H[3]}
template <int D0> __device__ __forceinline__ void pv_one(f32x16& od, int vb, bf16x8 pa0, bf16x8 pa1, bf16x8 pa2, bf16x8 pa3) {
  const s16x4 l0 = tr_read<v_rd_off(D0, 0, 0)>(vb), h0 = tr_read<v_rd_off(D0, 0, 1)>(vb), l1 = tr_read<v_rd_off(D0, 1, 0)>(vb), h1 = tr_read<v_rd_off(D0, 1, 1)>(vb);
  const s16x4 l2 = tr_read<v_rd_off(D0, 2, 0)>(vb), h2 = tr_read<v_rd_off(D0, 2, 1)>(vb), l3 = tr_read<v_rd_off(D0, 3, 0)>(vb), h3 = tr_read<v_rd_off(D0, 3, 1)>(vb);
  asm volatile("s_waitcnt lgkmcnt(0)" ::: "memory"); SBAR();
  od = __builtin_amdgcn_mfma_f32_32x32x16_bf16(pa0, PKV(l0, h0), od, 0, 0, 0);
  od = __builtin_amdgcn_mfma_f32_32x32x16_bf16(pa1, PKV(l1, h1), od, 0, 0, 0);
  od = __builtin_amdgcn_mfma_f32_32x32x16_bf16(pa2, PKV(l2, h2), od, 0, 0, 0);
  od = __builtin_amdgcn_mfma_f32_32x32x16_bf16(pa3, PKV(l3, h3), od, 0, 0, 0);
}
__device__ __forceinline__ void pv_d0(f32x16* o, int vb, bf16x8 pa0, bf16x8 pa1, bf16x8 pa2, bf16x8 pa3) {
  pv_one<0>(o[0], vb, pa0, pa1, pa2, pa3); pv_one<1>(o[1], vb, pa0, pa1, pa2, pa3); pv_one<2>(o[2], vb, pa0, pa1, pa2, pa3); pv_one<3>(o[3], vb, pa0, pa1, pa2, pa3);
}

__device__ __forceinline__ void attn_body(const bf16_t* __restrict__ Qb, const float* __restrict__ cs, const bf16_t* __restrict__ Kn, const bf16_t* __restrict__ Vh,
                                          const bf16_t* __restrict__ Kr, bf16_t* __restrict__ Ob, int seq, char* lds) {
  int tid = threadIdx.x; asm volatile("" : "+v"(tid));
  const int wid = tid >> 6, lane = tid & 63, r32 = lane & 31, hi = lane >> 5;
  char* V_lds = lds + OFF_V; char* K_lds = lds + OFF_K; char* KR_lds = lds + OFF_KR;
  float* ws = (float*)(lds + OFF_WS) + wid * 64; float* li_l = ws; float* al_l = ws + 32;
  float m_reg = -1e30f, l_reg = 0; f32x16 o[4] = {}; bf16x8 qr[8];
  char* qrl = lds + OFF_QR + wid * 4096 + lane * 16;
  { const int qrow = wid * QBLK + r32;
    const unsigned qoff = (unsigned)(qrow * LDQ + hi * 8) * 2u;
    const char* Qc = (const char*)Qb;
    bf16x8 qro[4];
#pragma unroll
    for (int d0 = 0; d0 < 8; ++d0) qr[d0] = *reinterpret_cast<const bf16x8*>(Qc + qoff + d0 * 32);
#pragma unroll
    for (int d0 = 0; d0 < 4; ++d0) qro[d0] = *reinterpret_cast<const bf16x8*>(Qc + qoff + 256 + d0 * 32);
    const char* csc = (const char*)cs; const unsigned csoff = (unsigned)qrow * 256u;
#pragma unroll
    for (int a = 0; a < 2; ++a) {
      const int i0 = a * 16 + hi * 8;
      bf16x8 x1 = qro[a], x2 = qro[2 + a], y1, y2;
#pragma unroll
      for (int j = 0; j < 8; ++j) {
        const f32x2 c_s = *reinterpret_cast<const f32x2*>(csc + csoff + 8 * (i0 + j));
        const float f1 = bf2f((unsigned short)x1[j]), f2 = bf2f((unsigned short)x2[j]);
        const float g1 = f1 * c_s.x - f2 * c_s.y, g2 = f2 * c_s.x + f1 * c_s.y;
        const unsigned pk = cvt_pk_bf16(g1, g2);
        y1[j] = (short)(pk & 0xffffu); y2[j] = (short)(pk >> 16);
      }
      *reinterpret_cast<bf16x8*>(qrl + a * 1024) = y1; *reinterpret_cast<bf16x8*>(qrl + (2 + a) * 1024) = y2;
    }
  }
  const int sr = tid >> 4, sc = (tid & 15) * 8, vst0 = v_st(sr, sc), vst1 = v_st(32 + sr, sc);
  const int krr = tid >> 3, krc = (tid & 7) * 8;
  const int vb0 = (int)(uintptr_t)V_lds + v_rd_base(lane);
  constexpr int SDEPTH = ATT_SDEPTH;
  struct { bf16x8 vs0, vs1, ks0, ks1, kr0; } sr_[SDEPTH];
  const unsigned vo0 = (unsigned)(sr * LDK + sc) * 2u, vo1 = (unsigned)((32 + sr) * LDK + sc) * 2u, kro = (unsigned)(krr * LDKR + krc) * 2u;
#define SLOAD(i, k0) do { const char* vt_ = (const char*)Vh + (size_t)(k0) * (LDK * 2); const char* kt_ = (const char*)Kn + (size_t)(k0) * (LDK * 2); const char* krt_ = (const char*)Kr + (size_t)(k0) * (LDKR * 2); \
    sr_[i].vs0 = *reinterpret_cast<const bf16x8*>(vt_ + vo0); sr_[i].vs1 = *reinterpret_cast<const bf16x8*>(vt_ + vo1); \
    sr_[i].ks0 = *reinterpret_cast<const bf16x8*>(kt_ + vo0); sr_[i].ks1 = *reinterpret_cast<const bf16x8*>(kt_ + vo1); \
    sr_[i].kr0 = *reinterpret_cast<const bf16x8*>(krt_ + kro); } while (0)
#define SWRITE(b, i) do { *(bf16x8*)(V_lds + (b) * SHM_V + vst0) = sr_[i].vs0;          \
    *(bf16x8*)(V_lds + (b) * SHM_V + vst1) = sr_[i].vs1; const int kc = sc * 2;               \
    *(bf16x8*)(K_lds + (b) * SHM_K + KSWZ(sr, kc)) = sr_[i].ks0;                       \
    *(bf16x8*)(K_lds + (b) * SHM_K + KSWZ(32 + sr, kc)) = sr_[i].ks1;                  \
    *(bf16x8*)(KR_lds + (b) * SHM_KR + KRSWZ(krr, krc * 2)) = sr_[i].kr0; } while (0)
#define SWAIT() do { if constexpr (SDEPTH == 2) asm volatile("s_waitcnt vmcnt(5)" ::: "memory"); else asm volatile("s_waitcnt vmcnt(0)" ::: "memory"); } while (0)
#define RESC(a) do { if (__any((a) < 1.f)) { if (hi == 0) al_l[r32] = (a); asm volatile("s_waitcnt lgkmcnt(0)" ::: "memory"); \
    _Pragma("unroll") for (int d = 0; d < 4; ++d) _Pragma("unroll") for (int r = 0; r < 16; ++r) o[d][r] *= al_l[crow(r, hi)]; } } while (0)
  f32x16 pA0, pA1, pB0, pB1; float mnA, mnB, alA, alB; bf16x8 pa0, pa1, pa2, pa3; const int NT = seq / KVBLK;
  constexpr int SE = 0, SO = SDEPTH - 1;
  SLOAD(SE, 0); asm volatile("s_waitcnt vmcnt(0)" ::: "memory"); SWRITE(0, SE); __syncthreads();
  qkt(pA0, pA1, K_lds, KR_lds, qr, qrl, r32, hi); partialSM(pA0, pA1, m_reg, mnA, alA);
  SLOAD(SO, KVBLK); if constexpr (SDEPTH == 2) { if (2 < NT) SLOAD(SE, 2 * KVBLK); }
  SWAIT(); SWRITE(1, SO); __syncthreads();
  for (int j = 1; j + 1 < NT; j += 2) {
    SBAR(); qkt(pB0, pB1, K_lds + SHM_K, KR_lds + SHM_KR, qr, qrl, r32, hi);
    finishSM(pA0, pA1, alA, l_reg, pa0, pa1, pa2, pa3); SBAR();
    SLOAD(SO, (j + SDEPTH) * KVBLK); SBAR();
    pv_d0(o, vb0, pa0, pa1, pa2, pa3); partialSM(pB0, pB1, m_reg, mnB, alB);
    __syncthreads(); SWAIT(); SWRITE(0, SE);
    RESC(alB); __syncthreads();
    SBAR(); qkt(pA0, pA1, K_lds, KR_lds, qr, qrl, r32, hi);
    finishSM(pB0, pB1, alB, l_reg, pa0, pa1, pa2, pa3); SBAR();
    if (SDEPTH == 1 || j + 3 < NT) SLOAD(SE, (j + 1 + SDEPTH) * KVBLK); SBAR();
    pv_d0(o, vb0 + SHM_V, pa0, pa1, pa2, pa3); partialSM(pA0, pA1, m_reg, mnA, alA);
    __syncthreads(); SWAIT(); SWRITE(1, SO);
    RESC(alA); __syncthreads();
  }
  SBAR(); qkt(pB0, pB1, K_lds + SHM_K, KR_lds + SHM_KR, qr, qrl, r32, hi);
  finishSM(pA0, pA1, alA, l_reg, pa0, pa1, pa2, pa3); SBAR();
  pv_d0(o, vb0, pa0, pa1, pa2, pa3); partialSM(pB0, pB1, m_reg, mnB, alB);
  __syncthreads(); RESC(alB);
  finishSM(pB0, pB1, alB, l_reg, pa0, pa1, pa2, pa3); SBAR();
  pv_d0(o, vb0 + SHM_V, pa0, pa1, pa2, pa3);
  if (hi == 0) li_l[r32] = l_reg; asm volatile("s_waitcnt lgkmcnt(0)" ::: "memory");
  float rli[16];
#pragma unroll
  for (int r = 0; r < 16; ++r) rli[r] = __builtin_amdgcn_rcpf(li_l[crow(r, hi)]);
  __syncthreads();
  int tid2 = threadIdx.x; asm volatile("" : "+v"(tid2));
  const int wid2 = tid2 >> 6, lane2 = tid2 & 63;
  char* ot = lds + wid2 * (32 * 272);
#pragma unroll
  for (int r = 0; r < 16; ++r) { const int orow = crow(r, lane2 >> 5);
#pragma unroll
    for (int d0 = 0; d0 < 4; ++d0) *(bf16_t*)(ot + orow * 272 + (d0 * 32 + (lane2 & 31)) * 2) = (bf16_t)(cvt_pk_bf16(o[d0][r] * rli[r], 0.f) & 0xffffu); }
  asm volatile("s_waitcnt lgkmcnt(0)" ::: "memory");
  char* Oc = (char*)Ob;
#pragma unroll
  for (int i = 0; i < 8; ++i) { const int id = lane2 + 64 * i, row = id >> 4, ch = id & 15;
    const u32x4 v = *(const u32x4*)(ot + row * 272 + ch * 16);
    *(u32x4*)(Oc + (unsigned)((wid2 * QBLK + row) * LDO + ch * 8) * 2u) = v; }
  __syncthreads();
#undef SLOAD
#undef SWRITE
#undef SWAIT
#undef RESC
}
}

namespace mls {
constexpr int OFF_Q = 0, OFF_K = 16384, OFF_VA = 32768, OFF_VB = 49152, OFF_C = 57344, OFF_N = 65536, OFF_VEC = 73728, LDS_NEED = 73728 + 1024;
__device__ __forceinline__ unsigned off_b(unsigned row, unsigned ch) { return 256u * row + 16u * (ch ^ (((row & 3) << 2) | ((row >> 2) & 3))); }
__device__ __forceinline__ unsigned off_vb(unsigned row, unsigned ch) { return 1024u * (row >> 3) + 512u * (ch >> 2) + 64u * (row & 7) + 16u * ((ch & 3) ^ ((row >> 2) & 3)); }
__device__ __forceinline__ s16x4 trr(unsigned addr) { s16x4 r; asm volatile("ds_read_b64_tr_b16 %0, %1" : "=&v"(r) : "v"(addr) : "memory"); return r; }

struct Tensors { const bf16_t* qkc; const bf16_t* proj; const float* gvec; float* hs; };

__device__ __forceinline__ void scan_unit(const Tensors& Tn, int unit, char* lds) {
  int tid = threadIdx.x; asm volatile("" : "+v"(tid));
  const int wid = __builtin_amdgcn_readfirstlane(tid >> 6), lane = tid & 63, r32 = lane & 31, hi = lane >> 5;
  const int chain = unit >> 3, vs = unit & 7, dir = chain >> 4, bb = (chain >> 2) & 3, hd = chain & 3;
  const unsigned lbase = (unsigned)(uintptr_t)lds;
  float* vec = (float*)(lds + OFF_VEC);
  unsigned qko[2];
#pragma unroll
  for (int i = 0; i < 2; ++i) { const int idx = tid + 512 * i, row = idx >> 4, ch = idx & 15; qko[i] = (unsigned)(((dir ? 63 - row : row) * 1024 + ch * 8) * 2); }
  const int vrow = (tid & 255) >> 2, vch = tid & 3;
  const unsigned vo = (unsigned)(((dir ? 63 - vrow : vrow) * ML_INP + vch * 8) * 2), awo = (unsigned)vrow * 4u;
  const char* gvb = (const char*)Tn.gvec + (size_t)chain * SEQ * 4;
  const unsigned veo = (unsigned)((tid >> 6) * 32 * SEQ + (tid & 63)) * 4u;
  const char* awsrc = gvb + (size_t)3 * 32 * SEQ * 4;
  bf16x8 sq[2], sk[2], sv; float sawl = 0.f, svec = 0.f;
#define TB(c) ((size_t)bb * SEQ + (dir ? (SEQ - 64 * ((c) + 1)) : 64 * (c)))
#define MLOAD(c) do { const size_t tb_ = TB(c); \
    const char* qb_ = (const char*)Tn.qkc + (tb_ * 1024 + hd * 128) * 2; const char* kb_ = qb_ + 1024; \
    const char* vb_ = (const char*)Tn.proj + (tb_ * ML_INP + 1024 + hd * 256 + vs * 32) * 2; \
    _Pragma("unroll") for (int i = 0; i < 2; ++i) { sq[i] = *reinterpret_cast<const bf16x8*>(qb_ + qko[i]); sk[i] = *reinterpret_cast<const bf16x8*>(kb_ + qko[i]); } \
    sv = *reinterpret_cast<const bf16x8*>(vb_ + vo); sawl = *reinterpret_cast<const float*>(awsrc + (size_t)(c) * 256 + awo); \
    if (tid < 192) svec = *reinterpret_cast<const float*>(gvb + (size_t)(c) * 256 + veo); } while (0)
#define MWRITE() do { \
    _Pragma("unroll") for (int i = 0; i < 2; ++i) { const int idx = tid + 512 * i, row = idx >> 4, ch = idx & 15; \
      *(bf16x8*)(lds + OFF_Q + off_b(row, ch)) = sq[i]; *(bf16x8*)(lds + OFF_K + off_b(row, ch)) = sk[i]; } \
    if (tid < 256) { *(bf16x8*)(lds + OFF_VA + att::v_st(vrow, vch * 8)) = sv; \
      float f[8]; _Pragma("unroll") for (int j = 0; j < 8; ++j) f[j] = bf2f((unsigned short)sv[j]) * sawl; \
      u32x4 w; w.x = cvt_pk_bf16(f[0], f[1]); w.y = cvt_pk_bf16(f[2], f[3]); w.z = cvt_pk_bf16(f[4], f[5]); w.w = cvt_pk_bf16(f[6], f[7]); \
      *(u32x4*)(lds + OFF_VB + off_vb(vrow, vch)) = w; } \
    else { const unsigned a = cvt_pk_bf16(sawl, sawl); u32x4 w = {a, a, a, a}; *(u32x4*)(lds + OFF_VB + off_vb(vrow, 4 + vch)) = w; } \
    if (tid < 192) vec[tid] = svec; } while (0)

  f32x16 Cst = {}, Nst = {};
  float m = 0.f;
  const int blk = wid - 2;
  MLOAD(0);
  asm volatile("s_waitcnt vmcnt(0)" ::: "memory");
  MWRITE();
  if (wid >= 2 && wid < 6) {
#pragma unroll
    for (int g = 0; g < 4; ++g) { const unsigned a = off_b(r32, 4 * blk + g) + 8 * hi; *(u32x2*)(lds + OFF_C + a) = (u32x2){0u, 0u}; *(u32x2*)(lds + OFF_N + a) = (u32x2){0u, 0u}; }
  }
  __syncthreads();
  const bf16x8 ones = {(short)0x3F80, (short)0x3F80, (short)0x3F80, (short)0x3F80, (short)0x3F80, (short)0x3F80, (short)0x3F80, (short)0x3F80};
  const int th = wid & 1;
  const unsigned hso = (unsigned)(((dir ? 63 - 32 * th - 4 * hi : 32 * th + 4 * hi) * D + hd * 256 + vs * 32 + r32) * 4);
  const int hstep = dir ? -(D * 4) : (D * 4);
  for (int c = 0; c < 64; ++c) {
    if (c + 1 < 64) MLOAD(c + 1);
    const float pm63 = vec[128 + 63], bL = vec[63];
    const float Mx = fmaxf(m, pm63);
    if (wid < 2) {
      int ln_ = lane; asm volatile("" : "+v"(ln_));
      const int r32 = ln_ & 31, hi = ln_ >> 5;
      f32x16 qc = {}, qn = {}, p0 = {}, p1 = {};
      {
        bf16x8 qf[8];
#pragma unroll
        for (int ks = 0; ks < 8; ++ks) qf[ks] = *(const bf16x8*)(lds + OFF_Q + off_b(32 * th + r32, 2 * ks + hi));
#pragma unroll
        for (int ks = 0; ks < 8; ++ks) {
          const bf16x8 cf = *(const bf16x8*)(lds + OFF_C + off_b(r32, 2 * ks + hi));
          const bf16x8 nf = *(const bf16x8*)(lds + OFF_N + off_b(r32, 2 * ks + hi));
          qc = __builtin_amdgcn_mfma_f32_32x32x16_bf16(qf[ks], cf, qc, 0, 0, 0);
          qn = __builtin_amdgcn_mfma_f32_32x32x16_bf16(qf[ks], nf, qn, 0, 0, 0);
        }
#pragma unroll
        for (int ks = 0; ks < 8; ++ks) {
          const bf16x8 k0 = *(const bf16x8*)(lds + OFF_K + off_b(r32, 2 * ks + hi));
          const bf16x8 k1 = *(const bf16x8*)(lds + OFF_K + off_b(32 + r32, 2 * ks + hi));
          p0 = __builtin_amdgcn_mfma_f32_32x32x16_bf16(k0, qf[ks], p0, 0, 0, 0);
          p1 = __builtin_amdgcn_mfma_f32_32x32x16_bf16(k1, qf[ks], p1, 0, 0, 0);
        }
      }
      const int t = 32 * th + r32;
      const float Mt = fmaxf(m, vec[128 + t]);
#pragma unroll
      for (int r = 0; r < 16; ++r) { const int s0 = att::crow(r, hi), s1 = 32 + s0;
        const float w0 = (s0 <= t) ? fast_exp(vec[64 + s0] - Mt) : 0.f, w1 = (s1 <= t) ? fast_exp(vec[64 + s1] - Mt) : 0.f;
        p0[r] *= w0; p1[r] *= w1; }
      bf16x8 pa0, pa1, pa2, pa3;
      PK4(p0, 0, pa0); PK4(p0, 8, pa1); PK4(p1, 0, pa2); PK4(p1, 8, pa3);
      f32x16 pv = {}, pd = {};
      att::pv_one<0>(pv, (int)(lbase + OFF_VA) + att::v_rd_base(ln_), pa0, pa1, pa2, pa3);
      pd = __builtin_amdgcn_mfma_f32_32x32x16_bf16(pa0, ones, pd, 0, 0, 0);
      pd = __builtin_amdgcn_mfma_f32_32x32x16_bf16(pa1, ones, pd, 0, 0, 0);
      pd = __builtin_amdgcn_mfma_f32_32x32x16_bf16(pa2, ones, pd, 0, 0, 0);
      pd = __builtin_amdgcn_mfma_f32_32x32x16_bf16(pa3, ones, pd, 0, 0, 0);
      char* hsb = (char*)Tn.hs + ((size_t)dir * T + TB(c)) * (D * 4);
#pragma unroll
      for (int r = 0; r < 16; ++r) { const int rr = (r & 3) + 8 * (r >> 2), tr_ = 32 * th + 4 * hi + rr;
        const float Mr = fmaxf(m, vec[128 + tr_]), gw = fast_exp(m - Mr), en = fast_exp(-(vec[tr_] + Mr));
        const float num = gw * qc[r] + pv[r], den = gw * qn[r] + pd[r];
        const float h = num * fast_rcp(fmaxf(fabsf(den), en));
        *(float*)(hsb + (unsigned)((int)hso + rr * hstep)) = h; }
    } else if (wid < 6) {
      int ln_ = lane; asm volatile("" : "+v"(ln_));
      const int hi = ln_ >> 5;
      f32x16 kv = {}, kn = {};
#pragma unroll
      for (int ks = 0; ks < 4; ++ks) {
        const unsigned hb = (ln_ >> 4) & 1, q = (ln_ & 15) >> 2, p = ln_ & 3;
        const unsigned row0 = 16 * ks + 8 * hi + q;
        const s16x4 ka = trr(lbase + OFF_K + off_b(row0, 4 * blk + 2 * hb + (p >> 1)) + 8 * (p & 1));
        const s16x4 kb = trr(lbase + OFF_K + off_b(row0 + 4, 4 * blk + 2 * hb + (p >> 1)) + 8 * (p & 1));
        const s16x4 va = trr(lbase + OFF_VB + off_vb(row0, 2 * hb + (p >> 1)) + 8 * (p & 1));
        const s16x4 vb_ = trr(lbase + OFF_VB + off_vb(row0 + 4, 2 * hb + (p >> 1)) + 8 * (p & 1));
        const s16x4 aa = trr(lbase + OFF_VB + off_vb(row0, 4 + 2 * hb + (p >> 1)) + 8 * (p & 1));
        const s16x4 ab = trr(lbase + OFF_VB + off_vb(row0 + 4, 4 + 2 * hb + (p >> 1)) + 8 * (p & 1));
        asm volatile("s_waitcnt lgkmcnt(0)" ::: "memory"); __builtin_amdgcn_sched_barrier(0);
        const bf16x8 kf = PKV(ka, kb), vf = PKV(va, vb_), af = PKV(aa, ab);
        kv = __builtin_amdgcn_mfma_f32_32x32x16_bf16(kf, vf, kv, 0, 0, 0);
        kn = __builtin_amdgcn_mfma_f32_32x32x16_bf16(kf, af, kn, 0, 0, 0);
      }
      const float cw = fast_exp(m - Mx), sc = fast_exp(pm63 - Mx);
#pragma unroll
      for (int r = 0; r < 16; ++r) { Cst[r] = cw * Cst[r] + sc * kv[r]; Nst[r] = cw * Nst[r] + sc * kn[r]; }
    }
    m = bL + Mx;
    __syncthreads();
    if (c + 1 < 64) {
      asm volatile("s_waitcnt vmcnt(0)" ::: "memory");
      MWRITE();
      if (wid >= 2 && wid < 6) {
#pragma unroll
        for (int g = 0; g < 4; ++g) { const unsigned a = off_b(r32, 4 * blk + g) + 8 * hi;
          *(u32x2*)(lds + OFF_C + a) = (u32x2){cvt_pk_bf16(Cst[4 * g], Cst[4 * g + 1]), cvt_pk_bf16(Cst[4 * g + 2], Cst[4 * g + 3])};
          *(u32x2*)(lds + OFF_N + a) = (u32x2){cvt_pk_bf16(Nst[4 * g], Nst[4 * g + 1]), cvt_pk_bf16(Nst[4 * g + 2], Nst[4 * g + 3])}; }
      }
    }
    __syncthreads();
  }
#undef TB
#undef MLOAD
#undef MWRITE
}
}

#define XB_TMO      128
#define XB_XCNT(j)  (256  + 64 * (j))
#define XB_XSUB(j)  (1280 + 64 * (j))
#define XB_XGEN(j)  (2304 + 64 * (j))
#define XB_TOP      3328
#define XB_TOPGEN   3392
#define XCD_BAR_WORDS 3456
#define XB_SPIN_CAP (1u << 18)
__device__ __forceinline__ unsigned xb_ld(unsigned* p)              { return __hip_atomic_load(p, __ATOMIC_RELAXED, __HIP_MEMORY_SCOPE_AGENT); }
__device__ __forceinline__ unsigned xb_add(unsigned* p, unsigned v) { return __hip_atomic_fetch_add(p, v, __ATOMIC_RELAXED, __HIP_MEMORY_SCOPE_AGENT); }
__device__ __forceinline__ unsigned xb_xcc_id() { return (unsigned)__builtin_amdgcn_s_getreg((3 << 11) | 20) & 0xFu; }
#define XB_SPIN(cond, bar) do { unsigned _sp = 0; while (cond) { __builtin_amdgcn_s_sleep(1); \
    if ((++_sp & 255u) == 0u) { if (xb_ld(&(bar)[XB_TMO])) break; if (_sp > XB_SPIN_CAP) { atomicAdd(&(bar)[XB_TMO], 1u); break; } } } } while (0)
struct XcdBarrier { unsigned* bar; unsigned x; volatile LAS unsigned* st; };
__device__ __forceinline__ XcdBarrier xcd_barrier_post(unsigned* bar, volatile LAS unsigned* st) {
    XcdBarrier b; b.bar = bar; b.x = xb_xcc_id(); b.st = st;
    if (threadIdx.x == 0) (void)xb_add(&bar[XB_XCNT(b.x)], 1u);
    return b;
}
__device__ __forceinline__ void xcd_barrier_complete(unsigned* bar, unsigned x, unsigned& nloc, unsigned& nx) {
    const unsigned G = gridDim.x * gridDim.y * gridDim.z;
    unsigned sum, cnt, mine, sp = 0u;
    for (;;) {
        sum = 0u; cnt = 0u; mine = 0u;
#pragma unroll
        for (unsigned j = 0; j < 16; ++j) { const unsigned c = xb_ld(&bar[XB_XCNT(j)]); sum += c; cnt += (c > 0u) ? 1u : 0u; mine = (j == x) ? c : mine; }
        if (sum == G) break;
        __builtin_amdgcn_s_sleep(1);
        if ((++sp & 255u) == 0u) { if (xb_ld(&bar[XB_TMO])) break; if (sp > XB_SPIN_CAP) { atomicAdd(&bar[XB_TMO], 1u); break; } }
    }
    nloc = mine > 0u ? mine : 1u; nx = cnt > 0u ? cnt : 1u;
}
__device__ __forceinline__ void xcd_barrier(const XcdBarrier& b) {
    asm volatile("s_waitcnt vmcnt(0)" ::: "memory");
    __syncthreads();
    if (threadIdx.x == 0) {
        unsigned* bar = b.bar;
        __builtin_amdgcn_s_waitcnt(0);
        unsigned nloc = b.st[0], nx = b.st[1];
        if (nloc == 0u) { xcd_barrier_complete(bar, b.x, nloc, nx); b.st[0] = nloc; b.st[1] = nx; }
        const unsigned old = xb_add(&bar[XB_XSUB(b.x)], 1u);
        const unsigned gen = old / nloc;
        if (old + 1u == (gen + 1u) * nloc) {
            __builtin_amdgcn_fence(__ATOMIC_RELEASE, "agent");
            asm volatile("s_waitcnt vmcnt(0)" ::: "memory");
            const unsigned og = xb_add(&bar[XB_TOP], 1u);
            const unsigned tg = og / nx;
            if (og + 1u == (tg + 1u) * nx) xb_add(&bar[XB_TOPGEN], 1u);
            else XB_SPIN(xb_ld(&bar[XB_TOPGEN]) == tg, bar);
            __builtin_amdgcn_fence(__ATOMIC_ACQUIRE, "agent");
            xb_add(&bar[XB_XGEN(b.x)], 1u);
            asm volatile("s_waitcnt vmcnt(0)" ::: "memory");
        } else {
            XB_SPIN(xb_ld(&bar[XB_XGEN(b.x)]) == gen, bar);
            __builtin_amdgcn_fence(__ATOMIC_ACQUIRE, "agent");
            asm volatile("s_waitcnt vmcnt(0)" ::: "memory");
        }
    }
    __syncthreads();
}

struct Args { const float* in[24]; float* out; unsigned char* ws; int ph_lo, ph_hi; };
constexpr int NPH = 38;
struct Frame {
    char* lds; int tid, lane, wave, G, bid;
    unsigned char* ws;
};

struct CvtJob { const float* src; bf16_t* dst; int K, N, sld; int grp, gstride, goff; const float* sk; const float* sn; };
__device__ __forceinline__ void cvt_tiles(const Frame& F, const CvtJob& j, int& rot) {
    float* tile = (float*)F.lds;
    const int tk = j.K / 64, tn = j.N / 64, nt = tk * tn;
    int start = F.bid - (rot % F.G); if (start < 0) start += F.G;
    for (int it = start; it < nt; it += F.G) {
        const int k0 = (it / tn) * 64, n0 = (it % tn) * 64;
        __syncthreads();
#pragma unroll
        for (int i = 0; i < 8; ++i) { const int k = i * 8 + (F.tid >> 6), n = F.tid & 63;
            float v = j.src[(size_t)(k0 + k) * j.sld + n0 + n];
            if (j.sk) v *= j.sk[k0 + k];
            if (j.sn) v *= j.sn[n0 + n];
            tile[k * 65 + n] = v; }
        __syncthreads();
        { const int n = F.tid >> 3, kc = F.tid & 7; float f[8];
#pragma unroll
          for (int q = 0; q < 8; ++q) f[q] = tile[(kc * 8 + q) * 65 + n];
          u32x4 w; w.x = cvt_pk_bf16(f[0], f[1]); w.y = cvt_pk_bf16(f[2], f[3]); w.z = cvt_pk_bf16(f[4], f[5]); w.w = cvt_pk_bf16(f[6], f[7]);
          const int nn = n0 + n, drow = (nn / j.grp) * j.gstride + j.goff + (nn % j.grp);
          *(u32x4*)(j.dst + (size_t)drow * j.K + k0 + kc * 8) = w; }
    }
    rot += nt;
}
__device__ __forceinline__ CvtJob mkjob(const float* src, bf16_t* dst, int K, int N, int sld) { CvtJob j; j.src = src; j.dst = dst; j.K = K; j.N = N; j.sld = sld; j.grp = N; j.gstride = 0; j.goff = 0; j.sk = nullptr; j.sn = nullptr; return j; }

__device__ __forceinline__ void phase_convert_small(const Frame& F, const Args& a) {
    bf16_t* W = (bf16_t*)(F.ws + WS_W); int rot = 0;
    for (int j = 0; j < 2; ++j) {
        { CvtJob c = mkjob(a.in[2] + (size_t)j * D * MLA_IN, (bf16_t*)((char*)W + W_DQKV) + (size_t)j * MLA_INP * D, D, MLA_IN, MLA_IN); cvt_tiles(F, c, rot); }
        { CvtJob c = mkjob(a.in[4] + (size_t)j * MLA_QR * MLA_QW, (bf16_t*)((char*)W + W_UQ) + (size_t)j * MLA_QW * MLA_QR, MLA_QR, MLA_QW, MLA_QW); c.sk = a.in[3] + j * MLA_QR; cvt_tiles(F, c, rot); }
        { CvtJob c = mkjob(a.in[6] + (size_t)j * MLA_KVR * MLA_KVW, (bf16_t*)((char*)W + W_UKV) + (size_t)j * MLA_KVW * MLA_KVR, MLA_KVR, MLA_KVW, MLA_KVW); c.sk = a.in[5] + j * MLA_KVR; cvt_tiles(F, c, rot); }
        { CvtJob c = mkjob(a.in[7] + (size_t)j * D * D, (bf16_t*)((char*)W + W_O) + (size_t)j * D * D, D, D, D); cvt_tiles(F, c, rot); }
        { bf16_t* z = (bf16_t*)((char*)W + W_DQKV) + (size_t)j * MLA_INP * D + (size_t)MLA_IN * D;
          for (int i = F.bid * NTHR + F.tid; i < (MLA_INP - MLA_IN) * D / 8; i += F.G * NTHR) *(u32x4*)(z + (size_t)i * 8) = (u32x4){0u, 0u, 0u, 0u}; }
    }
    for (int g = 0; g < 4; ++g) { CvtJob c = mkjob(a.in[8] + (size_t)g * 256 * 256, (bf16_t*)((char*)W + W_POOL) + (size_t)g * 256 * 256, 256, 256, 256); c.sn = a.in[9] + g * 256; cvt_tiles(F, c, rot); }
    { CvtJob c = mkjob(a.in[10], (bf16_t*)((char*)W + W_IN), D, ML_INP, ML_IN); cvt_tiles(F, c, rot); }
    { CvtJob c = mkjob(a.in[14], (bf16_t*)((char*)W + W_OUT), D, D, D); cvt_tiles(F, c, rot); }
    for (int j = 0; j < 2; ++j) {
        { CvtJob c = mkjob(a.in[15] + (size_t)j * D * DFF, (bf16_t*)((char*)W + W_GU) + (size_t)j * 2 * DFF * D, D, DFF, DFF); c.grp = 128; c.gstride = 256; c.goff = 0; cvt_tiles(F, c, rot); }
        { CvtJob c = mkjob(a.in[16] + (size_t)j * D * DFF, (bf16_t*)((char*)W + W_GU) + (size_t)j * 2 * DFF * D, D, DFF, DFF); c.grp = 128; c.gstride = 256; c.goff = 128; cvt_tiles(F, c, rot); }
        { CvtJob c = mkjob(a.in[17] + (size_t)j * DFF * D, (bf16_t*)((char*)W + W_DN) + (size_t)j * D * DFF, DFF, D, D); cvt_tiles(F, c, rot); }
    }
    { const float* x = a.in[0]; bf16_t* xb = (bf16_t*)(F.ws + WS_XB);
      for (size_t i = (size_t)F.bid * NTHR + F.tid; i < (size_t)T * D / 8; i += (size_t)F.G * NTHR) {
          const f32x4 v0 = *(const f32x4*)(x + i * 8), v1 = *(const f32x4*)(x + i * 8 + 4);
          u32x4 w; w.x = cvt_pk_bf16(v0[0], v0[1]); w.y = cvt_pk_bf16(v0[2], v0[3]); w.z = cvt_pk_bf16(v1[0], v1[1]); w.w = cvt_pk_bf16(v1[2], v1[3]);
          *(u32x4*)(xb + i * 8) = w; } }
}
__device__ __forceinline__ void phase_convert_moe(const Frame& F, const Args& a, int c) {
    bf16_t* GU = (bf16_t*)(F.ws + WS_WMOE + WM_GU); bf16_t* DN = (bf16_t*)(F.ws + WS_WMOE + WM_DN); int rot = 0;
    for (int e = 0; e < NEXP; ++e) {
        const size_t eo = ((size_t)c * NEXP + e) * (size_t)D * DFFE;
        { CvtJob j = mkjob(a.in[19] + eo, GU + (size_t)e * 2 * DFFE * D, D, DFFE, DFFE); j.grp = 128; j.gstride = 256; j.goff = 0; cvt_tiles(F, j, rot); }
        { CvtJob j = mkjob(a.in[20] + eo, GU + (size_t)e * 2 * DFFE * D, D, DFFE, DFFE); j.grp = 128; j.gstride = 256; j.goff = 128; cvt_tiles(F, j, rot); }
        { CvtJob j = mkjob(a.in[21] + eo, DN + (size_t)e * D * DFFE, DFFE, D, D); cvt_tiles(F, j, rot); }
    }
}

template <int MODE>
__device__ __forceinline__ void phase_ln(const Frame& F, const float* xin, const float* y, float* xout, bf16_t* xb, const float* g, const float* b,
                                         const float* wproj  , const float* bgate) {
    constexpr bool MOE_IN = MODE & 1, ROUTER = (MODE & 2) != 0, GATES = (MODE & 4) != 0, FINAL = (MODE & 8) != 0;
    constexpr int NP = ROUTER ? 8 : (GATES ? 16 : 0); constexpr int NPA = NP ? NP : 4;
    float* wl = (float*)F.lds;
    int* sel = (int*)(F.lds + 65536);
    const int* toke = (const int*)(F.ws + WS_META + MT_TOKE); const float* tokw = (const float*)(F.ws + WS_META + MT_TOKW);
    if constexpr (NP != 0) {
        for (int i = F.tid; i < 1024 * NPA; i += NTHR) { const int c = i / NPA, p = i % NPA; wl[i] = ROUTER ? wproj[c * 8 + p] : wproj[(size_t)c * ML_IN + ML_INP + p]; }
        __syncthreads();
    }
    f32x4 gg[4], bb[4];
#pragma unroll
    for (int j = 0; j < 4; ++j) { gg[j] = *(const f32x4*)(g + F.lane * 4 + 256 * j); bb[j] = *(const f32x4*)(b + F.lane * 4 + 256 * j); }
    for (int blk = F.bid; blk < T / 64; blk += F.G) {
        for (int rr = 0; rr < 8; ++rr) {
            const int row = blk * 64 + F.wave * 8 + rr;
            f32x4 v[4]; float w1 = 0.f, w2 = 0.f;
            if (MOE_IN) { w1 = tokw[row * 2]; w2 = tokw[row * 2 + 1]; }
#pragma unroll
            for (int j = 0; j < 4; ++j) { const int c = F.lane * 4 + 256 * j;
                const f32x4 xv = *(const f32x4*)(xin + (size_t)row * D + c);
                f32x4 yv;
                if (MOE_IN) { const f32x4 ya = *(const f32x4*)(y + (size_t)(2 * row) * D + c), yb = *(const f32x4*)(y + (size_t)(2 * row + 1) * D + c); yv = ya * w1 + yb * w2; }
                else yv = *(const f32x4*)(y + (size_t)row * D + c);
                v[j] = xv * DN_ALPHA + yv; }
            float s = 0.f;
#pragma unroll
            for (int j = 0; j < 4; ++j) s += (v[j][0] + v[j][1]) + (v[j][2] + v[j][3]);
            const float mu = wave_sum(s) * (1.0f / 1024.0f);
            float q = 0.f;
#pragma unroll
            for (int j = 0; j < 4; ++j) { const f32x4 d = v[j] - mu; q += (d[0] * d[0] + d[1] * d[1]) + (d[2] * d[2] + d[3] * d[3]); }
            const float rstd = 1.0f / sqrtf(wave_sum(q) * (1.0f / 1024.0f) + LN_EPS);
#pragma unroll
            for (int j = 0; j < 4; ++j) { const int c = F.lane * 4 + 256 * j;
                v[j] = (v[j] - mu) * rstd * gg[j] + bb[j];
                *(f32x4*)(xout + (size_t)row * D + c) = v[j];
                if (!FINAL) { u32x2 w; w.x = cvt_pk_bf16(v[j][0], v[j][1]); w.y = cvt_pk_bf16(v[j][2], v[j][3]); *(u32x2*)(xb + (size_t)row * D + c) = w; } }
            if constexpr (NP != 0) {
                float pr[NPA];
#pragma unroll
                for (int p = 0; p < NP; ++p) pr[p] = 0.f;
#pragma unroll
                for (int j = 0; j < 4; ++j)
#pragma unroll
                    for (int i = 0; i < 4; ++i) { const int c = F.lane * 4 + 256 * j + i;
#pragma unroll
                        for (int p4 = 0; p4 < NPA / 4; ++p4) { const f32x4 wv = *(const f32x4*)(wl + c * NPA + p4 * 4);
                            pr[p4 * 4 + 0] += v[j][i] * wv[0]; pr[p4 * 4 + 1] += v[j][i] * wv[1]; pr[p4 * 4 + 2] += v[j][i] * wv[2]; pr[p4 * 4 + 3] += v[j][i] * wv[3]; } }
#pragma unroll
                for (int p = 0; p < NP; ++p) pr[p] = wave_sum(pr[p]);
                if constexpr (ROUTER) {
                    int e1 = 0; float v1 = pr[0];
#pragma unroll
                    for (int p = 1; p < 8; ++p) if (pr[p] > v1) { v1 = pr[p]; e1 = p; }
                    int e2 = -1; float v2 = -3.0e38f;
#pragma unroll
                    for (int p = 0; p < 8; ++p) if (p != e1 && pr[p] > v2) { v2 = pr[p]; e2 = p; }
                    const float ww2 = 1.0f / (1.0f + expf(v1 - v2)), ww1 = 1.0f - ww2;
                    if (F.lane == 0) { int* te = (int*)(F.ws + WS_META + MT_TOKE); float* tw = (float*)(F.ws + WS_META + MT_TOKW);
                        te[row * 2] = e1; te[row * 2 + 1] = e2; tw[row * 2] = ww1; tw[row * 2 + 1] = ww2;
                        sel[F.wave * 16 + rr * 2] = e1; sel[F.wave * 16 + rr * 2 + 1] = e2; }
                }
                if constexpr (GATES) { if (F.lane < 16) { float gv = 0.f;
#pragma unroll
                        for (int p = 0; p < 16; ++p) gv = (F.lane == p) ? pr[p] : gv;
                        ((float*)(F.ws + WS_META + MT_GATES))[(size_t)row * 16 + F.lane] = gv + bgate[F.lane]; } }
            }
        }
        if constexpr (ROUTER) {
            __syncthreads();
            if (F.tid < 128) { const int e = sel[F.tid]; int rk = 0; for (int p = 0; p < F.tid; ++p) rk += (sel[p] == e) ? 1 : 0;
                const int row = blk * 64 + (F.tid >> 4) * 8 + ((F.tid & 15) >> 1);
                ((int*)(F.ws + WS_META + MT_RANK))[row * 2 + (F.tid & 1)] = rk; }
            if (F.tid >= 128 && F.tid < 136) { const int e = F.tid - 128; int cn = 0; for (int p = 0; p < 128; ++p) cn += (sel[p] == e) ? 1 : 0;
                ((int*)(F.ws + WS_META + MT_CNTW))[blk * 8 + e] = cn; }
            __syncthreads();
        }
    }
    (void)toke;
}

__device__ __forceinline__ void phase_moe_permute(const Frame& F) {
    int* cl = (int*)F.lds;
    int* tot = cl + 2048; int* toff = cl + 2056; int* base = cl + 2072;
    const int* cntw = (const int*)(F.ws + WS_META + MT_CNTW);
    for (int i = F.tid; i < 2048; i += NTHR) cl[i] = cntw[i];
    __syncthreads();
    if (F.tid < 8) { int s = 0; for (int w = 0; w < 256; ++w) s += cl[w * 8 + F.tid]; tot[F.tid] = s; }
    __syncthreads();
    if (F.tid == 0) { int o = 0; for (int e = 0; e < 8; ++e) { toff[e] = o; o += (tot[e] + 255) >> 8; } toff[8] = o;
        if (F.bid == 0) { int* meta = (int*)(F.ws + WS_META + MT_MOE); for (int e = 0; e < 8; ++e) meta[e] = tot[e]; for (int e = 0; e < 9; ++e) meta[8 + e] = toff[e]; } }
    __syncthreads();
    const int* toke = (const int*)(F.ws + WS_META + MT_TOKE); const int* rank = (const int*)(F.ws + WS_META + MT_RANK);
    int* rowtok = (int*)(F.ws + WS_META + MT_ROWTOK);
    const bf16_t* xb = (const bf16_t*)(F.ws + WS_XB); bf16_t* xp = (bf16_t*)(F.ws + WS_SCR + SC_XP);
    for (int blk = F.bid; blk < T / 64; blk += F.G) {
        __syncthreads();
        if (F.tid < 8) { int s = 0; for (int w = 0; w < blk; ++w) s += cl[w * 8 + F.tid]; base[F.tid] = toff[F.tid] * 256 + s; }
        __syncthreads();
        for (int pp = F.wave; pp < 128; pp += NWAVES) {
            const int tok = blk * 64 + (pp >> 1), k = pp & 1, e = toke[tok * 2 + k], row = base[e] + rank[tok * 2 + k];
            const u32x4 v0 = *(const u32x4*)(xb + (size_t)tok * D + F.lane * 8), v1 = *(const u32x4*)(xb + (size_t)tok * D + 512 + F.lane * 8);
            *(u32x4*)(xp + (size_t)row * D + F.lane * 8) = v0; *(u32x4*)(xp + (size_t)row * D + 512 + F.lane * 8) = v1;
            if (F.lane == 0) rowtok[row] = tok * 2 + k;
        }
    }
}

__device__ __forceinline__ void phase_mla_rows(const Frame& F, const int* positions) {
    const float* lat = (const float*)(F.ws + WS_SCR + SC_LAT);
    bf16_t* cqn = (bf16_t*)(F.ws + WS_SCR + SC_CQN); bf16_t* ckvn = (bf16_t*)(F.ws + WS_SCR + SC_CKVN); bf16_t* kr = (bf16_t*)(F.ws + WS_SCR + SC_KR);
    float* rope = (float*)(F.ws + WS_META + MT_ROPE);
    for (int row = F.bid * NWAVES + F.wave; row < T; row += F.G * NWAVES) {
        const float* lr = lat + (size_t)row * MLA_INP;
        float cq[6], ck[4]; float s1 = 0.f, s2 = 0.f;
#pragma unroll
        for (int j = 0; j < 6; ++j) { cq[j] = lr[F.lane + 64 * j]; s1 += cq[j] * cq[j]; }
#pragma unroll
        for (int j = 0; j < 4; ++j) { ck[j] = lr[MLA_QR + F.lane + 64 * j]; s2 += ck[j] * ck[j]; }
        const float r1 = 1.0f / sqrtf(wave_sum(s1) * (1.0f / MLA_QR) + RMS_EPS), r2 = 1.0f / sqrtf(wave_sum(s2) * (1.0f / MLA_KVR) + RMS_EPS);
#pragma unroll
        for (int j = 0; j < 6; ++j) cqn[(size_t)row * MLA_QR + F.lane + 64 * j] = (bf16_t)(cvt_pk_bf16(cq[j] * r1, 0.f) & 0xffffu);
#pragma unroll
        for (int j = 0; j < 4; ++j) ckvn[(size_t)row * MLA_KVR + F.lane + 64 * j] = (bf16_t)(cvt_pk_bf16(ck[j] * r2, 0.f) & 0xffffu);
        const float kx = lr[MLA_QR + MLA_KVR + F.lane];
        const float ko = __shfl_xor(kx, 32);
        const int i = F.lane & 31;
        const float invf = exp2f(-(float)i * (13.287712379549449f / 32.0f));
        const float ang = (float)positions[row] * invf;
        const double rev = (double)ang * 0.15915494309189535;
        const float fr = (float)(rev - floor(rev));
        const float sn = __builtin_amdgcn_sinf(fr), cs = __builtin_amdgcn_cosf(fr);
        const float out = (F.lane < 32) ? (kx * cs - ko * sn) : (kx * cs + ko * sn);
        kr[(size_t)row * MLA_ROPE + F.lane] = (bf16_t)(cvt_pk_bf16(out, 0.f) & 0xffffu);
        if (F.lane < 32) *(f32x2*)(rope + (size_t)row * 64 + 2 * i) = (f32x2){cs, sn};
    }
}

__device__ __forceinline__ void phase_pool_z(const Frame& F) {
    const float* x = (const float*)(F.ws + WS_X); bf16_t* z = (bf16_t*)(F.ws + WS_SCR + SC_Z);
    const int c = F.tid * 2, half = 1 << (c >> 8);
    for (int blk = F.bid; blk < T / 64; blk += F.G) {
        const int b0 = (blk * 64) / SEQ * SEQ, t0 = blk * 64 - b0;
        f32x2 sum = {0.f, 0.f};
        for (int s = t0 - half; s < t0 + half; ++s) if (s >= 0 && s < SEQ) { const f32x2 v = *(const f32x2*)(x + (size_t)(b0 + s) * D + c); sum += v; }
        for (int t = t0; t < t0 + 64; ++t) {
            const int lo = t - half < 0 ? 0 : t - half, hi = t + half > SEQ ? SEQ : t + half;
            const f32x2 xv = *(const f32x2*)(x + (size_t)(b0 + t) * D + c);
            const float inv = 1.0f / (float)(hi - lo);
            const f32x2 zz = sum * inv - xv;
            *(unsigned*)(z + (size_t)(b0 + t) * D + c) = cvt_pk_bf16(zz[0], zz[1]);
            if (t + half < SEQ) { const f32x2 v = *(const f32x2*)(x + (size_t)(b0 + t + half) * D + c); sum += v; }
            if (t - half >= 0) { const f32x2 v = *(const f32x2*)(x + (size_t)(b0 + t - half) * D + c); sum -= v; }
        }
    }
}

__device__ __forceinline__ void phase_mlstm_prep(const Frame& F, const float* convw) {
    const bf16_t* proj = (const bf16_t*)(F.ws + WS_SCR + SC_PROJ); bf16_t* qkc = (bf16_t*)(F.ws + WS_SCR + SC_QKC);
    const int c = F.tid * 2;
    float w0[5], w1[5];
#pragma unroll
    for (int j = 0; j < 5; ++j) { w0[j] = convw[j * 1024 + c]; w1[j] = convw[j * 1024 + c + 1]; }
    const float ksc = (c >= 512) ? 0.08838834764831845f : 1.0f;
    for (int blk = F.bid; blk < T / 64; blk += F.G) {
        const int b0 = (blk * 64) / SEQ * SEQ, t0 = blk * 64 - b0;
        float a0[5], a1[5];
#pragma unroll
        for (int j = 0; j < 4; ++j) { const int s = t0 - 2 + j; unsigned w = 0u; if (s >= 0 && s < SEQ) w = *(const unsigned*)(proj + (size_t)(b0 + s) * ML_INP + c); a0[j + 1] = bflo(w); a1[j + 1] = bfhi(w); }
        for (int t = t0; t < t0 + 64; ++t) {
#pragma unroll
            for (int j = 0; j < 4; ++j) { a0[j] = a0[j + 1]; a1[j] = a1[j + 1]; }
            { const int s = t + 2; unsigned w = 0u; if (s < SEQ) w = *(const unsigned*)(proj + (size_t)(b0 + s) * ML_INP + c); a0[4] = bflo(w); a1[4] = bfhi(w); }
            float r0 = 0.f, r1 = 0.f;
#pragma unroll
            for (int j = 0; j < 5; ++j) { r0 += a0[j] * w0[j]; r1 += a1[j] * w1[j]; }
            r0 = silu_f(r0) * ksc; r1 = silu_f(r1) * ksc;
            *(unsigned*)(qkc + (size_t)(b0 + t) * D + c) = cvt_pk_bf16(r0, r1);
        }
    }
    const float* gates = (const float*)(F.ws + WS_META + MT_GATES);
    float* gb = (float*)(F.ws + WS_META + MT_GVEC); float* gu = gb + 32 * SEQ; float* gpm = gu + 32 * SEQ; float* gawl = gpm + 32 * SEQ;
    for (int wg = F.bid * NWAVES + F.wave; wg < 32 * 64; wg += F.G * NWAVES) {
        const int chain = wg >> 6, cch = wg & 63, dir = chain >> 4, bb = (chain >> 2) & 3, hd = chain & 3;
        const int pos = cch * 64 + F.lane, tok = dir ? (SEQ - 1 - pos) : pos;
        const size_t row = (size_t)bb * SEQ + tok;
        const float li = gates[row * 16 + dir * 4 + hd], f = gates[row * 16 + 8 + dir * 4 + hd];
        const float lf = fminf(f, 0.f) - log1pf(expf(-fabsf(f)));
        float bsum = lf;
#pragma unroll
        for (int o = 1; o < 64; o <<= 1) { const float n = __shfl_up(bsum, o); if (F.lane >= o) bsum += n; }
        const float u = li - bsum;
        float pm = u;
#pragma unroll
        for (int o = 1; o < 64; o <<= 1) { const float n = __shfl_up(pm, o); if (F.lane >= o) pm = fmaxf(pm, n); }
        const float pm63 = __shfl(pm, 63);
        const size_t o_ = (size_t)chain * SEQ + pos;
        gb[o_] = bsum; gu[o_] = u; gpm[o_] = pm; gawl[o_] = expf(u - pm63);
    }
}

__device__ __forceinline__ void phase_mlstm_combine(const Frame& F, const float* norm_g) {
    const float* hs = (const float*)(F.ws + WS_SCR + SC_HS); const bf16_t* proj = (const bf16_t*)(F.ws + WS_SCR + SC_PROJ); bf16_t* ym = (bf16_t*)(F.ws + WS_SCR + SC_YM);
    for (int row = F.bid * NWAVES + F.wave; row < T; row += F.G * NWAVES) {
#pragma unroll
        for (int hd = 0; hd < 4; ++hd) { const int c = hd * 256 + F.lane * 4;
            const f32x4 h = *(const f32x4*)(hs + (size_t)row * D + c) + *(const f32x4*)(hs + (size_t)T * D + (size_t)row * D + c);
            const float mu = wave_sum((h[0] + h[1]) + (h[2] + h[3])) * (1.0f / 256.0f);
            const f32x4 d = h - mu;
            const float rstd = 1.0f / sqrtf(wave_sum((d[0] * d[0] + d[1] * d[1]) + (d[2] * d[2] + d[3] * d[3])) * (1.0f / 256.0f) + LN_EPS);
            const f32x4 gn = *(const f32x4*)(norm_g + c);
            const u32x2 ow = *(const u32x2*)(proj + (size_t)row * ML_INP + 2048 + c);
            const float o0 = bflo(ow.x), o1 = bfhi(ow.x), o2 = bflo(ow.y), o3 = bfhi(ow.y);
            const float y0 = d[0] * rstd * gn[0] * sigmoid_f(o0), y1 = d[1] * rstd * gn[1] * sigmoid_f(o1), y2 = d[2] * rstd * gn[2] * sigmoid_f(o2), y3 = d[3] * rstd * gn[3] * sigmoid_f(o3);
            *(u32x2*)(ym + (size_t)row * D + c) = (u32x2){cvt_pk_bf16(y0, y1), cvt_pk_bf16(y2, y3)}; }
    }
}

__global__ void __launch_bounds__(NTHR, 2) fwd_kernel(Args args) {
    extern __shared__ __attribute__((aligned(16))) unsigned char lds_raw[];
    Frame F;
    F.lds = (char*)lds_raw; F.tid = threadIdx.x; F.lane = F.tid & 63; F.wave = __builtin_amdgcn_readfirstlane(F.tid >> 6); F.G = gridDim.x; F.bid = blockIdx.x; F.ws = args.ws;
    LAS unsigned char* ldsl = (LAS unsigned char*)lds_raw;
    volatile LAS unsigned* MISC = (volatile LAS unsigned*)(ldsl + LDS_MISC);
    if (F.tid < 64) MISC[F.tid] = 0u;
    __syncthreads();
    const int lo = args.ph_lo, hi = args.ph_hi;
    XcdBarrier bar; bar.bar = (unsigned*)(args.ws + WS_CTL) + 4096; bar.x = 0; bar.st = nullptr;
    if (hi - lo > 1) bar = xcd_barrier_post((unsigned*)(args.ws + WS_CTL) + 4096, MISC + 8);
#ifndef EN_MASK
#define EN_MASK 0xffffffffu
#endif
#define EN(b) ((EN_MASK >> (b)) & 1u)
#define IN(k) (lo <= (k) && (k) < hi)
#define SEAM(k) do { if (IN(k) && IN((k) + 1)) xcd_barrier(bar); } while (0)
    int ph = 0;
#define PTRS unsigned char* ws = args.ws; asm volatile("" : "+s"(ws)); F.ws = ws; unsigned char* scr = ws + WS_SCR; bf16_t* Wb = (bf16_t*)(ws + WS_W); \
    float* X = (float*)(ws + WS_X); bf16_t* XB = (bf16_t*)(ws + WS_XB); float* Y = (float*)(ws + WS_Y); const float* lng = args.in[22]; const float* lnb = args.in[23]; \
    (void)scr; (void)Wb; (void)X; (void)XB; (void)Y; (void)lng; (void)lnb;

    if (EN(0) && IN(ph)) { PTRS phase_convert_small(F, args); }
    SEAM(ph); ++ph;
    if (EN(0) && IN(ph)) { PTRS phase_convert_moe(F, args, 0); }
    SEAM(ph); ++ph;

#define GEMM_DENSE(EPI, Aptr, lda_, Bptr, ldb_, K_, Mrows, Ncols, epi) do { \
        pg8::Gemm g{(const bf16_t*)(Aptr), (const bf16_t*)(Bptr), (lda_), (ldb_), (K_)}; pg8::DenseOrder S; S.init((Mrows), (Ncols), F.G, F.bid); \
        pg8::gemm_phase<EPI, pg8::DenseOrder, true>(ldsl, g, S, epi); } while (0)

#define MLA_PHASES(j, xres, lnidx, LNMODE, wproj_) do { \
    if (EN(11) && IN(ph)) { PTRS  pg8::EpiF32 E{(float*)(scr + SC_LAT), MLA_INP}; GEMM_DENSE(pg8::EpiF32, XB, D, (char*)Wb + W_DQKV + (size_t)(j) * MLA_INP * D * 2, D, D, T, MLA_INP, E); } \
    SEAM(ph); ++ph; \
    if (EN(2) && IN(ph)) { PTRS phase_mla_rows(F, (const int*)args.in[1]); } \
    SEAM(ph); ++ph; \
    if (EN(12) && IN(ph)) { PTRS  { pg8::EpiBf16 E{(bf16_t*)(scr + SC_Q), MLA_QW}; GEMM_DENSE(pg8::EpiBf16, scr + SC_CQN, MLA_QR, (char*)Wb + W_UQ + (size_t)(j) * MLA_QW * MLA_QR * 2, MLA_QR, MLA_QR, T, MLA_QW, E); } \
                  { pg8::EpiBf16 E{(bf16_t*)(scr + SC_KV), MLA_KVW}; GEMM_DENSE(pg8::EpiBf16, scr + SC_CKVN, MLA_KVR, (char*)Wb + W_UKV + (size_t)(j) * MLA_KVW * MLA_KVR * 2, MLA_KVR, MLA_KVR, T, MLA_KVW, E); } } \
    SEAM(ph); ++ph; \
    if (EN(3) && IN(ph)) { PTRS  const int x8 = F.bid & 7, jj = F.bid >> 3, per = F.G >> 3; \
        for (int lu = jj; lu < 64; lu += per) { const int bh = x8 * 4 + (lu >> 4), qb = lu & 15, b_ = bh >> 3, h_ = bh & 7; const size_t r0 = (size_t)b_ * SEQ + (size_t)qb * 256; \
            att::attn_body((const bf16_t*)(scr + SC_Q) + r0 * MLA_QW + h_ * 192, (const float*)(ws + WS_META + MT_ROPE) + r0 * 64, \
                           (const bf16_t*)(scr + SC_KV) + (size_t)b_ * SEQ * MLA_KVW + h_ * 256, (const bf16_t*)(scr + SC_KV) + (size_t)b_ * SEQ * MLA_KVW + h_ * 256 + 128, \
                           (const bf16_t*)(scr + SC_KR) + (size_t)b_ * SEQ * MLA_ROPE, (bf16_t*)(scr + SC_O) + r0 * D + h_ * 128, SEQ, F.lds); } } \
    SEAM(ph); ++ph; \
    if (EN(13) && IN(ph)) { PTRS  pg8::EpiF32 E{Y, D}; GEMM_DENSE(pg8::EpiF32, scr + SC_O, D, (char*)Wb + W_O + (size_t)(j) * D * D * 2, D, D, T, D, E); } \
    SEAM(ph); ++ph; \
    if (EN(4) && IN(ph)) { PTRS phase_ln<LNMODE>(F, xres, Y, X, XB, lng + (lnidx) * D, lnb + (lnidx) * D, wproj_, nullptr); } \
    SEAM(ph); ++ph; } while (0)

#define DENSE_PHASES(c, lnidx, LNMODE) do { \
    if (EN(14) && IN(ph)) { PTRS  pg8::EpiSwiGLU E{(bf16_t*)(scr + SC_H), DFF}; GEMM_DENSE(pg8::EpiSwiGLU, XB, D, (char*)Wb + W_GU + (size_t)(c) * 2 * DFF * D * 2, D, D, T, 2 * DFF, E); } \
    SEAM(ph); ++ph; \
    if (EN(15) && IN(ph)) { PTRS  pg8::EpiF32 E{Y, D}; GEMM_DENSE(pg8::EpiF32, scr + SC_H, DFF, (char*)Wb + W_DN + (size_t)(c) * D * DFF * 2, DFF, DFF, T, D, E); } \
    SEAM(ph); ++ph; \
    if (EN(4) && IN(ph)) { PTRS phase_ln<LNMODE>(F, X, Y, X, XB, lng + (lnidx) * D, lnb + (lnidx) * D, nullptr, nullptr); } \
    SEAM(ph); ++ph; } while (0)

#define MOE_PHASES(c, lnidx, LNMODE, xout_, wproj_, bgate_) do { \
    if (EN(6) && IN(ph)) { PTRS phase_moe_permute(F); } \
    SEAM(ph); ++ph; \
    if (EN(7) && IN(ph)) { PTRS  pg8::Gemm g{(const bf16_t*)(scr + SC_XP), (const bf16_t*)(ws + WS_WMOE + WM_GU), D, D, D}; pg8::MoeOrder S; S.build_table((const int*)(ws + WS_META + MT_MOE), (LAS int*)(ldsl + LDS_MISC + 1024), 2 * DFFE, F.G, F.bid); \
        pg8::EpiSwiGLU E{(bf16_t*)(scr + SC_HM), DFFE}; pg8::gemm_phase<pg8::EpiSwiGLU, pg8::MoeOrder, true>(ldsl, g, S, E); } \
    SEAM(ph); ++ph; \
    if (EN(7) && IN(ph)) { PTRS  pg8::Gemm g{(const bf16_t*)(scr + SC_HM), (const bf16_t*)(ws + WS_WMOE + WM_DN), DFFE, DFFE, DFFE}; pg8::MoeOrder S; S.build_table((const int*)(ws + WS_META + MT_MOE), (LAS int*)(ldsl + LDS_MISC + 1024), D, F.G, F.bid); \
        pg8::EpiF32Scatter E{(float*)(scr + SC_Y2), (const int*)(ws + WS_META + MT_ROWTOK)}; pg8::gemm_phase<pg8::EpiF32Scatter, pg8::MoeOrder, true>(ldsl, g, S, E); } \
    SEAM(ph); ++ph; \
    if (EN(4) && IN(ph)) { PTRS phase_ln<LNMODE>(F, X, (const float*)(scr + SC_Y2), xout_, XB, lng + (lnidx) * D, lnb + (lnidx) * D, wproj_, bgate_); } \
    SEAM(ph); ++ph; } while (0)

    MLA_PHASES(0, args.in[0], 0, 0, nullptr);
    DENSE_PHASES(0, 1, 0);
    if (EN(5) && IN(ph)) { PTRS phase_pool_z(F); }
    SEAM(ph); ++ph;
    if (EN(16) && IN(ph)) { PTRS  pg8::Gemm g{(const bf16_t*)(scr + SC_Z), (const bf16_t*)((char*)Wb + W_POOL), D, 256, 256}; pg8::PoolOrder S; S.init(T, D, F.G, F.bid);
        pg8::EpiF32 E{Y, D}; pg8::gemm_phase<pg8::EpiF32, pg8::PoolOrder, true>(ldsl, g, S, E); }
    SEAM(ph); ++ph;
    if (EN(4) && IN(ph)) { PTRS phase_ln<2>(F, X, Y, X, XB, lng + 2 * D, lnb + 2 * D, args.in[18], nullptr); }
    SEAM(ph); ++ph;
    MOE_PHASES(0, 3, 1 | 4, X, args.in[10], args.in[12]);
    if (EN(0) && IN(ph)) { PTRS phase_convert_moe(F, args, 1); }
    SEAM(ph); ++ph;
    if (EN(17) && IN(ph)) { PTRS  pg8::EpiBf16 E{(bf16_t*)(scr + SC_PROJ), ML_INP}; GEMM_DENSE(pg8::EpiBf16, XB, D, (char*)Wb + W_IN, D, D, T, ML_INP, E); }
    SEAM(ph); ++ph;
    if (EN(8) && IN(ph)) { PTRS phase_mlstm_prep(F, args.in[11]); }
    SEAM(ph); ++ph;
    if (EN(9) && IN(ph)) { PTRS  mls::Tensors Tn; Tn.qkc = (const bf16_t*)(scr + SC_QKC); Tn.proj = (const bf16_t*)(scr + SC_PROJ);
        Tn.gvec = (const float*)(ws + WS_META + MT_GVEC); Tn.hs = (float*)(scr + SC_HS);
        for (int u = F.bid; u < 256; u += F.G) mls::scan_unit(Tn, u, F.lds); }
    SEAM(ph); ++ph;
    if (EN(10) && IN(ph)) { PTRS phase_mlstm_combine(F, args.in[13]); }
    SEAM(ph); ++ph;
    if (EN(18) && IN(ph)) { PTRS  pg8::EpiF32 E{Y, D}; GEMM_DENSE(pg8::EpiF32, scr + SC_YM, D, (char*)Wb + W_OUT, D, D, T, D, E); }
    SEAM(ph); ++ph;
    if (EN(4) && IN(ph)) { PTRS phase_ln<0>(F, X, Y, X, XB, lng + 4 * D, lnb + 4 * D, nullptr, nullptr); }
    SEAM(ph); ++ph;
    DENSE_PHASES(1, 5, 0);
    MLA_PHASES(1, X, 6, 2, args.in[18] + (size_t)D * NEXP);
    MOE_PHASES(1, 7, 1 | 8, args.out, nullptr, nullptr);
#undef IN
#undef SEAM
}

extern "C" void kernel_launch(void* const* d_in, const int* in_sizes, int n_in, void* d_out, int out_size, void* d_ws, size_t ws_size, hipStream_t stream) {
    static int grid = 0;
    if (grid == 0) {
        if (n_in != 24 || in_sizes[0] != T * D || out_size != T * D || ws_size < WS_END) {
            fprintf(stderr, "kernel_launch: shape mismatch: n_in %d in0 %d out %d ws %zu (need %zu)\n", n_in, n_in > 0 ? in_sizes[0] : -1, out_size, ws_size, (size_t)WS_END); grid = -1; return; }
        int dev = 0, cus = 0, per_cu = 0;
        if (hipGetDevice(&dev) != hipSuccess || hipDeviceGetAttribute(&cus, hipDeviceAttributeMultiprocessorCount, dev) != hipSuccess) { grid = -1; return; }
        if (hipFuncSetAttribute((const void*)fwd_kernel, hipFuncAttributeMaxDynamicSharedMemorySize, LDS_BYTES) != hipSuccess) { fprintf(stderr, "kernel_launch: hipFuncSetAttribute failed\n"); grid = -1; return; }
        if (hipOccupancyMaxActiveBlocksPerMultiprocessor(&per_cu, (const void*)fwd_kernel, NTHR, LDS_BYTES) != hipSuccess || per_cu < 1)
            fprintf(stderr, "kernel_launch: occupancy query reports %d blocks per CU\n", per_cu);
        (void)hipGetLastError();
        grid = cus;
    }
    if (grid < 0) return;
    if (hipMemsetAsync((char*)d_ws + WS_CTL, 0, CTL_ZERO_BYTES, stream) != hipSuccess) { fprintf(stderr, "kernel_launch: memset failed\n"); return; }
    Args a{};
    for (int i = 0; i < 24; ++i) a.in[i] = (const float*)d_in[i];
    a.out = (float*)d_out; a.ws = (unsigned char*)d_ws;
#ifndef MK_ONE_LAUNCH
#define MK_ONE_LAUNCH 1
#endif
    if (MK_ONE_LAUNCH) { a.ph_lo = 0; a.ph_hi = NPH; hipLaunchKernelGGL(fwd_kernel, dim3(grid), dim3(NTHR), LDS_BYTES, stream, a); }
    else for (int p = 0; p < NPH; ++p) { a.ph_lo = p; a.ph_hi = p + 1; hipLaunchKernelGGL(fwd_kernel, dim3(grid), dim3(NTHR), LDS_BYTES, stream, a); }
    const hipError_t le = hipPeekAtLastError();
    if (le != hipSuccess) fprintf(stderr, "kernel_launch: launch failed: %s\n", hipGetErrorName(le));
}
```

```cpp
#include <hip/hip_runtime.h>
#include <cstdio>
#include <cstdint>

#define LAS __attribute__((address_space(3)))
#define GAS __attribute__((address_space(1)))
typedef unsigned short bf16_t;
typedef short bf16x8 __attribute__((ext_vector_type(8)));
typedef short s16x4 __attribute__((ext_vector_type(4)));
typedef float f32x4 __attribute__((ext_vector_type(4)));
typedef float f32x2 __attribute__((ext_vector_type(2)));
typedef float f32x16 __attribute__((ext_vector_type(16)));
typedef unsigned u32x4 __attribute__((ext_vector_type(4)));
typedef unsigned u32x2 __attribute__((ext_vector_type(2)));
typedef GAS unsigned gu32;

constexpr int BATCH = 4, SEQ = 4096, T = BATCH * SEQ, D = 1024;
constexpr float DN_ALPHA = 1.6817928305074290f;
constexpr float LN_EPS = 1e-5f, RMS_EPS = 1e-6f;
constexpr int MLA_H = 8, MLA_QR = 384, MLA_KVR = 256, MLA_NOPE = 128, MLA_ROPE = 64, MLA_V = 128, MLA_IN = 704, MLA_INP = 768;
constexpr int MLA_QW = MLA_H * (MLA_NOPE + MLA_ROPE);
constexpr int MLA_KVW = MLA_H * (MLA_NOPE + MLA_V);
constexpr int ML_H = 4, ML_DK = 128, ML_DV = 256, ML_IN = 3088, ML_INP = 3072;
constexpr int DFF = 2816, NEXP = 8, DFFE = 3584;
constexpr int MOE_MAXT = 136;
constexpr int NWAVES = 8, NTHR = 512;

constexpr size_t MiB = 1u << 20;
constexpr size_t WS_CTL = 0, CTL_ZERO_BYTES = 1 * MiB;
constexpr size_t WS_META = 1 * MiB;
constexpr size_t MT_CNTW = 0;
constexpr size_t MT_MOE = 16384;
constexpr size_t MT_TOKE = 32768;
constexpr size_t MT_TOKW = MT_TOKE + (size_t)T * 8;
constexpr size_t MT_RANK = MT_TOKW + (size_t)T * 8;
constexpr size_t MT_ROWTOK = MT_RANK + (size_t)T * 8;
constexpr size_t MT_GATES = 1 * MiB;
constexpr size_t MT_GVEC = 2 * MiB;
constexpr size_t MT_ROPE = 4 * MiB;
static_assert(MT_ROWTOK + (size_t)MOE_MAXT * 256 * 4 <= MT_GATES, "meta map");
constexpr size_t WS_W = 17 * MiB;
constexpr size_t W_DQKV = 0;
constexpr size_t W_UQ = W_DQKV + 2 * (size_t)MLA_INP * D * 2;
constexpr size_t W_UKV = W_UQ + 2 * (size_t)MLA_QW * MLA_QR * 2;
constexpr size_t W_O = W_UKV + 2 * (size_t)MLA_KVW * MLA_KVR * 2;
constexpr size_t W_POOL = W_O + 2 * (size_t)D * D * 2;
constexpr size_t W_IN = W_POOL + 4 * (size_t)256 * 256 * 2;
constexpr size_t W_OUT = W_IN + (size_t)ML_INP * D * 2;
constexpr size_t W_GU = W_OUT + (size_t)D * D * 2;
constexpr size_t W_DN = W_GU + 2 * (size_t)2 * DFF * D * 2;
constexpr size_t W_END = W_DN + 2 * (size_t)D * DFF * 2;
static_assert(W_END <= 55 * MiB, "weights map");
constexpr size_t WS_WMOE = 72 * MiB;
constexpr size_t WM_GU = 0, WM_DN = (size_t)NEXP * 2 * DFFE * D * 2;
static_assert(WM_DN + (size_t)NEXP * D * DFFE * 2 == 168 * MiB, "moe weights map");
constexpr size_t WS_X = 240 * MiB;
constexpr size_t WS_XB = 304 * MiB;
constexpr size_t WS_Y = 336 * MiB;
constexpr size_t WS_SCR = 400 * MiB;
constexpr size_t WS_END = 834 * MiB;
constexpr size_t SC_LAT = 0, SC_CQN = 48 * MiB, SC_CKVN = 60 * MiB, SC_KR = 68 * MiB, SC_Q = 70 * MiB, SC_KV = 118 * MiB, SC_O = 182 * MiB;
constexpr size_t SC_H = 0;
constexpr size_t SC_Z = 0;
constexpr size_t SC_XP = 0, SC_HM = 68 * MiB, SC_Y2 = 306 * MiB;
static_assert(SC_Y2 + (size_t)2 * T * D * 4 == 434 * MiB, "moe scratch");
constexpr size_t SC_PROJ = 0, SC_QKC = 96 * MiB, SC_HS = 128 * MiB, SC_YM = 256 * MiB;

constexpr int LDS_MAIN = 131072;
constexpr int LDS_MISC = LDS_MAIN;
constexpr int LDS_BYTES = 147456;

#define RLX_AGENT __ATOMIC_RELAXED, __HIP_MEMORY_SCOPE_AGENT
__device__ __forceinline__ unsigned cvt_pk_bf16(float lo, float hi) { unsigned r; asm volatile("v_cvt_pk_bf16_f32 %0, %1, %2" : "=v"(r) : "v"(lo), "v"(hi)); return r; }
__device__ __forceinline__ float bf2f(unsigned short b) { return __builtin_bit_cast(float, (unsigned)b << 16); }
__device__ __forceinline__ float bflo(unsigned w) { return __builtin_bit_cast(float, w << 16); }
__device__ __forceinline__ float bfhi(unsigned w) { return __builtin_bit_cast(float, w & 0xffff0000u); }
__device__ __forceinline__ float wave_sum(float v) {
#pragma unroll
    for (int o = 32; o >= 1; o >>= 1) v += __shfl_xor(v, o);
    return v;
}
__device__ __forceinline__ float fast_exp(float x) { return __builtin_amdgcn_exp2f(x * 1.4426950408889634f); }
__device__ __forceinline__ float fast_rcp(float x) { return __builtin_amdgcn_rcpf(x); }
__device__ __forceinline__ float silu_f(float x) { return x * fast_rcp(1.0f + fast_exp(-x)); }
__device__ __forceinline__ float sigmoid_f(float x) { return fast_rcp(1.0f + fast_exp(-x)); }

namespace pg8 {
constexpr int BM = 256, BK = 64, HALF = 128, HTB = HALF * BK * 2, STAGE_BYTES = 8 * HTB, NXCD = 8, WGM = 8;
__host__ __device__ __forceinline__ int lds_byte(int r, int c) { const int st = (r >> 4) * 2 + (c >> 5), rr = r & 15, cc = c & 31, ob = rr * 64 + cc * 2; return st * 1024 + (ob ^ (((ob >> 9) & 1) << 5)); }
__host__ __device__ __forceinline__ void stage_rc(int b, int& R, int& C) { const int st = b / 1024, sb = b % 1024, swz = sb ^ (((sb >> 9) & 1) << 5); R = (st >> 1) * 16 + swz / 64; C = (st & 1) * 32 + (swz % 64) / 2; }
__host__ __device__ __forceinline__ int perm32(int rho) { const int n = rho >> 4, i = rho & 15; return 8 * (i >> 2) + 4 * n + (i & 3); }

struct Unit { int pm, pn, e, nv; };
struct Gemm { const bf16_t* A; const bf16_t* Bt; int lda, ldb, K; };

struct DenseOrder {
    int nM, nN, nwg, G, c;
    __device__ __forceinline__ void init(int M, int N, int G_, int c_) { nM = M / BM; nN = N / BM; nwg = nM * nN; G = G_; c = c_; }
    __device__ __forceinline__ bool next(int i, Unit& u) const {
        const long L = (long)i * G + c; if (L >= nwg) return false;
        int wgid = (int)L; { const int q = nwg / NXCD, r = nwg % NXCD, xcd = wgid % NXCD, off = wgid / NXCD; wgid = (xcd < r ? xcd * (q + 1) : r * (q + 1) + (xcd - r) * q) + off; }
        const int nig = WGM * nN, gid = wgid / nig, fm = gid * WGM, gsz = (nM - fm) < WGM ? (nM - fm) : WGM;
        u.pm = fm + ((wgid % nig) % gsz); u.pn = (wgid % nig) / gsz; u.e = 0; u.nv = 256; return true;
    }
    __device__ __forceinline__ const char* a_tile(const Unit& u, const Gemm& g) const { return (const char*)g.A + (size_t)u.pm * BM * g.lda * 2; }
    __device__ __forceinline__ const char* b_tile(const Unit& u, const Gemm& g) const { return (const char*)g.Bt + (size_t)u.pn * BM * g.ldb * 2; }
};
struct PoolOrder : DenseOrder {
    __device__ __forceinline__ const char* a_tile(const Unit& u, const Gemm& g) const { return (const char*)g.A + ((size_t)u.pm * BM * g.lda + (size_t)u.pn * 256) * 2; }
    __device__ __forceinline__ const char* b_tile(const Unit& u, const Gemm& g) const { return (const char*)g.Bt + (size_t)u.pn * 256 * 256 * 2; }
};
struct MoeOrder {
    const LAS int* tab; int ntiles, nN, Nexp, G, c;
    __device__ __forceinline__ void build_table(const int* meta, LAS int* tabw, int Nexp_, int G_, int c_) {
        const int tid = threadIdx.x;
        if (tid < MOE_MAXT) {
            int e = 0;
#pragma unroll
            for (int k = 1; k < 8; ++k) e += (tid >= meta[8 + k]) ? 1 : 0;
            const int rem = meta[e] - (tid - meta[8 + e]) * 256;
            tabw[2 * tid] = e; tabw[2 * tid + 1] = rem < 256 ? rem : 256;
        }
        ntiles = __builtin_amdgcn_readfirstlane(meta[16]);
        __syncthreads();
        tab = tabw; Nexp = Nexp_; nN = Nexp_ / BM; G = G_; c = c_;
    }
    __device__ __forceinline__ bool next(int i, Unit& u) const {
        const long L = (long)i * G + c; if (L >= (long)ntiles * nN) return false;
        const int rt = (int)(L / nN); u.pn = (int)(L % nN); u.pm = rt;
        u.e = __builtin_amdgcn_readfirstlane(tab[2 * rt]); u.nv = __builtin_amdgcn_readfirstlane(tab[2 * rt + 1]); return true;
    }
    __device__ __forceinline__ const char* a_tile(const Unit& u, const Gemm& g) const { return (const char*)g.A + (size_t)u.pm * BM * g.lda * 2; }
    __device__ __forceinline__ const char* b_tile(const Unit& u, const Gemm& g) const { return (const char*)g.Bt + ((size_t)u.e * Nexp + (size_t)u.pn * BM) * g.ldb * 2; }
};

struct EpiF32 {
    static constexpr bool PERM = false;
    float* C; int ldc;
    __device__ __forceinline__ void operator()(const f32x4 (&acc)[2][2][4][2], const Unit& u, int wr, int wc, int fr, int fq) const {
        const int row0 = u.pm * BM + wr * 64 + fr, col0 = u.pn * BM + wc * 32 + 4 * fq;
#pragma unroll
        for (int ai = 0; ai < 2; ++ai)
#pragma unroll
            for (int m = 0; m < 4; ++m) { float* rowp = C + (size_t)(row0 + ai * HALF + m * 16) * ldc + col0;
#pragma unroll
                for (int bj = 0; bj < 2; ++bj)
#pragma unroll
                    for (int n = 0; n < 2; ++n) *(f32x4*)(rowp + bj * HALF + n * 16) = acc[ai][bj][m][n]; }
    }
};
struct EpiF32Scatter {
    static constexpr bool PERM = false;
    float* C; const int* rowtok;
    __device__ __forceinline__ void operator()(const f32x4 (&acc)[2][2][4][2], const Unit& u, int wr, int wc, int fr, int fq) const {
        const int col0 = u.pn * BM + wc * 32 + 4 * fq;
#pragma unroll
        for (int ai = 0; ai < 2; ++ai)
#pragma unroll
            for (int m = 0; m < 4; ++m) { const int rl = ai * HALF + wr * 64 + m * 16 + fr;
                if (rl < u.nv) { const int dst = rowtok[u.pm * BM + rl]; float* rowp = C + (size_t)dst * D + col0;
#pragma unroll
                    for (int bj = 0; bj < 2; ++bj)
#pragma unroll
                        for (int n = 0; n < 2; ++n) *(f32x4*)(rowp + bj * HALF + n * 16) = acc[ai][bj][m][n]; } }
    }
};
struct EpiBf16 {
    static constexpr bool PERM = true;
    bf16_t* O; int ldc;
    __device__ __forceinline__ void operator()(const f32x4 (&acc)[2][2][4][2], const Unit& u, int wr, int wc, int fr, int fq) const {
        const int row0 = u.pm * BM + wr * 64 + fr, col0 = u.pn * BM + wc * 32 + 8 * fq;
#pragma unroll
        for (int ai = 0; ai < 2; ++ai)
#pragma unroll
            for (int m = 0; m < 4; ++m) { bf16_t* rowp = O + (size_t)(row0 + ai * HALF + m * 16) * ldc + col0;
#pragma unroll
                for (int bj = 0; bj < 2; ++bj) { const f32x4 v0 = acc[ai][bj][m][0], v1 = acc[ai][bj][m][1];
                    u32x4 w; w.x = cvt_pk_bf16(v0[0], v0[1]); w.y = cvt_pk_bf16(v0[2], v0[3]); w.z = cvt_pk_bf16(v1[0], v1[1]); w.w = cvt_pk_bf16(v1[2], v1[3]);
                    *(u32x4*)(rowp + bj * HALF) = w; } }
    }
};
struct EpiSwiGLU {
    static constexpr bool PERM = true;
    bf16_t* O; int ldc;
    __device__ __forceinline__ void operator()(const f32x4 (&acc)[2][2][4][2], const Unit& u, int wr, int wc, int fr, int fq) const {
        const int row0 = u.pm * BM + wr * 64 + fr, col0 = u.pn * HALF + wc * 32 + 8 * fq;
#pragma unroll
        for (int ai = 0; ai < 2; ++ai)
#pragma unroll
            for (int m = 0; m < 4; ++m) { bf16_t* rowp = O + (size_t)(row0 + ai * HALF + m * 16) * ldc + col0;
                float h[8];
#pragma unroll
                for (int n = 0; n < 2; ++n)
#pragma unroll
                    for (int i = 0; i < 4; ++i) h[n * 4 + i] = silu_f(acc[ai][0][m][n][i]) * acc[ai][1][m][n][i];
                u32x4 w; w.x = cvt_pk_bf16(h[0], h[1]); w.y = cvt_pk_bf16(h[2], h[3]); w.z = cvt_pk_bf16(h[4], h[5]); w.w = cvt_pk_bf16(h[6], h[7]);
                *(u32x4*)rowp = w; }
    }
};

template <class Epi, class Sched, bool ALIGN_EPI = true>
__device__ __forceinline__ void gemm_phase(LAS unsigned char* lds, const Gemm g, const Sched& S, const Epi& E) {
    const int tid = threadIdx.x, wid = __builtin_amdgcn_readfirstlane(tid >> 6), lane = tid & 63, wr = wid >> 2, wc = wid & 3, fr = lane & 15, fq = lane >> 4;
    int K = g.K; asm volatile("" : "+s"(K));
    const int nt = K / BK;
    unsigned voffA[2], voffB[2];
#pragma unroll
    for (int i = 0; i < 2; ++i) { int R, C; stage_rc(tid * 16 + i * 8192, R, C); const int Rb = Epi::PERM ? ((R & ~31) + perm32(R & 31)) : R;
        voffA[i] = (unsigned)(R * g.lda + C) * 2u; voffB[i] = (unsigned)(Rb * g.ldb + C) * 2u; }
    const size_t kstep = (size_t)(BK * 2);
    const size_t hstepA = (size_t)HALF * g.lda * 2, hstepB = (size_t)HALF * g.ldb * 2;
    const unsigned ldsw = (unsigned)wid * 1024u;
    const int aoff = lds_byte(wr * 64 + fr, fq * 8), boff = lds_byte(wc * 32 + fr, fq * 8);
#define PG8_SA(b, h) (((b) * 2 + (h)) * HTB)
#define PG8_SB(b, h) ((4 + (b) * 2 + (h)) * HTB)
#define PG8_STAGE(bufoff, gbase, voff) do { _Pragma("unroll") for (int _i = 0; _i < 2; ++_i) \
        __builtin_amdgcn_global_load_lds((const unsigned*)((const char*)(gbase) + (voff)[_i]), (LAS unsigned*)(lds + (bufoff) + ldsw + _i * 8192), 16, 0, 0); } while (0)
#define PG8_LDA(dst, b, h) do { _Pragma("unroll") for (int m = 0; m < 4; ++m) _Pragma("unroll") for (int k = 0; k < 2; ++k) dst[m][k] = *(const LAS bf16x8*)(lds + PG8_SA(b, h) + aoff + m * 2048 + k * 1024); } while (0)
#define PG8_LDB(dst, b, h) do { _Pragma("unroll") for (int n = 0; n < 2; ++n) _Pragma("unroll") for (int k = 0; k < 2; ++k) dst[n][k] = *(const LAS bf16x8*)(lds + PG8_SB(b, h) + boff + n * 2048 + k * 1024); } while (0)
#define PG8_MMA(ai, bj, At, Bt) do { __builtin_amdgcn_s_setprio(1); _Pragma("unroll") for (int m = 0; m < 4; ++m) _Pragma("unroll") for (int n = 0; n < 2; ++n) _Pragma("unroll") for (int k = 0; k < 2; ++k) \
        acc[ai][bj][m][n] = __builtin_amdgcn_mfma_f32_16x16x32_bf16(Bt[n][k], At[m][k], acc[ai][bj][m][n], 0, 0, 0); __builtin_amdgcn_s_setprio(0); } while (0)
#define PG8_WAIT_V(n) asm volatile("s_waitcnt vmcnt(" #n ")" ::: "memory")
#define PG8_WAIT_L(n) asm volatile("s_waitcnt lgkmcnt(" #n ")" ::: "memory")
#define PG8_BAR __builtin_amdgcn_s_barrier()
#define PG8_SCHED __builtin_amdgcn_sched_barrier(0)
    Unit cur, nxt; int ui = 0;
    if (!S.next(0, cur)) return;
    f32x4 acc[2][2][4][2];
#pragma unroll
    for (int a = 0; a < 2; ++a)
#pragma unroll
        for (int b = 0; b < 2; ++b)
#pragma unroll
            for (int m = 0; m < 4; ++m)
#pragma unroll
                for (int n = 0; n < 2; ++n) acc[a][b][m][n] = (f32x4){0.f, 0.f, 0.f, 0.f};
    bf16x8 At[4][2], B0[2][2], B1[2][2];
    const char* cA = S.a_tile(cur, g); const char* cB = S.b_tile(cur, g);
    PG8_STAGE(PG8_SB(0, 0), cB, voffB); PG8_STAGE(PG8_SB(0, 1), cB + hstepB, voffB); PG8_STAGE(PG8_SA(0, 0), cA, voffA); PG8_STAGE(PG8_SA(0, 1), cA + hstepA, voffA);
    if (wr == 1) PG8_BAR;
    PG8_WAIT_V(2); PG8_BAR;
    PG8_STAGE(PG8_SB(1, 0), cB + kstep, voffB); PG8_STAGE(PG8_SA(1, 0), cA + kstep, voffA); PG8_STAGE(PG8_SB(1, 1), cB + hstepB + kstep, voffB);
    PG8_WAIT_V(6); PG8_BAR;
    for (;;) {
        const bool has_next = S.next(ui + 1, nxt);
        const char* nA = has_next ? S.a_tile(nxt, g) : cA; const char* nB = has_next ? S.b_tile(nxt, g) : cB;
        for (int t = 0; t < nt; t += 2) {
            const bool last = (t == nt - 2);
            const char* a1 = cA + (size_t)(t + 1) * kstep;
            const char* a2 = last ? nA : cA + (size_t)(t + 2) * kstep; const char* b2 = last ? nB : cB + (size_t)(t + 2) * kstep;
            const char* a3 = a2 + kstep; const char* b3 = b2 + kstep;
            PG8_LDB(B0, 0, 0); PG8_LDB(B1, 0, 1); PG8_SCHED; PG8_LDA(At, 0, 0); PG8_STAGE(PG8_SA(1, 1), a1 + hstepA, voffA);
            PG8_WAIT_V(8); PG8_WAIT_L(0); PG8_BAR; PG8_MMA(0, 0, At, B0); PG8_MMA(0, 1, At, B1); PG8_BAR; PG8_SCHED;
            PG8_LDA(At, 0, 1); PG8_STAGE(PG8_SB(0, 0), b2, voffB); PG8_STAGE(PG8_SB(0, 1), b2 + hstepB, voffB); PG8_STAGE(PG8_SA(0, 0), a2, voffA);
            PG8_WAIT_V(8); PG8_WAIT_L(0); PG8_BAR; PG8_MMA(1, 0, At, B0); PG8_MMA(1, 1, At, B1); PG8_BAR; PG8_SCHED;
            PG8_LDB(B0, 1, 0); PG8_LDB(B1, 1, 1); PG8_SCHED; PG8_LDA(At, 1, 0); PG8_STAGE(PG8_SA(0, 1), a2 + hstepA, voffA);
            PG8_WAIT_V(8); PG8_WAIT_L(0); PG8_BAR; PG8_MMA(0, 0, At, B0); PG8_MMA(0, 1, At, B1); PG8_BAR; PG8_SCHED;
            PG8_LDA(At, 1, 1); PG8_STAGE(PG8_SB(1, 0), b3, voffB); PG8_STAGE(PG8_SB(1, 1), b3 + hstepB, voffB); PG8_STAGE(PG8_SA(1, 0), a3, voffA);
            PG8_WAIT_V(8); PG8_WAIT_L(0); PG8_BAR; PG8_MMA(1, 0, At, B0); PG8_MMA(1, 1, At, B1); PG8_BAR; PG8_SCHED;
        }
        if constexpr (ALIGN_EPI) { if (wr == 0) PG8_BAR; }
        E(acc, cur, wr, wc, fr, fq);
        if (!has_next) break;
#pragma unroll
        for (int a = 0; a < 2; ++a)
#pragma unroll
            for (int b = 0; b < 2; ++b)
#pragma unroll
                for (int m = 0; m < 4; ++m)
#pragma unroll
                    for (int n = 0; n < 2; ++n) acc[a][b][m][n] = (f32x4){0.f, 0.f, 0.f, 0.f};
        cur = nxt; cA = nA; cB = nB; ++ui;
        if constexpr (ALIGN_EPI) { if (wr == 1) PG8_BAR; }
    }
    PG8_WAIT_V(0);
    if constexpr (!ALIGN_EPI) { if (wr == 0) PG8_BAR; }
    PG8_BAR;
#undef PG8_SA
#undef PG8_SB
#undef PG8_STAGE
#undef PG8_LDA
#undef PG8_LDB
#undef PG8_MMA
#undef PG8_WAIT_V
#undef PG8_WAIT_L
#undef PG8_BAR
#undef PG8_SCHED
}
}

#ifndef ATT_SDEPTH
#define ATT_SDEPTH 1
#endif
namespace att {
constexpr int NW = 8, QBLK = 32, KVBLK = 64;
constexpr float SCALE = 0.07216878364870322f;
constexpr float THR = 8.f;
constexpr int LDQ = MLA_QW, LDK = MLA_KVW, LDKR = MLA_ROPE, LDO = D;
constexpr int SHM_V = KVBLK * 128 * 2, SHM_K = KVBLK * 128 * 2, SHM_KR = KVBLK * 64 * 2;
constexpr int OFF_V = 0, OFF_K = 2 * SHM_V, OFF_KR = OFF_K + 2 * SHM_K, OFF_WS = OFF_KR + 2 * SHM_KR, OFF_QR = OFF_WS + NW * 64 * 4, SHM_ATTN = OFF_QR + NW * 4096;
#define KSWZ(row, colB) ((row) * 256 + ((colB) ^ (((row) & 7) << 4)))
#define KRSWZ(row, colB) ((row) * 128 + ((colB) ^ ((((row) >> 1) & 7) << 4)))
#define SBAR() __builtin_amdgcn_sched_barrier(0)
__device__ __forceinline__ int crow(int r, int hi) { return (r & 3) + 8 * (r >> 2) + 4 * hi; }

__device__ __forceinline__ void partialSM(f32x16& p0, f32x16& p1, float& m_reg, float& mn, float& alpha) {
  constexpr float C = SCALE * 1.4426950408889634f;
  float pmax = p0[0];
#pragma unroll
  for (int r = 1; r < 16; ++r) pmax = fmaxf(pmax, p0[r]);
#pragma unroll
  for (int r = 0; r < 16; ++r) pmax = fmaxf(pmax, p1[r]);
  { auto rr = __builtin_amdgcn_permlane32_swap(__float_as_uint(pmax), __float_as_uint(pmax), false, false);
    pmax = fmaxf(__uint_as_float(rr[0]), __uint_as_float(rr[1])); }
  if (__builtin_expect(__all(pmax - m_reg <= THR / SCALE), 1)) { mn = m_reg; alpha = 1.f; }
  else { mn = fmaxf(m_reg, pmax); alpha = __builtin_amdgcn_exp2f((m_reg - mn) * C); m_reg = mn; }
  float mnC = -mn * C;
#pragma unroll
  for (int r = 0; r < 16; ++r) p0[r] = fmaf(p0[r], C, mnC);
#pragma unroll
  for (int r = 0; r < 16; ++r) p1[r] = fmaf(p1[r], C, mnC);
#pragma unroll
  for (int r = 0; r < 16; ++r) p0[r] = __builtin_amdgcn_exp2f(p0[r]);
}
__device__ __forceinline__ void finishSM(f32x16& p0, f32x16& p1, float alpha, float& l_reg, bf16x8& pa0, bf16x8& pa1, bf16x8& pa2, bf16x8& pa3) {
#pragma unroll
  for (int r = 0; r < 16; ++r) p1[r] = __builtin_amdgcn_exp2f(p1[r]);
  float ps = 0;
#pragma unroll
  for (int r = 0; r < 16; ++r) ps += p0[r];
#pragma unroll
  for (int r = 0; r < 16; ++r) ps += p1[r];
  { auto rr = __builtin_amdgcn_permlane32_swap(__float_as_uint(ps), __float_as_uint(ps), false, false);
    ps = __uint_as_float(rr[0]) + __uint_as_float(rr[1]); }
  l_reg = l_reg * alpha + ps;
#define PK4(P, BASE, OUT) do { unsigned a0 = cvt_pk_bf16(P[BASE + 0], P[BASE + 1]), a1 = cvt_pk_bf16(P[BASE + 2], P[BASE + 3]);   \
    unsigned b0 = cvt_pk_bf16(P[BASE + 4], P[BASE + 5]), b1 = cvt_pk_bf16(P[BASE + 6], P[BASE + 7]);                              \
    auto r0 = __builtin_amdgcn_permlane32_swap(a0, b0, false, false); auto r1 = __builtin_amdgcn_permlane32_swap(a1, b1, false, false); \
    u32x4 w = {r0[0], r1[0], r0[1], r1[1]}; OUT = __builtin_bit_cast(bf16x8, w); } while (0)
  PK4(p0, 0, pa0); PK4(p0, 8, pa1); PK4(p1, 0, pa2); PK4(p1, 8, pa3);
}
__device__ __forceinline__ void qkt(f32x16& p0, f32x16& p1, const char* Ks, const char* Krs, const bf16x8* qr, const char* qrl, int r32, int hi) {
  p0 = f32x16{}; p1 = f32x16{};
#pragma unroll
  for (int d0 = 0; d0 < 8; ++d0) { const int cb = (d0 * 16 + hi * 8) * 2;
    bf16x8 b0 = *reinterpret_cast<const bf16x8*>(Ks + KSWZ(r32, cb));
    bf16x8 b1 = *reinterpret_cast<const bf16x8*>(Ks + KSWZ(32 + r32, cb));
    p0 = __builtin_amdgcn_mfma_f32_32x32x16_bf16(b0, qr[d0], p0, 0, 0, 0);
    p1 = __builtin_amdgcn_mfma_f32_32x32x16_bf16(b1, qr[d0], p1, 0, 0, 0); }
#pragma unroll
  for (int d0 = 0; d0 < 4; ++d0) { const int cb = (d0 * 16 + hi * 8) * 2;
    bf16x8 b0 = *reinterpret_cast<const bf16x8*>(Krs + KRSWZ(r32, cb));
    bf16x8 b1 = *reinterpret_cast<const bf16x8*>(Krs + KRSWZ(32 + r32, cb));
    const bf16x8 qq = *reinterpret_cast<const bf16x8*>(qrl + d0 * 1024);
    p0 = __builtin_amdgcn_mfma_f32_32x32x16_bf16(b0, qq, p0, 0, 0, 0);
    p1 = __builtin_amdgcn_mfma_f32_32x32x16_bf16(b1, qq, p1, 0, 0, 0); }
}
__device__ __forceinline__ int v_st(int k, int c) { const int kk = (k & ~0xC) | ((k & 4) << 1) | ((k & 8) >> 1); return ((kk >> 3) * 4 + (c >> 5)) * 512 + ((kk & 7) * 32 + (c & 31)) * 2; }
__device__ __forceinline__ int v_rd_base(int lane) { return ((lane & 3) << 3) | (((lane >> 2) & 3) << 6) | (((lane >> 4) & 1) << 5) | (((lane >> 5) & 1) << 8); }
constexpr int v_rd_off(int d0, int ks, int half) { return d0 * 512 + ks * 4096 + half * 2048; }
template <int OFF> __device__ __forceinline__ s16x4 tr_read(int vb) {
  s16x4 r; asm volatile("ds_read_b64_tr_b16 %0, %1 offset:%2" : "=&v"(r) : "v"(vb), "i"(OFF) : "memory"); return r;
}
#define PKV(L, H) (bf16x8){L[0], L[1], L[2], L[3], H[0], H[1], H[2], H[3]}
template <int D0> __device__ __forceinline__ void pv_one(f32x16& od, int vb, bf16x8 pa0, bf16x8 pa1, bf16x8 pa2, bf16x8 pa3) {
  const s16x4 l0 = tr_read<v_rd_off(D0, 0, 0)>(vb), h0 = tr_read<v_rd_off(D0, 0, 1)>(vb), l1 = tr_read<v_rd_off(D0, 1, 0)>(vb), h1 = tr_read<v_rd_off(D0, 1, 1)>(vb);
  const s16x4 l2 = tr_read<v_rd_off(D0, 2, 0)>(vb), h2 = tr_read<v_rd_off(D0, 2, 1)>(vb), l3 = tr_read<v_rd_off(D0, 3, 0)>(vb), h3 = tr_read<v_rd_off(D0, 3, 1)>(vb);
  asm volatile("s_waitcnt lgkmcnt(0)" ::: "memory"); SBAR();
  od = __builtin_amdgcn_mfma_f32_32x32x16_bf16(pa0, PKV(l0, h0), od, 0, 0, 0);
  od = __builtin_amdgcn_mfma_f32_32x32x16_bf16(pa1, PKV(l1, h1), od, 0, 0, 0);
  od = __builtin_amdgcn_mfma_f32_32x32x16_bf16(pa2, PKV(l2, h2), od, 0, 0, 0);
  od = __builtin_amdgcn_mfma_f32_32x32x16_bf16(pa3, PKV(l3, h3), od, 0, 0, 0);
}
__device__ __forceinline__ void pv_d0(f32x16* o, int vb, bf16x8 pa0, bf16x8 pa1, bf16x8 pa2, bf16x8 pa3) {
  pv_one<0>(o[0], vb, pa0, pa1, pa2, pa3); pv_one<1>(o[1], vb, pa0, pa1, pa2, pa3); pv_one<2>(o[2], vb, pa0, pa1, pa2, pa3); pv_one<3>(o[3], vb, pa0, pa1, pa2, pa3);
}

__device__ __forceinline__ void attn_body(const bf16_t* __restrict__ Qb, const float* __restrict__ cs, const bf16_t* __restrict__ Kn, const bf16_t* __restrict__ Vh,
                                          const bf16_t* __restrict__ Kr, bf16_t* __restrict__ Ob, int seq, char* lds) {
  int tid = threadIdx.x; asm volatile("" : "+v"(tid));
  const int wid = tid >> 6, lane = tid & 63, r32 = lane & 31, hi = lane >> 5;
  char* V_lds = lds + OFF_V; char* K_lds = lds + OFF_K; char* KR_lds = lds + OFF_KR;
  float* ws = (float*)(lds + OFF_WS) + wid * 64; float* li_l = ws; float* al_l = ws + 32;
  float m_reg = -1e30f, l_reg = 0; f32x16 o[4] = {}; bf16x8 qr[8];
  char* qrl = lds + OFF_QR + wid * 4096 + lane * 16;
  { const int qrow = wid * QBLK + r32;
    const unsigned qoff = (unsigned)(qrow * LDQ + hi * 8) * 2u;
    const char* Qc = (const char*)Qb;
    bf16x8 qro[4];
#pragma unroll
    for (int d0 = 0; d0 < 8; ++d0) qr[d0] = *reinterpret_cast<const bf16x8*>(Qc + qoff + d0 * 32);
#pragma unroll
    for (int d0 = 0; d0 < 4; ++d0) qro[d0] = *reinterpret_cast<const bf16x8*>(Qc + qoff + 256 + d0 * 32);
    const char* csc = (const char*)cs; const unsigned csoff = (unsigned)qrow * 256u;
#pragma unroll
    for (int a = 0; a < 2; ++a) {
      const int i0 = a * 16 + hi * 8;
      bf16x8 x1 = qro[a], x2 = qro[2 + a], y1, y2;
#pragma unroll
      for (int j = 0; j < 8; ++j) {
        const f32x2 c_s = *reinterpret_cast<const f32x2*>(csc + csoff + 8 * (i0 + j));
        const float f1 = bf2f((unsigned short)x1[j]), f2 = bf2f((unsigned short)x2[j]);
        const float g1 = f1 * c_s.x - f2 * c_s.y, g2 = f2 * c_s.x + f1 * c_s.y;
        const unsigned pk = cvt_pk_bf16(g1, g2);
        y1[j] = (short)(pk & 0xffffu); y2[j] = (short)(pk >> 16);
      }
      *reinterpret_cast<bf16x8*>(qrl + a * 1024) = y1; *reinterpret_cast<bf16x8*>(qrl + (2 + a) * 1024) = y2;
    }
  }
  const int sr = tid >> 4, sc = (tid & 15) * 8, vst0 = v_st(sr, sc), vst1 = v_st(32 + sr, sc);
  const int krr = tid >> 3, krc = (tid & 7) * 8;
  const int vb0 = (int)(uintptr_t)V_lds + v_rd_base(lane);
  constexpr int SDEPTH = ATT_SDEPTH;
  struct { bf16x8 vs0, vs1, ks0, ks1, kr0; } sr_[SDEPTH];
  const unsigned vo0 = (unsigned)(sr * LDK + sc) * 2u, vo1 = (unsigned)((32 + sr) * LDK + sc) * 2u, kro = (unsigned)(krr * LDKR + krc) * 2u;
#define SLOAD(i, k0) do { const char* vt_ = (const char*)Vh + (size_t)(k0) * (LDK * 2); const char* kt_ = (const char*)Kn + (size_t)(k0) * (LDK * 2); const char* krt_ = (const char*)Kr + (size_t)(k0) * (LDKR * 2); \
    sr_[i].vs0 = *reinterpret_cast<const bf16x8*>(vt_ + vo0); sr_[i].vs1 = *reinterpret_cast<const bf16x8*>(vt_ + vo1); \
    sr_[i].ks0 = *reinterpret_cast<const bf16x8*>(kt_ + vo0); sr_[i].ks1 = *reinterpret_cast<const bf16x8*>(kt_ + vo1); \
    sr_[i].kr0 = *reinterpret_cast<const bf16x8*>(krt_ + kro); } while (0)
#define SWRITE(b, i) do { *(bf16x8*)(V_lds + (b) * SHM_V + vst0) = sr_[i].vs0;          \
    *(bf16x8*)(V_lds + (b) * SHM_V + vst1) = sr_[i].vs1; const int kc = sc * 2;               \
    *(bf16x8*)(K_lds + (b) * SHM_K + KSWZ(sr, kc)) = sr_[i].ks0;                       \
    *(bf16x8*)(K_lds + (b) * SHM_K + KSWZ(32 + sr, kc)) = sr_[i].ks1;                  \
    *(bf16x8*)(KR_lds + (b) * SHM_KR + KRSWZ(krr, krc * 2)) = sr_[i].kr0; } while (0)
#define SWAIT() do { if constexpr (SDEPTH == 2) asm volatile("s_waitcnt vmcnt(5)" ::: "memory"); else asm volatile("s_waitcnt vmcnt(0)" ::: "memory"); } while (0)
#define RESC(a) do { if (__any((a) < 1.f)) { if (hi == 0) al_l[r32] = (a); asm volatile("s_waitcnt lgkmcnt(0)" ::: "memory"); \
    _Pragma("unroll") for (int d = 0; d < 4; ++d) _Pragma("unroll") for (int r = 0; r < 16; ++r) o[d][r] *= al_l[crow(r, hi)]; } } while (0)
  f32x16 pA0, pA1, pB0, pB1; float mnA, mnB, alA, alB; bf16x8 pa0, pa1, pa2, pa3; const int NT = seq / KVBLK;
  constexpr int SE = 0, SO = SDEPTH - 1;
  SLOAD(SE, 0); asm volatile("s_waitcnt vmcnt(0)" ::: "memory"); SWRITE(0, SE); __syncthreads();
  qkt(pA0, pA1, K_lds, KR_lds, qr, qrl, r32, hi); partialSM(pA0, pA1, m_reg, mnA, alA);
  SLOAD(SO, KVBLK); if constexpr (SDEPTH == 2) { if (2 < NT) SLOAD(SE, 2 * KVBLK); }
  SWAIT(); SWRITE(1, SO); __syncthreads();
  for (int j = 1; j + 1 < NT; j += 2) {
    SBAR(); qkt(pB0, pB1, K_lds + SHM_K, KR_lds + SHM_KR, qr, qrl, r32, hi);
    finishSM(pA0, pA1, alA, l_reg, pa0, pa1, pa2, pa3); SBAR();
    SLOAD(SO, (j + SDEPTH) * KVBLK); SBAR();
    pv_d0(o, vb0, pa0, pa1, pa2, pa3); partialSM(pB0, pB1, m_reg, mnB, alB);
    __syncthreads(); SWAIT(); SWRITE(0, SE);
    RESC(alB); __syncthreads();
    SBAR(); qkt(pA0, pA1, K_lds, KR_lds, qr, qrl, r32, hi);
    finishSM(pB0, pB1, alB, l_reg, pa0, pa1, pa2, pa3); SBAR();
    if (SDEPTH == 1 || j + 3 < NT) SLOAD(SE, (j + 1 + SDEPTH) * KVBLK); SBAR();
    pv_d0(o, vb0 + SHM_V, pa0, pa1, pa2, pa3); partialSM(pA0, pA1, m_reg, mnA, alA);
    __syncthreads(); SWAIT(); SWRITE(1, SO);
    RESC(alA); __syncthreads();
  }
  SBAR(); qkt(pB0, pB1, K_lds + SHM_K, KR_lds + SHM_KR, qr, qrl, r32, hi);
  finishSM(pA0, pA1, alA, l_reg, pa0, pa1, pa2, pa3); SBAR();
  pv_d0(o, vb0, pa0, pa1, pa2, pa3); partialSM(pB0, pB1, m_reg, mnB, alB);
  __syncthreads(); RESC(alB);
  finishSM(pB0, pB1, alB, l_reg, pa0, pa1, pa2, pa3); SBAR();
  pv_d0(o, vb0 + SHM_V, pa0, pa1, pa2, pa3);
  if (hi == 0) li_l[r32] = l_reg; asm volatile("s_waitcnt lgkmcnt(0)" ::: "memory");
  float rli[16];
#pragma unroll
  for (int r = 0; r < 16; ++r) rli[r] = __builtin_amdgcn_rcpf(li_l[crow(r, hi)]);
  __syncthreads();
  int tid2 = threadIdx.x; asm volatile("" : "+v"(tid2));
  const int wid2 = tid2 >> 6, lane2 = tid2 & 63;
  char* ot = lds + wid2 * (32 * 272);
#pragma unroll
  for (int r = 0; r < 16; ++r) { const int orow = crow(r, lane2 >> 5);
#pragma unroll
    for (int d0 = 0; d0 < 4; ++d0) *(bf16_t*)(ot + orow * 272 + (d0 * 32 + (lane2 & 31)) * 2) = (bf16_t)(cvt_pk_bf16(o[d0][r] * rli[r], 0.f) & 0xffffu); }
  asm volatile("s_waitcnt lgkmcnt(0)" ::: "memory");
  char* Oc = (char*)Ob;
#pragma unroll
  for (int i = 0; i < 8; ++i) { const int id = lane2 + 64 * i, row = id >> 4, ch = id & 15;
    const u32x4 v = *(const u32x4*)(ot + row * 272 + ch * 16);
    *(u32x4*)(Oc + (unsigned)((wid2 * QBLK + row) * LDO + ch * 8) * 2u) = v; }
  __syncthreads();
#undef SLOAD
#undef SWRITE
#undef SWAIT
#undef RESC
}
}

namespace mls {
constexpr int OFF_Q = 0, OFF_K = 16384, OFF_VA = 32768, OFF_VB = 49152, OFF_C = 57344, OFF_N = 65536, OFF_VEC = 73728, LDS_NEED = 73728 + 1024;
__device__ __forceinline__ unsigned off_b(unsigned row, unsigned ch) { return 256u * row + 16u * (ch ^ (((row & 3) << 2) | ((row >> 2) & 3))); }
__device__ __forceinline__ unsigned off_vb(unsigned row, unsigned ch) { return 1024u * (row >> 3) + 512u * (ch >> 2) + 64u * (row & 7) + 16u * ((ch & 3) ^ ((row >> 2) & 3)); }
__device__ __forceinline__ s16x4 trr(unsigned addr) { s16x4 r; asm volatile("ds_read_b64_tr_b16 %0, %1" : "=&v"(r) : "v"(addr) : "memory"); return r; }

struct Tensors { const bf16_t* qkc; const bf16_t* proj; const float* gvec; float* hs; };

__device__ __forceinline__ void scan_unit(const Tensors& Tn, int unit, char* lds) {
  int tid = threadIdx.x; asm volatile("" : "+v"(tid));
  const int wid = __builtin_amdgcn_readfirstlane(tid >> 6), lane = tid & 63, r32 = lane & 31, hi = lane >> 5;
  const int chain = unit >> 3, vs = unit & 7, dir = chain >> 4, bb = (chain >> 2) & 3, hd = chain & 3;
  const unsigned lbase = (unsigned)(uintptr_t)lds;
  float* vec = (float*)(lds + OFF_VEC);
  unsigned qko[2];
#pragma unroll
  for (int i = 0; i < 2; ++i) { const int idx = tid + 512 * i, row = idx >> 4, ch = idx & 15; qko[i] = (unsigned)(((dir ? 63 - row : row) * 1024 + ch * 8) * 2); }
  const int vrow = (tid & 255) >> 2, vch = tid & 3;
  const unsigned vo = (unsigned)(((dir ? 63 - vrow : vrow) * ML_INP + vch * 8) * 2), awo = (unsigned)vrow * 4u;
  const char* gvb = (const char*)Tn.gvec + (size_t)chain * SEQ * 4;
  const unsigned veo = (unsigned)((tid >> 6) * 32 * SEQ + (tid & 63)) * 4u;
  const char* awsrc = gvb + (size_t)3 * 32 * SEQ * 4;
  bf16x8 sq[2], sk[2], sv; float sawl = 0.f, svec = 0.f;
#define TB(c) ((size_t)bb * SEQ + (dir ? (SEQ - 64 * ((c) + 1)) : 64 * (c)))
#define MLOAD(c) do { const size_t tb_ = TB(c); \
    const char* qb_ = (const char*)Tn.qkc + (tb_ * 1024 + hd * 128) * 2; const char* kb_ = qb_ + 1024; \
    const char* vb_ = (const char*)Tn.proj + (tb_ * ML_INP + 1024 + hd * 256 + vs * 32) * 2; \
    _Pragma("unroll") for (int i = 0; i < 2; ++i) { sq[i] = *reinterpret_cast<const bf16x8*>(qb_ + qko[i]); sk[i] = *reinterpret_cast<const bf16x8*>(kb_ + qko[i]); } \
    sv = *reinterpret_cast<const bf16x8*>(vb_ + vo); sawl = *reinterpret_cast<const float*>(awsrc + (size_t)(c) * 256 + awo); \
    if (tid < 192) svec = *reinterpret_cast<const float*>(gvb + (size_t)(c) * 256 + veo); } while (0)
#define MWRITE() do { \
    _Pragma("unroll") for (int i = 0; i < 2; ++i) { const int idx = tid + 512 * i, row = idx >> 4, ch = idx & 15; \
      *(bf16x8*)(lds + OFF_Q + off_b(row, ch)) = sq[i]; *(bf16x8*)(lds + OFF_K + off_b(row, ch)) = sk[i]; } \
    if (tid < 256) { *(bf16x8*)(lds + OFF_VA + att::v_st(vrow, vch * 8)) = sv; \
      float f[8]; _Pragma("unroll") for (int j = 0; j < 8; ++j) f[j] = bf2f((unsigned short)sv[j]) * sawl; \
      u32x4 w; w.x = cvt_pk_bf16(f[0], f[1]); w.y = cvt_pk_bf16(f[2], f[3]); w.z = cvt_pk_bf16(f[4], f[5]); w.w = cvt_pk_bf16(f[6], f[7]); \
      *(u32x4*)(lds + OFF_VB + off_vb(vrow, vch)) = w; } \
    else { const unsigned a = cvt_pk_bf16(sawl, sawl); u32x4 w = {a, a, a, a}; *(u32x4*)(lds + OFF_VB + off_vb(vrow, 4 + vch)) = w; } \
    if (tid < 192) vec[tid] = svec; } while (0)

  f32x16 Cst = {}, Nst = {};
  float m = 0.f;
  const int blk = wid - 2;
  MLOAD(0);
  asm volatile("s_waitcnt vmcnt(0)" ::: "memory");
  MWRITE();
  if (wid >= 2 && wid < 6) {
#pragma unroll
    for (int g = 0; g < 4; ++g) { const unsigned a = off_b(r32, 4 * blk + g) + 8 * hi; *(u32x2*)(lds + OFF_C + a) = (u32x2){0u, 0u}; *(u32x2*)(lds + OFF_N + a) = (u32x2){0u, 0u}; }
  }
  __syncthreads();
  const bf16x8 ones = {(short)0x3F80, (short)0x3F80, (short)0x3F80, (short)0x3F80, (short)0x3F80, (short)0x3F80, (short)0x3F80, (short)0x3F80};
  const int th = wid & 1;
  const unsigned hso = (unsigned)(((dir ? 63 - 32 * th - 4 * hi : 32 * th + 4 * hi) * D + hd * 256 + vs * 32 + r32) * 4);
  const int hstep = dir ? -(D * 4) : (D * 4);
  for (int c = 0; c < 64; ++c) {
    if (c + 1 < 64) MLOAD(c + 1);
    const float pm63 = vec[128 + 63], bL = vec[63];
    const float Mx = fmaxf(m, pm63);
    if (wid < 2) {
      int ln_ = lane; asm volatile("" : "+v"(ln_));
      const int r32 = ln_ & 31, hi = ln_ >> 5;
      f32x16 qc = {}, qn = {}, p0 = {}, p1 = {};
      {
        bf16x8 qf[8];
#pragma unroll
        for (int ks = 0; ks < 8; ++ks) qf[ks] = *(const bf16x8*)(lds + OFF_Q + off_b(32 * th + r32, 2 * ks + hi));
#pragma unroll
        for (int ks = 0; ks < 8; ++ks) {
          const bf16x8 cf = *(const bf16x8*)(lds + OFF_C + off_b(r32, 2 * ks + hi));
          const bf16x8 nf = *(const bf16x8*)(lds + OFF_N + off_b(r32, 2 * ks + hi));
          qc = __builtin_amdgcn_mfma_f32_32x32x16_bf16(qf[ks], cf, qc, 0, 0, 0);
          qn = __builtin_amdgcn_mfma_f32_32x32x16_bf16(qf[ks], nf, qn, 0, 0, 0);
        }
#pragma unroll
        for (int ks = 0; ks < 8; ++ks) {
          const bf16x8 k0 = *(const bf16x8*)(lds + OFF_K + off_b(r32, 2 * ks + hi));
          const bf16x8 k1 = *(const bf16x8*)(lds + OFF_K + off_b(32 + r32, 2 * ks + hi));
          p0 = __builtin_amdgcn_mfma_f32_32x32x16_bf16(k0, qf[ks], p0, 0, 0, 0);
          p1 = __builtin_amdgcn_mfma_f32_32x32x16_bf16(k1, qf[ks], p1, 0, 0, 0);
        }
      }
      const int t = 32 * th + r32;
      const float Mt = fmaxf(m, vec[128 + t]);
#pragma unroll
      for (int r = 0; r < 16; ++r) { const int s0 = att::crow(r, hi), s1 = 32 + s0;
        float w0 = fast_exp(vec[64 + s0] - Mt), w1 = fast_exp(vec[64 + s1] - Mt); w0 = (s0 <= t) ? w0 : 0.f; w1 = (s1 <= t) ? w1 : 0.f;
        p0[r] *= w0; p1[r] *= w1; }
      bf16x8 pa0, pa1, pa2, pa3;
      PK4(p0, 0, pa0); PK4(p0, 8, pa1); PK4(p1, 0, pa2); PK4(p1, 8, pa3);
      f32x16 pv = {}, pd = {};
      att::pv_one<0>(pv, (int)(lbase + OFF_VA) + att::v_rd_base(ln_), pa0, pa1, pa2, pa3);
      pd = __builtin_amdgcn_mfma_f32_32x32x16_bf16(pa0, ones, pd, 0, 0, 0);
      pd = __builtin_amdgcn_mfma_f32_32x32x16_bf16(pa1, ones, pd, 0, 0, 0);
      pd = __builtin_amdgcn_mfma_f32_32x32x16_bf16(pa2, ones, pd, 0, 0, 0);
      pd = __builtin_amdgcn_mfma_f32_32x32x16_bf16(pa3, ones, pd, 0, 0, 0);
      char* hsb = (char*)Tn.hs + ((size_t)dir * T + TB(c)) * (D * 4);
#pragma unroll
      for (int r = 0; r < 16; ++r) { const int rr = (r & 3) + 8 * (r >> 2), tr_ = 32 * th + 4 * hi + rr;
        const float Mr = fmaxf(m, vec[128 + tr_]), gw = fast_exp(m - Mr), en = fast_exp(-(vec[tr_] + Mr));
        const float num = gw * qc[r] + pv[r], den = gw * qn[r] + pd[r];
        const float h = num * fast_rcp(fmaxf(fabsf(den), en));
        *(float*)(hsb + (unsigned)((int)hso + rr * hstep)) = h; }
    } else if (wid < 6) {
      int ln_ = lane; asm volatile("" : "+v"(ln_));
      const int hi = ln_ >> 5;
      f32x16 kv = {}, kn = {};
#pragma unroll
      for (int ks = 0; ks < 4; ++ks) {
        const unsigned hb = (ln_ >> 4) & 1, q = (ln_ & 15) >> 2, p = ln_ & 3;
        const unsigned row0 = 16 * ks + 8 * hi + q;
        const s16x4 ka = trr(lbase + OFF_K + off_b(row0, 4 * blk + 2 * hb + (p >> 1)) + 8 * (p & 1));
        const s16x4 kb = trr(lbase + OFF_K + off_b(row0 + 4, 4 * blk + 2 * hb + (p >> 1)) + 8 * (p & 1));
        const s16x4 va = trr(lbase + OFF_VB + off_vb(row0, 2 * hb + (p >> 1)) + 8 * (p & 1));
        const s16x4 vb_ = trr(lbase + OFF_VB + off_vb(row0 + 4, 2 * hb + (p >> 1)) + 8 * (p & 1));
        const s16x4 aa = trr(lbase + OFF_VB + off_vb(row0, 4 + 2 * hb + (p >> 1)) + 8 * (p & 1));
        const s16x4 ab = trr(lbase + OFF_VB + off_vb(row0 + 4, 4 + 2 * hb + (p >> 1)) + 8 * (p & 1));
        asm volatile("s_waitcnt lgkmcnt(0)" ::: "memory"); __builtin_amdgcn_sched_barrier(0);
        const bf16x8 kf = PKV(ka, kb), vf = PKV(va, vb_), af = PKV(aa, ab);
        kv = __builtin_amdgcn_mfma_f32_32x32x16_bf16(kf, vf, kv, 0, 0, 0);
        kn = __builtin_amdgcn_mfma_f32_32x32x16_bf16(kf, af, kn, 0, 0, 0);
      }
      const float cw = fast_exp(m - Mx), sc = fast_exp(pm63 - Mx);
#pragma unroll
      for (int r = 0; r < 16; ++r) { Cst[r] = cw * Cst[r] + sc * kv[r]; Nst[r] = cw * Nst[r] + sc * kn[r]; }
    }
    m = bL + Mx;
    __syncthreads();
    if (c + 1 < 64) {
      if (wid < 2) asm volatile("s_waitcnt vmcnt(16)" ::: "memory");
      else asm volatile("s_waitcnt vmcnt(0)" ::: "memory");
      MWRITE();
      if (wid >= 2 && wid < 6) {
#pragma unroll
        for (int g = 0; g < 4; ++g) { const unsigned a = off_b(r32, 4 * blk + g) + 8 * hi;
          *(u32x2*)(lds + OFF_C + a) = (u32x2){cvt_pk_bf16(Cst[4 * g], Cst[4 * g + 1]), cvt_pk_bf16(Cst[4 * g + 2], Cst[4 * g + 3])};
          *(u32x2*)(lds + OFF_N + a) = (u32x2){cvt_pk_bf16(Nst[4 * g], Nst[4 * g + 1]), cvt_pk_bf16(Nst[4 * g + 2], Nst[4 * g + 3])}; }
      }
    }
    __syncthreads();
  }
#undef TB
#undef MLOAD
#undef MWRITE
}
}

#define XB_TMO      128
#define XB_XCNT(j)  (256  + 64 * (j))
#define XB_XSUB(j)  (1280 + 64 * (j))
#define XB_XGEN(j)  (2304 + 64 * (j))
#define XB_TOP      3328
#define XB_TOPGEN   3392
#define XCD_BAR_WORDS 3456
#define XB_SPIN_CAP (1u << 18)
__device__ __forceinline__ unsigned xb_ld(unsigned* p)              { return __hip_atomic_load(p, __ATOMIC_RELAXED, __HIP_MEMORY_SCOPE_AGENT); }
__device__ __forceinline__ unsigned xb_add(unsigned* p, unsigned v) { return __hip_atomic_fetch_add(p, v, __ATOMIC_RELAXED, __HIP_MEMORY_SCOPE_AGENT); }
__device__ __forceinline__ unsigned xb_xcc_id() { return (unsigned)__builtin_amdgcn_s_getreg((3 << 11) | 20) & 0xFu; }
#define XB_SPIN(cond, bar) do { unsigned _sp = 0; while (cond) { __builtin_amdgcn_s_sleep(1); \
    if ((++_sp & 255u) == 0u) { if (xb_ld(&(bar)[XB_TMO])) break; if (_sp > XB_SPIN_CAP) { atomicAdd(&(bar)[XB_TMO], 1u); break; } } } } while (0)
struct XcdBarrier { unsigned* bar; unsigned x; volatile LAS unsigned* st; };
__device__ __forceinline__ XcdBarrier xcd_barrier_post(unsigned* bar, volatile LAS unsigned* st) {
    XcdBarrier b; b.bar = bar; b.x = xb_xcc_id(); b.st = st;
    if (threadIdx.x == 0) (void)xb_add(&bar[XB_XCNT(b.x)], 1u);
    return b;
}
__device__ __forceinline__ void xcd_barrier_complete(unsigned* bar, unsigned x, unsigned& nloc, unsigned& nx) {
    const unsigned G = gridDim.x * gridDim.y * gridDim.z;
    unsigned sum, cnt, mine, sp = 0u;
    for (;;) {
        sum = 0u; cnt = 0u; mine = 0u;
#pragma unroll
        for (unsigned j = 0; j < 16; ++j) { const unsigned c = xb_ld(&bar[XB_XCNT(j)]); sum += c; cnt += (c > 0u) ? 1u : 0u; mine = (j == x) ? c : mine; }
        if (sum == G) break;
        __builtin_amdgcn_s_sleep(1);
        if ((++sp & 255u) == 0u) { if (xb_ld(&bar[XB_TMO])) break; if (sp > XB_SPIN_CAP) { atomicAdd(&bar[XB_TMO], 1u); break; } }
    }
    nloc = mine > 0u ? mine : 1u; nx = cnt > 0u ? cnt : 1u;
}
__device__ __forceinline__ void xcd_barrier(const XcdBarrier& b) {
    asm volatile("s_waitcnt vmcnt(0)" ::: "memory");
    __syncthreads();
    if (threadIdx.x == 0) {
        unsigned* bar = b.bar;
        __builtin_amdgcn_s_waitcnt(0);
        unsigned nloc = b.st[0], nx = b.st[1];
        if (nloc == 0u) { xcd_barrier_complete(bar, b.x, nloc, nx); b.st[0] = nloc; b.st[1] = nx; }
        const unsigned old = xb_add(&bar[XB_XSUB(b.x)], 1u);
        const unsigned gen = old / nloc;
        if (old + 1u == (gen + 1u) * nloc) {
            __builtin_amdgcn_fence(__ATOMIC_RELEASE, "agent");
            asm volatile("s_waitcnt vmcnt(0)" ::: "memory");
            const unsigned og = xb_add(&bar[XB_TOP], 1u);
            const unsigned tg = og / nx;
            if (og + 1u == (tg + 1u) * nx) xb_add(&bar[XB_TOPGEN], 1u);
            else XB_SPIN(xb_ld(&bar[XB_TOPGEN]) == tg, bar);
            __builtin_amdgcn_fence(__ATOMIC_ACQUIRE, "agent");
            xb_add(&bar[XB_XGEN(b.x)], 1u);
            asm volatile("s_waitcnt vmcnt(0)" ::: "memory");
        } else {
            XB_SPIN(xb_ld(&bar[XB_XGEN(b.x)]) == gen, bar);
            __builtin_amdgcn_fence(__ATOMIC_ACQUIRE, "agent");
            asm volatile("s_waitcnt vmcnt(0)" ::: "memory");
        }
    }
    __syncthreads();
}

struct Args { const float* in[24]; float* out; unsigned char* ws; int ph_lo, ph_hi; };
constexpr int NPH = 38;
struct Frame {
    char* lds; int tid, lane, wave, G, bid;
    unsigned char* ws;
};

struct CvtJob { const float* src; bf16_t* dst; int K, N, sld; int grp, gstride, goff; const float* sk; const float* sn; };
__device__ __forceinline__ void cvt_tiles(const Frame& F, const CvtJob& j, int& rot) {
    const int tk = j.K / 64, tn = (j.N + 255) / 256, nt = tk * tn;
    int start = F.bid - (rot % F.G); if (start < 0) start += F.G;
    rot += nt;
    if (start >= nt) return;
    const int n4 = F.lane * 4, kq = F.wave;
    f32x4 v[8], vn[8];
#define CVT_LOAD(dst, it_) do { const int k0_ = ((it_) / tn) * 64 + kq * 8, n0_ = ((it_) % tn) * 256 + n4; \
        if (n0_ < j.N) { _Pragma("unroll") for (int r = 0; r < 8; ++r) dst[r] = *(const f32x4*)(j.src + (size_t)(k0_ + r) * j.sld + n0_); } } while (0)
    CVT_LOAD(v, start);
    int buf = 0;
    for (int it = start; it < nt; it += F.G) {
        const bool has_next = it + F.G < nt;
        if (has_next) CVT_LOAD(vn, it + F.G);
        const int k0 = (it / tn) * 64, n0 = (it % tn) * 256;
        char* img = F.lds + buf * 32768;
        if (n0 + n4 < j.N) {
            if (j.sk) {
#pragma unroll
                for (int r = 0; r < 8; ++r) v[r] = v[r] * j.sk[k0 + kq * 8 + r];
            }
            if (j.sn) { const f32x4 sn = *(const f32x4*)(j.sn + n0 + n4);
#pragma unroll
                for (int r = 0; r < 8; ++r) v[r] = v[r] * sn; }
#pragma unroll
            for (int c = 0; c < 4; ++c) {
                u32x4 w; w.x = cvt_pk_bf16(v[0][c], v[1][c]); w.y = cvt_pk_bf16(v[2][c], v[3][c]); w.z = cvt_pk_bf16(v[4][c], v[5][c]); w.w = cvt_pk_bf16(v[6][c], v[7][c]);
                *(u32x4*)(img + (n4 + c) * 128 + ((kq ^ (F.lane & 7)) * 16)) = w;
            }
        }
        __syncthreads();
#pragma unroll
        for (int q = 0; q < 4; ++q) { const int id = F.tid + 512 * q, n = id >> 3, kc = id & 7;
            if (n0 + n < j.N) { const u32x4 w = *(const u32x4*)(img + n * 128 + ((kc ^ ((n >> 2) & 7)) * 16));
                const int nn = n0 + n, drow = (nn / j.grp) * j.gstride + j.goff + (nn % j.grp);
                *(u32x4*)(j.dst + (size_t)drow * j.K + k0 + kc * 8) = w; } }
        buf ^= 1;
        if (has_next) {
#pragma unroll
            for (int r = 0; r < 8; ++r) v[r] = vn[r];
        }
    }
    __syncthreads();
#undef CVT_LOAD
}
__device__ __forceinline__ CvtJob mkjob(const float* src, bf16_t* dst, int K, int N, int sld) { CvtJob j; j.src = src; j.dst = dst; j.K = K; j.N = N; j.sld = sld; j.grp = N; j.gstride = 0; j.goff = 0; j.sk = nullptr; j.sn = nullptr; return j; }

__device__ __forceinline__ void phase_convert_small(const Frame& F, const Args& a) {
    bf16_t* W = (bf16_t*)(F.ws + WS_W); int rot = 0;
    for (int j = 0; j < 2; ++j) {
        { CvtJob c = mkjob(a.in[2] + (size_t)j * D * MLA_IN, (bf16_t*)((char*)W + W_DQKV) + (size_t)j * MLA_INP * D, D, MLA_IN, MLA_IN); cvt_tiles(F, c, rot); }
        { CvtJob c = mkjob(a.in[4] + (size_t)j * MLA_QR * MLA_QW, (bf16_t*)((char*)W + W_UQ) + (size_t)j * MLA_QW * MLA_QR, MLA_QR, MLA_QW, MLA_QW); c.sk = a.in[3] + j * MLA_QR; cvt_tiles(F, c, rot); }
        { CvtJob c = mkjob(a.in[6] + (size_t)j * MLA_KVR * MLA_KVW, (bf16_t*)((char*)W + W_UKV) + (size_t)j * MLA_KVW * MLA_KVR, MLA_KVR, MLA_KVW, MLA_KVW); c.sk = a.in[5] + j * MLA_KVR; cvt_tiles(F, c, rot); }
        { CvtJob c = mkjob(a.in[7] + (size_t)j * D * D, (bf16_t*)((char*)W + W_O) + (size_t)j * D * D, D, D, D); cvt_tiles(F, c, rot); }
        { bf16_t* z = (bf16_t*)((char*)W + W_DQKV) + (size_t)j * MLA_INP * D + (size_t)MLA_IN * D;
          for (int i = F.bid * NTHR + F.tid; i < (MLA_INP - MLA_IN) * D / 8; i += F.G * NTHR) *(u32x4*)(z + (size_t)i * 8) = (u32x4){0u, 0u, 0u, 0u}; }
    }
    for (int g = 0; g < 4; ++g) { CvtJob c = mkjob(a.in[8] + (size_t)g * 256 * 256, (bf16_t*)((char*)W + W_POOL) + (size_t)g * 256 * 256, 256, 256, 256); c.sn = a.in[9] + g * 256; cvt_tiles(F, c, rot); }
    { CvtJob c = mkjob(a.in[10], (bf16_t*)((char*)W + W_IN), D, ML_INP, ML_IN); cvt_tiles(F, c, rot); }
    { CvtJob c = mkjob(a.in[14], (bf16_t*)((char*)W + W_OUT), D, D, D); cvt_tiles(F, c, rot); }
    for (int j = 0; j < 2; ++j) {
        { CvtJob c = mkjob(a.in[15] + (size_t)j * D * DFF, (bf16_t*)((char*)W + W_GU) + (size_t)j * 2 * DFF * D, D, DFF, DFF); c.grp = 128; c.gstride = 256; c.goff = 0; cvt_tiles(F, c, rot); }
        { CvtJob c = mkjob(a.in[16] + (size_t)j * D * DFF, (bf16_t*)((char*)W + W_GU) + (size_t)j * 2 * DFF * D, D, DFF, DFF); c.grp = 128; c.gstride = 256; c.goff = 128; cvt_tiles(F, c, rot); }
        { CvtJob c = mkjob(a.in[17] + (size_t)j * DFF * D, (bf16_t*)((char*)W + W_DN) + (size_t)j * D * DFF, DFF, D, D); cvt_tiles(F, c, rot); }
    }
    { const float* x = a.in[0]; bf16_t* xb = (bf16_t*)(F.ws + WS_XB);
      for (size_t i = (size_t)F.bid * NTHR + F.tid; i < (size_t)T * D / 8; i += (size_t)F.G * NTHR) {
          const f32x4 v0 = *(const f32x4*)(x + i * 8), v1 = *(const f32x4*)(x + i * 8 + 4);
          u32x4 w; w.x = cvt_pk_bf16(v0[0], v0[1]); w.y = cvt_pk_bf16(v0[2], v0[3]); w.z = cvt_pk_bf16(v1[0], v1[1]); w.w = cvt_pk_bf16(v1[2], v1[3]);
          *(u32x4*)(xb + i * 8) = w; } }
}
__device__ __forceinline__ void phase_convert_moe(const Frame& F, const Args& a, int c) {
    bf16_t* GU = (bf16_t*)(F.ws + WS_WMOE + WM_GU); bf16_t* DN = (bf16_t*)(F.ws + WS_WMOE + WM_DN); int rot = 0;
    for (int e = 0; e < NEXP; ++e) {
        const size_t eo = ((size_t)c * NEXP + e) * (size_t)D * DFFE;
        { CvtJob j = mkjob(a.in[19] + eo, GU + (size_t)e * 2 * DFFE * D, D, DFFE, DFFE); j.grp = 128; j.gstride = 256; j.goff = 0; cvt_tiles(F, j, rot); }
        { CvtJob j = mkjob(a.in[20] + eo, GU + (size_t)e * 2 * DFFE * D, D, DFFE, DFFE); j.grp = 128; j.gstride = 256; j.goff = 128; cvt_tiles(F, j, rot); }
        { CvtJob j = mkjob(a.in[21] + eo, DN + (size_t)e * D * DFFE, DFFE, D, D); cvt_tiles(F, j, rot); }
    }
}

template <int MODE>
__device__ __forceinline__ void phase_ln(const Frame& F, const float* xin, const float* y, float* xout, bf16_t* xb, const float* g, const float* b,
                                         const float* wproj  , const float* bgate) {
    constexpr bool MOE_IN = MODE & 1, ROUTER = (MODE & 2) != 0, GATES = (MODE & 4) != 0, FINAL = (MODE & 8) != 0;
    constexpr int NP = ROUTER ? 8 : (GATES ? 16 : 0); constexpr int NPA = NP ? NP : 4;
    float* wl = (float*)F.lds;
    int* sel = (int*)(F.lds + 65536);
    const int* toke = (const int*)(F.ws + WS_META + MT_TOKE); const float* tokw = (const float*)(F.ws + WS_META + MT_TOKW);
    if constexpr (NP != 0) {
        for (int i = F.tid; i < 1024 * NPA; i += NTHR) { const int c = i / NPA, p = i % NPA; wl[i] = ROUTER ? wproj[c * 8 + p] : wproj[(size_t)c * ML_IN + ML_INP + p]; }
        __syncthreads();
    }
    f32x4 gg[4], bb[4];
#pragma unroll
    for (int j = 0; j < 4; ++j) { gg[j] = *(const f32x4*)(g + F.lane * 4 + 256 * j); bb[j] = *(const f32x4*)(b + F.lane * 4 + 256 * j); }
    for (int blk = F.bid; blk < T / 64; blk += F.G) {
        for (int rp = 0; rp < 8; rp += 2) {
            f32x4 v[2][4]; float w1[2] = {0.f, 0.f}, w2[2] = {0.f, 0.f};
#pragma unroll
            for (int u = 0; u < 2; ++u) { const int row = blk * 64 + F.wave * 8 + rp + u;
                if (MOE_IN) { w1[u] = tokw[row * 2]; w2[u] = tokw[row * 2 + 1]; } }
            f32x4 xv[2][4], ya[2][4], yb[2][4];
#pragma unroll
            for (int u = 0; u < 2; ++u) { const int row = blk * 64 + F.wave * 8 + rp + u;
#pragma unroll
                for (int j = 0; j < 4; ++j) { const int c = F.lane * 4 + 256 * j;
                    xv[u][j] = *(const f32x4*)(xin + (size_t)row * D + c);
                    if (MOE_IN) { ya[u][j] = *(const f32x4*)(y + (size_t)(2 * row) * D + c); yb[u][j] = *(const f32x4*)(y + (size_t)(2 * row + 1) * D + c); }
                    else ya[u][j] = *(const f32x4*)(y + (size_t)row * D + c); } }
#pragma unroll
            for (int u = 0; u < 2; ++u)
#pragma unroll
                for (int j = 0; j < 4; ++j) { f32x4 yv; if (MOE_IN) yv = ya[u][j] * w1[u] + yb[u][j] * w2[u]; else yv = ya[u][j]; v[u][j] = xv[u][j] * DN_ALPHA + yv; }
            float mu[2], rstd[2];
#pragma unroll
            for (int u = 0; u < 2; ++u) { float s_ = 0.f;
#pragma unroll
                for (int j = 0; j < 4; ++j) s_ += (v[u][j][0] + v[u][j][1]) + (v[u][j][2] + v[u][j][3]);
                mu[u] = s_; }
            mu[0] = wave_sum(mu[0]) * (1.0f / 1024.0f); mu[1] = wave_sum(mu[1]) * (1.0f / 1024.0f);
#pragma unroll
            for (int u = 0; u < 2; ++u) { float q = 0.f;
#pragma unroll
                for (int j = 0; j < 4; ++j) { const f32x4 d = v[u][j] - mu[u]; q += (d[0] * d[0] + d[1] * d[1]) + (d[2] * d[2] + d[3] * d[3]); }
                rstd[u] = q; }
            rstd[0] = 1.0f / sqrtf(wave_sum(rstd[0]) * (1.0f / 1024.0f) + LN_EPS); rstd[1] = 1.0f / sqrtf(wave_sum(rstd[1]) * (1.0f / 1024.0f) + LN_EPS);
#pragma unroll
            for (int u = 0; u < 2; ++u) { const int row = blk * 64 + F.wave * 8 + rp + u, rr = rp + u;
#pragma unroll
            for (int j = 0; j < 4; ++j) { const int c = F.lane * 4 + 256 * j;
                v[u][j] = (v[u][j] - mu[u]) * rstd[u] * gg[j] + bb[j];
                *(f32x4*)(xout + (size_t)row * D + c) = v[u][j];
                if (!FINAL) { u32x2 w; w.x = cvt_pk_bf16(v[u][j][0], v[u][j][1]); w.y = cvt_pk_bf16(v[u][j][2], v[u][j][3]); *(u32x2*)(xb + (size_t)row * D + c) = w; } }
            if constexpr (NP != 0) {
                float pr[NPA];
#pragma unroll
                for (int p = 0; p < NPA; ++p) pr[p] = 0.f;
#pragma unroll
                for (int j = 0; j < 4; ++j)
#pragma unroll
                    for (int i = 0; i < 4; ++i) { const int c = F.lane * 4 + 256 * j + i;
#pragma unroll
                        for (int p4 = 0; p4 < NPA / 4; ++p4) { const f32x4 wv = *(const f32x4*)(wl + c * NPA + p4 * 4);
                            pr[p4 * 4 + 0] += v[u][j][i] * wv[0]; pr[p4 * 4 + 1] += v[u][j][i] * wv[1]; pr[p4 * 4 + 2] += v[u][j][i] * wv[2]; pr[p4 * 4 + 3] += v[u][j][i] * wv[3]; } }
#pragma unroll
                for (int p = 0; p < NPA; ++p) pr[p] = wave_sum(pr[p]);
                if constexpr (ROUTER) {
                    int e1 = 0; float v1 = pr[0];
#pragma unroll
                    for (int p = 1; p < 8; ++p) if (pr[p] > v1) { v1 = pr[p]; e1 = p; }
                    int e2 = -1; float v2 = -3.0e38f;
#pragma unroll
                    for (int p = 0; p < 8; ++p) if (p != e1 && pr[p] > v2) { v2 = pr[p]; e2 = p; }
                    const float ww2 = 1.0f / (1.0f + expf(v1 - v2)), ww1 = 1.0f - ww2;
                    if (F.lane == 0) { int* te = (int*)(F.ws + WS_META + MT_TOKE); float* tw = (float*)(F.ws + WS_META + MT_TOKW);
                        te[row * 2] = e1; te[row * 2 + 1] = e2; tw[row * 2] = ww1; tw[row * 2 + 1] = ww2;
                        sel[F.wave * 16 + rr * 2] = e1; sel[F.wave * 16 + rr * 2 + 1] = e2; }
                }
                if constexpr (GATES) { if (F.lane < 16) { float gv = 0.f;
#pragma unroll
                        for (int p = 0; p < 16; ++p) gv = (F.lane == p) ? pr[p] : gv;
                        ((float*)(F.ws + WS_META + MT_GATES))[(size_t)row * 16 + F.lane] = gv + bgate[F.lane]; } }
            }
            }
        }
        if constexpr (ROUTER) {
            __syncthreads();
            if (F.tid < 128) { const int e = sel[F.tid]; int rk = 0; for (int p = 0; p < F.tid; ++p) rk += (sel[p] == e) ? 1 : 0;
                const int row = blk * 64 + (F.tid >> 4) * 8 + ((F.tid & 15) >> 1);
                ((int*)(F.ws + WS_META + MT_RANK))[row * 2 + (F.tid & 1)] = rk; }
            if (F.tid >= 128 && F.tid < 136) { const int e = F.tid - 128; int cn = 0; for (int p = 0; p < 128; ++p) cn += (sel[p] == e) ? 1 : 0;
                ((int*)(F.ws + WS_META + MT_CNTW))[blk * 8 + e] = cn; }
            __syncthreads();
        }
    }
    (void)toke;
}

__device__ __forceinline__ void phase_moe_permute(const Frame& F) {
    int* cl = (int*)F.lds;
    int* tot = cl + 2048; int* toff = cl + 2056; int* base = cl + 2072;
    const int* cntw = (const int*)(F.ws + WS_META + MT_CNTW);
    for (int i = F.tid; i < 2048; i += NTHR) cl[i] = cntw[i];
    __syncthreads();
    if (F.tid < 8) { int s = 0; for (int w = 0; w < 256; ++w) s += cl[w * 8 + F.tid]; tot[F.tid] = s; }
    __syncthreads();
    if (F.tid == 0) { int o = 0; for (int e = 0; e < 8; ++e) { toff[e] = o; o += (tot[e] + 255) >> 8; } toff[8] = o;
        if (F.bid == 0) { int* meta = (int*)(F.ws + WS_META + MT_MOE); for (int e = 0; e < 8; ++e) meta[e] = tot[e]; for (int e = 0; e < 9; ++e) meta[8 + e] = toff[e]; } }
    __syncthreads();
    const int* toke = (const int*)(F.ws + WS_META + MT_TOKE); const int* rank = (const int*)(F.ws + WS_META + MT_RANK);
    int* rowtok = (int*)(F.ws + WS_META + MT_ROWTOK);
    const bf16_t* xb = (const bf16_t*)(F.ws + WS_XB); bf16_t* xp = (bf16_t*)(F.ws + WS_SCR + SC_XP);
    for (int blk = F.bid; blk < T / 64; blk += F.G) {
        __syncthreads();
        if (F.tid < 8) { int s = 0; for (int w = 0; w < blk; ++w) s += cl[w * 8 + F.tid]; base[F.tid] = toff[F.tid] * 256 + s; }
        __syncthreads();
        for (int pp = F.wave; pp < 128; pp += NWAVES) {
            const int tok = blk * 64 + (pp >> 1), k = pp & 1, e = toke[tok * 2 + k], row = base[e] + rank[tok * 2 + k];
            const u32x4 v0 = *(const u32x4*)(xb + (size_t)tok * D + F.lane * 8), v1 = *(const u32x4*)(xb + (size_t)tok * D + 512 + F.lane * 8);
            *(u32x4*)(xp + (size_t)row * D + F.lane * 8) = v0; *(u32x4*)(xp + (size_t)row * D + 512 + F.lane * 8) = v1;
            if (F.lane == 0) rowtok[row] = tok * 2 + k;
        }
    }
}

__device__ __forceinline__ void phase_mla_rows(const Frame& F, const int* positions) {
    const float* lat = (const float*)(F.ws + WS_SCR + SC_LAT);
    bf16_t* cqn = (bf16_t*)(F.ws + WS_SCR + SC_CQN); bf16_t* ckvn = (bf16_t*)(F.ws + WS_SCR + SC_CKVN); bf16_t* kr = (bf16_t*)(F.ws + WS_SCR + SC_KR);
    float* rope = (float*)(F.ws + WS_META + MT_ROPE);
    for (int row = F.bid * NWAVES + F.wave; row < T; row += F.G * NWAVES) {
        const float* lr = lat + (size_t)row * MLA_INP;
        float cq[6], ck[4]; float s1 = 0.f, s2 = 0.f;
#pragma unroll
        for (int j = 0; j < 6; ++j) { cq[j] = lr[F.lane + 64 * j]; s1 += cq[j] * cq[j]; }
#pragma unroll
        for (int j = 0; j < 4; ++j) { ck[j] = lr[MLA_QR + F.lane + 64 * j]; s2 += ck[j] * ck[j]; }
        const float r1 = 1.0f / sqrtf(wave_sum(s1) * (1.0f / MLA_QR) + RMS_EPS), r2 = 1.0f / sqrtf(wave_sum(s2) * (1.0f / MLA_KVR) + RMS_EPS);
#pragma unroll
        for (int j = 0; j < 6; ++j) cqn[(size_t)row * MLA_QR + F.lane + 64 * j] = (bf16_t)(cvt_pk_bf16(cq[j] * r1, 0.f) & 0xffffu);
#pragma unroll
        for (int j = 0; j < 4; ++j) ckvn[(size_t)row * MLA_KVR + F.lane + 64 * j] = (bf16_t)(cvt_pk_bf16(ck[j] * r2, 0.f) & 0xffffu);
        const float kx = lr[MLA_QR + MLA_KVR + F.lane];
        const float ko = __shfl_xor(kx, 32);
        const int i = F.lane & 31;
        const float invf = exp2f(-(float)i * (13.287712379549449f / 32.0f));
        const float ang = (float)positions[row] * invf;
        const double rev = (double)ang * 0.15915494309189535;
        const float fr = (float)(rev - floor(rev));
        const float sn = __builtin_amdgcn_sinf(fr), cs = __builtin_amdgcn_cosf(fr);
        const float out = (F.lane < 32) ? (kx * cs - ko * sn) : (kx * cs + ko * sn);
        kr[(size_t)row * MLA_ROPE + F.lane] = (bf16_t)(cvt_pk_bf16(out, 0.f) & 0xffffu);
        if (F.lane < 32) *(f32x2*)(rope + (size_t)row * 64 + 2 * i) = (f32x2){cs, sn};
    }
}

__device__ __forceinline__ void phase_pool_z(const Frame& F) {
    const float* x = (const float*)(F.ws + WS_X); bf16_t* z = (bf16_t*)(F.ws + WS_SCR + SC_Z);
    const int c = F.tid * 2, half = 1 << (c >> 8);
    for (int blk = F.bid; blk < T / 64; blk += F.G) {
        const int b0 = (blk * 64) / SEQ * SEQ, t0 = blk * 64 - b0;
        f32x2 sum = {0.f, 0.f};
        for (int s = t0 - half; s < t0 + half; ++s) if (s >= 0 && s < SEQ) { const f32x2 v = *(const f32x2*)(x + (size_t)(b0 + s) * D + c); sum += v; }
        for (int t = t0; t < t0 + 64; ++t) {
            const int lo = t - half < 0 ? 0 : t - half, hi = t + half > SEQ ? SEQ : t + half;
            const f32x2 xv = *(const f32x2*)(x + (size_t)(b0 + t) * D + c);
            const float inv = 1.0f / (float)(hi - lo);
            const f32x2 zz = sum * inv - xv;
            *(unsigned*)(z + (size_t)(b0 + t) * D + c) = cvt_pk_bf16(zz[0], zz[1]);
            if (t + half < SEQ) { const f32x2 v = *(const f32x2*)(x + (size_t)(b0 + t + half) * D + c); sum += v; }
            if (t - half >= 0) { const f32x2 v = *(const f32x2*)(x + (size_t)(b0 + t - half) * D + c); sum -= v; }
        }
    }
}

__device__ __forceinline__ void phase_mlstm_prep(const Frame& F, const float* convw) {
    const bf16_t* proj = (const bf16_t*)(F.ws + WS_SCR + SC_PROJ); bf16_t* qkc = (bf16_t*)(F.ws + WS_SCR + SC_QKC);
    const int c = F.tid * 2;
    float w0[5], w1[5];
#pragma unroll
    for (int j = 0; j < 5; ++j) { w0[j] = convw[j * 1024 + c]; w1[j] = convw[j * 1024 + c + 1]; }
    const float ksc = (c >= 512) ? 0.08838834764831845f : 1.0f;
    for (int blk = F.bid; blk < T / 64; blk += F.G) {
        const int b0 = (blk * 64) / SEQ * SEQ, t0 = blk * 64 - b0;
        float a0[5], a1[5];
#pragma unroll
        for (int j = 0; j < 4; ++j) { const int s = t0 - 2 + j; unsigned w = 0u; if (s >= 0 && s < SEQ) w = *(const unsigned*)(proj + (size_t)(b0 + s) * ML_INP + c); a0[j + 1] = bflo(w); a1[j + 1] = bfhi(w); }
        for (int t = t0; t < t0 + 64; ++t) {
#pragma unroll
            for (int j = 0; j < 4; ++j) { a0[j] = a0[j + 1]; a1[j] = a1[j + 1]; }
            { const int s = t + 2; unsigned w = 0u; if (s < SEQ) w = *(const unsigned*)(proj + (size_t)(b0 + s) * ML_INP + c); a0[4] = bflo(w); a1[4] = bfhi(w); }
            float r0 = 0.f, r1 = 0.f;
#pragma unroll
            for (int j = 0; j < 5; ++j) { r0 += a0[j] * w0[j]; r1 += a1[j] * w1[j]; }
            r0 = silu_f(r0) * ksc; r1 = silu_f(r1) * ksc;
            *(unsigned*)(qkc + (size_t)(b0 + t) * D + c) = cvt_pk_bf16(r0, r1);
        }
    }
    const float* gates = (const float*)(F.ws + WS_META + MT_GATES);
    float* gb = (float*)(F.ws + WS_META + MT_GVEC); float* gu = gb + 32 * SEQ; float* gpm = gu + 32 * SEQ; float* gawl = gpm + 32 * SEQ;
    for (int wg = F.bid * NWAVES + F.wave; wg < 32 * 64; wg += F.G * NWAVES) {
        const int chain = wg >> 6, cch = wg & 63, dir = chain >> 4, bb = (chain >> 2) & 3, hd = chain & 3;
        const int pos = cch * 64 + F.lane, tok = dir ? (SEQ - 1 - pos) : pos;
        const size_t row = (size_t)bb * SEQ + tok;
        const float li = gates[row * 16 + dir * 4 + hd], f = gates[row * 16 + 8 + dir * 4 + hd];
        const float lf = fminf(f, 0.f) - log1pf(expf(-fabsf(f)));
        float bsum = lf;
#pragma unroll
        for (int o = 1; o < 64; o <<= 1) { const float n = __shfl_up(bsum, o); if (F.lane >= o) bsum += n; }
        const float u = li - bsum;
        float pm = u;
#pragma unroll
        for (int o = 1; o < 64; o <<= 1) { const float n = __shfl_up(pm, o); if (F.lane >= o) pm = fmaxf(pm, n); }
        const float pm63 = __shfl(pm, 63);
        const size_t o_ = (size_t)chain * SEQ + pos;
        gb[o_] = bsum; gu[o_] = u; gpm[o_] = pm; gawl[o_] = expf(u - pm63);
    }
}

__device__ __forceinline__ void phase_mlstm_combine(const Frame& F, const float* norm_g) {
    const float* hs = (const float*)(F.ws + WS_SCR + SC_HS); const bf16_t* proj = (const bf16_t*)(F.ws + WS_SCR + SC_PROJ); bf16_t* ym = (bf16_t*)(F.ws + WS_SCR + SC_YM);
    for (int row = F.bid * NWAVES + F.wave; row < T; row += F.G * NWAVES) {
#pragma unroll
        for (int hd = 0; hd < 4; ++hd) { const int c = hd * 256 + F.lane * 4;
            const f32x4 h = *(const f32x4*)(hs + (size_t)row * D + c) + *(const f32x4*)(hs + (size_t)T * D + (size_t)row * D + c);
            const float mu = wave_sum((h[0] + h[1]) + (h[2] + h[3])) * (1.0f / 256.0f);
            const f32x4 d = h - mu;
            const float rstd = 1.0f / sqrtf(wave_sum((d[0] * d[0] + d[1] * d[1]) + (d[2] * d[2] + d[3] * d[3])) * (1.0f / 256.0f) + LN_EPS);
            const f32x4 gn = *(const f32x4*)(norm_g + c);
            const u32x2 ow = *(const u32x2*)(proj + (size_t)row * ML_INP + 2048 + c);
            const float o0 = bflo(ow.x), o1 = bfhi(ow.x), o2 = bflo(ow.y), o3 = bfhi(ow.y);
            const float y0 = d[0] * rstd * gn[0] * sigmoid_f(o0), y1 = d[1] * rstd * gn[1] * sigmoid_f(o1), y2 = d[2] * rstd * gn[2] * sigmoid_f(o2), y3 = d[3] * rstd * gn[3] * sigmoid_f(o3);
            *(u32x2*)(ym + (size_t)row * D + c) = (u32x2){cvt_pk_bf16(y0, y1), cvt_pk_bf16(y2, y3)}; }
    }
}

__global__ void __launch_bounds__(NTHR, 2) fwd_kernel(Args args) {
    extern __shared__ __attribute__((aligned(16))) unsigned char lds_raw[];
    Frame F;
    F.lds = (char*)lds_raw; F.tid = threadIdx.x; F.lane = F.tid & 63; F.wave = __builtin_amdgcn_readfirstlane(F.tid >> 6); F.G = gridDim.x; F.bid = blockIdx.x; F.ws = args.ws;
    LAS unsigned char* ldsl = (LAS unsigned char*)lds_raw;
    volatile LAS unsigned* MISC = (volatile LAS unsigned*)(ldsl + LDS_MISC);
    if (F.tid < 64) MISC[F.tid] = 0u;
    __syncthreads();
    const int lo = args.ph_lo, hi = args.ph_hi;
    XcdBarrier bar; bar.bar = (unsigned*)(args.ws + WS_CTL) + 4096; bar.x = 0; bar.st = nullptr;
    if (hi - lo > 1) bar = xcd_barrier_post((unsigned*)(args.ws + WS_CTL) + 4096, MISC + 8);
#ifndef EN_MASK
#define EN_MASK 0xffffffffu
#endif
#define EN(b) ((EN_MASK >> (b)) & 1u)
#define IN(k) (lo <= (k) && (k) < hi)
#define SEAM(k) do { if (IN(k) && IN((k) + 1)) xcd_barrier(bar); } while (0)
    int ph = 0;
#define PTRS size_t zoff_ = 0; asm volatile("" : "+s"(zoff_)); unsigned char* ws = args.ws + zoff_; F.ws = ws; unsigned char* scr = ws + WS_SCR; bf16_t* Wb = (bf16_t*)(ws + WS_W); \
    float* X = (float*)(ws + WS_X); bf16_t* XB = (bf16_t*)(ws + WS_XB); float* Y = (float*)(ws + WS_Y); const float* lng = args.in[22]; const float* lnb = args.in[23]; \
    (void)scr; (void)Wb; (void)X; (void)XB; (void)Y; (void)lng; (void)lnb;

    if (EN(0) && IN(ph)) { PTRS phase_convert_small(F, args); }
    SEAM(ph); ++ph;
    if (EN(0) && IN(ph)) { PTRS phase_convert_moe(F, args, 0); }
    SEAM(ph); ++ph;

#define GEMM_DENSE(EPI, Aptr, lda_, Bptr, ldb_, K_, Mrows, Ncols, epi) do { \
        pg8::Gemm g{(const bf16_t*)(Aptr), (const bf16_t*)(Bptr), (lda_), (ldb_), (K_)}; pg8::DenseOrder S; S.init((Mrows), (Ncols), F.G, F.bid); \
        pg8::gemm_phase<EPI, pg8::DenseOrder, true>(ldsl, g, S, epi); } while (0)

#define MLA_PHASES(j, xres, lnidx, LNMODE, wproj_) do { \
    if (EN(11) && IN(ph)) { PTRS  pg8::EpiF32 E{(float*)(scr + SC_LAT), MLA_INP}; GEMM_DENSE(pg8::EpiF32, XB, D, (char*)Wb + W_DQKV + (size_t)(j) * MLA_INP * D * 2, D, D, T, MLA_INP, E); } \
    SEAM(ph); ++ph; \
    if (EN(2) && IN(ph)) { PTRS phase_mla_rows(F, (const int*)args.in[1]); } \
    SEAM(ph); ++ph; \
    if (EN(12) && IN(ph)) { PTRS  { pg8::EpiBf16 E{(bf16_t*)(scr + SC_Q), MLA_QW}; GEMM_DENSE(pg8::EpiBf16, scr + SC_CQN, MLA_QR, (char*)Wb + W_UQ + (size_t)(j) * MLA_QW * MLA_QR * 2, MLA_QR, MLA_QR, T, MLA_QW, E); } \
                  { pg8::EpiBf16 E{(bf16_t*)(scr + SC_KV), MLA_KVW}; GEMM_DENSE(pg8::EpiBf16, scr + SC_CKVN, MLA_KVR, (char*)Wb + W_UKV + (size_t)(j) * MLA_KVW * MLA_KVR * 2, MLA_KVR, MLA_KVR, T, MLA_KVW, E); } } \
    SEAM(ph); ++ph; \
    if (EN(3) && IN(ph)) { PTRS  const int x8 = F.bid & 7, jj = F.bid >> 3, per = F.G >> 3; \
        for (int lu = jj; lu < 64; lu += per) { const int bh = x8 * 4 + (lu >> 4), qb = lu & 15, b_ = bh >> 3, h_ = bh & 7; const size_t r0 = (size_t)b_ * SEQ + (size_t)qb * 256; \
            att::attn_body((const bf16_t*)(scr + SC_Q) + r0 * MLA_QW + h_ * 192, (const float*)(ws + WS_META + MT_ROPE) + r0 * 64, \
                           (const bf16_t*)(scr + SC_KV) + (size_t)b_ * SEQ * MLA_KVW + h_ * 256, (const bf16_t*)(scr + SC_KV) + (size_t)b_ * SEQ * MLA_KVW + h_ * 256 + 128, \
                           (const bf16_t*)(scr + SC_KR) + (size_t)b_ * SEQ * MLA_ROPE, (bf16_t*)(scr + SC_O) + r0 * D + h_ * 128, SEQ, F.lds); } } \
    SEAM(ph); ++ph; \
    if (EN(13) && IN(ph)) { PTRS  pg8::EpiF32 E{Y, D}; GEMM_DENSE(pg8::EpiF32, scr + SC_O, D, (char*)Wb + W_O + (size_t)(j) * D * D * 2, D, D, T, D, E); } \
    SEAM(ph); ++ph; \
    if (EN(4) && IN(ph)) { PTRS phase_ln<LNMODE>(F, xres, Y, X, XB, lng + (lnidx) * D, lnb + (lnidx) * D, wproj_, nullptr); } \
    SEAM(ph); ++ph; } while (0)

#define DENSE_PHASES(c, lnidx, LNMODE) do { \
    if (EN(14) && IN(ph)) { PTRS  pg8::EpiSwiGLU E{(bf16_t*)(scr + SC_H), DFF}; GEMM_DENSE(pg8::EpiSwiGLU, XB, D, (char*)Wb + W_GU + (size_t)(c) * 2 * DFF * D * 2, D, D, T, 2 * DFF, E); } \
    SEAM(ph); ++ph; \
    if (EN(15) && IN(ph)) { PTRS  pg8::EpiF32 E{Y, D}; GEMM_DENSE(pg8::EpiF32, scr + SC_H, DFF, (char*)Wb + W_DN + (size_t)(c) * D * DFF * 2, DFF, DFF, T, D, E); } \
    SEAM(ph); ++ph; \
    if (EN(4) && IN(ph)) { PTRS phase_ln<LNMODE>(F, X, Y, X, XB, lng + (lnidx) * D, lnb + (lnidx) * D, nullptr, nullptr); } \
    SEAM(ph); ++ph; } while (0)

#define MOE_PHASES(c, lnidx, LNMODE, xout_, wproj_, bgate_) do { \
    if (EN(6) && IN(ph)) { PTRS phase_moe_permute(F); } \
    SEAM(ph); ++ph; \
    if (EN(7) && IN(ph)) { PTRS  pg8::Gemm g{(const bf16_t*)(scr + SC_XP), (const bf16_t*)(ws + WS_WMOE + WM_GU), D, D, D}; pg8::MoeOrder S; S.build_table((const int*)(ws + WS_META + MT_MOE), (LAS int*)(ldsl + LDS_MISC + 1024), 2 * DFFE, F.G, F.bid); \
        pg8::EpiSwiGLU E{(bf16_t*)(scr + SC_HM), DFFE}; pg8::gemm_phase<pg8::EpiSwiGLU, pg8::MoeOrder, true>(ldsl, g, S, E); } \
    SEAM(ph); ++ph; \
    if (EN(7) && IN(ph)) { PTRS  pg8::Gemm g{(const bf16_t*)(scr + SC_HM), (const bf16_t*)(ws + WS_WMOE + WM_DN), DFFE, DFFE, DFFE}; pg8::MoeOrder S; S.build_table((const int*)(ws + WS_META + MT_MOE), (LAS int*)(ldsl + LDS_MISC + 1024), D, F.G, F.bid); \
        pg8::EpiF32Scatter E{(float*)(scr + SC_Y2), (const int*)(ws + WS_META + MT_ROWTOK)}; pg8::gemm_phase<pg8::EpiF32Scatter, pg8::MoeOrder, true>(ldsl, g, S, E); } \
    SEAM(ph); ++ph; \
    if (EN(4) && IN(ph)) { PTRS phase_ln<LNMODE>(F, X, (const float*)(scr + SC_Y2), xout_, XB, lng + (lnidx) * D, lnb + (lnidx) * D, wproj_, bgate_); } \
    SEAM(ph); ++ph; } while (0)

    MLA_PHASES(0, args.in[0], 0, 0, nullptr);
    DENSE_PHASES(0, 1, 0);
    if (EN(5) && IN(ph)) { PTRS phase_pool_z(F); }
    SEAM(ph); ++ph;
    if (EN(16) && IN(ph)) { PTRS  pg8::Gemm g{(const bf16_t*)(scr + SC_Z), (const bf16_t*)((char*)Wb + W_POOL), D, 256, 256}; pg8::PoolOrder S; S.init(T, D, F.G, F.bid);
        pg8::EpiF32 E{Y, D}; pg8::gemm_phase<pg8::EpiF32, pg8::PoolOrder, true>(ldsl, g, S, E); }
    SEAM(ph); ++ph;
    if (EN(4) && IN(ph)) { PTRS phase_ln<2>(F, X, Y, X, XB, lng + 2 * D, lnb + 2 * D, args.in[18], nullptr); }
    SEAM(ph); ++ph;
    MOE_PHASES(0, 3, 1 | 4, X, args.in[10], args.in[12]);
    if (EN(0) && IN(ph)) { PTRS phase_convert_moe(F, args, 1); }
    SEAM(ph); ++ph;
    if (EN(17) && IN(ph)) { PTRS  pg8::EpiBf16 E{(bf16_t*)(scr + SC_PROJ), ML_INP}; GEMM_DENSE(pg8::EpiBf16, XB, D, (char*)Wb + W_IN, D, D, T, ML_INP, E); }
    SEAM(ph); ++ph;
    if (EN(8) && IN(ph)) { PTRS phase_mlstm_prep(F, args.in[11]); }
    SEAM(ph); ++ph;
    if (EN(9) && IN(ph)) { PTRS  mls::Tensors Tn; Tn.qkc = (const bf16_t*)(scr + SC_QKC); Tn.proj = (const bf16_t*)(scr + SC_PROJ);
        Tn.gvec = (const float*)(ws + WS_META + MT_GVEC); Tn.hs = (float*)(scr + SC_HS);
        for (int u = F.bid; u < 256; u += F.G) { const int x8 = u & 7, jj = u >> 3; mls::scan_unit(Tn, (x8 * 4 + (jj >> 3)) * 8 + (jj & 7), F.lds); } }
    SEAM(ph); ++ph;
    if (EN(10) && IN(ph)) { PTRS phase_mlstm_combine(F, args.in[13]); }
    SEAM(ph); ++ph;
    if (EN(18) && IN(ph)) { PTRS  pg8::EpiF32 E{Y, D}; GEMM_DENSE(pg8::EpiF32, scr + SC_YM, D, (char*)Wb + W_OUT, D, D, T, D, E); }
    SEAM(ph); ++ph;
    if (EN(4) && IN(ph)) { PTRS phase_ln<0>(F, X, Y, X, XB, lng + 4 * D, lnb + 4 * D, nullptr, nullptr); }
    SEAM(ph); ++ph;
    DENSE_PHASES(1, 5, 0);
    MLA_PHASES(1, X, 6, 2, args.in[18] + (size_t)D * NEXP);
    MOE_PHASES(1, 7, 1 | 8, args.out, nullptr, nullptr);
#undef IN
#undef SEAM
}

extern "C" void kernel_launch(void* const* d_in, const int* in_sizes, int n_in, void* d_out, int out_size, void* d_ws, size_t ws_size, hipStream_t stream) {
    static int grid = 0;
    if (grid == 0) {
        if (n_in != 24 || in_sizes[0] != T * D || out_size != T * D || ws_size < WS_END) {
            fprintf(stderr, "kernel_launch: shape mismatch: n_in %d in0 %d out %d ws %zu (need %zu)\n", n_in, n_in > 0 ? in_sizes[0] : -1, out_size, ws_size, (size_t)WS_END); grid = -1; return; }
        int dev = 0, cus = 0, per_cu = 0;
        if (hipGetDevice(&dev) != hipSuccess || hipDeviceGetAttribute(&cus, hipDeviceAttributeMultiprocessorCount, dev) != hipSuccess) { grid = -1; return; }
        if (hipFuncSetAttribute((const void*)fwd_kernel, hipFuncAttributeMaxDynamicSharedMemorySize, LDS_BYTES) != hipSuccess) { fprintf(stderr, "kernel_launch: hipFuncSetAttribute failed\n"); grid = -1; return; }
        if (hipOccupancyMaxActiveBlocksPerMultiprocessor(&per_cu, (const void*)fwd_kernel, NTHR, LDS_BYTES) != hipSuccess || per_cu < 1)
            fprintf(stderr, "kernel_launch: occupancy query reports %d blocks per CU\n", per_cu);
        (void)hipGetLastError();
        grid = cus;
    }
    if (grid < 0) return;
    if (hipMemsetAsync((char*)d_ws + WS_CTL, 0, CTL_ZERO_BYTES, stream) != hipSuccess) { fprintf(stderr, "kernel_launch: memset failed\n"); return; }
    Args a{};
    for (int i = 0; i < 24; ++i) a.in[i] = (const float*)d_in[i];
    a.out = (float*)d_out; a.ws = (unsigned char*)d_ws;
#ifndef MK_ONE_LAUNCH
#define MK_ONE_LAUNCH 1
#endif
    if (MK_ONE_LAUNCH) { a.ph_lo = 0; a.ph_hi = NPH; hipLaunchKernelGGL(fwd_kernel, dim3(grid), dim3(NTHR), LDS_BYTES, stream, a);
#ifdef PROBE_PHASE
        for (int r = 0; r < PROBE_REPS; ++r) { a.ph_lo = PROBE_PHASE; a.ph_hi = PROBE_PHASE + 1; hipLaunchKernelGGL(fwd_kernel, dim3(grid), dim3(NTHR), LDS_BYTES, stream, a); }
#endif
    }
    else for (int p = 0; p < NPH; ++p) { a.ph_lo = p; a.ph_hi = p + 1; hipLaunchKernelGGL(fwd_kernel, dim3(grid), dim3(NTHR), LDS_BYTES, stream, a); }
    const hipError_t le = hipPeekAtLastError();
    if (le != hipSuccess) fprintf(stderr, "kernel_launch: launch failed: %s\n", hipGetErrorName(le));
}
```

```cpp
#include <hip/hip_runtime.h>
#include <cstdio>
#include <cstdint>

#define LAS __attribute__((address_space(3)))
#define GAS __attribute__((address_space(1)))
typedef unsigned short bf16_t;
typedef short bf16x8 __attribute__((ext_vector_type(8)));
typedef short s16x4 __attribute__((ext_vector_type(4)));
typedef float f32x4 __attribute__((ext_vector_type(4)));
typedef float f32x2 __attribute__((ext_vector_type(2)));
typedef float f32x16 __attribute__((ext_vector_type(16)));
typedef unsigned u32x4 __attribute__((ext_vector_type(4)));
typedef unsigned u32x2 __attribute__((ext_vector_type(2)));
typedef GAS unsigned gu32;

constexpr int BATCH = 4, SEQ = 4096, T = BATCH * SEQ, D = 1024;
constexpr float DN_ALPHA = 1.6817928305074290f;
constexpr float LN_EPS = 1e-5f, RMS_EPS = 1e-6f;
constexpr int MLA_H = 8, MLA_QR = 384, MLA_KVR = 256, MLA_NOPE = 128, MLA_ROPE = 64, MLA_V = 128, MLA_IN = 704, MLA_INP = 768;
constexpr int MLA_QW = MLA_H * (MLA_NOPE + MLA_ROPE);
constexpr int MLA_KVW = MLA_H * (MLA_NOPE + MLA_V);
constexpr int ML_H = 4, ML_DK = 128, ML_DV = 256, ML_IN = 3088, ML_INP = 3072;
constexpr int DFF = 2816, NEXP = 8, DFFE = 3584;
constexpr int MOE_MAXT = 136;
constexpr int NWAVES = 8, NTHR = 512;

constexpr size_t MiB = 1u << 20;
constexpr size_t WS_CTL = 0, CTL_ZERO_BYTES = 1 * MiB;
constexpr size_t WS_META = 1 * MiB;
constexpr size_t MT_CNTW = 0;
constexpr size_t MT_MOE = 16384;
constexpr size_t MT_TOKE = 32768;
constexpr size_t MT_TOKW = MT_TOKE + (size_t)T * 8;
constexpr size_t MT_RANK = MT_TOKW + (size_t)T * 8;
constexpr size_t MT_ROWTOK = MT_RANK + (size_t)T * 8;
constexpr size_t MT_GATES = 1 * MiB;
constexpr size_t MT_GVEC = 2 * MiB;
constexpr size_t MT_ROPE = 4 * MiB;
static_assert(MT_ROWTOK + (size_t)MOE_MAXT * 256 * 4 <= MT_GATES, "meta map");
constexpr size_t WS_W = 17 * MiB;
constexpr size_t W_DQKV = 0;
constexpr size_t W_UQ = W_DQKV + 2 * (size_t)MLA_INP * D * 2;
constexpr size_t W_UKV = W_UQ + 2 * (size_t)MLA_QW * MLA_QR * 2;
constexpr size_t W_O = W_UKV + 2 * (size_t)MLA_KVW * MLA_KVR * 2;
constexpr size_t W_POOL = W_O + 2 * (size_t)D * D * 2;
constexpr size_t W_IN = W_POOL + 4 * (size_t)256 * 256 * 2;
constexpr size_t W_OUT = W_IN + (size_t)ML_INP * D * 2;
constexpr size_t W_GU = W_OUT + (size_t)D * D * 2;
constexpr size_t W_DN = W_GU + 2 * (size_t)2 * DFF * D * 2;
constexpr size_t W_END = W_DN + 2 * (size_t)D * DFF * 2;
static_assert(W_END <= 55 * MiB, "weights map");
constexpr size_t WS_WMOE = 72 * MiB;
constexpr size_t WM_GU = 0, WM_DN = (size_t)NEXP * 2 * DFFE * D * 2;
static_assert(WM_DN + (size_t)NEXP * D * DFFE * 2 == 168 * MiB, "moe weights map");
constexpr size_t WS_X = 240 * MiB;
constexpr size_t WS_XB = 304 * MiB;
constexpr size_t WS_Y = 336 * MiB;
constexpr size_t WS_SCR = 400 * MiB;
constexpr size_t WS_END = 834 * MiB;
constexpr size_t SC_LAT = 0, SC_CQN = 48 * MiB, SC_CKVN = 60 * MiB, SC_KR = 68 * MiB, SC_Q = 70 * MiB, SC_KV = 118 * MiB, SC_O = 182 * MiB;
constexpr size_t SC_H = 0;
constexpr size_t SC_Z = 0;
constexpr size_t SC_XP = 0, SC_HM = 68 * MiB, SC_Y2 = 306 * MiB;
static_assert(SC_Y2 + (size_t)2 * T * D * 4 == 434 * MiB, "moe scratch");
constexpr size_t SC_PROJ = 0, SC_QKC = 96 * MiB, SC_HS = 128 * MiB, SC_YM = 256 * MiB;

constexpr int LDS_MAIN = 131072;
constexpr int LDS_MISC = LDS_MAIN;
constexpr int LDS_BYTES = 147456;

#define RLX_AGENT __ATOMIC_RELAXED, __HIP_MEMORY_SCOPE_AGENT
__device__ __forceinline__ unsigned cvt_pk_bf16(float lo, float hi) { unsigned r; asm volatile("v_cvt_pk_bf16_f32 %0, %1, %2" : "=v"(r) : "v"(lo), "v"(hi)); return r; }
__device__ __forceinline__ float bf2f(unsigned short b) { return __builtin_bit_cast(float, (unsigned)b << 16); }
__device__ __forceinline__ float bflo(unsigned w) { return __builtin_bit_cast(float, w << 16); }
__device__ __forceinline__ float bfhi(unsigned w) { return __builtin_bit_cast(float, w & 0xffff0000u); }
__device__ __forceinline__ float wave_sum(float v) {
#pragma unroll
    for (int o = 32; o >= 1; o >>= 1) v += __shfl_xor(v, o);
    return v;
}
__device__ __forceinline__ float fast_exp(float x) { return __builtin_amdgcn_exp2f(x * 1.4426950408889634f); }
__device__ __forceinline__ float fast_rcp(float x) { return __builtin_amdgcn_rcpf(x); }
__device__ __forceinline__ float silu_f(float x) { return x * fast_rcp(1.0f + fast_exp(-x)); }
__device__ __forceinline__ float sigmoid_f(float x) { return fast_rcp(1.0f + fast_exp(-x)); }

namespace pg8 {
constexpr int BM = 256, BK = 64, HALF = 128, HTB = HALF * BK * 2, STAGE_BYTES = 8 * HTB, NXCD = 8, WGM = 8;
__host__ __device__ __forceinline__ int lds_byte(int r, int c) { const int st = (r >> 4) * 2 + (c >> 5), rr = r & 15, cc = c & 31, ob = rr * 64 + cc * 2; return st * 1024 + (ob ^ (((ob >> 9) & 1) << 5)); }
__host__ __device__ __forceinline__ void stage_rc(int b, int& R, int& C) { const int st = b / 1024, sb = b % 1024, swz = sb ^ (((sb >> 9) & 1) << 5); R = (st >> 1) * 16 + swz / 64; C = (st & 1) * 32 + (swz % 64) / 2; }
__host__ __device__ __forceinline__ int perm32(int rho) { const int n = rho >> 4, i = rho & 15; return 8 * (i >> 2) + 4 * n + (i & 3); }

struct Unit { int pm, pn, e, nv; };
struct Gemm { const bf16_t* A; const bf16_t* Bt; int lda, ldb, K; };

struct DenseOrder {
    int nM, nN, nwg, G, c;
    __device__ __forceinline__ void init(int M, int N, int G_, int c_) { nM = M / BM; nN = N / BM; nwg = nM * nN; G = G_; c = c_; }
    __device__ __forceinline__ bool next(int i, Unit& u) const {
        const long L = (long)i * G + c; if (L >= nwg) return false;
        int wgid = (int)L; { const int q = nwg / NXCD, r = nwg % NXCD, xcd = wgid % NXCD, off = wgid / NXCD; wgid = (xcd < r ? xcd * (q + 1) : r * (q + 1) + (xcd - r) * q) + off; }
        const int nig = WGM * nN, gid = wgid / nig, fm = gid * WGM, gsz = (nM - fm) < WGM ? (nM - fm) : WGM;
        u.pm = fm + ((wgid % nig) % gsz); u.pn = (wgid % nig) / gsz; u.e = 0; u.nv = 256; return true;
    }
    __device__ __forceinline__ const char* a_tile(const Unit& u, const Gemm& g) const { return (const char*)g.A + (size_t)u.pm * BM * g.lda * 2; }
    __device__ __forceinline__ const char* b_tile(const Unit& u, const Gemm& g) const { return (const char*)g.Bt + (size_t)u.pn * BM * g.ldb * 2; }
};
struct PoolOrder : DenseOrder {
    __device__ __forceinline__ const char* a_tile(const Unit& u, const Gemm& g) const { return (const char*)g.A + ((size_t)u.pm * BM * g.lda + (size_t)u.pn * 256) * 2; }
    __device__ __forceinline__ const char* b_tile(const Unit& u, const Gemm& g) const { return (const char*)g.Bt + (size_t)u.pn * 256 * 256 * 2; }
};
struct MoeOrder {
    const LAS int* tab; int ntiles, nN, Nexp, G, c;
    __device__ __forceinline__ void build_table(const int* meta, LAS int* tabw, int Nexp_, int G_, int c_) {
        const int tid = threadIdx.x;
        if (tid < MOE_MAXT) {
            int e = 0;
#pragma unroll
            for (int k = 1; k < 8; ++k) e += (tid >= meta[8 + k]) ? 1 : 0;
            const int rem = meta[e] - (tid - meta[8 + e]) * 256;
            tabw[2 * tid] = e; tabw[2 * tid + 1] = rem < 256 ? rem : 256;
        }
        ntiles = __builtin_amdgcn_readfirstlane(meta[16]);
        __syncthreads();
        tab = tabw; Nexp = Nexp_; nN = Nexp_ / BM; G = G_; c = c_;
    }
    __device__ __forceinline__ bool next(int i, Unit& u) const {
        const long L = (long)i * G + c; if (L >= (long)ntiles * nN) return false;
        const int rt = (int)(L / nN); u.pn = (int)(L % nN); u.pm = rt;
        u.e = __builtin_amdgcn_readfirstlane(tab[2 * rt]); u.nv = __builtin_amdgcn_readfirstlane(tab[2 * rt + 1]); return true;
    }
    __device__ __forceinline__ const char* a_tile(const Unit& u, const Gemm& g) const { return (const char*)g.A + (size_t)u.pm * BM * g.lda * 2; }
    __device__ __forceinline__ const char* b_tile(const Unit& u, const Gemm& g) const { return (const char*)g.Bt + ((size_t)u.e * Nexp + (size_t)u.pn * BM) * g.ldb * 2; }
};

struct EpiF32 {
    static constexpr bool PERM = false;
    float* C; int ldc;
    __device__ __forceinline__ void operator()(const f32x4 (&acc)[2][2][4][2], const Unit& u, int wr, int wc, int fr, int fq) const {
        const int row0 = u.pm * BM + wr * 64 + fr, col0 = u.pn * BM + wc * 32 + 4 * fq;
#pragma unroll
        for (int ai = 0; ai < 2; ++ai)
#pragma unroll
            for (int m = 0; m < 4; ++m) { float* rowp = C + (size_t)(row0 + ai * HALF + m * 16) * ldc + col0;
#pragma unroll
                for (int bj = 0; bj < 2; ++bj)
#pragma unroll
                    for (int n = 0; n < 2; ++n) *(f32x4*)(rowp + bj * HALF + n * 16) = acc[ai][bj][m][n]; }
    }
};
struct EpiF32Scatter {
    static constexpr bool PERM = false;
    float* C; const int* rowtok;
    __device__ __forceinline__ void operator()(const f32x4 (&acc)[2][2][4][2], const Unit& u, int wr, int wc, int fr, int fq) const {
        const int col0 = u.pn * BM + wc * 32 + 4 * fq;
#pragma unroll
        for (int ai = 0; ai < 2; ++ai)
#pragma unroll
            for (int m = 0; m < 4; ++m) { const int rl = ai * HALF + wr * 64 + m * 16 + fr;
                if (rl < u.nv) { const int dst = rowtok[u.pm * BM + rl]; float* rowp = C + (size_t)dst * D + col0;
#pragma unroll
                    for (int bj = 0; bj < 2; ++bj)
#pragma unroll
                        for (int n = 0; n < 2; ++n) *(f32x4*)(rowp + bj * HALF + n * 16) = acc[ai][bj][m][n]; } }
    }
};
struct EpiBf16 {
    static constexpr bool PERM = true;
    bf16_t* O; int ldc;
    __device__ __forceinline__ void operator()(const f32x4 (&acc)[2][2][4][2], const Unit& u, int wr, int wc, int fr, int fq) const {
        const int row0 = u.pm * BM + wr * 64 + fr, col0 = u.pn * BM + wc * 32 + 8 * fq;
#pragma unroll
        for (int ai = 0; ai < 2; ++ai)
#pragma unroll
            for (int m = 0; m < 4; ++m) { bf16_t* rowp = O + (size_t)(row0 + ai * HALF + m * 16) * ldc + col0;
#pragma unroll
                for (int bj = 0; bj < 2; ++bj) { const f32x4 v0 = acc[ai][bj][m][0], v1 = acc[ai][bj][m][1];
                    u32x4 w; w.x = cvt_pk_bf16(v0[0], v0[1]); w.y = cvt_pk_bf16(v0[2], v0[3]); w.z = cvt_pk_bf16(v1[0], v1[1]); w.w = cvt_pk_bf16(v1[2], v1[3]);
                    *(u32x4*)(rowp + bj * HALF) = w; } }
    }
};
struct EpiSwiGLU {
    static constexpr bool PERM = true;
    bf16_t* O; int ldc;
    __device__ __forceinline__ void operator()(const f32x4 (&acc)[2][2][4][2], const Unit& u, int wr, int wc, int fr, int fq) const {
        const int row0 = u.pm * BM + wr * 64 + fr, col0 = u.pn * HALF + wc * 32 + 8 * fq;
#pragma unroll
        for (int ai = 0; ai < 2; ++ai)
#pragma unroll
            for (int m = 0; m < 4; ++m) { bf16_t* rowp = O + (size_t)(row0 + ai * HALF + m * 16) * ldc + col0;
                float h[8];
#pragma unroll
                for (int n = 0; n < 2; ++n)
#pragma unroll
                    for (int i = 0; i < 4; ++i) h[n * 4 + i] = silu_f(acc[ai][0][m][n][i]) * acc[ai][1][m][n][i];
                u32x4 w; w.x = cvt_pk_bf16(h[0], h[1]); w.y = cvt_pk_bf16(h[2], h[3]); w.z = cvt_pk_bf16(h[4], h[5]); w.w = cvt_pk_bf16(h[6], h[7]);
                *(u32x4*)rowp = w; }
    }
};

template <class Epi, class Sched, bool ALIGN_EPI = true>
__device__ __forceinline__ void gemm_phase(LAS unsigned char* lds, const Gemm g, const Sched& S, const Epi& E) {
    const int tid = threadIdx.x, wid = __builtin_amdgcn_readfirstlane(tid >> 6), lane = tid & 63, wr = wid >> 2, wc = wid & 3, fr = lane & 15, fq = lane >> 4;
    int K = g.K; asm volatile("" : "+s"(K));
    const int nt = K / BK;
    unsigned voffA[2], voffB[2];
#pragma unroll
    for (int i = 0; i < 2; ++i) { int R, C; stage_rc(tid * 16 + i * 8192, R, C); const int Rb = Epi::PERM ? ((R & ~31) + perm32(R & 31)) : R;
        voffA[i] = (unsigned)(R * g.lda + C) * 2u; voffB[i] = (unsigned)(Rb * g.ldb + C) * 2u; }
    const size_t kstep = (size_t)(BK * 2);
    const size_t hstepA = (size_t)HALF * g.lda * 2, hstepB = (size_t)HALF * g.ldb * 2;
    const unsigned ldsw = (unsigned)wid * 1024u;
    const int aoff = lds_byte(wr * 64 + fr, fq * 8), boff = lds_byte(wc * 32 + fr, fq * 8);
#define PG8_SA(b, h) (((b) * 2 + (h)) * HTB)
#define PG8_SB(b, h) ((4 + (b) * 2 + (h)) * HTB)
#define PG8_STAGE(bufoff, gbase, voff) do { _Pragma("unroll") for (int _i = 0; _i < 2; ++_i) \
        __builtin_amdgcn_global_load_lds((const unsigned*)((const char*)(gbase) + (voff)[_i]), (LAS unsigned*)(lds + (bufoff) + ldsw + _i * 8192), 16, 0, 0); } while (0)
#define PG8_LDA(dst, b, h) do { _Pragma("unroll") for (int m = 0; m < 4; ++m) _Pragma("unroll") for (int k = 0; k < 2; ++k) dst[m][k] = *(const LAS bf16x8*)(lds + PG8_SA(b, h) + aoff + m * 2048 + k * 1024); } while (0)
#define PG8_LDB(dst, b, h) do { _Pragma("unroll") for (int n = 0; n < 2; ++n) _Pragma("unroll") for (int k = 0; k < 2; ++k) dst[n][k] = *(const LAS bf16x8*)(lds + PG8_SB(b, h) + boff + n * 2048 + k * 1024); } while (0)
#define PG8_MMA(ai, bj, At, Bt) do { __builtin_amdgcn_s_setprio(1); _Pragma("unroll") for (int m = 0; m < 4; ++m) _Pragma("unroll") for (int n = 0; n < 2; ++n) _Pragma("unroll") for (int k = 0; k < 2; ++k) \
        acc[ai][bj][m][n] = __builtin_amdgcn_mfma_f32_16x16x32_bf16(Bt[n][k], At[m][k], acc[ai][bj][m][n], 0, 0, 0); __builtin_amdgcn_s_setprio(0); } while (0)
#define PG8_WAIT_V(n) asm volatile("s_waitcnt vmcnt(" #n ")" ::: "memory")
#define PG8_WAIT_L(n) asm volatile("s_waitcnt lgkmcnt(" #n ")" ::: "memory")
#define PG8_BAR __builtin_amdgcn_s_barrier()
#define PG8_SCHED __builtin_amdgcn_sched_barrier(0)
    Unit cur, nxt; int ui = 0;
    if (!S.next(0, cur)) return;
    f32x4 acc[2][2][4][2];
#pragma unroll
    for (int a = 0; a < 2; ++a)
#pragma unroll
        for (int b = 0; b < 2; ++b)
#pragma unroll
            for (int m = 0; m < 4; ++m)
#pragma unroll
                for (int n = 0; n < 2; ++n) acc[a][b][m][n] = (f32x4){0.f, 0.f, 0.f, 0.f};
    bf16x8 At[4][2], B0[2][2], B1[2][2];
    const char* cA = S.a_tile(cur, g); const char* cB = S.b_tile(cur, g);
    PG8_STAGE(PG8_SB(0, 0), cB, voffB); PG8_STAGE(PG8_SB(0, 1), cB + hstepB, voffB); PG8_STAGE(PG8_SA(0, 0), cA, voffA); PG8_STAGE(PG8_SA(0, 1), cA + hstepA, voffA);
    if (wr == 1) PG8_BAR;
    PG8_WAIT_V(2); PG8_BAR;
    PG8_STAGE(PG8_SB(1, 0), cB + kstep, voffB); PG8_STAGE(PG8_SA(1, 0), cA + kstep, voffA); PG8_STAGE(PG8_SB(1, 1), cB + hstepB + kstep, voffB);
    PG8_WAIT_V(6); PG8_BAR;
    for (;;) {
        const bool has_next = S.next(ui + 1, nxt);
        const char* nA = has_next ? S.a_tile(nxt, g) : cA; const char* nB = has_next ? S.b_tile(nxt, g) : cB;
        for (int t = 0; t < nt; t += 2) {
            const bool last = (t == nt - 2);
            const char* a1 = cA + (size_t)(t + 1) * kstep;
            const char* a2 = last ? nA : cA + (size_t)(t + 2) * kstep; const char* b2 = last ? nB : cB + (size_t)(t + 2) * kstep;
            const char* a3 = a2 + kstep; const char* b3 = b2 + kstep;
            PG8_LDB(B0, 0, 0); PG8_LDB(B1, 0, 1); PG8_SCHED; PG8_LDA(At, 0, 0); PG8_STAGE(PG8_SA(1, 1), a1 + hstepA, voffA);
            PG8_WAIT_V(8); PG8_WAIT_L(0); PG8_BAR; PG8_MMA(0, 0, At, B0); PG8_MMA(0, 1, At, B1); PG8_BAR; PG8_SCHED;
            PG8_LDA(At, 0, 1); PG8_STAGE(PG8_SB(0, 0), b2, voffB); PG8_STAGE(PG8_SB(0, 1), b2 + hstepB, voffB); PG8_STAGE(PG8_SA(0, 0), a2, voffA);
            PG8_WAIT_V(8); PG8_WAIT_L(0); PG8_BAR; PG8_MMA(1, 0, At, B0); PG8_MMA(1, 1, At, B1); PG8_BAR; PG8_SCHED;
            PG8_LDB(B0, 1, 0); PG8_LDB(B1, 1, 1); PG8_SCHED; PG8_LDA(At, 1, 0); PG8_STAGE(PG8_SA(0, 1), a2 + hstepA, voffA);
            PG8_WAIT_V(8); PG8_WAIT_L(0); PG8_BAR; PG8_MMA(0, 0, At, B0); PG8_MMA(0, 1, At, B1); PG8_BAR; PG8_SCHED;
            PG8_LDA(At, 1, 1); PG8_STAGE(PG8_SB(1, 0), b3, voffB); PG8_STAGE(PG8_SB(1, 1), b3 + hstepB, voffB); PG8_STAGE(PG8_SA(1, 0), a3, voffA);
            PG8_WAIT_V(8); PG8_WAIT_L(0); PG8_BAR; PG8_MMA(1, 0, At, B0); PG8_MMA(1, 1, At, B1); PG8_BAR; PG8_SCHED;
        }
        if constexpr (ALIGN_EPI) { if (wr == 0) PG8_BAR; }
        E(acc, cur, wr, wc, fr, fq);
        if (!has_next) break;
#pragma unroll
        for (int a = 0; a < 2; ++a)
#pragma unroll
            for (int b = 0; b < 2; ++b)
#pragma unroll
                for (int m = 0; m < 4; ++m)
#pragma unroll
                    for (int n = 0; n < 2; ++n) acc[a][b][m][n] = (f32x4){0.f, 0.f, 0.f, 0.f};
        cur = nxt; cA = nA; cB = nB; ++ui;
        if constexpr (ALIGN_EPI) { if (wr == 1) PG8_BAR; }
    }
    PG8_WAIT_V(0);
    if constexpr (!ALIGN_EPI) { if (wr == 0) PG8_BAR; }
    PG8_BAR;
#undef PG8_SA
#undef PG8_SB
#undef PG8_STAGE
#undef PG8_LDA
#undef PG8_LDB
#undef PG8_MMA
#undef PG8_WAIT_V
#undef PG8_WAIT_L
#undef PG8_BAR
#undef PG8_SCHED
}
}

#ifndef ATT_SDEPTH
#define ATT_SDEPTH 1
#endif
namespace att {
constexpr int NW = 8, QBLK = 32, KVBLK = 64;
constexpr float SCALE = 0.07216878364870322f;
constexpr float THR = 8.f;
constexpr int LDQ = MLA_QW, LDK = MLA_KVW, LDKR = MLA_ROPE, LDO = D;
constexpr int SHM_V = KVBLK * 128 * 2, SHM_K = KVBLK * 128 * 2, SHM_KR = KVBLK * 64 * 2;
constexpr int OFF_V = 0, OFF_K = 2 * SHM_V, OFF_KR = OFF_K + 2 * SHM_K, OFF_WS = OFF_KR + 2 * SHM_KR, OFF_QR = OFF_WS + NW * 64 * 4, SHM_ATTN = OFF_QR + NW * 4096;
#define KSWZ(row, colB) ((row) * 256 + ((colB) ^ (((row) & 7) << 4)))
#define KRSWZ(row, colB) ((row) * 128 + ((colB) ^ ((((row) >> 1) & 7) << 4)))
#define SBAR() __builtin_amdgcn_sched_barrier(0)
__device__ __forceinline__ int crow(int r, int hi) { return (r & 3) + 8 * (r >> 2) + 4 * hi; }

__device__ __forceinline__ void partialSM(f32x16& p0, f32x16& p1, float& m_reg, float& mn, float& alpha) {
  constexpr float C = SCALE * 1.4426950408889634f;
  float pmax = p0[0];
#pragma unroll
  for (int r = 1; r < 16; ++r) pmax = fmaxf(pmax, p0[r]);
#pragma unroll
  for (int r = 0; r < 16; ++r) pmax = fmaxf(pmax, p1[r]);
  { auto rr = __builtin_amdgcn_permlane32_swap(__float_as_uint(pmax), __float_as_uint(pmax), false, false);
    pmax = fmaxf(__uint_as_float(rr[0]), __uint_as_float(rr[1])); }
  if (__builtin_expect(__all(pmax - m_reg <= THR / SCALE), 1)) { mn = m_reg; alpha = 1.f; }
  else { mn = fmaxf(m_reg, pmax); alpha = __builtin_amdgcn_exp2f((m_reg - mn) * C); m_reg = mn; }
  float mnC = -mn * C;
#pragma unroll
  for (int r = 0; r < 16; ++r) p0[r] = fmaf(p0[r], C, mnC);
#pragma unroll
  for (int r = 0; r < 16; ++r) p1[r] = fmaf(p1[r], C, mnC);
#pragma unroll
  for (int r = 0; r < 16; ++r) p0[r] = __builtin_amdgcn_exp2f(p0[r]);
}
__device__ __forceinline__ void finishSM(f32x16& p0, f32x16& p1, float alpha, float& l_reg, bf16x8& pa0, bf16x8& pa1, bf16x8& pa2, bf16x8& pa3) {
#pragma unroll
  for (int r = 0; r < 16; ++r) p1[r] = __builtin_amdgcn_exp2f(p1[r]);
  float ps = 0;
#pragma unroll
  for (int r = 0; r < 16; ++r) ps += p0[r];
#pragma unroll
  for (int r = 0; r < 16; ++r) ps += p1[r];
  { auto rr = __builtin_amdgcn_permlane32_swap(__float_as_uint(ps), __float_as_uint(ps), false, false);
    ps = __uint_as_float(rr[0]) + __uint_as_float(rr[1]); }
  l_reg = l_reg * alpha + ps;
#define PK4(P, BASE, OUT) do { unsigned a0 = cvt_pk_bf16(P[BASE + 0], P[BASE + 1]), a1 = cvt_pk_bf16(P[BASE + 2], P[BASE + 3]);   \
    unsigned b0 = cvt_pk_bf16(P[BASE + 4], P[BASE + 5]), b1 = cvt_pk_bf16(P[BASE + 6], P[BASE + 7]);                              \
    auto r0 = __builtin_amdgcn_permlane32_swap(a0, b0, false, false); auto r1 = __builtin_amdgcn_permlane32_swap(a1, b1, false, false); \
    u32x4 w = {r0[0], r1[0], r0[1], r1[1]}; OUT = __builtin_bit_cast(bf16x8, w); } while (0)
  PK4(p0, 0, pa0); PK4(p0, 8, pa1); PK4(p1, 0, pa2); PK4(p1, 8, pa3);
}
__device__ __forceinline__ void qkt(f32x16& p0, f32x16& p1, const char* Ks, const char* Krs, const bf16x8* qr, const char* qrl, int r32, int hi) {
  p0 = f32x16{}; p1 = f32x16{};
#pragma unroll
  for (int d0 = 0; d0 < 8; ++d0) { const int cb = (d0 * 16 + hi * 8) * 2;
    bf16x8 b0 = *reinterpret_cast<const bf16x8*>(Ks + KSWZ(r32, cb));
    bf16x8 b1 = *reinterpret_cast<const bf16x8*>(Ks + KSWZ(32 + r32, cb));
    p0 = __builtin_amdgcn_mfma_f32_32x32x16_bf16(b0, qr[d0], p0, 0, 0, 0);
    p1 = __builtin_amdgcn_mfma_f32_32x32x16_bf16(b1, qr[d0], p1, 0, 0, 0); }
#pragma unroll
  for (int d0 = 0; d0 < 4; ++d0) { const int cb = (d0 * 16 + hi * 8) * 2;
    bf16x8 b0 = *reinterpret_cast<const bf16x8*>(Krs + KRSWZ(r32, cb));
    bf16x8 b1 = *reinterpret_cast<const bf16x8*>(Krs + KRSWZ(32 + r32, cb));
    const bf16x8 qq = *reinterpret_cast<const bf16x8*>(qrl + d0 * 1024);
    p0 = __builtin_amdgcn_mfma_f32_32x32x16_bf16(b0, qq, p0, 0, 0, 0);
    p1 = __builtin_amdgcn_mfma_f32_32x32x16_bf16(b1, qq, p1, 0, 0, 0); }
}
__device__ __forceinline__ int v_st(int k, int c) { const int kk = (k & ~0xC) | ((k & 4) << 1) | ((k & 8) >> 1); return ((kk >> 3) * 4 + (c >> 5)) * 512 + ((kk & 7) * 32 + (c & 31)) * 2; }
__device__ __forceinline__ int v_rd_base(int lane) { return ((lane & 3) << 3) | (((lane >> 2) & 3) << 6) | (((lane >> 4) & 1) << 5) | (((lane >> 5) & 1) << 8); }
constexpr int v_rd_off(int d0, int ks, int half) { return d0 * 512 + ks * 4096 + half * 2048; }
template <int OFF> __device__ __forceinline__ s16x4 tr_read(int vb) {
  s16x4 r; asm volatile("ds_read_b64_tr_b16 %0, %1 offset:%2" : "=&v"(r) : "v"(vb), "i"(OFF) : "memory"); return r;
}
#define PKV(L, H) (bf16x8){L[0], L[1], L[2], L[3], H[0], H[1], H[2], H[3]}
template <int D0> __device__ __forceinline__ void pv_one(f32x16& od, int vb, bf16x8 pa0, bf16x8 pa1, bf16x8 pa2, bf16x8 pa3) {
  const s16x4 l0 = tr_read<v_rd_off(D0, 0, 0)>(vb), h0 = tr_read<v_rd_off(D0, 0, 1)>(vb), l1 = tr_read<v_rd_off(D0, 1, 0)>(vb), h1 = tr_read<v_rd_off(D0, 1, 1)>(vb);
  const s16x4 l2 = tr_read<v_rd_off(D0, 2, 0)>(vb), h2 = tr_read<v_rd_off(D0, 2, 1)>(vb), l3 = tr_read<v_rd_off(D0, 3, 0)>(vb), h3 = tr_read<v_rd_off(D0, 3, 1)>(vb);
  asm volatile("s_waitcnt lgkmcnt(0)" ::: "memory"); SBAR();
  od = __builtin_amdgcn_mfma_f32_32x32x16_bf16(pa0, PKV(l0, h0), od, 0, 0, 0);
  od = __builtin_amdgcn_mfma_f32_32x32x16_bf16(pa1, PKV(l1, h1), od, 0, 0, 0);
  od = __builtin_amdgcn_mfma_f32_32x32x16_bf16(pa2, PKV(l2, h2), od, 0, 0, 0);
  od = __builtin_amdgcn_mfma_f32_32x32x16_bf16(pa3, PKV(l3, h3), od, 0, 0, 0);
}
__device__ __forceinline__ void pv_d0(f32x16* o, int vb, bf16x8 pa0, bf16x8 pa1, bf16x8 pa2, bf16x8 pa3) {
  pv_one<0>(o[0], vb, pa0, pa1, pa2, pa3); pv_one<1>(o[1], vb, pa0, pa1, pa2, pa3); pv_one<2>(o[2], vb, pa0, pa1, pa2, pa3); pv_one<3>(o[3], vb, pa0, pa1, pa2, pa3);
}

__device__ __forceinline__ void attn_body(const bf16_t* __restrict__ Qb, const float* __restrict__ cs, const bf16_t* __restrict__ Kn, const bf16_t* __restrict__ Vh,
                                          const bf16_t* __restrict__ Kr, bf16_t* __restrict__ Ob, int seq, char* lds) {
  int tid = threadIdx.x; asm volatile("" : "+v"(tid));
  const int wid = tid >> 6, lane = tid & 63, r32 = lane & 31, hi = lane >> 5;
  char* V_lds = lds + OFF_V; char* K_lds = lds + OFF_K; char* KR_lds = lds + OFF_KR;
  float* ws = (float*)(lds + OFF_WS) + wid * 64; float* li_l = ws; float* al_l = ws + 32;
  float m_reg = -1e30f, l_reg = 0; f32x16 o[4] = {}; bf16x8 qr[8];
  char* qrl = lds + OFF_QR + wid * 4096 + lane * 16;
  { const int qrow = wid * QBLK + r32;
    const unsigned qoff = (unsigned)(qrow * LDQ + hi * 8) * 2u;
    const char* Qc = (const char*)Qb;
    bf16x8 qro[4];
#pragma unroll
    for (int d0 = 0; d0 < 8; ++d0) qr[d0] = *reinterpret_cast<const bf16x8*>(Qc + qoff + d0 * 32);
#pragma unroll
    for (int d0 = 0; d0 < 4; ++d0) qro[d0] = *reinterpret_cast<const bf16x8*>(Qc + qoff + 256 + d0 * 32);
    const char* csc = (const char*)cs; const unsigned csoff = (unsigned)qrow * 256u;
#pragma unroll
    for (int a = 0; a < 2; ++a) {
      const int i0 = a * 16 + hi * 8;
      bf16x8 x1 = qro[a], x2 = qro[2 + a], y1, y2;
#pragma unroll
      for (int j = 0; j < 8; ++j) {
        const f32x2 c_s = *reinterpret_cast<const f32x2*>(csc + csoff + 8 * (i0 + j));
        const float f1 = bf2f((unsigned short)x1[j]), f2 = bf2f((unsigned short)x2[j]);
        const float g1 = f1 * c_s.x - f2 * c_s.y, g2 = f2 * c_s.x + f1 * c_s.y;
        const unsigned pk = cvt_pk_bf16(g1, g2);
        y1[j] = (short)(pk & 0xffffu); y2[j] = (short)(pk >> 16);
      }
      *reinterpret_cast<bf16x8*>(qrl + a * 1024) = y1; *reinterpret_cast<bf16x8*>(qrl + (2 + a) * 1024) = y2;
    }
  }
  const int sr = tid >> 4, sc = (tid & 15) * 8, vst0 = v_st(sr, sc), vst1 = v_st(32 + sr, sc);
  const int krr = tid >> 3, krc = (tid & 7) * 8;
  const int vb0 = (int)(uintptr_t)V_lds + v_rd_base(lane);
  constexpr int SDEPTH = ATT_SDEPTH;
  struct { bf16x8 vs0, vs1, ks0, ks1, kr0; } sr_[SDEPTH];
  const unsigned vo0 = (unsigned)(sr * LDK + sc) * 2u, vo1 = (unsigned)((32 + sr) * LDK + sc) * 2u, kro = (unsigned)(krr * LDKR + krc) * 2u;
#define SLOAD(i, k0) do { const char* vt_ = (const char*)Vh + (size_t)(k0) * (LDK * 2); const char* kt_ = (const char*)Kn + (size_t)(k0) * (LDK * 2); const char* krt_ = (const char*)Kr + (size_t)(k0) * (LDKR * 2); \
    sr_[i].vs0 = *reinterpret_cast<const bf16x8*>(vt_ + vo0); sr_[i].vs1 = *reinterpret_cast<const bf16x8*>(vt_ + vo1); \
    sr_[i].ks0 = *reinterpret_cast<const bf16x8*>(kt_ + vo0); sr_[i].ks1 = *reinterpret_cast<const bf16x8*>(kt_ + vo1); \
    sr_[i].kr0 = *reinterpret_cast<const bf16x8*>(krt_ + kro); } while (0)
#define SWRITE(b, i) do { *(bf16x8*)(V_lds + (b) * SHM_V + vst0) = sr_[i].vs0;          \
    *(bf16x8*)(V_lds + (b) * SHM_V + vst1) = sr_[i].vs1; const int kc = sc * 2;               \
    *(bf16x8*)(K_lds + (b) * SHM_K + KSWZ(sr, kc)) = sr_[i].ks0;                       \
    *(bf16x8*)(K_lds + (b) * SHM_K + KSWZ(32 + sr, kc)) = sr_[i].ks1;                  \
    *(bf16x8*)(KR_lds + (b) * SHM_KR + KRSWZ(krr, krc * 2)) = sr_[i].kr0; } while (0)
#define SWAIT() do { if constexpr (SDEPTH == 2) asm volatile("s_waitcnt vmcnt(5)" ::: "memory"); else asm volatile("s_waitcnt vmcnt(0)" ::: "memory"); } while (0)
#define RESC(a) do { if (__any((a) < 1.f)) { if (hi == 0) al_l[r32] = (a); asm volatile("s_waitcnt lgkmcnt(0)" ::: "memory"); \
    _Pragma("unroll") for (int d = 0; d < 4; ++d) _Pragma("unroll") for (int r = 0; r < 16; ++r) o[d][r] *= al_l[crow(r, hi)]; } } while (0)
  f32x16 pA0, pA1, pB0, pB1; float mnA, mnB, alA, alB; bf16x8 pa0, pa1, pa2, pa3; const int NT = seq / KVBLK;
  constexpr int SE = 0, SO = SDEPTH - 1;
  SLOAD(SE, 0); asm volatile("s_waitcnt vmcnt(0)" ::: "memory"); SWRITE(0, SE); __syncthreads();
  qkt(pA0, pA1, K_lds, KR_lds, qr, qrl, r32, hi); partialSM(pA0, pA1, m_reg, mnA, alA);
  SLOAD(SO, KVBLK); if constexpr (SDEPTH == 2) { if (2 < NT) SLOAD(SE, 2 * KVBLK); }
  SWAIT(); SWRITE(1, SO); __syncthreads();
  for (int j = 1; j + 1 < NT; j += 2) {
    SBAR(); qkt(pB0, pB1, K_lds + SHM_K, KR_lds + SHM_KR, qr, qrl, r32, hi);
    finishSM(pA0, pA1, alA, l_reg, pa0, pa1, pa2, pa3); SBAR();
    SLOAD(SO, (j + SDEPTH) * KVBLK); SBAR();
    pv_d0(o, vb0, pa0, pa1, pa2, pa3); partialSM(pB0, pB1, m_reg, mnB, alB);
    __syncthreads(); SWAIT(); SWRITE(0, SE);
    RESC(alB); __syncthreads();
    SBAR(); qkt(pA0, pA1, K_lds, KR_lds, qr, qrl, r32, hi);
    finishSM(pB0, pB1, alB, l_reg, pa0, pa1, pa2, pa3); SBAR();
    if (SDEPTH == 1 || j + 3 < NT) SLOAD(SE, (j + 1 + SDEPTH) * KVBLK); SBAR();
    pv_d0(o, vb0 + SHM_V, pa0, pa1, pa2, pa3); partialSM(pA0, pA1, m_reg, mnA, alA);
    __syncthreads(); SWAIT(); SWRITE(1, SO);
    RESC(alA); __syncthreads();
  }
  SBAR(); qkt(pB0, pB1, K_lds + SHM_K, KR_lds + SHM_KR, qr, qrl, r32, hi);
  finishSM(pA0, pA1, alA, l_reg, pa0, pa1, pa2, pa3); SBAR();
  pv_d0(o, vb0, pa0, pa1, pa2, pa3); partialSM(pB0, pB1, m_reg, mnB, alB);
  __syncthreads(); RESC(alB);
  finishSM(pB0, pB1, alB, l_reg, pa0, pa1, pa2, pa3); SBAR();
  pv_d0(o, vb0 + SHM_V, pa0, pa1, pa2, pa3);
  if (hi == 0) li_l[r32] = l_reg; asm volatile("s_waitcnt lgkmcnt(0)" ::: "memory");
  float rli[16];
#pragma unroll
  for (int r = 0; r < 16; ++r) rli[r] = __builtin_amdgcn_rcpf(li_l[crow(r, hi)]);
  __syncthreads();
  int tid2 = threadIdx.x; asm volatile("" : "+v"(tid2));
  const int wid2 = tid2 >> 6, lane2 = tid2 & 63;
  char* ot = lds + wid2 * (32 * 272);
#pragma unroll
  for (int r = 0; r < 16; ++r) { const int orow = crow(r, lane2 >> 5);
#pragma unroll
    for (int d0 = 0; d0 < 4; ++d0) *(bf16_t*)(ot + orow * 272 + (d0 * 32 + (lane2 & 31)) * 2) = (bf16_t)(cvt_pk_bf16(o[d0][r] * rli[r], 0.f) & 0xffffu); }
  asm volatile("s_waitcnt lgkmcnt(0)" ::: "memory");
  char* Oc = (char*)Ob;
#pragma unroll
  for (int i = 0; i < 8; ++i) { const int id = lane2 + 64 * i, row = id >> 4, ch = id & 15;
    const u32x4 v = *(const u32x4*)(ot + row * 272 + ch * 16);
    *(u32x4*)(Oc + (unsigned)((wid2 * QBLK + row) * LDO + ch * 8) * 2u) = v; }
  __syncthreads();
#undef SLOAD
#undef SWRITE
#undef SWAIT
#undef RESC
}
}

namespace mls {
constexpr int OFF_Q = 0, OFF_K = 16384, OFF_VA = 32768, OFF_VB = 49152, OFF_C = 57344, OFF_N = 65536, OFF_VEC = 73728, LDS_NEED = 73728 + 1024;
__device__ __forceinline__ unsigned off_b(unsigned row, unsigned ch) { return 256u * row + 16u * (ch ^ (((row & 3) << 2) | ((row >> 2) & 3))); }
__device__ __forceinline__ unsigned off_vb(unsigned row, unsigned ch) { return 1024u * (row >> 3) + 512u * (ch >> 2) + 64u * (row & 7) + 16u * ((ch & 3) ^ ((row >> 2) & 3)); }
__device__ __forceinline__ s16x4 trr(unsigned addr) { s16x4 r; asm volatile("ds_read_b64_tr_b16 %0, %1" : "=&v"(r) : "v"(addr) : "memory"); return r; }

struct Tensors { const bf16_t* qkc; const bf16_t* proj; const float* gvec; float* hs; };

__device__ __forceinline__ void scan_unit(const Tensors& Tn, int unit, char* lds) {
  int tid = threadIdx.x; asm volatile("" : "+v"(tid));
  const int wid = __builtin_amdgcn_readfirstlane(tid >> 6), lane = tid & 63, r32 = lane & 31, hi = lane >> 5;
  const int chain = unit >> 3, vs = unit & 7, dir = chain >> 4, bb = (chain >> 2) & 3, hd = chain & 3;
  const unsigned lbase = (unsigned)(uintptr_t)lds;
  float* vec = (float*)(lds + OFF_VEC);
  unsigned qko[2];
#pragma unroll
  for (int i = 0; i < 2; ++i) { const int idx = tid + 512 * i, row = idx >> 4, ch = idx & 15; qko[i] = (unsigned)(((dir ? 63 - row : row) * 1024 + ch * 8) * 2); }
  const int vrow = (tid & 255) >> 2, vch = tid & 3;
  const unsigned vo = (unsigned)(((dir ? 63 - vrow : vrow) * ML_INP + vch * 8) * 2), awo = (unsigned)vrow * 4u;
  const char* gvb = (const char*)Tn.gvec + (size_t)chain * SEQ * 4;
  const unsigned veo = (unsigned)((tid >> 6) * 32 * SEQ + (tid & 63)) * 4u;
  const char* awsrc = gvb + (size_t)3 * 32 * SEQ * 4;
  bf16x8 sq[2], sk[2], sv; float sawl = 0.f, svec = 0.f;
#define TB(c) ((size_t)bb * SEQ + (dir ? (SEQ - 64 * ((c) + 1)) : 64 * (c)))
#define MLOAD(c) do { const size_t tb_ = TB(c); \
    const char* qb_ = (const char*)Tn.qkc + (tb_ * 1024 + hd * 128) * 2; const char* kb_ = qb_ + 1024; \
    const char* vb_ = (const char*)Tn.proj + (tb_ * ML_INP + 1024 + hd * 256 + vs * 32) * 2; \
    _Pragma("unroll") for (int i = 0; i < 2; ++i) { sq[i] = *reinterpret_cast<const bf16x8*>(qb_ + qko[i]); sk[i] = *reinterpret_cast<const bf16x8*>(kb_ + qko[i]); } \
    sv = *reinterpret_cast<const bf16x8*>(vb_ + vo); sawl = *reinterpret_cast<const float*>(awsrc + (size_t)(c) * 256 + awo); \
    if (tid < 192) svec = *reinterpret_cast<const float*>(gvb + (size_t)(c) * 256 + veo); } while (0)
#define MWRITE() do { \
    _Pragma("unroll") for (int i = 0; i < 2; ++i) { const int idx = tid + 512 * i, row = idx >> 4, ch = idx & 15; \
      *(bf16x8*)(lds + OFF_Q + off_b(row, ch)) = sq[i]; *(bf16x8*)(lds + OFF_K + off_b(row, ch)) = sk[i]; } \
    if (tid < 256) { *(bf16x8*)(lds + OFF_VA + att::v_st(vrow, vch * 8)) = sv; \
      float f[8]; _Pragma("unroll") for (int j = 0; j < 8; ++j) f[j] = bf2f((unsigned short)sv[j]) * sawl; \
      u32x4 w; w.x = cvt_pk_bf16(f[0], f[1]); w.y = cvt_pk_bf16(f[2], f[3]); w.z = cvt_pk_bf16(f[4], f[5]); w.w = cvt_pk_bf16(f[6], f[7]); \
      *(u32x4*)(lds + OFF_VB + off_vb(vrow, vch)) = w; } \
    else { const unsigned a = cvt_pk_bf16(sawl, sawl); u32x4 w = {a, a, a, a}; *(u32x4*)(lds + OFF_VB + off_vb(vrow, 4 + vch)) = w; } \
    if (tid < 192) vec[tid] = svec; } while (0)

  f32x16 Cst = {}, Nst = {};
  float m = 0.f;
  const int blk = wid - 2;
  MLOAD(0);
  asm volatile("s_waitcnt vmcnt(0)" ::: "memory");
  MWRITE();
  if (wid >= 2 && wid < 6) {
#pragma unroll
    for (int g = 0; g < 4; ++g) { const unsigned a = off_b(r32, 4 * blk + g) + 8 * hi; *(u32x2*)(lds + OFF_C + a) = (u32x2){0u, 0u}; *(u32x2*)(lds + OFF_N + a) = (u32x2){0u, 0u}; }
  }
  __syncthreads();
  const bf16x8 ones = {(short)0x3F80, (short)0x3F80, (short)0x3F80, (short)0x3F80, (short)0x3F80, (short)0x3F80, (short)0x3F80, (short)0x3F80};
  const int th = wid & 1;
  const unsigned hso = (unsigned)(((dir ? 63 - 32 * th - 4 * hi : 32 * th + 4 * hi) * D + hd * 256 + vs * 32 + r32) * 4);
  const int hstep = dir ? -(D * 4) : (D * 4);
  for (int c = 0; c < 64; ++c) {
    if (c + 1 < 64) MLOAD(c + 1);
    const float pm63 = vec[128 + 63], bL = vec[63];
    const float Mx = fmaxf(m, pm63);
    if (wid < 2) {
      int ln_ = lane; asm volatile("" : "+v"(ln_));
      const int r32 = ln_ & 31, hi = ln_ >> 5;
      f32x16 qc = {}, qn = {}, p0 = {}, p1 = {};
      {
        bf16x8 qf[8];
#pragma unroll
        for (int ks = 0; ks < 8; ++ks) qf[ks] = *(const bf16x8*)(lds + OFF_Q + off_b(32 * th + r32, 2 * ks + hi));
#pragma unroll
        for (int ks = 0; ks < 8; ++ks) {
          const bf16x8 cf = *(const bf16x8*)(lds + OFF_C + off_b(r32, 2 * ks + hi));
          const bf16x8 nf = *(const bf16x8*)(lds + OFF_N + off_b(r32, 2 * ks + hi));
          qc = __builtin_amdgcn_mfma_f32_32x32x16_bf16(qf[ks], cf, qc, 0, 0, 0);
          qn = __builtin_amdgcn_mfma_f32_32x32x16_bf16(qf[ks], nf, qn, 0, 0, 0);
        }
#pragma unroll
        for (int ks = 0; ks < 8; ++ks) {
          const bf16x8 k0 = *(const bf16x8*)(lds + OFF_K + off_b(r32, 2 * ks + hi));
          const bf16x8 k1 = *(const bf16x8*)(lds + OFF_K + off_b(32 + r32, 2 * ks + hi));
          p0 = __builtin_amdgcn_mfma_f32_32x32x16_bf16(k0, qf[ks], p0, 0, 0, 0);
          p1 = __builtin_amdgcn_mfma_f32_32x32x16_bf16(k1, qf[ks], p1, 0, 0, 0);
        }
      }
      const int t = 32 * th + r32;
      const float Mt = fmaxf(m, vec[128 + t]);
#pragma unroll
      for (int r = 0; r < 16; ++r) { const int s0 = att::crow(r, hi), s1 = 32 + s0;
        float w0 = fast_exp(vec[64 + s0] - Mt), w1 = fast_exp(vec[64 + s1] - Mt); w0 = (s0 <= t) ? w0 : 0.f; w1 = (s1 <= t) ? w1 : 0.f;
        p0[r] *= w0; p1[r] *= w1; }
      bf16x8 pa0, pa1, pa2, pa3;
      PK4(p0, 0, pa0); PK4(p0, 8, pa1); PK4(p1, 0, pa2); PK4(p1, 8, pa3);
      f32x16 pv = {}, pd = {};
      att::pv_one<0>(pv, (int)(lbase + OFF_VA) + att::v_rd_base(ln_), pa0, pa1, pa2, pa3);
      pd = __builtin_amdgcn_mfma_f32_32x32x16_bf16(pa0, ones, pd, 0, 0, 0);
      pd = __builtin_amdgcn_mfma_f32_32x32x16_bf16(pa1, ones, pd, 0, 0, 0);
      pd = __builtin_amdgcn_mfma_f32_32x32x16_bf16(pa2, ones, pd, 0, 0, 0);
      pd = __builtin_amdgcn_mfma_f32_32x32x16_bf16(pa3, ones, pd, 0, 0, 0);
      char* hsb = (char*)Tn.hs + ((size_t)dir * T + TB(c)) * (D * 4);
#pragma unroll
      for (int r = 0; r < 16; ++r) { const int rr = (r & 3) + 8 * (r >> 2), tr_ = 32 * th + 4 * hi + rr;
        const float Mr = fmaxf(m, vec[128 + tr_]), gw = fast_exp(m - Mr), en = fast_exp(-(vec[tr_] + Mr));
        const float num = gw * qc[r] + pv[r], den = gw * qn[r] + pd[r];
        const float h = num * fast_rcp(fmaxf(fabsf(den), en));
        *(float*)(hsb + (unsigned)((int)hso + rr * hstep)) = h; }
    } else if (wid < 6) {
      int ln_ = lane; asm volatile("" : "+v"(ln_));
      const int hi = ln_ >> 5;
      f32x16 kv = {}, kn = {};
#pragma unroll
      for (int ks = 0; ks < 4; ++ks) {
        const unsigned hb = (ln_ >> 4) & 1, q = (ln_ & 15) >> 2, p = ln_ & 3;
        const unsigned row0 = 16 * ks + 8 * hi + q;
        const s16x4 ka = trr(lbase + OFF_K + off_b(row0, 4 * blk + 2 * hb + (p >> 1)) + 8 * (p & 1));
        const s16x4 kb = trr(lbase + OFF_K + off_b(row0 + 4, 4 * blk + 2 * hb + (p >> 1)) + 8 * (p & 1));
        const s16x4 va = trr(lbase + OFF_VB + off_vb(row0, 2 * hb + (p >> 1)) + 8 * (p & 1));
        const s16x4 vb_ = trr(lbase + OFF_VB + off_vb(row0 + 4, 2 * hb + (p >> 1)) + 8 * (p & 1));
        const s16x4 aa = trr(lbase + OFF_VB + off_vb(row0, 4 + 2 * hb + (p >> 1)) + 8 * (p & 1));
        const s16x4 ab = trr(lbase + OFF_VB + off_vb(row0 + 4, 4 + 2 * hb + (p >> 1)) + 8 * (p & 1));
        asm volatile("s_waitcnt lgkmcnt(0)" ::: "memory"); __builtin_amdgcn_sched_barrier(0);
        const bf16x8 kf = PKV(ka, kb), vf = PKV(va, vb_), af = PKV(aa, ab);
        kv = __builtin_amdgcn_mfma_f32_32x32x16_bf16(kf, vf, kv, 0, 0, 0);
        kn = __builtin_amdgcn_mfma_f32_32x32x16_bf16(kf, af, kn, 0, 0, 0);
      }
      const float cw = fast_exp(m - Mx), sc = fast_exp(pm63 - Mx);
#pragma unroll
      for (int r = 0; r < 16; ++r) { Cst[r] = cw * Cst[r] + sc * kv[r]; Nst[r] = cw * Nst[r] + sc * kn[r]; }
    }
    m = bL + Mx;
    __syncthreads();
    if (c + 1 < 64) {
      if (wid < 2) asm volatile("s_waitcnt vmcnt(16)" ::: "memory");
      else asm volatile("s_waitcnt vmcnt(0)" ::: "memory");
      MWRITE();
      if (wid >= 2 && wid < 6) {
#pragma unroll
        for (int g = 0; g < 4; ++g) { const unsigned a = off_b(r32, 4 * blk + g) + 8 * hi;
          *(u32x2*)(lds + OFF_C + a) = (u32x2){cvt_pk_bf16(Cst[4 * g], Cst[4 * g + 1]), cvt_pk_bf16(Cst[4 * g + 2], Cst[4 * g + 3])};
          *(u32x2*)(lds + OFF_N + a) = (u32x2){cvt_pk_bf16(Nst[4 * g], Nst[4 * g + 1]), cvt_pk_bf16(Nst[4 * g + 2], Nst[4 * g + 3])}; }
      }
    }
    __syncthreads();
  }
#undef TB
#undef MLOAD
#undef MWRITE
}
}

#define XB_TMO      128
#define XB_XCNT(j)  (256  + 64 * (j))
#define XB_XSUB(j)  (1280 + 64 * (j))
#define XB_XGEN(j)  (2304 + 64 * (j))
#define XB_TOP      3328
#define XB_TOPGEN   3392
#define XCD_BAR_WORDS 3456
#define XB_SPIN_CAP (1u << 18)
__device__ __forceinline__ unsigned xb_ld(unsigned* p)              { return __hip_atomic_load(p, __ATOMIC_RELAXED, __HIP_MEMORY_SCOPE_AGENT); }
__device__ __forceinline__ unsigned xb_add(unsigned* p, unsigned v) { return __hip_atomic_fetch_add(p, v, __ATOMIC_RELAXED, __HIP_MEMORY_SCOPE_AGENT); }
__device__ __forceinline__ unsigned xb_xcc_id() { return (unsigned)__builtin_amdgcn_s_getreg((3 << 11) | 20) & 0xFu; }
#define XB_SPIN(cond, bar) do { unsigned _sp = 0; while (cond) { __builtin_amdgcn_s_sleep(1); \
    if ((++_sp & 255u) == 0u) { if (xb_ld(&(bar)[XB_TMO])) break; if (_sp > XB_SPIN_CAP) { atomicAdd(&(bar)[XB_TMO], 1u); break; } } } } while (0)
struct XcdBarrier { unsigned* bar; unsigned x; volatile LAS unsigned* st; };
__device__ __forceinline__ XcdBarrier xcd_barrier_post(unsigned* bar, volatile LAS unsigned* st) {
    XcdBarrier b; b.bar = bar; b.x = xb_xcc_id(); b.st = st;
    if (threadIdx.x == 0) (void)xb_add(&bar[XB_XCNT(b.x)], 1u);
    return b;
}
__device__ __forceinline__ void xcd_barrier_complete(unsigned* bar, unsigned x, unsigned& nloc, unsigned& nx) {
    const unsigned G = gridDim.x * gridDim.y * gridDim.z;
    unsigned sum, cnt, mine, sp = 0u;
    for (;;) {
        sum = 0u; cnt = 0u; mine = 0u;
#pragma unroll
        for (unsigned j = 0; j < 16; ++j) { const unsigned c = xb_ld(&bar[XB_XCNT(j)]); sum += c; cnt += (c > 0u) ? 1u : 0u; mine = (j == x) ? c : mine; }
        if (sum == G) break;
        __builtin_amdgcn_s_sleep(1);
        if ((++sp & 255u) == 0u) { if (xb_ld(&bar[XB_TMO])) break; if (sp > XB_SPIN_CAP) { atomicAdd(&bar[XB_TMO], 1u); break; } }
    }
    nloc = mine > 0u ? mine : 1u; nx = cnt > 0u ? cnt : 1u;
}
__device__ __forceinline__ void xcd_barrier(const XcdBarrier& b) {
    asm volatile("s_waitcnt vmcnt(0)" ::: "memory");
    __syncthreads();
    if (threadIdx.x == 0) {
        unsigned* bar = b.bar;
        __builtin_amdgcn_s_waitcnt(0);
        unsigned nloc = b.st[0], nx = b.st[1];
        if (nloc == 0u) { xcd_barrier_complete(bar, b.x, nloc, nx); b.st[0] = nloc; b.st[1] = nx; }
        const unsigned old = xb_add(&bar[XB_XSUB(b.x)], 1u);
        const unsigned gen = old / nloc;
        if (old + 1u == (gen + 1u) * nloc) {
            __builtin_amdgcn_fence(__ATOMIC_RELEASE, "agent");
            asm volatile("s_waitcnt vmcnt(0)" ::: "memory");
            const unsigned og = xb_add(&bar[XB_TOP], 1u);
            const unsigned tg = og / nx;
            if (og + 1u == (tg + 1u) * nx) xb_add(&bar[XB_TOPGEN], 1u);
            else XB_SPIN(xb_ld(&bar[XB_TOPGEN]) == tg, bar);
            __builtin_amdgcn_fence(__ATOMIC_ACQUIRE, "agent");
            xb_add(&bar[XB_XGEN(b.x)], 1u);
            asm volatile("s_waitcnt vmcnt(0)" ::: "memory");
        } else {
            XB_SPIN(xb_ld(&bar[XB_XGEN(b.x)]) == gen, bar);
            __builtin_amdgcn_fence(__ATOMIC_ACQUIRE, "agent");
            asm volatile("s_waitcnt vmcnt(0)" ::: "memory");
        }
    }
    __syncthreads();
}

struct Args { const float* in[24]; float* out; unsigned char* ws; int ph_lo, ph_hi; };
constexpr int NPH = 38;
struct Frame {
    char* lds; int tid, lane, wave, G, bid;
    unsigned char* ws;
};

struct CvtJob { const float* src; bf16_t* dst; int K, N, sld; int grp, gstride, goff; const float* sk; const float* sn; };
__device__ __forceinline__ void cvt_tiles(const Frame& F, const CvtJob& j, int& rot) {
    const int tk = j.K / 64, tn = (j.N + 255) / 256, nt = tk * tn;
    int start = F.bid - (rot % F.G); if (start < 0) start += F.G;
    rot += nt;
    if (start >= nt) return;
    const int n4 = F.lane * 4, kq = F.wave;
    f32x4 v[8], vn[8];
#define CVT_LOAD(dst, it_) do { const int k0_ = ((it_) / tn) * 64 + kq * 8, n0_ = ((it_) % tn) * 256 + n4; \
        if (n0_ < j.N) { _Pragma("unroll") for (int r = 0; r < 8; ++r) dst[r] = *(const f32x4*)(j.src + (size_t)(k0_ + r) * j.sld + n0_); } } while (0)
    CVT_LOAD(v, start);
    int buf = 0;
    for (int it = start; it < nt; it += F.G) {
        const bool has_next = it + F.G < nt;
        if (has_next) CVT_LOAD(vn, it + F.G);
        const int k0 = (it / tn) * 64, n0 = (it % tn) * 256;
        char* img = F.lds + buf * 32768;
        if (n0 + n4 < j.N) {
            if (j.sk) {
#pragma unroll
                for (int r = 0; r < 8; ++r) v[r] = v[r] * j.sk[k0 + kq * 8 + r];
            }
            if (j.sn) { const f32x4 sn = *(const f32x4*)(j.sn + n0 + n4);
#pragma unroll
                for (int r = 0; r < 8; ++r) v[r] = v[r] * sn; }
#pragma unroll
            for (int c = 0; c < 4; ++c) {
                u32x4 w; w.x = cvt_pk_bf16(v[0][c], v[1][c]); w.y = cvt_pk_bf16(v[2][c], v[3][c]); w.z = cvt_pk_bf16(v[4][c], v[5][c]); w.w = cvt_pk_bf16(v[6][c], v[7][c]);
                *(u32x4*)(img + (n4 + c) * 128 + ((kq ^ (F.lane & 7)) * 16)) = w;
            }
        }
        __syncthreads();
#pragma unroll
        for (int q = 0; q < 4; ++q) { const int id = F.tid + 512 * q, n = id >> 3, kc = id & 7;
            if (n0 + n < j.N) { const u32x4 w = *(const u32x4*)(img + n * 128 + ((kc ^ ((n >> 2) & 7)) * 16));
                const int nn = n0 + n, drow = (nn / j.grp) * j.gstride + j.goff + (nn % j.grp);
                *(u32x4*)(j.dst + (size_t)drow * j.K + k0 + kc * 8) = w; } }
        buf ^= 1;
        if (has_next) {
#pragma unroll
            for (int r = 0; r < 8; ++r) v[r] = vn[r];
        }
    }
    __syncthreads();
#undef CVT_LOAD
}
__device__ __forceinline__ CvtJob mkjob(const float* src, bf16_t* dst, int K, int N, int sld) { CvtJob j; j.src = src; j.dst = dst; j.K = K; j.N = N; j.sld = sld; j.grp = N; j.gstride = 0; j.goff = 0; j.sk = nullptr; j.sn = nullptr; return j; }

__device__ __forceinline__ void phase_convert_small(const Frame& F, const Args& a) {
    bf16_t* W = (bf16_t*)(F.ws + WS_W); int rot = 0;
    for (int j = 0; j < 2; ++j) {
        { CvtJob c = mkjob(a.in[2] + (size_t)j * D * MLA_IN, (bf16_t*)((char*)W + W_DQKV) + (size_t)j * MLA_INP * D, D, MLA_IN, MLA_IN); cvt_tiles(F, c, rot); }
        { CvtJob c = mkjob(a.in[4] + (size_t)j * MLA_QR * MLA_QW, (bf16_t*)((char*)W + W_UQ) + (size_t)j * MLA_QW * MLA_QR, MLA_QR, MLA_QW, MLA_QW); c.sk = a.in[3] + j * MLA_QR; cvt_tiles(F, c, rot); }
        { CvtJob c = mkjob(a.in[6] + (size_t)j * MLA_KVR * MLA_KVW, (bf16_t*)((char*)W + W_UKV) + (size_t)j * MLA_KVW * MLA_KVR, MLA_KVR, MLA_KVW, MLA_KVW); c.sk = a.in[5] + j * MLA_KVR; cvt_tiles(F, c, rot); }
        { CvtJob c = mkjob(a.in[7] + (size_t)j * D * D, (bf16_t*)((char*)W + W_O) + (size_t)j * D * D, D, D, D); cvt_tiles(F, c, rot); }
        { bf16_t* z = (bf16_t*)((char*)W + W_DQKV) + (size_t)j * MLA_INP * D + (size_t)MLA_IN * D;
          for (int i = F.bid * NTHR + F.tid; i < (MLA_INP - MLA_IN) * D / 8; i += F.G * NTHR) *(u32x4*)(z + (size_t)i * 8) = (u32x4){0u, 0u, 0u, 0u}; }
    }
    for (int g = 0; g < 4; ++g) { CvtJob c = mkjob(a.in[8] + (size_t)g * 256 * 256, (bf16_t*)((char*)W + W_POOL) + (size_t)g * 256 * 256, 256, 256, 256); c.sn = a.in[9] + g * 256; cvt_tiles(F, c, rot); }
    { CvtJob c = mkjob(a.in[10], (bf16_t*)((char*)W + W_IN), D, ML_INP, ML_IN); cvt_tiles(F, c, rot); }
    { CvtJob c = mkjob(a.in[14], (bf16_t*)((char*)W + W_OUT), D, D, D); cvt_tiles(F, c, rot); }
    for (int j = 0; j < 2; ++j) {
        { CvtJob c = mkjob(a.in[15] + (size_t)j * D * DFF, (bf16_t*)((char*)W + W_GU) + (size_t)j * 2 * DFF * D, D, DFF, DFF); c.grp = 128; c.gstride = 256; c.goff = 0; cvt_tiles(F, c, rot); }
        { CvtJob c = mkjob(a.in[16] + (size_t)j * D * DFF, (bf16_t*)((char*)W + W_GU) + (size_t)j * 2 * DFF * D, D, DFF, DFF); c.grp = 128; c.gstride = 256; c.goff = 128; cvt_tiles(F, c, rot); }
        { CvtJob c = mkjob(a.in[17] + (size_t)j * DFF * D, (bf16_t*)((char*)W + W_DN) + (size_t)j * D * DFF, DFF, D, D); cvt_tiles(F, c, rot); }
    }
    { const float* x = a.in[0]; bf16_t* xb = (bf16_t*)(F.ws + WS_XB);
      for (size_t i = (size_t)F.bid * NTHR + F.tid; i < (size_t)T * D / 8; i += (size_t)F.G * NTHR) {
          const f32x4 v0 = *(const f32x4*)(x + i * 8), v1 = *(const f32x4*)(x + i * 8 + 4);
          u32x4 w; w.x = cvt_pk_bf16(v0[0], v0[1]); w.y = cvt_pk_bf16(v0[2], v0[3]); w.z = cvt_pk_bf16(v1[0], v1[1]); w.w = cvt_pk_bf16(v1[2], v1[3]);
          *(u32x4*)(xb + i * 8) = w; } }
}
__device__ __forceinline__ void phase_convert_moe(const Frame& F, const Args& a, int c) {
    bf16_t* GU = (bf16_t*)(F.ws + WS_WMOE + WM_GU); bf16_t* DN = (bf16_t*)(F.ws + WS_WMOE + WM_DN); int rot = 0;
    for (int e = 0; e < NEXP; ++e) {
        const size_t eo = ((size_t)c * NEXP + e) * (size_t)D * DFFE;
        { CvtJob j = mkjob(a.in[19] + eo, GU + (size_t)e * 2 * DFFE * D, D, DFFE, DFFE); j.grp = 128; j.gstride = 256; j.goff = 0; cvt_tiles(F, j, rot); }
        { CvtJob j = mkjob(a.in[20] + eo, GU + (size_t)e * 2 * DFFE * D, D, DFFE, DFFE); j.grp = 128; j.gstride = 256; j.goff = 128; cvt_tiles(F, j, rot); }
        { CvtJob j = mkjob(a.in[21] + eo, DN + (size_t)e * D * DFFE, DFFE, D, D); cvt_tiles(F, j, rot); }
    }
}

template <int MODE>
__device__ __forceinline__ void phase_ln(const Frame& F, const float* xin, const float* y, float* xout, bf16_t* xb, const float* g, const float* b,
                                         const float* wproj  , const float* bgate) {
    constexpr bool MOE_IN = MODE & 1, ROUTER = (MODE & 2) != 0, GATES = (MODE & 4) != 0, FINAL = (MODE & 8) != 0;
    constexpr int NP = ROUTER ? 8 : (GATES ? 16 : 0); constexpr int NPA = NP ? NP : 4;
    float* wl = (float*)F.lds;
    int* sel = (int*)(F.lds + 65536);
    const int* toke = (const int*)(F.ws + WS_META + MT_TOKE); const float* tokw = (const float*)(F.ws + WS_META + MT_TOKW);
    if constexpr (NP != 0) {
        for (int i = F.tid; i < 1024 * NPA; i += NTHR) { const int c = i / NPA, p = i % NPA; wl[p * 1024 + c] = ROUTER ? wproj[c * 8 + p] : wproj[(size_t)c * ML_IN + ML_INP + p]; }
        __syncthreads();
    }
    f32x4 gg[4], bb[4];
#pragma unroll
    for (int j = 0; j < 4; ++j) { gg[j] = *(const f32x4*)(g + F.lane * 4 + 256 * j); bb[j] = *(const f32x4*)(b + F.lane * 4 + 256 * j); }
    for (int blk = F.bid; blk < T / 64; blk += F.G) {
        for (int rp = 0; rp < 8; rp += 2) {
            f32x4 v[2][4]; float w1[2] = {0.f, 0.f}, w2[2] = {0.f, 0.f};
#pragma unroll
            for (int u = 0; u < 2; ++u) { const int row = blk * 64 + F.wave * 8 + rp + u;
                if (MOE_IN) { w1[u] = tokw[row * 2]; w2[u] = tokw[row * 2 + 1]; } }
            f32x4 xv[2][4], ya[2][4], yb[2][4];
#pragma unroll
            for (int u = 0; u < 2; ++u) { const int row = blk * 64 + F.wave * 8 + rp + u;
#pragma unroll
                for (int j = 0; j < 4; ++j) { const int c = F.lane * 4 + 256 * j;
                    xv[u][j] = *(const f32x4*)(xin + (size_t)row * D + c);
                    if (MOE_IN) { ya[u][j] = *(const f32x4*)(y + (size_t)(2 * row) * D + c); yb[u][j] = *(const f32x4*)(y + (size_t)(2 * row + 1) * D + c); }
                    else ya[u][j] = *(const f32x4*)(y + (size_t)row * D + c); } }
#pragma unroll
            for (int u = 0; u < 2; ++u)
#pragma unroll
                for (int j = 0; j < 4; ++j) { f32x4 yv; if (MOE_IN) yv = ya[u][j] * w1[u] + yb[u][j] * w2[u]; else yv = ya[u][j]; v[u][j] = xv[u][j] * DN_ALPHA + yv; }
            float mu[2], rstd[2];
#pragma unroll
            for (int u = 0; u < 2; ++u) { float s_ = 0.f;
#pragma unroll
                for (int j = 0; j < 4; ++j) s_ += (v[u][j][0] + v[u][j][1]) + (v[u][j][2] + v[u][j][3]);
                mu[u] = s_; }
            mu[0] = wave_sum(mu[0]) * (1.0f / 1024.0f); mu[1] = wave_sum(mu[1]) * (1.0f / 1024.0f);
#pragma unroll
            for (int u = 0; u < 2; ++u) { float q = 0.f;
#pragma unroll
                for (int j = 0; j < 4; ++j) { const f32x4 d = v[u][j] - mu[u]; q += (d[0] * d[0] + d[1] * d[1]) + (d[2] * d[2] + d[3] * d[3]); }
                rstd[u] = q; }
            rstd[0] = 1.0f / sqrtf(wave_sum(rstd[0]) * (1.0f / 1024.0f) + LN_EPS); rstd[1] = 1.0f / sqrtf(wave_sum(rstd[1]) * (1.0f / 1024.0f) + LN_EPS);
#pragma unroll
            for (int u = 0; u < 2; ++u) { const int row = blk * 64 + F.wave * 8 + rp + u, rr = rp + u;
#pragma unroll
            for (int j = 0; j < 4; ++j) { const int c = F.lane * 4 + 256 * j;
                v[u][j] = (v[u][j] - mu[u]) * rstd[u] * gg[j] + bb[j];
                *(f32x4*)(xout + (size_t)row * D + c) = v[u][j];
                if (!FINAL) { u32x2 w; w.x = cvt_pk_bf16(v[u][j][0], v[u][j][1]); w.y = cvt_pk_bf16(v[u][j][2], v[u][j][3]); *(u32x2*)(xb + (size_t)row * D + c) = w; } }
            if constexpr (NP != 0) {
                float pr[NPA];
#pragma unroll
                for (int p = 0; p < NPA; ++p) pr[p] = 0.f;
#pragma unroll
                for (int j = 0; j < 4; ++j)
#pragma unroll
                    for (int p = 0; p < NPA; ++p) { const f32x4 wv = *(const f32x4*)(wl + p * 1024 + F.lane * 4 + 256 * j);
                        pr[p] += (v[u][j][0] * wv[0] + v[u][j][1] * wv[1]) + (v[u][j][2] * wv[2] + v[u][j][3] * wv[3]); }
                {
                    int np = NPA, msk = 32;
#pragma unroll
                    for (int st = 0; st < (NPA == 16 ? 4 : 3); ++st) { np >>= 1; const bool up = (F.lane & msk) != 0;
#pragma unroll
                        for (int k = 0; k < 8; ++k) if (k < np) { const float keep = up ? pr[k + np] : pr[k], send = up ? pr[k] : pr[k + np]; pr[k] = keep + __shfl_xor(send, msk); }
                        msk >>= 1; }
                    float tot = pr[0];
#pragma unroll
                    for (int o = (NPA == 16 ? 2 : 4); o >= 1; o >>= 1) tot += __shfl_xor(tot, o);
                    if (NPA == 16) { pr[0] = tot; } else { pr[0] = tot; }
                }
                if constexpr (ROUTER) {
                    { const float mine = pr[0];
#pragma unroll
                      for (int p = 0; p < 8; ++p) pr[p] = __shfl(mine, 8 * p); }
                    int e1 = 0; float v1 = pr[0];
#pragma unroll
                    for (int p = 1; p < 8; ++p) if (pr[p] > v1) { v1 = pr[p]; e1 = p; }
                    int e2 = -1; float v2 = -3.0e38f;
#pragma unroll
                    for (int p = 0; p < 8; ++p) if (p != e1 && pr[p] > v2) { v2 = pr[p]; e2 = p; }
                    const float ww2 = 1.0f / (1.0f + expf(v1 - v2)), ww1 = 1.0f - ww2;
                    if (F.lane == 0) { int* te = (int*)(F.ws + WS_META + MT_TOKE); float* tw = (float*)(F.ws + WS_META + MT_TOKW);
                        te[row * 2] = e1; te[row * 2 + 1] = e2; tw[row * 2] = ww1; tw[row * 2 + 1] = ww2;
                        sel[F.wave * 16 + rr * 2] = e1; sel[F.wave * 16 + rr * 2 + 1] = e2; }
                }
                if constexpr (GATES) { if ((F.lane & 3) == 0) { const int p = F.lane >> 2;
                        ((float*)(F.ws + WS_META + MT_GATES))[(size_t)row * 16 + p] = pr[0] + bgate[p]; } }
            }
            }
        }
        if constexpr (ROUTER) {
            __syncthreads();
            if (F.tid < 128) { const int e = sel[F.tid]; int rk = 0; for (int p = 0; p < F.tid; ++p) rk += (sel[p] == e) ? 1 : 0;
                const int row = blk * 64 + (F.tid >> 4) * 8 + ((F.tid & 15) >> 1);
                ((int*)(F.ws + WS_META + MT_RANK))[row * 2 + (F.tid & 1)] = rk; }
            if (F.tid >= 128 && F.tid < 136) { const int e = F.tid - 128; int cn = 0; for (int p = 0; p < 128; ++p) cn += (sel[p] == e) ? 1 : 0;
                ((int*)(F.ws + WS_META + MT_CNTW))[blk * 8 + e] = cn; }
            __syncthreads();
        }
    }
    (void)toke;
}

__device__ __forceinline__ void phase_moe_permute(const Frame& F) {
    int* cl = (int*)F.lds;
    int* tot = cl + 2048; int* toff = cl + 2056; int* base = cl + 2072;
    const int* cntw = (const int*)(F.ws + WS_META + MT_CNTW);
    for (int i = F.tid; i < 2048; i += NTHR) cl[i] = cntw[i];
    __syncthreads();
    if (F.tid < 8) { int s = 0; for (int w = 0; w < 256; ++w) s += cl[w * 8 + F.tid]; tot[F.tid] = s; }
    __syncthreads();
    if (F.tid == 0) { int o = 0; for (int e = 0; e < 8; ++e) { toff[e] = o; o += (tot[e] + 255) >> 8; } toff[8] = o;
        if (F.bid == 0) { int* meta = (int*)(F.ws + WS_META + MT_MOE); for (int e = 0; e < 8; ++e) meta[e] = tot[e]; for (int e = 0; e < 9; ++e) meta[8 + e] = toff[e]; } }
    __syncthreads();
    const int* toke = (const int*)(F.ws + WS_META + MT_TOKE); const int* rank = (const int*)(F.ws + WS_META + MT_RANK);
    int* rowtok = (int*)(F.ws + WS_META + MT_ROWTOK);
    const bf16_t* xb = (const bf16_t*)(F.ws + WS_XB); bf16_t* xp = (bf16_t*)(F.ws + WS_SCR + SC_XP);
    for (int blk = F.bid; blk < T / 64; blk += F.G) {
        __syncthreads();
        if (F.tid < 8) { int s = 0; for (int w = 0; w < blk; ++w) s += cl[w * 8 + F.tid]; base[F.tid] = toff[F.tid] * 256 + s; }
        __syncthreads();
        for (int pp = F.wave; pp < 128; pp += NWAVES) {
            const int tok = blk * 64 + (pp >> 1), k = pp & 1, e = toke[tok * 2 + k], row = base[e] + rank[tok * 2 + k];
            const u32x4 v0 = *(const u32x4*)(xb + (size_t)tok * D + F.lane * 8), v1 = *(const u32x4*)(xb + (size_t)tok * D + 512 + F.lane * 8);
            *(u32x4*)(xp + (size_t)row * D + F.lane * 8) = v0; *(u32x4*)(xp + (size_t)row * D + 512 + F.lane * 8) = v1;
            if (F.lane == 0) rowtok[row] = tok * 2 + k;
        }
    }
}

__device__ __forceinline__ void phase_mla_rows(const Frame& F, const int* positions) {
    const float* lat = (const float*)(F.ws + WS_SCR + SC_LAT);
    bf16_t* cqn = (bf16_t*)(F.ws + WS_SCR + SC_CQN); bf16_t* ckvn = (bf16_t*)(F.ws + WS_SCR + SC_CKVN); bf16_t* kr = (bf16_t*)(F.ws + WS_SCR + SC_KR);
    float* rope = (float*)(F.ws + WS_META + MT_ROPE);
    for (int row = F.bid * NWAVES + F.wave; row < T; row += F.G * NWAVES) {
        const float* lr = lat + (size_t)row * MLA_INP;
        float cq[6], ck[4]; float s1 = 0.f, s2 = 0.f;
#pragma unroll
        for (int j = 0; j < 6; ++j) { cq[j] = lr[F.lane + 64 * j]; s1 += cq[j] * cq[j]; }
#pragma unroll
        for (int j = 0; j < 4; ++j) { ck[j] = lr[MLA_QR + F.lane + 64 * j]; s2 += ck[j] * ck[j]; }
        const float r1 = 1.0f / sqrtf(wave_sum(s1) * (1.0f / MLA_QR) + RMS_EPS), r2 = 1.0f / sqrtf(wave_sum(s2) * (1.0f / MLA_KVR) + RMS_EPS);
#pragma unroll
        for (int j = 0; j < 6; ++j) cqn[(size_t)row * MLA_QR + F.lane + 64 * j] = (bf16_t)(cvt_pk_bf16(cq[j] * r1, 0.f) & 0xffffu);
#pragma unroll
        for (int j = 0; j < 4; ++j) ckvn[(size_t)row * MLA_KVR + F.lane + 64 * j] = (bf16_t)(cvt_pk_bf16(ck[j] * r2, 0.f) & 0xffffu);
        const float kx = lr[MLA_QR + MLA_KVR + F.lane];
        const float ko = __shfl_xor(kx, 32);
        const int i = F.lane & 31;
        const float invf = exp2f(-(float)i * (13.287712379549449f / 32.0f));
        const float ang = (float)positions[row] * invf;
        const double rev = (double)ang * 0.15915494309189535;
        const float fr = (float)(rev - floor(rev));
        const float sn = __builtin_amdgcn_sinf(fr), cs = __builtin_amdgcn_cosf(fr);
        const float out = (F.lane < 32) ? (kx * cs - ko * sn) : (kx * cs + ko * sn);
        kr[(size_t)row * MLA_ROPE + F.lane] = (bf16_t)(cvt_pk_bf16(out, 0.f) & 0xffffu);
        if (F.lane < 32) *(f32x2*)(rope + (size_t)row * 64 + 2 * i) = (f32x2){cs, sn};
    }
}

__device__ __forceinline__ void phase_pool_z(const Frame& F) {
    const float* x = (const float*)(F.ws + WS_X); bf16_t* z = (bf16_t*)(F.ws + WS_SCR + SC_Z);
    const int c = F.tid * 2, half = 1 << (c >> 8);
    for (int blk = F.bid; blk < T / 64; blk += F.G) {
        const int b0 = (blk * 64) / SEQ * SEQ, t0 = blk * 64 - b0;
        f32x2 sum = {0.f, 0.f};
        for (int s = t0 - half; s < t0 + half; ++s) if (s >= 0 && s < SEQ) { const f32x2 v = *(const f32x2*)(x + (size_t)(b0 + s) * D + c); sum += v; }
        for (int t = t0; t < t0 + 64; ++t) {
            const int lo = t - half < 0 ? 0 : t - half, hi = t + half > SEQ ? SEQ : t + half;
            const f32x2 xv = *(const f32x2*)(x + (size_t)(b0 + t) * D + c);
            const float inv = 1.0f / (float)(hi - lo);
            const f32x2 zz = sum * inv - xv;
            *(unsigned*)(z + (size_t)(b0 + t) * D + c) = cvt_pk_bf16(zz[0], zz[1]);
            if (t + half < SEQ) { const f32x2 v = *(const f32x2*)(x + (size_t)(b0 + t + half) * D + c); sum += v; }
            if (t - half >= 0) { const f32x2 v = *(const f32x2*)(x + (size_t)(b0 + t - half) * D + c); sum -= v; }
        }
    }
}

__device__ __forceinline__ void phase_mlstm_prep(const Frame& F, const float* convw) {
    const bf16_t* proj = (const bf16_t*)(F.ws + WS_SCR + SC_PROJ); bf16_t* qkc = (bf16_t*)(F.ws + WS_SCR + SC_QKC);
    const int c = F.tid * 2;
    float w0[5], w1[5];
#pragma unroll
    for (int j = 0; j < 5; ++j) { w0[j] = convw[j * 1024 + c]; w1[j] = convw[j * 1024 + c + 1]; }
    const float ksc = (c >= 512) ? 0.08838834764831845f : 1.0f;
    for (int blk = F.bid; blk < T / 64; blk += F.G) {
        const int b0 = (blk * 64) / SEQ * SEQ, t0 = blk * 64 - b0;
        float a0[5], a1[5];
#pragma unroll
        for (int j = 0; j < 4; ++j) { const int s = t0 - 2 + j; unsigned w = 0u; if (s >= 0 && s < SEQ) w = *(const unsigned*)(proj + (size_t)(b0 + s) * ML_INP + c); a0[j + 1] = bflo(w); a1[j + 1] = bfhi(w); }
        for (int t = t0; t < t0 + 64; ++t) {
#pragma unroll
            for (int j = 0; j < 4; ++j) { a0[j] = a0[j + 1]; a1[j] = a1[j + 1]; }
            { const int s = t + 2; unsigned w = 0u; if (s < SEQ) w = *(const unsigned*)(proj + (size_t)(b0 + s) * ML_INP + c); a0[4] = bflo(w); a1[4] = bfhi(w); }
            float r0 = 0.f, r1 = 0.f;
#pragma unroll
            for (int j = 0; j < 5; ++j) { r0 += a0[j] * w0[j]; r1 += a1[j] * w1[j]; }
            r0 = silu_f(r0) * ksc; r1 = silu_f(r1) * ksc;
            *(unsigned*)(qkc + (size_t)(b0 + t) * D + c) = cvt_pk_bf16(r0, r1);
        }
    }
    const float* gates = (const float*)(F.ws + WS_META + MT_GATES);
    float* gb = (float*)(F.ws + WS_META + MT_GVEC); float* gu = gb + 32 * SEQ; float* gpm = gu + 32 * SEQ; float* gawl = gpm + 32 * SEQ;
    for (int wg = F.bid * NWAVES + F.wave; wg < 32 * 64; wg += F.G * NWAVES) {
        const int chain = wg >> 6, cch = wg & 63, dir = chain >> 4, bb = (chain >> 2) & 3, hd = chain & 3;
        const int pos = cch * 64 + F.lane, tok = dir ? (SEQ - 1 - pos) : pos;
        const size_t row = (size_t)bb * SEQ + tok;
        const float li = gates[row * 16 + dir * 4 + hd], f = gates[row * 16 + 8 + dir * 4 + hd];
        const float lf = fminf(f, 0.f) - log1pf(expf(-fabsf(f)));
        float bsum = lf;
#pragma unroll
        for (int o = 1; o < 64; o <<= 1) { const float n = __shfl_up(bsum, o); if (F.lane >= o) bsum += n; }
        const float u = li - bsum;
        float pm = u;
#pragma unroll
        for (int o = 1; o < 64; o <<= 1) { const float n = __shfl_up(pm, o); if (F.lane >= o) pm = fmaxf(pm, n); }
        const float pm63 = __shfl(pm, 63);
        const size_t o_ = (size_t)chain * SEQ + pos;
        gb[o_] = bsum; gu[o_] = u; gpm[o_] = pm; gawl[o_] = expf(u - pm63);
    }
}

__device__ __forceinline__ void phase_mlstm_combine(const Frame& F, const float* norm_g) {
    const float* hs = (const float*)(F.ws + WS_SCR + SC_HS); const bf16_t* proj = (const bf16_t*)(F.ws + WS_SCR + SC_PROJ); bf16_t* ym = (bf16_t*)(F.ws + WS_SCR + SC_YM);
    for (int row = F.bid * NWAVES + F.wave; row < T; row += F.G * NWAVES) {
#pragma unroll
        for (int hd = 0; hd < 4; ++hd) { const int c = hd * 256 + F.lane * 4;
            const f32x4 h = *(const f32x4*)(hs + (size_t)row * D + c) + *(const f32x4*)(hs + (size_t)T * D + (size_t)row * D + c);
            const float mu = wave_sum((h[0] + h[1]) + (h[2] + h[3])) * (1.0f / 256.0f);
            const f32x4 d = h - mu;
            const float rstd = 1.0f / sqrtf(wave_sum((d[0] * d[0] + d[1] * d[1]) + (d[2] * d[2] + d[3] * d[3])) * (1.0f / 256.0f) + LN_EPS);
            const f32x4 gn = *(const f32x4*)(norm_g + c);
            const u32x2 ow = *(const u32x2*)(proj + (size_t)row * ML_INP + 2048 + c);
            const float o0 = bflo(ow.x), o1 = bfhi(ow.x), o2 = bflo(ow.y), o3 = bfhi(ow.y);
            const float y0 = d[0] * rstd * gn[0] * sigmoid_f(o0), y1 = d[1] * rstd * gn[1] * sigmoid_f(o1), y2 = d[2] * rstd * gn[2] * sigmoid_f(o2), y3 = d[3] * rstd * gn[3] * sigmoid_f(o3);
            *(u32x2*)(ym + (size_t)row * D + c) = (u32x2){cvt_pk_bf16(y0, y1), cvt_pk_bf16(y2, y3)}; }
    }
}

__global__ void __launch_bounds__(NTHR, 2) fwd_kernel(Args args) {
    extern __shared__ __attribute__((aligned(16))) unsigned char lds_raw[];
    Frame F;
    F.lds = (char*)lds_raw; F.tid = threadIdx.x; F.lane = F.tid & 63; F.wave = __builtin_amdgcn_readfirstlane(F.tid >> 6); F.G = gridDim.x; F.bid = blockIdx.x; F.ws = args.ws;
    LAS unsigned char* ldsl = (LAS unsigned char*)lds_raw;
    volatile LAS unsigned* MISC = (volatile LAS unsigned*)(ldsl + LDS_MISC);
    if (F.tid < 64) MISC[F.tid] = 0u;
    __syncthreads();
    const int lo = args.ph_lo, hi = args.ph_hi;
    XcdBarrier bar; bar.bar = (unsigned*)(args.ws + WS_CTL) + 4096; bar.x = 0; bar.st = nullptr;
    if (hi - lo > 1) bar = xcd_barrier_post((unsigned*)(args.ws + WS_CTL) + 4096, MISC + 8);
#ifndef EN_MASK
#define EN_MASK 0xffffffffu
#endif
#define EN(b) ((EN_MASK >> (b)) & 1u)
#define IN(k) (lo <= (k) && (k) < hi)
#define SEAM(k) do { if (IN(k) && IN((k) + 1)) xcd_barrier(bar); } while (0)
    int ph = 0;
#define PTRS size_t zoff_ = 0; asm volatile("" : "+s"(zoff_)); unsigned char* ws = args.ws + zoff_; F.ws = ws; unsigned char* scr = ws + WS_SCR; bf16_t* Wb = (bf16_t*)(ws + WS_W); \
    float* X = (float*)(ws + WS_X); bf16_t* XB = (bf16_t*)(ws + WS_XB); float* Y = (float*)(ws + WS_Y); const float* lng = args.in[22]; const float* lnb = args.in[23]; \
    (void)scr; (void)Wb; (void)X; (void)XB; (void)Y; (void)lng; (void)lnb;

    if (EN(0) && IN(ph)) { PTRS phase_convert_small(F, args); }
    SEAM(ph); ++ph;
    if (EN(0) && IN(ph)) { PTRS phase_convert_moe(F, args, 0); }
    SEAM(ph); ++ph;

#define GEMM_DENSE(EPI, Aptr, lda_, Bptr, ldb_, K_, Mrows, Ncols, epi) do { \
        pg8::Gemm g{(const bf16_t*)(Aptr), (const bf16_t*)(Bptr), (lda_), (ldb_), (K_)}; pg8::DenseOrder S; S.init((Mrows), (Ncols), F.G, F.bid); \
        pg8::gemm_phase<EPI, pg8::DenseOrder, true>(ldsl, g, S, epi); } while (0)

#define MLA_PHASES(j, xres, lnidx, LNMODE, wproj_) do { \
    if (EN(11) && IN(ph)) { PTRS  pg8::EpiF32 E{(float*)(scr + SC_LAT), MLA_INP}; GEMM_DENSE(pg8::EpiF32, XB, D, (char*)Wb + W_DQKV + (size_t)(j) * MLA_INP * D * 2, D, D, T, MLA_INP, E); } \
    SEAM(ph); ++ph; \
    if (EN(2) && IN(ph)) { PTRS phase_mla_rows(F, (const int*)args.in[1]); } \
    SEAM(ph); ++ph; \
    if (EN(12) && IN(ph)) { PTRS  { pg8::EpiBf16 E{(bf16_t*)(scr + SC_Q), MLA_QW}; GEMM_DENSE(pg8::EpiBf16, scr + SC_CQN, MLA_QR, (char*)Wb + W_UQ + (size_t)(j) * MLA_QW * MLA_QR * 2, MLA_QR, MLA_QR, T, MLA_QW, E); } \
                  { pg8::EpiBf16 E{(bf16_t*)(scr + SC_KV), MLA_KVW}; GEMM_DENSE(pg8::EpiBf16, scr + SC_CKVN, MLA_KVR, (char*)Wb + W_UKV + (size_t)(j) * MLA_KVW * MLA_KVR * 2, MLA_KVR, MLA_KVR, T, MLA_KVW, E); } } \
    SEAM(ph); ++ph; \
    if (EN(3) && IN(ph)) { PTRS  const int x8 = F.bid & 7, jj = F.bid >> 3, per = F.G >> 3; \
        for (int lu = jj; lu < 64; lu += per) { const int bh = x8 * 4 + (lu >> 4), qb = lu & 15, b_ = bh >> 3, h_ = bh & 7; const size_t r0 = (size_t)b_ * SEQ + (size_t)qb * 256; \
            att::attn_body((const bf16_t*)(scr + SC_Q) + r0 * MLA_QW + h_ * 192, (const float*)(ws + WS_META + MT_ROPE) + r0 * 64, \
                           (const bf16_t*)(scr + SC_KV) + (size_t)b_ * SEQ * MLA_KVW + h_ * 256, (const bf16_t*)(scr + SC_KV) + (size_t)b_ * SEQ * MLA_KVW + h_ * 256 + 128, \
                           (const bf16_t*)(scr + SC_KR) + (size_t)b_ * SEQ * MLA_ROPE, (bf16_t*)(scr + SC_O) + r0 * D + h_ * 128, SEQ, F.lds); } } \
    SEAM(ph); ++ph; \
    if (EN(13) && IN(ph)) { PTRS  pg8::EpiF32 E{Y, D}; GEMM_DENSE(pg8::EpiF32, scr + SC_O, D, (char*)Wb + W_O + (size_t)(j) * D * D * 2, D, D, T, D, E); } \
    SEAM(ph); ++ph; \
    if (EN(4) && IN(ph)) { PTRS phase_ln<LNMODE>(F, xres, Y, X, XB, lng + (lnidx) * D, lnb + (lnidx) * D, wproj_, nullptr); } \
    SEAM(ph); ++ph; } while (0)

#define DENSE_PHASES(c, lnidx, LNMODE) do { \
    if (EN(14) && IN(ph)) { PTRS  pg8::EpiSwiGLU E{(bf16_t*)(scr + SC_H), DFF}; GEMM_DENSE(pg8::EpiSwiGLU, XB, D, (char*)Wb + W_GU + (size_t)(c) * 2 * DFF * D * 2, D, D, T, 2 * DFF, E); } \
    SEAM(ph); ++ph; \
    if (EN(15) && IN(ph)) { PTRS  pg8::EpiF32 E{Y, D}; GEMM_DENSE(pg8::EpiF32, scr + SC_H, DFF, (char*)Wb + W_DN + (size_t)(c) * D * DFF * 2, DFF, DFF, T, D, E); } \
    SEAM(ph); ++ph; \
    if (EN(4) && IN(ph)) { PTRS phase_ln<LNMODE>(F, X, Y, X, XB, lng + (lnidx) * D, lnb + (lnidx) * D, nullptr, nullptr); } \
    SEAM(ph); ++ph; } while (0)

#define MOE_PHASES(c, lnidx, LNMODE, xout_, wproj_, bgate_) do { \
    if (EN(6) && IN(ph)) { PTRS phase_moe_permute(F); } \
    SEAM(ph); ++ph; \
    if (EN(7) && IN(ph)) { PTRS  pg8::Gemm g{(const bf16_t*)(scr + SC_XP), (const bf16_t*)(ws + WS_WMOE + WM_GU), D, D, D}; pg8::MoeOrder S; S.build_table((const int*)(ws + WS_META + MT_MOE), (LAS int*)(ldsl + LDS_MISC + 1024), 2 * DFFE, F.G, F.bid); \
        pg8::EpiSwiGLU E{(bf16_t*)(scr + SC_HM), DFFE}; pg8::gemm_phase<pg8::EpiSwiGLU, pg8::MoeOrder, true>(ldsl, g, S, E); } \
    SEAM(ph); ++ph; \
    if (EN(7) && IN(ph)) { PTRS  pg8::Gemm g{(const bf16_t*)(scr + SC_HM), (const bf16_t*)(ws + WS_WMOE + WM_DN), DFFE, DFFE, DFFE}; pg8::MoeOrder S; S.build_table((const int*)(ws + WS_META + MT_MOE), (LAS int*)(ldsl + LDS_MISC + 1024), D, F.G, F.bid); \
        pg8::EpiF32Scatter E{(float*)(scr + SC_Y2), (const int*)(ws + WS_META + MT_ROWTOK)}; pg8::gemm_phase<pg8::EpiF32Scatter, pg8::MoeOrder, true>(ldsl, g, S, E); } \
    SEAM(ph); ++ph; \
    if (EN(4) && IN(ph)) { PTRS phase_ln<LNMODE>(F, X, (const float*)(scr + SC_Y2), xout_, XB, lng + (lnidx) * D, lnb + (lnidx) * D, wproj_, bgate_); } \
    SEAM(ph); ++ph; } while (0)

    MLA_PHASES(0, args.in[0], 0, 0, nullptr);
    DENSE_PHASES(0, 1, 0);
    if (EN(5) && IN(ph)) { PTRS phase_pool_z(F); }
    SEAM(ph); ++ph;
    if (EN(16) && IN(ph)) { PTRS  pg8::Gemm g{(const bf16_t*)(scr + SC_Z), (const bf16_t*)((char*)Wb + W_POOL), D, 256, 256}; pg8::PoolOrder S; S.init(T, D, F.G, F.bid);
        pg8::EpiF32 E{Y, D}; pg8::gemm_phase<pg8::EpiF32, pg8::PoolOrder, true>(ldsl, g, S, E); }
    SEAM(ph); ++ph;
    if (EN(4) && IN(ph)) { PTRS phase_ln<2>(F, X, Y, X, XB, lng + 2 * D, lnb + 2 * D, args.in[18], nullptr); }
    SEAM(ph); ++ph;
    MOE_PHASES(0, 3, 1 | 4, X, args.in[10], args.in[12]);
    if (EN(0) && IN(ph)) { PTRS phase_convert_moe(F, args, 1); }
    SEAM(ph); ++ph;
    if (EN(17) && IN(ph)) { PTRS  pg8::EpiBf16 E{(bf16_t*)(scr + SC_PROJ), ML_INP}; GEMM_DENSE(pg8::EpiBf16, XB, D, (char*)Wb + W_IN, D, D, T, ML_INP, E); }
    SEAM(ph); ++ph;
    if (EN(8) && IN(ph)) { PTRS phase_mlstm_prep(F, args.in[11]); }
    SEAM(ph); ++ph;
    if (EN(9) && IN(ph)) { PTRS  mls::Tensors Tn; Tn.qkc = (const bf16_t*)(scr + SC_QKC); Tn.proj = (const bf16_t*)(scr + SC_PROJ);
        Tn.gvec = (const float*)(ws + WS_META + MT_GVEC); Tn.hs = (float*)(scr + SC_HS);
        for (int u = F.bid; u < 256; u += F.G) { const int x8 = u & 7, jj = u >> 3; mls::scan_unit(Tn, (x8 * 4 + (jj >> 3)) * 8 + (jj & 7), F.lds); } }
    SEAM(ph); ++ph;
    if (EN(10) && IN(ph)) { PTRS phase_mlstm_combine(F, args.in[13]); }
    SEAM(ph); ++ph;
    if (EN(18) && IN(ph)) { PTRS  pg8::EpiF32 E{Y, D}; GEMM_DENSE(pg8::EpiF32, scr + SC_YM, D, (char*)Wb + W_OUT, D, D, T, D, E); }
    SEAM(ph); ++ph;
    if (EN(4) && IN(ph)) { PTRS phase_ln<0>(F, X, Y, X, XB, lng + 4 * D, lnb + 4 * D, nullptr, nullptr); }
    SEAM(ph); ++ph;
    DENSE_PHASES(1, 5, 0);
    MLA_PHASES(1, X, 6, 2, args.in[18] + (size_t)D * NEXP);
    MOE_PHASES(1, 7, 1 | 8, args.out, nullptr, nullptr);
#undef IN
#undef SEAM
}

extern "C" void kernel_launch(void* const* d_in, const int* in_sizes, int n_in, void* d_out, int out_size, void* d_ws, size_t ws_size, hipStream_t stream) {
    static int grid = 0;
    if (grid == 0) {
        if (n_in != 24 || in_sizes[0] != T * D || out_size != T * D || ws_size < WS_END) {
            fprintf(stderr, "kernel_launch: shape mismatch: n_in %d in0 %d out %d ws %zu (need %zu)\n", n_in, n_in > 0 ? in_sizes[0] : -1, out_size, ws_size, (size_t)WS_END); grid = -1; return; }
        int dev = 0, cus = 0, per_cu = 0;
        if (hipGetDevice(&dev) != hipSuccess || hipDeviceGetAttribute(&cus, hipDeviceAttributeMultiprocessorCount, dev) != hipSuccess) { grid = -1; return; }
        if (hipFuncSetAttribute((const void*)fwd_kernel, hipFuncAttributeMaxDynamicSharedMemorySize, LDS_BYTES) != hipSuccess) { fprintf(stderr, "kernel_launch: hipFuncSetAttribute failed\n"); grid = -1; return; }
        if (hipOccupancyMaxActiveBlocksPerMultiprocessor(&per_cu, (const void*)fwd_kernel, NTHR, LDS_BYTES) != hipSuccess || per_cu < 1)
            fprintf(stderr, "kernel_launch: occupancy query reports %d blocks per CU\n", per_cu);
        (void)hipGetLastError();
        grid = cus;
    }
    if (grid < 0) return;
    if (hipMemsetAsync((char*)d_ws + WS_CTL, 0, CTL_ZERO_BYTES, stream) != hipSuccess) { fprintf(stderr, "kernel_launch: memset failed\n"); return; }
    Args a{};
    for (int i = 0; i < 24; ++i) a.in[i] = (const float*)d_in[i];
    a.out = (float*)d_out; a.ws = (unsigned char*)d_ws;
#ifndef MK_ONE_LAUNCH
#define MK_ONE_LAUNCH 1
#endif
    if (MK_ONE_LAUNCH) { a.ph_lo = 0; a.ph_hi = NPH; hipLaunchKernelGGL(fwd_kernel, dim3(grid), dim3(NTHR), LDS_BYTES, stream, a);
#ifdef PROBE_PHASE
        for (int r = 0; r < PROBE_REPS; ++r) { a.ph_lo = PROBE_PHASE; a.ph_hi = PROBE_PHASE + 1; hipLaunchKernelGGL(fwd_kernel, dim3(grid), dim3(NTHR), LDS_BYTES, stream, a); }
#endif
    }
    else for (int p = 0; p < NPH; ++p) { a.ph_lo = p; a.ph_hi = p + 1; hipLaunchKernelGGL(fwd_kernel, dim3(grid), dim3(NTHR), LDS_BYTES, stream, a); }
    const hipError_t le = hipPeekAtLastError();
    if (le != hipSuccess) fprintf(stderr, "kernel_launch: launch failed: %s\n", hipGetErrorName(le));
}
```

```cpp
#include <hip/hip_runtime.h>
#include <cstdio>
#include <cstdint>

#define LAS __attribute__((address_space(3)))
#define GAS __attribute__((address_space(1)))
typedef unsigned short bf16_t;
typedef short bf16x8 __attribute__((ext_vector_type(8)));
typedef short s16x4 __attribute__((ext_vector_type(4)));
typedef float f32x4 __attribute__((ext_vector_type(4)));
typedef float f32x2 __attribute__((ext_vector_type(2)));
typedef float f32x16 __attribute__((ext_vector_type(16)));
typedef unsigned u32x4 __attribute__((ext_vector_type(4)));
typedef unsigned u32x2 __attribute__((ext_vector_type(2)));
typedef GAS unsigned gu32;

constexpr int BATCH = 4, SEQ = 4096, T = BATCH * SEQ, D = 1024;
constexpr float DN_ALPHA = 1.6817928305074290f;
constexpr float LN_EPS = 1e-5f, RMS_EPS = 1e-6f;
constexpr int MLA_H = 8, MLA_QR = 384, MLA_KVR = 256, MLA_NOPE = 128, MLA_ROPE = 64, MLA_V = 128, MLA_IN = 704, MLA_INP = 768;
constexpr int MLA_QW = MLA_H * (MLA_NOPE + MLA_ROPE);
constexpr int MLA_KVW = MLA_H * (MLA_NOPE + MLA_V);
constexpr int ML_H = 4, ML_DK = 128, ML_DV = 256, ML_IN = 3088, ML_INP = 3072;
constexpr int DFF = 2816, NEXP = 8, DFFE = 3584;
constexpr int MOE_MAXT = 136;
constexpr int NWAVES = 8, NTHR = 512;

constexpr size_t MiB = 1u << 20;
constexpr size_t WS_CTL = 0, CTL_ZERO_BYTES = 1 * MiB;
constexpr size_t WS_META = 1 * MiB;
constexpr size_t MT_CNTW = 0;
constexpr size_t MT_MOE = 16384;
constexpr size_t MT_TOKE = 32768;
constexpr size_t MT_TOKW = MT_TOKE + (size_t)T * 8;
constexpr size_t MT_RANK = MT_TOKW + (size_t)T * 8;
constexpr size_t MT_ROWTOK = MT_RANK + (size_t)T * 8;
constexpr size_t MT_GATES = 1 * MiB;
constexpr size_t MT_GVEC = 2 * MiB;
constexpr size_t MT_ROPE = 4 * MiB;
static_assert(MT_ROWTOK + (size_t)MOE_MAXT * 256 * 4 <= MT_GATES, "meta map");
constexpr size_t WS_W = 17 * MiB;
constexpr size_t W_DQKV = 0;
constexpr size_t W_UQ = W_DQKV + 2 * (size_t)MLA_INP * D * 2;
constexpr size_t W_UKV = W_UQ + 2 * (size_t)MLA_QW * MLA_QR * 2;
constexpr size_t W_O = W_UKV + 2 * (size_t)MLA_KVW * MLA_KVR * 2;
constexpr size_t W_POOL = W_O + 2 * (size_t)D * D * 2;
constexpr size_t W_IN = W_POOL + 4 * (size_t)256 * 256 * 2;
constexpr size_t W_OUT = W_IN + (size_t)ML_INP * D * 2;
constexpr size_t W_GU = W_OUT + (size_t)D * D * 2;
constexpr size_t W_DN = W_GU + 2 * (size_t)2 * DFF * D * 2;
constexpr size_t W_END = W_DN + 2 * (size_t)D * DFF * 2;
static_assert(W_END <= 55 * MiB, "weights map");
constexpr size_t WS_WMOE = 72 * MiB;
constexpr size_t WM_GU = 0, WM_DN = (size_t)NEXP * 2 * DFFE * D * 2;
static_assert(WM_DN + (size_t)NEXP * D * DFFE * 2 == 168 * MiB, "moe weights map");
constexpr size_t WS_X = 240 * MiB;
constexpr size_t WS_XB = 304 * MiB;
constexpr size_t WS_Y = 336 * MiB;
constexpr size_t WS_SCR = 400 * MiB;
constexpr size_t WS_END = 834 * MiB;
constexpr size_t SC_LAT = 0, SC_CQN = 48 * MiB, SC_CKVN = 60 * MiB, SC_KR = 68 * MiB, SC_Q = 70 * MiB, SC_KV = 118 * MiB, SC_O = 182 * MiB;
constexpr size_t SC_H = 0;
constexpr size_t SC_Z = 0;
constexpr size_t SC_XP = 0, SC_HM = 68 * MiB, SC_Y2 = 306 * MiB;
static_assert(SC_Y2 + (size_t)2 * T * D * 4 == 434 * MiB, "moe scratch");
constexpr size_t SC_PROJ = 0, SC_QKC = 96 * MiB, SC_HS = 128 * MiB, SC_YM = 256 * MiB;

constexpr int LDS_MAIN = 131072;
constexpr int LDS_MISC = LDS_MAIN;
constexpr int LDS_BYTES = 147456;

#define RLX_AGENT __ATOMIC_RELAXED, __HIP_MEMORY_SCOPE_AGENT
__device__ __forceinline__ unsigned cvt_pk_bf16(float lo, float hi) { unsigned r; asm volatile("v_cvt_pk_bf16_f32 %0, %1, %2" : "=v"(r) : "v"(lo), "v"(hi)); return r; }
__device__ __forceinline__ float bf2f(unsigned short b) { return __builtin_bit_cast(float, (unsigned)b << 16); }
__device__ __forceinline__ float bflo(unsigned w) { return __builtin_bit_cast(float, w << 16); }
__device__ __forceinline__ float bfhi(unsigned w) { return __builtin_bit_cast(float, w & 0xffff0000u); }
__device__ __forceinline__ float wave_sum(float v) {
#pragma unroll
    for (int o = 32; o >= 1; o >>= 1) v += __shfl_xor(v, o);
    return v;
}
__device__ __forceinline__ unsigned pack4_fp8(float a, float b, float c, float d) {
    a = __builtin_amdgcn_fmed3f(a, -448.f, 448.f); b = __builtin_amdgcn_fmed3f(b, -448.f, 448.f); c = __builtin_amdgcn_fmed3f(c, -448.f, 448.f); d = __builtin_amdgcn_fmed3f(d, -448.f, 448.f);
    int w = __builtin_amdgcn_cvt_pk_fp8_f32(a, b, 0, false); w = __builtin_amdgcn_cvt_pk_fp8_f32(c, d, w, true); return (unsigned)w; }
__device__ __forceinline__ float fast_exp(float x) { return __builtin_amdgcn_exp2f(x * 1.4426950408889634f); }
__device__ __forceinline__ float fast_rcp(float x) { return __builtin_amdgcn_rcpf(x); }
__device__ __forceinline__ float silu_f(float x) { return x * fast_rcp(1.0f + fast_exp(-x)); }
__device__ __forceinline__ float sigmoid_f(float x) { return fast_rcp(1.0f + fast_exp(-x)); }

namespace pg8 {
constexpr int BM = 256, BK = 64, HALF = 128, HTB = HALF * BK * 2, STAGE_BYTES = 8 * HTB, NXCD = 8, WGM = 8;
__host__ __device__ __forceinline__ int lds_byte(int r, int c) { const int st = (r >> 4) * 2 + (c >> 5), rr = r & 15, cc = c & 31, ob = rr * 64 + cc * 2; return st * 1024 + (ob ^ (((ob >> 9) & 1) << 5)); }
__host__ __device__ __forceinline__ void stage_rc(int b, int& R, int& C) { const int st = b / 1024, sb = b % 1024, swz = sb ^ (((sb >> 9) & 1) << 5); R = (st >> 1) * 16 + swz / 64; C = (st & 1) * 32 + (swz % 64) / 2; }
__host__ __device__ __forceinline__ int perm32(int rho) { const int n = rho >> 4, i = rho & 15; return 8 * (i >> 2) + 4 * n + (i & 3); }

struct Unit { int pm, pn, e, nv; };
struct Gemm { const bf16_t* A; const bf16_t* Bt; int lda, ldb, K; };

struct DenseOrder {
    int nM, nN, nwg, G, c;
    __device__ __forceinline__ void init(int M, int N, int G_, int c_) { nM = M / BM; nN = N / BM; nwg = nM * nN; G = G_; c = c_; }
    __device__ __forceinline__ bool next(int i, Unit& u) const {
        const long L = (long)i * G + c; if (L >= nwg) return false;
        int wgid = (int)L; { const int q = nwg / NXCD, r = nwg % NXCD, xcd = wgid % NXCD, off = wgid / NXCD; wgid = (xcd < r ? xcd * (q + 1) : r * (q + 1) + (xcd - r) * q) + off; }
        const int nig = WGM * nN, gid = wgid / nig, fm = gid * WGM, gsz = (nM - fm) < WGM ? (nM - fm) : WGM;
        u.pm = fm + ((wgid % nig) % gsz); u.pn = (wgid % nig) / gsz; u.e = 0; u.nv = 256; return true;
    }
    __device__ __forceinline__ const char* a_tile(const Unit& u, const Gemm& g) const { return (const char*)g.A + (size_t)u.pm * BM * g.lda * 2; }
    __device__ __forceinline__ const char* b_tile(const Unit& u, const Gemm& g) const { return (const char*)g.Bt + (size_t)u.pn * BM * g.ldb * 2; }
};
struct PoolOrder : DenseOrder {
    __device__ __forceinline__ const char* a_tile(const Unit& u, const Gemm& g) const { return (const char*)g.A + ((size_t)u.pm * BM * g.lda + (size_t)u.pn * 256) * 2; }
    __device__ __forceinline__ const char* b_tile(const Unit& u, const Gemm& g) const { return (const char*)g.Bt + (size_t)u.pn * 256 * 256 * 2; }
};
struct MoeOrder {
    const LAS int* tab; int ntiles, nN, Nexp, G, c;
    __device__ __forceinline__ void build_table(const int* meta, LAS int* tabw, int Nexp_, int G_, int c_) {
        const int tid = threadIdx.x;
        if (tid < MOE_MAXT) {
            int e = 0;
#pragma unroll
            for (int k = 1; k < 8; ++k) e += (tid >= meta[8 + k]) ? 1 : 0;
            const int rem = meta[e] - (tid - meta[8 + e]) * 256;
            tabw[2 * tid] = e; tabw[2 * tid + 1] = rem < 256 ? rem : 256;
        }
        ntiles = __builtin_amdgcn_readfirstlane(meta[16]);
        __syncthreads();
        tab = tabw; Nexp = Nexp_; nN = Nexp_ / BM; G = G_; c = c_;
    }
    __device__ __forceinline__ bool next(int i, Unit& u) const {
        const long L = (long)i * G + c; if (L >= (long)ntiles * nN) return false;
        const int rt = (int)(L / nN); u.pn = (int)(L % nN); u.pm = rt;
        u.e = __builtin_amdgcn_readfirstlane(tab[2 * rt]); u.nv = __builtin_amdgcn_readfirstlane(tab[2 * rt + 1]); return true;
    }
    __device__ __forceinline__ const char* a_tile(const Unit& u, const Gemm& g) const { return (const char*)g.A + (size_t)u.pm * BM * g.lda * 2; }
    __device__ __forceinline__ const char* b_tile(const Unit& u, const Gemm& g) const { return (const char*)g.Bt + ((size_t)u.e * Nexp + (size_t)u.pn * BM) * g.ldb * 2; }
};

struct EpiF32 {
    static constexpr bool PERM = false;
    float* C; int ldc;
    __device__ __forceinline__ void operator()(const f32x4 (&acc)[2][2][4][2], const Unit& u, int wr, int wc, int fr, int fq) const {
        const int row0 = u.pm * BM + wr * 64 + fr, col0 = u.pn * BM + wc * 32 + 4 * fq;
#pragma unroll
        for (int ai = 0; ai < 2; ++ai)
#pragma unroll
            for (int m = 0; m < 4; ++m) { float* rowp = C + (size_t)(row0 + ai * HALF + m * 16) * ldc + col0;
#pragma unroll
                for (int bj = 0; bj < 2; ++bj)
#pragma unroll
                    for (int n = 0; n < 2; ++n) *(f32x4*)(rowp + bj * HALF + n * 16) = acc[ai][bj][m][n]; }
    }
};
struct EpiF32Scatter {
    static constexpr bool PERM = false;
    float* C; const int* rowtok;
    __device__ __forceinline__ void operator()(const f32x4 (&acc)[2][2][4][2], const Unit& u, int wr, int wc, int fr, int fq) const {
        const int col0 = u.pn * BM + wc * 32 + 4 * fq;
#pragma unroll
        for (int ai = 0; ai < 2; ++ai)
#pragma unroll
            for (int m = 0; m < 4; ++m) { const int rl = ai * HALF + wr * 64 + m * 16 + fr;
                if (rl < u.nv) { const int dst = rowtok[u.pm * BM + rl]; float* rowp = C + (size_t)dst * D + col0;
#pragma unroll
                    for (int bj = 0; bj < 2; ++bj)
#pragma unroll
                        for (int n = 0; n < 2; ++n) *(f32x4*)(rowp + bj * HALF + n * 16) = acc[ai][bj][m][n]; } }
    }
};
struct EpiBf16 {
    static constexpr bool PERM = true;
    bf16_t* O; int ldc;
    __device__ __forceinline__ void operator()(const f32x4 (&acc)[2][2][4][2], const Unit& u, int wr, int wc, int fr, int fq) const {
        const int row0 = u.pm * BM + wr * 64 + fr, col0 = u.pn * BM + wc * 32 + 8 * fq;
#pragma unroll
        for (int ai = 0; ai < 2; ++ai)
#pragma unroll
            for (int m = 0; m < 4; ++m) { bf16_t* rowp = O + (size_t)(row0 + ai * HALF + m * 16) * ldc + col0;
#pragma unroll
                for (int bj = 0; bj < 2; ++bj) { const f32x4 v0 = acc[ai][bj][m][0], v1 = acc[ai][bj][m][1];
                    u32x4 w; w.x = cvt_pk_bf16(v0[0], v0[1]); w.y = cvt_pk_bf16(v0[2], v0[3]); w.z = cvt_pk_bf16(v1[0], v1[1]); w.w = cvt_pk_bf16(v1[2], v1[3]);
                    *(u32x4*)(rowp + bj * HALF) = w; } }
    }
};
struct EpiSwiGLU {
    static constexpr bool PERM = true;
    bf16_t* O; int ldc;
    __device__ __forceinline__ void operator()(const f32x4 (&acc)[2][2][4][2], const Unit& u, int wr, int wc, int fr, int fq) const {
        const int row0 = u.pm * BM + wr * 64 + fr, col0 = u.pn * HALF + wc * 32 + 8 * fq;
#pragma unroll
        for (int ai = 0; ai < 2; ++ai)
#pragma unroll
            for (int m = 0; m < 4; ++m) { bf16_t* rowp = O + (size_t)(row0 + ai * HALF + m * 16) * ldc + col0;
                float h[8];
#pragma unroll
                for (int n = 0; n < 2; ++n)
#pragma unroll
                    for (int i = 0; i < 4; ++i) h[n * 4 + i] = silu_f(acc[ai][0][m][n][i]) * acc[ai][1][m][n][i];
                u32x4 w; w.x = cvt_pk_bf16(h[0], h[1]); w.y = cvt_pk_bf16(h[2], h[3]); w.z = cvt_pk_bf16(h[4], h[5]); w.w = cvt_pk_bf16(h[6], h[7]);
                *(u32x4*)rowp = w; }
    }
};

struct EpiSwiGLU8 {
    static constexpr bool PERM = true;
    unsigned char* O; int ldc; float oscale;
    __device__ __forceinline__ void operator()(const f32x4 (&acc)[2][2][4][2], const Unit& u, int wr, int wc, int fr, int fq) const {
        const int row0 = u.pm * BM + wr * 64 + fr, col0 = u.pn * HALF + wc * 32 + 8 * fq;
#pragma unroll
        for (int ai = 0; ai < 2; ++ai)
#pragma unroll
            for (int m = 0; m < 4; ++m) { unsigned char* rowp = O + (size_t)(row0 + ai * HALF + m * 16) * ldc + col0;
                float h[8];
#pragma unroll
                for (int n = 0; n < 2; ++n)
#pragma unroll
                    for (int i = 0; i < 4; ++i) h[n * 4 + i] = silu_f(acc[ai][0][m][n][i]) * acc[ai][1][m][n][i] * oscale;
                u32x2 w; w.x = pack4_fp8(h[0], h[1], h[2], h[3]); w.y = pack4_fp8(h[4], h[5], h[6], h[7]);
                *(u32x2*)rowp = w; }
    }
};

typedef int v8i32 __attribute__((ext_vector_type(8)));
template <class Epi, class Sched, bool ALIGN_EPI = true, bool FP8 = false>
__device__ __forceinline__ void gemm_phase(LAS unsigned char* lds, const Gemm g, const Sched& S, const Epi& E, int sclA = 127, int sclB = 127) {
    const int tid = threadIdx.x, wid = __builtin_amdgcn_readfirstlane(tid >> 6), lane = tid & 63, wr = wid >> 2, wc = wid & 3, fr = lane & 15, fq = lane >> 4;
    const int sclA4 = sclA * 0x01010101, sclB4 = sclB * 0x01010101; (void)sclA4; (void)sclB4;
    int K = g.K; asm volatile("" : "+s"(K));
    const int nt = K / BK;
    unsigned voffA[2], voffB[2];
#pragma unroll
    for (int i = 0; i < 2; ++i) { int R, C; stage_rc(tid * 16 + i * 8192, R, C); const int Rb = Epi::PERM ? ((R & ~31) + perm32(R & 31)) : R;
        voffA[i] = (unsigned)(R * g.lda + C) * 2u; voffB[i] = (unsigned)(Rb * g.ldb + C) * 2u; }
    const size_t kstep = (size_t)(BK * 2);
    const size_t hstepA = (size_t)HALF * g.lda * 2, hstepB = (size_t)HALF * g.ldb * 2;
    const unsigned ldsw = (unsigned)wid * 1024u;
    const int aoff = lds_byte(wr * 64 + fr, fq * 8), boff = lds_byte(wc * 32 + fr, fq * 8);
#define PG8_SA(b, h) (((b) * 2 + (h)) * HTB)
#define PG8_SB(b, h) ((4 + (b) * 2 + (h)) * HTB)
#define PG8_STAGE(bufoff, gbase, voff) do { _Pragma("unroll") for (int _i = 0; _i < 2; ++_i) \
        __builtin_amdgcn_global_load_lds((const unsigned*)((const char*)(gbase) + (voff)[_i]), (LAS unsigned*)(lds + (bufoff) + ldsw + _i * 8192), 16, 0, 0); } while (0)
#define PG8_LDA(dst, b, h) do { _Pragma("unroll") for (int m = 0; m < 4; ++m) _Pragma("unroll") for (int k = 0; k < 2; ++k) dst[m][k] = *(const LAS bf16x8*)(lds + PG8_SA(b, h) + aoff + m * 2048 + k * 1024); } while (0)
#define PG8_LDB(dst, b, h) do { _Pragma("unroll") for (int n = 0; n < 2; ++n) _Pragma("unroll") for (int k = 0; k < 2; ++k) dst[n][k] = *(const LAS bf16x8*)(lds + PG8_SB(b, h) + boff + n * 2048 + k * 1024); } while (0)
#define PG8_CAT(x0, x1) __builtin_shufflevector(__builtin_bit_cast(u32x4, x0), __builtin_bit_cast(u32x4, x1), 0, 1, 2, 3, 4, 5, 6, 7)
#define PG8_MMA(ai, bj, At, Bt) do { __builtin_amdgcn_s_setprio(1); \
        if constexpr (FP8) { _Pragma("unroll") for (int m = 0; m < 4; ++m) _Pragma("unroll") for (int n = 0; n < 2; ++n) \
            asm volatile("v_mfma_scale_f32_16x16x128_f8f6f4 %0, %1, %2, %0, %3, %4 op_sel_hi:[0,0,0]" : "+v"(acc[ai][bj][m][n]) \
                : "v"(__builtin_bit_cast(v8i32, PG8_CAT(Bt[n][0], Bt[n][1]))), "v"(__builtin_bit_cast(v8i32, PG8_CAT(At[m][0], At[m][1]))), "v"(sclB4), "v"(sclA4)); } \
        else { _Pragma("unroll") for (int m = 0; m < 4; ++m) _Pragma("unroll") for (int n = 0; n < 2; ++n) _Pragma("unroll") for (int k = 0; k < 2; ++k) \
            acc[ai][bj][m][n] = __builtin_amdgcn_mfma_f32_16x16x32_bf16(Bt[n][k], At[m][k], acc[ai][bj][m][n], 0, 0, 0); } \
        __builtin_amdgcn_s_setprio(0); } while (0)
#define PG8_WAIT_V(n) asm volatile("s_waitcnt vmcnt(" #n ")" ::: "memory")
#define PG8_WAIT_L(n) asm volatile("s_waitcnt lgkmcnt(" #n ")" ::: "memory")
#define PG8_BAR __builtin_amdgcn_s_barrier()
#define PG8_SCHED __builtin_amdgcn_sched_barrier(0)
    Unit cur, nxt; int ui = 0;
    if (!S.next(0, cur)) return;
    f32x4 acc[2][2][4][2];
#pragma unroll
    for (int a = 0; a < 2; ++a)
#pragma unroll
        for (int b = 0; b < 2; ++b)
#pragma unroll
            for (int m = 0; m < 4; ++m)
#pragma unroll
                for (int n = 0; n < 2; ++n) acc[a][b][m][n] = (f32x4){0.f, 0.f, 0.f, 0.f};
    bf16x8 At[4][2], B0[2][2], B1[2][2];
    const char* cA = S.a_tile(cur, g); const char* cB = S.b_tile(cur, g);
    PG8_STAGE(PG8_SB(0, 0), cB, voffB); PG8_STAGE(PG8_SB(0, 1), cB + hstepB, voffB); PG8_STAGE(PG8_SA(0, 0), cA, voffA); PG8_STAGE(PG8_SA(0, 1), cA + hstepA, voffA);
    if (wr == 1) PG8_BAR;
    PG8_WAIT_V(2); PG8_BAR;
    PG8_STAGE(PG8_SB(1, 0), cB + kstep, voffB); PG8_STAGE(PG8_SA(1, 0), cA + kstep, voffA); PG8_STAGE(PG8_SB(1, 1), cB + hstepB + kstep, voffB);
    PG8_WAIT_V(6); PG8_BAR;
    for (;;) {
        const bool has_next = S.next(ui + 1, nxt);
        const char* nA = has_next ? S.a_tile(nxt, g) : cA; const char* nB = has_next ? S.b_tile(nxt, g) : cB;
        for (int t = 0; t < nt; t += 2) {
            const bool last = (t == nt - 2);
            const char* a1 = cA + (size_t)(t + 1) * kstep;
            const char* a2 = last ? nA : cA + (size_t)(t + 2) * kstep; const char* b2 = last ? nB : cB + (size_t)(t + 2) * kstep;
            const char* a3 = a2 + kstep; const char* b3 = b2 + kstep;
            PG8_LDB(B0, 0, 0); PG8_LDB(B1, 0, 1); PG8_SCHED; PG8_LDA(At, 0, 0); PG8_STAGE(PG8_SA(1, 1), a1 + hstepA, voffA);
            PG8_WAIT_V(8); PG8_WAIT_L(0); PG8_BAR; PG8_MMA(0, 0, At, B0); PG8_MMA(0, 1, At, B1); PG8_BAR; PG8_SCHED;
            PG8_LDA(At, 0, 1); PG8_STAGE(PG8_SB(0, 0), b2, voffB); PG8_STAGE(PG8_SB(0, 1), b2 + hstepB, voffB); PG8_STAGE(PG8_SA(0, 0), a2, voffA);
            PG8_WAIT_V(8); PG8_WAIT_L(0); PG8_BAR; PG8_MMA(1, 0, At, B0); PG8_MMA(1, 1, At, B1); PG8_BAR; PG8_SCHED;
            PG8_LDB(B0, 1, 0); PG8_LDB(B1, 1, 1); PG8_SCHED; PG8_LDA(At, 1, 0); PG8_STAGE(PG8_SA(0, 1), a2 + hstepA, voffA);
            PG8_WAIT_V(8); PG8_WAIT_L(0); PG8_BAR; PG8_MMA(0, 0, At, B0); PG8_MMA(0, 1, At, B1); PG8_BAR; PG8_SCHED;
            PG8_LDA(At, 1, 1); PG8_STAGE(PG8_SB(1, 0), b3, voffB); PG8_STAGE(PG8_SB(1, 1), b3 + hstepB, voffB); PG8_STAGE(PG8_SA(1, 0), a3, voffA);
            PG8_WAIT_V(8); PG8_WAIT_L(0); PG8_BAR; PG8_MMA(1, 0, At, B0); PG8_MMA(1, 1, At, B1); PG8_BAR; PG8_SCHED;
        }
        if constexpr (ALIGN_EPI) { if (wr == 0) PG8_BAR; }
        if constexpr (FP8) asm volatile("s_nop 15\n\ts_nop 15" ::: "memory");
        { int ln_ = lane; asm volatile("" : "+v"(ln_));
          E(acc, cur, wr, wc, ln_ & 15, ln_ >> 4); }
        if (!has_next) break;
#pragma unroll
        for (int a = 0; a < 2; ++a)
#pragma unroll
            for (int b = 0; b < 2; ++b)
#pragma unroll
                for (int m = 0; m < 4; ++m)
#pragma unroll
                    for (int n = 0; n < 2; ++n) acc[a][b][m][n] = (f32x4){0.f, 0.f, 0.f, 0.f};
        cur = nxt; cA = nA; cB = nB; ++ui;
        if constexpr (ALIGN_EPI) { if (wr == 1) PG8_BAR; }
    }
    PG8_WAIT_V(0);
    if constexpr (!ALIGN_EPI) { if (wr == 0) PG8_BAR; }
    PG8_BAR;
#undef PG8_SA
#undef PG8_SB
#undef PG8_STAGE
#undef PG8_LDA
#undef PG8_LDB
#undef PG8_MMA
#undef PG8_CAT
#undef PG8_WAIT_V
#undef PG8_WAIT_L
#undef PG8_BAR
#undef PG8_SCHED
}
}

#ifndef ATT_SDEPTH
#define ATT_SDEPTH 1
#endif
namespace att {
constexpr int NW = 8, QBLK = 32, KVBLK = 64;
constexpr float SCALE = 0.07216878364870322f;
constexpr float THR = 8.f;
constexpr int LDQ = MLA_QW, LDK = MLA_KVW, LDKR = MLA_ROPE, LDO = D;
constexpr int SHM_V = KVBLK * 128 * 2, SHM_K = KVBLK * 128 * 2, SHM_KR = KVBLK * 64 * 2;
constexpr int OFF_V = 0, OFF_K = 2 * SHM_V, OFF_KR = OFF_K + 2 * SHM_K, OFF_WS = OFF_KR + 2 * SHM_KR, OFF_QR = OFF_WS + NW * 64 * 4, SHM_ATTN = OFF_QR + NW * 4096;
#define KSWZ(row, colB) ((row) * 256 + ((colB) ^ (((row) & 7) << 4)))
#define KRSWZ(row, colB) ((row) * 128 + ((colB) ^ ((((row) >> 1) & 7) << 4)))
#define SBAR() __builtin_amdgcn_sched_barrier(0)
__device__ __forceinline__ int crow(int r, int hi) { return (r & 3) + 8 * (r >> 2) + 4 * hi; }

__device__ __forceinline__ void partialSM(f32x16& p0, f32x16& p1, float& m_reg, float& mn, float& alpha) {
  constexpr float C = SCALE * 1.4426950408889634f;
  float pmax = p0[0];
#pragma unroll
  for (int r = 1; r < 16; ++r) pmax = fmaxf(pmax, p0[r]);
#pragma unroll
  for (int r = 0; r < 16; ++r) pmax = fmaxf(pmax, p1[r]);
  { auto rr = __builtin_amdgcn_permlane32_swap(__float_as_uint(pmax), __float_as_uint(pmax), false, false);
    pmax = fmaxf(__uint_as_float(rr[0]), __uint_as_float(rr[1])); }
  if (__builtin_expect(__all(pmax - m_reg <= THR / SCALE), 1)) { mn = m_reg; alpha = 1.f; }
  else { mn = fmaxf(m_reg, pmax); alpha = __builtin_amdgcn_exp2f((m_reg - mn) * C); m_reg = mn; }
  float mnC = -mn * C;
#pragma unroll
  for (int r = 0; r < 16; ++r) p0[r] = fmaf(p0[r], C, mnC);
#pragma unroll
  for (int r = 0; r < 16; ++r) p1[r] = fmaf(p1[r], C, mnC);
#pragma unroll
  for (int r = 0; r < 16; ++r) p0[r] = __builtin_amdgcn_exp2f(p0[r]);
}
__device__ __forceinline__ void finishSM(f32x16& p0, f32x16& p1, float alpha, float& l_reg, bf16x8& pa0, bf16x8& pa1, bf16x8& pa2, bf16x8& pa3) {
#pragma unroll
  for (int r = 0; r < 16; ++r) p1[r] = __builtin_amdgcn_exp2f(p1[r]);
  float ps = 0;
#pragma unroll
  for (int r = 0; r < 16; ++r) ps += p0[r];
#pragma unroll
  for (int r = 0; r < 16; ++r) ps += p1[r];
  { auto rr = __builtin_amdgcn_permlane32_swap(__float_as_uint(ps), __float_as_uint(ps), false, false);
    ps = __uint_as_float(rr[0]) + __uint_as_float(rr[1]); }
  l_reg = l_reg * alpha + ps;
#define PK4(P, BASE, OUT) do { unsigned a0 = cvt_pk_bf16(P[BASE + 0], P[BASE + 1]), a1 = cvt_pk_bf16(P[BASE + 2], P[BASE + 3]);   \
    unsigned b0 = cvt_pk_bf16(P[BASE + 4], P[BASE + 5]), b1 = cvt_pk_bf16(P[BASE + 6], P[BASE + 7]);                              \
    auto r0 = __builtin_amdgcn_permlane32_swap(a0, b0, false, false); auto r1 = __builtin_amdgcn_permlane32_swap(a1, b1, false, false); \
    u32x4 w = {r0[0], r1[0], r0[1], r1[1]}; OUT = __builtin_bit_cast(bf16x8, w); } while (0)
  PK4(p0, 0, pa0); PK4(p0, 8, pa1); PK4(p1, 0, pa2); PK4(p1, 8, pa3);
}
__device__ __forceinline__ void qkt(f32x16& p0, f32x16& p1, const char* Ks, const char* Krs, const bf16x8* qr, const char* qrl, int r32, int hi) {
  p0 = f32x16{}; p1 = f32x16{};
#pragma unroll
  for (int d0 = 0; d0 < 8; ++d0) { const int cb = (d0 * 16 + hi * 8) * 2;
    bf16x8 b0 = *reinterpret_cast<const bf16x8*>(Ks + KSWZ(r32, cb));
    bf16x8 b1 = *reinterpret_cast<const bf16x8*>(Ks + KSWZ(32 + r32, cb));
    p0 = __builtin_amdgcn_mfma_f32_32x32x16_bf16(b0, qr[d0], p0, 0, 0, 0);
    p1 = __builtin_amdgcn_mfma_f32_32x32x16_bf16(b1, qr[d0], p1, 0, 0, 0); }
#pragma unroll
  for (int d0 = 0; d0 < 4; ++d0) { const int cb = (d0 * 16 + hi * 8) * 2;
    bf16x8 b0 = *reinterpret_cast<const bf16x8*>(Krs + KRSWZ(r32, cb));
    bf16x8 b1 = *reinterpret_cast<const bf16x8*>(Krs + KRSWZ(32 + r32, cb));
    const bf16x8 qq = *reinterpret_cast<const bf16x8*>(qrl + d0 * 1024);
    p0 = __builtin_amdgcn_mfma_f32_32x32x16_bf16(b0, qq, p0, 0, 0, 0);
    p1 = __builtin_amdgcn_mfma_f32_32x32x16_bf16(b1, qq, p1, 0, 0, 0); }
}
__device__ __forceinline__ int v_st(int k, int c) { const int kk = (k & ~0xC) | ((k & 4) << 1) | ((k & 8) >> 1); return ((kk >> 3) * 4 + (c >> 5)) * 512 + ((kk & 7) * 32 + (c & 31)) * 2; }
__device__ __forceinline__ int v_rd_base(int lane) { return ((lane & 3) << 3) | (((lane >> 2) & 3) << 6) | (((lane >> 4) & 1) << 5) | (((lane >> 5) & 1) << 8); }
constexpr int v_rd_off(int d0, int ks, int half) { return d0 * 512 + ks * 4096 + half * 2048; }
template <int OFF> __device__ __forceinline__ s16x4 tr_read(int vb) {
  s16x4 r; asm volatile("ds_read_b64_tr_b16 %0, %1 offset:%2" : "=&v"(r) : "v"(vb), "i"(OFF) : "memory"); return r;
}
#define PKV(L, H) (bf16x8){L[0], L[1], L[2], L[3], H[0], H[1], H[2], H[3]}
template <int D0> __device__ __forceinline__ void pv_one(f32x16& od, int vb, bf16x8 pa0, bf16x8 pa1, bf16x8 pa2, bf16x8 pa3) {
  const s16x4 l0 = tr_read<v_rd_off(D0, 0, 0)>(vb), h0 = tr_read<v_rd_off(D0, 0, 1)>(vb), l1 = tr_read<v_rd_off(D0, 1, 0)>(vb), h1 = tr_read<v_rd_off(D0, 1, 1)>(vb);
  const s16x4 l2 = tr_read<v_rd_off(D0, 2, 0)>(vb), h2 = tr_read<v_rd_off(D0, 2, 1)>(vb), l3 = tr_read<v_rd_off(D0, 3, 0)>(vb), h3 = tr_read<v_rd_off(D0, 3, 1)>(vb);
  asm volatile("s_waitcnt lgkmcnt(0)" ::: "memory"); SBAR();
  od = __builtin_amdgcn_mfma_f32_32x32x16_bf16(pa0, PKV(l0, h0), od, 0, 0, 0);
  od = __builtin_amdgcn_mfma_f32_32x32x16_bf16(pa1, PKV(l1, h1), od, 0, 0, 0);
  od = __builtin_amdgcn_mfma_f32_32x32x16_bf16(pa2, PKV(l2, h2), od, 0, 0, 0);
  od = __builtin_amdgcn_mfma_f32_32x32x16_bf16(pa3, PKV(l3, h3), od, 0, 0, 0);
}
__device__ __forceinline__ void pv_d0(f32x16* o, int vb, bf16x8 pa0, bf16x8 pa1, bf16x8 pa2, bf16x8 pa3) {
  pv_one<0>(o[0], vb, pa0, pa1, pa2, pa3); pv_one<1>(o[1], vb, pa0, pa1, pa2, pa3); pv_one<2>(o[2], vb, pa0, pa1, pa2, pa3); pv_one<3>(o[3], vb, pa0, pa1, pa2, pa3);
}

__device__ __forceinline__ void attn_body(const bf16_t* __restrict__ Qb, const float* __restrict__ cs, const bf16_t* __restrict__ Kn, const bf16_t* __restrict__ Vh,
                                          const bf16_t* __restrict__ Kr, bf16_t* __restrict__ Ob, int seq, char* lds) {
  int tid = threadIdx.x; asm volatile("" : "+v"(tid));
  const int wid = tid >> 6, lane = tid & 63, r32 = lane & 31, hi = lane >> 5;
  char* V_lds = lds + OFF_V; char* K_lds = lds + OFF_K; char* KR_lds = lds + OFF_KR;
  float* ws = (float*)(lds + OFF_WS) + wid * 64; float* li_l = ws; float* al_l = ws + 32;
  float m_reg = -1e30f, l_reg = 0; f32x16 o[4] = {}; bf16x8 qr[8];
  char* qrl = lds + OFF_QR + wid * 4096 + lane * 16;
  { const int qrow = wid * QBLK + r32;
    const unsigned qoff = (unsigned)(qrow * LDQ + hi * 8) * 2u;
    const char* Qc = (const char*)Qb;
    bf16x8 qro[4];
#pragma unroll
    for (int d0 = 0; d0 < 8; ++d0) qr[d0] = *reinterpret_cast<const bf16x8*>(Qc + qoff + d0 * 32);
#pragma unroll
    for (int d0 = 0; d0 < 4; ++d0) qro[d0] = *reinterpret_cast<const bf16x8*>(Qc + qoff + 256 + d0 * 32);
    const char* csc = (const char*)cs; const unsigned csoff = (unsigned)qrow * 256u;
#pragma unroll
    for (int a = 0; a < 2; ++a) {
      const int i0 = a * 16 + hi * 8;
      bf16x8 x1 = qro[a], x2 = qro[2 + a], y1, y2;
#pragma unroll
      for (int j = 0; j < 8; ++j) {
        const f32x2 c_s = *reinterpret_cast<const f32x2*>(csc + csoff + 8 * (i0 + j));
        const float f1 = bf2f((unsigned short)x1[j]), f2 = bf2f((unsigned short)x2[j]);
        const float g1 = f1 * c_s.x - f2 * c_s.y, g2 = f2 * c_s.x + f1 * c_s.y;
        const unsigned pk = cvt_pk_bf16(g1, g2);
        y1[j] = (short)(pk & 0xffffu); y2[j] = (short)(pk >> 16);
      }
      *reinterpret_cast<bf16x8*>(qrl + a * 1024) = y1; *reinterpret_cast<bf16x8*>(qrl + (2 + a) * 1024) = y2;
    }
  }
  const int sr = tid >> 4, sc = (tid & 15) * 8, vst0 = v_st(sr, sc), vst1 = v_st(32 + sr, sc);
  const int krr = tid >> 3, krc = (tid & 7) * 8;
  const int vb0 = (int)(uintptr_t)V_lds + v_rd_base(lane);
  constexpr int SDEPTH = ATT_SDEPTH;
  struct { bf16x8 vs0, vs1, ks0, ks1, kr0; } sr_[SDEPTH];
  const unsigned vo0 = (unsigned)(sr * LDK + sc) * 2u, vo1 = (unsigned)((32 + sr) * LDK + sc) * 2u, kro = (unsigned)(krr * LDKR + krc) * 2u;
#define SLOAD(i, k0) do { const char* vt_ = (const char*)Vh + (size_t)(k0) * (LDK * 2); const char* kt_ = (const char*)Kn + (size_t)(k0) * (LDK * 2); const char* krt_ = (const char*)Kr + (size_t)(k0) * (LDKR * 2); \
    sr_[i].vs0 = *reinterpret_cast<const bf16x8*>(vt_ + vo0); sr_[i].vs1 = *reinterpret_cast<const bf16x8*>(vt_ + vo1); \
    sr_[i].ks0 = *reinterpret_cast<const bf16x8*>(kt_ + vo0); sr_[i].ks1 = *reinterpret_cast<const bf16x8*>(kt_ + vo1); \
    sr_[i].kr0 = *reinterpret_cast<const bf16x8*>(krt_ + kro); } while (0)
#define SWRITE(b, i) do { *(bf16x8*)(V_lds + (b) * SHM_V + vst0) = sr_[i].vs0;          \
    *(bf16x8*)(V_lds + (b) * SHM_V + vst1) = sr_[i].vs1; const int kc = sc * 2;               \
    *(bf16x8*)(K_lds + (b) * SHM_K + KSWZ(sr, kc)) = sr_[i].ks0;                       \
    *(bf16x8*)(K_lds + (b) * SHM_K + KSWZ(32 + sr, kc)) = sr_[i].ks1;                  \
    *(bf16x8*)(KR_lds + (b) * SHM_KR + KRSWZ(krr, krc * 2)) = sr_[i].kr0; } while (0)
#define SWAIT() do { if constexpr (SDEPTH == 2) asm volatile("s_waitcnt vmcnt(5)" ::: "memory"); else asm volatile("s_waitcnt vmcnt(0)" ::: "memory"); } while (0)
#define RESC(a) do { if (__any((a) < 1.f)) { if (hi == 0) al_l[r32] = (a); asm volatile("s_waitcnt lgkmcnt(0)" ::: "memory"); \
    _Pragma("unroll") for (int d = 0; d < 4; ++d) _Pragma("unroll") for (int r = 0; r < 16; ++r) o[d][r] *= al_l[crow(r, hi)]; } } while (0)
  f32x16 pA0, pA1, pB0, pB1; float mnA, mnB, alA, alB; bf16x8 pa0, pa1, pa2, pa3; const int NT = seq / KVBLK;
  constexpr int SE = 0, SO = SDEPTH - 1;
  SLOAD(SE, 0); asm volatile("s_waitcnt vmcnt(0)" ::: "memory"); SWRITE(0, SE); __syncthreads();
  qkt(pA0, pA1, K_lds, KR_lds, qr, qrl, r32, hi); partialSM(pA0, pA1, m_reg, mnA, alA);
  SLOAD(SO, KVBLK); if constexpr (SDEPTH == 2) { if (2 < NT) SLOAD(SE, 2 * KVBLK); }
  SWAIT(); SWRITE(1, SO); __syncthreads();
  for (int j = 1; j + 1 < NT; j += 2) {
    SBAR(); qkt(pB0, pB1, K_lds + SHM_K, KR_lds + SHM_KR, qr, qrl, r32, hi);
    finishSM(pA0, pA1, alA, l_reg, pa0, pa1, pa2, pa3); SBAR();
    SLOAD(SO, (j + SDEPTH) * KVBLK); SBAR();
    pv_d0(o, vb0, pa0, pa1, pa2, pa3); partialSM(pB0, pB1, m_reg, mnB, alB);
    __syncthreads(); SWAIT(); SWRITE(0, SE);
    RESC(alB); __syncthreads();
    SBAR(); qkt(pA0, pA1, K_lds, KR_lds, qr, qrl, r32, hi);
    finishSM(pB0, pB1, alB, l_reg, pa0, pa1, pa2, pa3); SBAR();
    if (SDEPTH == 1 || j + 3 < NT) SLOAD(SE, (j + 1 + SDEPTH) * KVBLK); SBAR();
    pv_d0(o, vb0 + SHM_V, pa0, pa1, pa2, pa3); partialSM(pA0, pA1, m_reg, mnA, alA);
    __syncthreads(); SWAIT(); SWRITE(1, SO);
    RESC(alA); __syncthreads();
  }
  SBAR(); qkt(pB0, pB1, K_lds + SHM_K, KR_lds + SHM_KR, qr, qrl, r32, hi);
  finishSM(pA0, pA1, alA, l_reg, pa0, pa1, pa2, pa3); SBAR();
  pv_d0(o, vb0, pa0, pa1, pa2, pa3); partialSM(pB0, pB1, m_reg, mnB, alB);
  __syncthreads(); RESC(alB);
  finishSM(pB0, pB1, alB, l_reg, pa0, pa1, pa2, pa3); SBAR();
  pv_d0(o, vb0 + SHM_V, pa0, pa1, pa2, pa3);
  if (hi == 0) li_l[r32] = l_reg; asm volatile("s_waitcnt lgkmcnt(0)" ::: "memory");
  float rli[16];
#pragma unroll
  for (int r = 0; r < 16; ++r) rli[r] = __builtin_amdgcn_rcpf(li_l[crow(r, hi)]);
  __syncthreads();
  int tid2 = threadIdx.x; asm volatile("" : "+v"(tid2));
  const int wid2 = tid2 >> 6, lane2 = tid2 & 63;
  char* ot = lds + wid2 * (32 * 272);
#pragma unroll
  for (int r = 0; r < 16; ++r) { const int orow = crow(r, lane2 >> 5);
#pragma unroll
    for (int d0 = 0; d0 < 4; ++d0) *(bf16_t*)(ot + orow * 272 + (d0 * 32 + (lane2 & 31)) * 2) = (bf16_t)(cvt_pk_bf16(o[d0][r] * rli[r], 0.f) & 0xffffu); }
  asm volatile("s_waitcnt lgkmcnt(0)" ::: "memory");
  char* Oc = (char*)Ob;
#pragma unroll
  for (int i = 0; i < 8; ++i) { const int id = lane2 + 64 * i, row = id >> 4, ch = id & 15;
    const u32x4 v = *(const u32x4*)(ot + row * 272 + ch * 16);
    *(u32x4*)(Oc + (unsigned)((wid2 * QBLK + row) * LDO + ch * 8) * 2u) = v; }
  __syncthreads();
#undef SLOAD
#undef SWRITE
#undef SWAIT
#undef RESC
}
}

namespace mls {
constexpr int OFF_Q = 0, OFF_K = 16384, OFF_VA = 32768, OFF_VB = 49152, OFF_C = 57344, OFF_N = 65536, OFF_VEC = 73728, LDS_NEED = 73728 + 1024;
__device__ __forceinline__ unsigned off_b(unsigned row, unsigned ch) { return 256u * row + 16u * (ch ^ (((row & 3) << 2) | ((row >> 2) & 3))); }
__device__ __forceinline__ unsigned off_vb(unsigned row, unsigned ch) { return 1024u * (row >> 3) + 512u * (ch >> 2) + 64u * (row & 7) + 16u * ((ch & 3) ^ ((row >> 2) & 3)); }
__device__ __forceinline__ s16x4 trr(unsigned addr) { s16x4 r; asm volatile("ds_read_b64_tr_b16 %0, %1" : "=&v"(r) : "v"(addr) : "memory"); return r; }

struct Tensors { const bf16_t* qkc; const bf16_t* proj; const float* gvec; float* hs; };

__device__ __forceinline__ void scan_unit(const Tensors& Tn, int unit, char* lds) {
  int tid = threadIdx.x; asm volatile("" : "+v"(tid));
  const int wid = __builtin_amdgcn_readfirstlane(tid >> 6), lane = tid & 63, r32 = lane & 31, hi = lane >> 5;
  const int chain = unit >> 3, vs = unit & 7, dir = chain >> 4, bb = (chain >> 2) & 3, hd = chain & 3;
  const unsigned lbase = (unsigned)(uintptr_t)lds;
  float* vec = (float*)(lds + OFF_VEC);
  unsigned qko[2];
#pragma unroll
  for (int i = 0; i < 2; ++i) { const int idx = tid + 512 * i, row = idx >> 4, ch = idx & 15; qko[i] = (unsigned)(((dir ? 63 - row : row) * 1024 + ch * 8) * 2); }
  const int vrow = (tid & 255) >> 2, vch = tid & 3;
  const unsigned vo = (unsigned)(((dir ? 63 - vrow : vrow) * ML_INP + vch * 8) * 2), awo = (unsigned)vrow * 4u;
  const char* gvb = (const char*)Tn.gvec + (size_t)chain * SEQ * 4;
  const unsigned veo = (unsigned)((tid >> 6) * 32 * SEQ + (tid & 63)) * 4u;
  const char* awsrc = gvb + (size_t)3 * 32 * SEQ * 4;
  bf16x8 sq[2], sk[2], sv; float sawl = 0.f, svec = 0.f;
#define TB(c) ((size_t)bb * SEQ + (dir ? (SEQ - 64 * ((c) + 1)) : 64 * (c)))
#define MLOAD(c) do { const size_t tb_ = TB(c); \
    const char* qb_ = (const char*)Tn.qkc + (tb_ * 1024 + hd * 128) * 2; const char* kb_ = qb_ + 1024; \
    const char* vb_ = (const char*)Tn.proj + (tb_ * ML_INP + 1024 + hd * 256 + vs * 32) * 2; \
    _Pragma("unroll") for (int i = 0; i < 2; ++i) { sq[i] = *reinterpret_cast<const bf16x8*>(qb_ + qko[i]); sk[i] = *reinterpret_cast<const bf16x8*>(kb_ + qko[i]); } \
    sv = *reinterpret_cast<const bf16x8*>(vb_ + vo); sawl = *reinterpret_cast<const float*>(awsrc + (size_t)(c) * 256 + awo); \
    if (tid < 192) svec = *reinterpret_cast<const float*>(gvb + (size_t)(c) * 256 + veo); } while (0)
#define MWRITE() do { \
    _Pragma("unroll") for (int i = 0; i < 2; ++i) { const int idx = tid + 512 * i, row = idx >> 4, ch = idx & 15; \
      *(bf16x8*)(lds + OFF_Q + off_b(row, ch)) = sq[i]; *(bf16x8*)(lds + OFF_K + off_b(row, ch)) = sk[i]; } \
    if (tid < 256) { *(bf16x8*)(lds + OFF_VA + att::v_st(vrow, vch * 8)) = sv; \
      float f[8]; _Pragma("unroll") for (int j = 0; j < 8; ++j) f[j] = bf2f((unsigned short)sv[j]) * sawl; \
      u32x4 w; w.x = cvt_pk_bf16(f[0], f[1]); w.y = cvt_pk_bf16(f[2], f[3]); w.z = cvt_pk_bf16(f[4], f[5]); w.w = cvt_pk_bf16(f[6], f[7]); \
      *(u32x4*)(lds + OFF_VB + off_vb(vrow, vch)) = w; } \
    else { const unsigned a = cvt_pk_bf16(sawl, sawl); u32x4 w = {a, a, a, a}; *(u32x4*)(lds + OFF_VB + off_vb(vrow, 4 + vch)) = w; } \
    if (tid < 192) vec[tid] = svec; } while (0)

  f32x16 Cst = {}, Nst = {};
  float m = 0.f;
  const int blk = wid - 2;
  MLOAD(0);
  asm volatile("s_waitcnt vmcnt(0)" ::: "memory");
  MWRITE();
  if (wid >= 2 && wid < 6) {
#pragma unroll
    for (int g = 0; g < 4; ++g) { const unsigned a = off_b(r32, 4 * blk + g) + 8 * hi; *(u32x2*)(lds + OFF_C + a) = (u32x2){0u, 0u}; *(u32x2*)(lds + OFF_N + a) = (u32x2){0u, 0u}; }
  }
  __syncthreads();
  const bf16x8 ones = {(short)0x3F80, (short)0x3F80, (short)0x3F80, (short)0x3F80, (short)0x3F80, (short)0x3F80, (short)0x3F80, (short)0x3F80};
  const int th = wid & 1;
  const unsigned hso = (unsigned)(((dir ? 63 - 32 * th - 4 * hi : 32 * th + 4 * hi) * D + hd * 256 + vs * 32 + r32) * 4);
  const int hstep = dir ? -(D * 4) : (D * 4);
  for (int c = 0; c < 64; ++c) {
    if (c + 1 < 64) MLOAD(c + 1);
    const float pm63 = vec[128 + 63], bL = vec[63];
    const float Mx = fmaxf(m, pm63);
    if (wid < 2) {
      int ln_ = lane; asm volatile("" : "+v"(ln_));
      const int r32 = ln_ & 31, hi = ln_ >> 5;
      f32x16 qc = {}, qn = {}, p0 = {}, p1 = {};
      {
        bf16x8 qf[8];
#pragma unroll
        for (int ks = 0; ks < 8; ++ks) qf[ks] = *(const bf16x8*)(lds + OFF_Q + off_b(32 * th + r32, 2 * ks + hi));
#pragma unroll
        for (int ks = 0; ks < 8; ++ks) {
          const bf16x8 cf = *(const bf16x8*)(lds + OFF_C + off_b(r32, 2 * ks + hi));
          const bf16x8 nf = *(const bf16x8*)(lds + OFF_N + off_b(r32, 2 * ks + hi));
          qc = __builtin_amdgcn_mfma_f32_32x32x16_bf16(qf[ks], cf, qc, 0, 0, 0);
          qn = __builtin_amdgcn_mfma_f32_32x32x16_bf16(qf[ks], nf, qn, 0, 0, 0);
        }
#pragma unroll
        for (int ks = 0; ks < 8; ++ks) {
          const bf16x8 k0 = *(const bf16x8*)(lds + OFF_K + off_b(r32, 2 * ks + hi));
          const bf16x8 k1 = *(const bf16x8*)(lds + OFF_K + off_b(32 + r32, 2 * ks + hi));
          p0 = __builtin_amdgcn_mfma_f32_32x32x16_bf16(k0, qf[ks], p0, 0, 0, 0);
          p1 = __builtin_amdgcn_mfma_f32_32x32x16_bf16(k1, qf[ks], p1, 0, 0, 0);
        }
      }
      const int t = 32 * th + r32;
      const float Mt = fmaxf(m, vec[128 + t]);
#pragma unroll
      for (int r = 0; r < 16; ++r) { const int s0 = att::crow(r, hi), s1 = 32 + s0;
        float w0 = fast_exp(vec[64 + s0] - Mt), w1 = fast_exp(vec[64 + s1] - Mt); w0 = (s0 <= t) ? w0 : 0.f; w1 = (s1 <= t) ? w1 : 0.f;
        p0[r] *= w0; p1[r] *= w1; }
      bf16x8 pa0, pa1, pa2, pa3;
      PK4(p0, 0, pa0); PK4(p0, 8, pa1); PK4(p1, 0, pa2); PK4(p1, 8, pa3);
      f32x16 pv = {}, pd = {};
      att::pv_one<0>(pv, (int)(lbase + OFF_VA) + att::v_rd_base(ln_), pa0, pa1, pa2, pa3);
      pd = __builtin_amdgcn_mfma_f32_32x32x16_bf16(pa0, ones, pd, 0, 0, 0);
      pd = __builtin_amdgcn_mfma_f32_32x32x16_bf16(pa1, ones, pd, 0, 0, 0);
      pd = __builtin_amdgcn_mfma_f32_32x32x16_bf16(pa2, ones, pd, 0, 0, 0);
      pd = __builtin_amdgcn_mfma_f32_32x32x16_bf16(pa3, ones, pd, 0, 0, 0);
      char* hsb = (char*)Tn.hs + ((size_t)dir * T + TB(c)) * (D * 4);
#pragma unroll
      for (int r = 0; r < 16; ++r) { const int rr = (r & 3) + 8 * (r >> 2), tr_ = 32 * th + 4 * hi + rr;
        const float Mr = fmaxf(m, vec[128 + tr_]), gw = fast_exp(m - Mr), en = fast_exp(-(vec[tr_] + Mr));
        const float num = gw * qc[r] + pv[r], den = gw * qn[r] + pd[r];
        const float h = num * fast_rcp(fmaxf(fabsf(den), en));
        *(float*)(hsb + (unsigned)((int)hso + rr * hstep)) = h; }
    } else if (wid < 6) {
      int ln_ = lane; asm volatile("" : "+v"(ln_));
      const int hi = ln_ >> 5;
      f32x16 kv = {}, kn = {};
#pragma unroll
      for (int ks = 0; ks < 4; ++ks) {
        const unsigned hb = (ln_ >> 4) & 1, q = (ln_ & 15) >> 2, p = ln_ & 3;
        const unsigned row0 = 16 * ks + 8 * hi + q;
        const s16x4 ka = trr(lbase + OFF_K + off_b(row0, 4 * blk + 2 * hb + (p >> 1)) + 8 * (p & 1));
        const s16x4 kb = trr(lbase + OFF_K + off_b(row0 + 4, 4 * blk + 2 * hb + (p >> 1)) + 8 * (p & 1));
        const s16x4 va = trr(lbase + OFF_VB + off_vb(row0, 2 * hb + (p >> 1)) + 8 * (p & 1));
        const s16x4 vb_ = trr(lbase + OFF_VB + off_vb(row0 + 4, 2 * hb + (p >> 1)) + 8 * (p & 1));
        const s16x4 aa = trr(lbase + OFF_VB + off_vb(row0, 4 + 2 * hb + (p >> 1)) + 8 * (p & 1));
        const s16x4 ab = trr(lbase + OFF_VB + off_vb(row0 + 4, 4 + 2 * hb + (p >> 1)) + 8 * (p & 1));
        asm volatile("s_waitcnt lgkmcnt(0)" ::: "memory"); __builtin_amdgcn_sched_barrier(0);
        const bf16x8 kf = PKV(ka, kb), vf = PKV(va, vb_), af = PKV(aa, ab);
        kv = __builtin_amdgcn_mfma_f32_32x32x16_bf16(kf, vf, kv, 0, 0, 0);
        kn = __builtin_amdgcn_mfma_f32_32x32x16_bf16(kf, af, kn, 0, 0, 0);
      }
      const float cw = fast_exp(m - Mx), sc = fast_exp(pm63 - Mx);
#pragma unroll
      for (int r = 0; r < 16; ++r) { Cst[r] = cw * Cst[r] + sc * kv[r]; Nst[r] = cw * Nst[r] + sc * kn[r]; }
    }
    m = bL + Mx;
    __syncthreads();
    if (c + 1 < 64) {
      if (wid < 2) asm volatile("s_waitcnt vmcnt(16)" ::: "memory");
      else asm volatile("s_waitcnt vmcnt(0)" ::: "memory");
      MWRITE();
      if (wid >= 2 && wid < 6) {
#pragma unroll
        for (int g = 0; g < 4; ++g) { const unsigned a = off_b(r32, 4 * blk + g) + 8 * hi;
          *(u32x2*)(lds + OFF_C + a) = (u32x2){cvt_pk_bf16(Cst[4 * g], Cst[4 * g + 1]), cvt_pk_bf16(Cst[4 * g + 2], Cst[4 * g + 3])};
          *(u32x2*)(lds + OFF_N + a) = (u32x2){cvt_pk_bf16(Nst[4 * g], Nst[4 * g + 1]), cvt_pk_bf16(Nst[4 * g + 2], Nst[4 * g + 3])}; }
      }
    }
    __syncthreads();
  }
#undef TB
#undef MLOAD
#undef MWRITE
}
}

#define XB_TMO      128
#define XB_XCNT(j)  (256  + 64 * (j))
#define XB_XSUB(j)  (1280 + 64 * (j))
#define XB_XGEN(j)  (2304 + 64 * (j))
#define XB_TOP      3328
#define XB_TOPGEN   3392
#define XCD_BAR_WORDS 3456
#define XB_SPIN_CAP (1u << 18)
__device__ __forceinline__ unsigned xb_ld(unsigned* p)              { return __hip_atomic_load(p, __ATOMIC_RELAXED, __HIP_MEMORY_SCOPE_AGENT); }
__device__ __forceinline__ unsigned xb_add(unsigned* p, unsigned v) { return __hip_atomic_fetch_add(p, v, __ATOMIC_RELAXED, __HIP_MEMORY_SCOPE_AGENT); }
__device__ __forceinline__ unsigned xb_xcc_id() { return (unsigned)__builtin_amdgcn_s_getreg((3 << 11) | 20) & 0xFu; }
#define XB_SPIN(cond, bar) do { unsigned _sp = 0; while (cond) { __builtin_amdgcn_s_sleep(1); \
    if ((++_sp & 255u) == 0u) { if (xb_ld(&(bar)[XB_TMO])) break; if (_sp > XB_SPIN_CAP) { atomicAdd(&(bar)[XB_TMO], 1u); break; } } } } while (0)
struct XcdBarrier { unsigned* bar; unsigned x; volatile LAS unsigned* st; };
__device__ __forceinline__ XcdBarrier xcd_barrier_post(unsigned* bar, volatile LAS unsigned* st) {
    XcdBarrier b; b.bar = bar; b.x = xb_xcc_id(); b.st = st;
    if (threadIdx.x == 0) (void)xb_add(&bar[XB_XCNT(b.x)], 1u);
    return b;
}
__device__ __forceinline__ void xcd_barrier_complete(unsigned* bar, unsigned x, unsigned& nloc, unsigned& nx) {
    const unsigned G = gridDim.x * gridDim.y * gridDim.z;
    unsigned sum, cnt, mine, sp = 0u;
    for (;;) {
        sum = 0u; cnt = 0u; mine = 0u;
#pragma unroll
        for (unsigned j = 0; j < 16; ++j) { const unsigned c = xb_ld(&bar[XB_XCNT(j)]); sum += c; cnt += (c > 0u) ? 1u : 0u; mine = (j == x) ? c : mine; }
        if (sum == G) break;
        __builtin_amdgcn_s_sleep(1);
        if ((++sp & 255u) == 0u) { if (xb_ld(&bar[XB_TMO])) break; if (sp > XB_SPIN_CAP) { atomicAdd(&bar[XB_TMO], 1u); break; } }
    }
    nloc = mine > 0u ? mine : 1u; nx = cnt > 0u ? cnt : 1u;
}
__device__ __forceinline__ void xcd_barrier(const XcdBarrier& b) {
    asm volatile("s_waitcnt vmcnt(0)" ::: "memory");
    __syncthreads();
    if (threadIdx.x == 0) {
        unsigned* bar = b.bar;
        __builtin_amdgcn_s_waitcnt(0);
        unsigned nloc = b.st[0], nx = b.st[1];
        if (nloc == 0u) { xcd_barrier_complete(bar, b.x, nloc, nx); b.st[0] = nloc; b.st[1] = nx; }
        const unsigned old = xb_add(&bar[XB_XSUB(b.x)], 1u);
        const unsigned gen = old / nloc;
        if (old + 1u == (gen + 1u) * nloc) {
            __builtin_amdgcn_fence(__ATOMIC_RELEASE, "agent");
            asm volatile("s_waitcnt vmcnt(0)" ::: "memory");
            const unsigned og = xb_add(&bar[XB_TOP], 1u);
            const unsigned tg = og / nx;
            if (og + 1u == (tg + 1u) * nx) xb_add(&bar[XB_TOPGEN], 1u);
            else XB_SPIN(xb_ld(&bar[XB_TOPGEN]) == tg, bar);
            __builtin_amdgcn_fence(__ATOMIC_ACQUIRE, "agent");
            xb_add(&bar[XB_XGEN(b.x)], 1u);
            asm volatile("s_waitcnt vmcnt(0)" ::: "memory");
        } else {
            XB_SPIN(xb_ld(&bar[XB_XGEN(b.x)]) == gen, bar);
            __builtin_amdgcn_fence(__ATOMIC_ACQUIRE, "agent");
            asm volatile("s_waitcnt vmcnt(0)" ::: "memory");
        }
    }
    __syncthreads();
}

struct Args { const float* in[24]; float* out; unsigned char* ws; int ph_lo, ph_hi; };
constexpr int NPH = 38;
struct Frame {
    char* lds; int tid, lane, wave, G, bid;
    unsigned char* ws;
};

struct CvtJob { const float* src; bf16_t* dst; int K, N, sld; int grp, gstride, goff; const float* sk; const float* sn; float oscale; };
template <bool FP8>
__device__ __forceinline__ void cvt_tiles(const Frame& F, const CvtJob& j, int& rot) {
    constexpr int RP = FP8 ? 16 : 8, KI = 8 * RP, ES = FP8 ? 1 : 2;
    const int tk = j.K / KI, tn = (j.N + 255) / 256, nt = tk * tn;
    int start = F.bid - (rot % F.G); if (start < 0) start += F.G;
    rot += nt;
    if (start >= nt) return;
    const int n4 = F.lane * 4, kq = F.wave;
    f32x4 v[RP], vn[RP];
#define CVT_LOAD(dst, it_) do { const int k0_ = ((it_) / tn) * KI + kq * RP, n0_ = ((it_) % tn) * 256 + n4; \
        if (n0_ < j.N) { _Pragma("unroll") for (int r = 0; r < RP; ++r) dst[r] = *(const f32x4*)(j.src + (size_t)(k0_ + r) * j.sld + n0_); } } while (0)
    CVT_LOAD(v, start);
    int buf = 0;
    for (int it = start; it < nt; it += F.G) {
        const bool has_next = it + F.G < nt;
        if (has_next) CVT_LOAD(vn, it + F.G);
        const int k0 = (it / tn) * KI, n0 = (it % tn) * 256;
        char* img = F.lds + buf * 32768;
        if (n0 + n4 < j.N) {
            if (j.sk) {
#pragma unroll
                for (int r = 0; r < RP; ++r) v[r] = v[r] * j.sk[k0 + kq * RP + r];
            }
            if (j.sn) { const f32x4 sn = *(const f32x4*)(j.sn + n0 + n4);
#pragma unroll
                for (int r = 0; r < RP; ++r) v[r] = v[r] * sn; }
#pragma unroll
            for (int c = 0; c < 4; ++c) {
                u32x4 w;
                if constexpr (FP8) { w.x = pack4_fp8(v[0][c] * j.oscale, v[1][c] * j.oscale, v[2][c] * j.oscale, v[3][c] * j.oscale); w.y = pack4_fp8(v[4][c] * j.oscale, v[5][c] * j.oscale, v[6][c] * j.oscale, v[7][c] * j.oscale);
                                     w.z = pack4_fp8(v[8 % RP][c] * j.oscale, v[9 % RP][c] * j.oscale, v[10 % RP][c] * j.oscale, v[11 % RP][c] * j.oscale); w.w = pack4_fp8(v[12 % RP][c] * j.oscale, v[13 % RP][c] * j.oscale, v[14 % RP][c] * j.oscale, v[15 % RP][c] * j.oscale); }
                else { w.x = cvt_pk_bf16(v[0][c], v[1][c]); w.y = cvt_pk_bf16(v[2][c], v[3][c]); w.z = cvt_pk_bf16(v[4][c], v[5][c]); w.w = cvt_pk_bf16(v[6][c], v[7][c]); }
                *(u32x4*)(img + (n4 + c) * 128 + ((kq ^ (F.lane & 7)) * 16)) = w;
            }
        }
        __syncthreads();
#pragma unroll
        for (int q = 0; q < 4; ++q) { const int id = F.tid + 512 * q, n = id >> 3, kc = id & 7;
            if (n0 + n < j.N) { const u32x4 w = *(const u32x4*)(img + n * 128 + ((kc ^ ((n >> 2) & 7)) * 16));
                const int nn = n0 + n, drow = (nn / j.grp) * j.gstride + j.goff + (nn % j.grp);
                *(u32x4*)((char*)j.dst + ((size_t)drow * j.K + k0) * ES + kc * 16) = w; } }
        buf ^= 1;
        if (has_next) {
#pragma unroll
            for (int r = 0; r < RP; ++r) v[r] = vn[r];
        }
    }
    __syncthreads();
#undef CVT_LOAD
}
__device__ __forceinline__ CvtJob mkjob(const float* src, bf16_t* dst, int K, int N, int sld) { CvtJob j; j.src = src; j.dst = dst; j.K = K; j.N = N; j.sld = sld; j.grp = N; j.gstride = 0; j.goff = 0; j.sk = nullptr; j.sn = nullptr; j.oscale = 1.f; return j; }

__device__ __forceinline__ void phase_convert_small(const Frame& F, const Args& a) {
    bf16_t* W = (bf16_t*)(F.ws + WS_W); int rot = 0;
    for (int j = 0; j < 2; ++j) {
        { CvtJob c = mkjob(a.in[2] + (size_t)j * D * MLA_IN, (bf16_t*)((char*)W + W_DQKV) + (size_t)j * MLA_INP * D, D, MLA_IN, MLA_IN); cvt_tiles<false>(F, c, rot); }
        { CvtJob c = mkjob(a.in[4] + (size_t)j * MLA_QR * MLA_QW, (bf16_t*)((char*)W + W_UQ) + (size_t)j * MLA_QW * MLA_QR, MLA_QR, MLA_QW, MLA_QW); c.sk = a.in[3] + j * MLA_QR; cvt_tiles<false>(F, c, rot); }
        { CvtJob c = mkjob(a.in[6] + (size_t)j * MLA_KVR * MLA_KVW, (bf16_t*)((char*)W + W_UKV) + (size_t)j * MLA_KVW * MLA_KVR, MLA_KVR, MLA_KVW, MLA_KVW); c.sk = a.in[5] + j * MLA_KVR; cvt_tiles<false>(F, c, rot); }
        { CvtJob c = mkjob(a.in[7] + (size_t)j * D * D, (bf16_t*)((char*)W + W_O) + (size_t)j * D * D, D, D, D); cvt_tiles<false>(F, c, rot); }
        { bf16_t* z = (bf16_t*)((char*)W + W_DQKV) + (size_t)j * MLA_INP * D + (size_t)MLA_IN * D;
          for (int i = F.bid * NTHR + F.tid; i < (MLA_INP - MLA_IN) * D / 8; i += F.G * NTHR) *(u32x4*)(z + (size_t)i * 8) = (u32x4){0u, 0u, 0u, 0u}; }
    }
    for (int g = 0; g < 4; ++g) { CvtJob c = mkjob(a.in[8] + (size_t)g * 256 * 256, (bf16_t*)((char*)W + W_POOL) + (size_t)g * 256 * 256, 256, 256, 256); c.sn = a.in[9] + g * 256; cvt_tiles<false>(F, c, rot); }
    { CvtJob c = mkjob(a.in[10], (bf16_t*)((char*)W + W_IN), D, ML_INP, ML_IN); cvt_tiles<false>(F, c, rot); }
    { CvtJob c = mkjob(a.in[14], (bf16_t*)((char*)W + W_OUT), D, D, D); cvt_tiles<false>(F, c, rot); }
    for (int j = 0; j < 2; ++j) {
        { CvtJob c = mkjob(a.in[15] + (size_t)j * D * DFF, (bf16_t*)((char*)W + W_GU) + (size_t)j * 2 * DFF * D, D, DFF, DFF); c.grp = 128; c.gstride = 256; c.goff = 0; cvt_tiles<false>(F, c, rot); }
        { CvtJob c = mkjob(a.in[16] + (size_t)j * D * DFF, (bf16_t*)((char*)W + W_GU) + (size_t)j * 2 * DFF * D, D, DFF, DFF); c.grp = 128; c.gstride = 256; c.goff = 128; cvt_tiles<false>(F, c, rot); }
        { CvtJob c = mkjob(a.in[17] + (size_t)j * DFF * D, (bf16_t*)((char*)W + W_DN) + (size_t)j * D * DFF, DFF, D, D); cvt_tiles<false>(F, c, rot); }
    }
    { const float* x = a.in[0]; bf16_t* xb = (bf16_t*)(F.ws + WS_XB);
      for (size_t i = (size_t)F.bid * NTHR + F.tid; i < (size_t)T * D / 8; i += (size_t)F.G * NTHR) {
          const f32x4 v0 = *(const f32x4*)(x + i * 8), v1 = *(const f32x4*)(x + i * 8 + 4);
          u32x4 w; w.x = cvt_pk_bf16(v0[0], v0[1]); w.y = cvt_pk_bf16(v0[2], v0[3]); w.z = cvt_pk_bf16(v1[0], v1[1]); w.w = cvt_pk_bf16(v1[2], v1[3]);
          *(u32x4*)(xb + i * 8) = w; } }
}
template <bool FP8>
__device__ __forceinline__ void phase_convert_moe(const Frame& F, const Args& a, int c) {
    constexpr int ES = FP8 ? 1 : 2;
    char* GU = (char*)(F.ws + WS_WMOE + WM_GU); char* DN = (char*)(F.ws + WS_WMOE + WM_DN); int rot = 0;
    for (int e = 0; e < NEXP; ++e) {
        const size_t eo = ((size_t)c * NEXP + e) * (size_t)D * DFFE;
        { CvtJob j = mkjob(a.in[19] + eo, (bf16_t*)(GU + (size_t)e * 2 * DFFE * D * ES), D, DFFE, DFFE); j.grp = 128; j.gstride = 256; j.goff = 0; j.oscale = 64.f; cvt_tiles<FP8>(F, j, rot); }
        { CvtJob j = mkjob(a.in[20] + eo, (bf16_t*)(GU + (size_t)e * 2 * DFFE * D * ES), D, DFFE, DFFE); j.grp = 128; j.gstride = 256; j.goff = 128; j.oscale = 64.f; cvt_tiles<FP8>(F, j, rot); }
        { CvtJob j = mkjob(a.in[21] + eo, (bf16_t*)(DN + (size_t)e * D * DFFE * ES), DFFE, D, D); j.oscale = 256.f; cvt_tiles<FP8>(F, j, rot); }
    }
}

template <int MODE>
__device__ __forceinline__ void phase_ln(const Frame& F, const float* xin, const float* y, float* xout, bf16_t* xb, const float* g, const float* b,
                                         const float* wproj  , const float* bgate) {
    constexpr bool MOE_IN = MODE & 1, ROUTER = (MODE & 2) != 0, GATES = (MODE & 4) != 0, FINAL = (MODE & 8) != 0;
    constexpr int NP = ROUTER ? 8 : (GATES ? 16 : 0); constexpr int NPA = NP ? NP : 4;
    float* wl = (float*)F.lds;
    int* sel = (int*)(F.lds + 65536);
    const int* toke = (const int*)(F.ws + WS_META + MT_TOKE); const float* tokw = (const float*)(F.ws + WS_META + MT_TOKW);
    if constexpr (NP != 0) {
        for (int i = F.tid; i < 1024 * NPA; i += NTHR) { const int c = i / NPA, p = i % NPA; wl[p * 1024 + c] = ROUTER ? wproj[c * 8 + p] : wproj[(size_t)c * ML_IN + ML_INP + p]; }
        __syncthreads();
    }
    f32x4 gg[4], bb[4];
#pragma unroll
    for (int j = 0; j < 4; ++j) { gg[j] = *(const f32x4*)(g + F.lane * 4 + 256 * j); bb[j] = *(const f32x4*)(b + F.lane * 4 + 256 * j); }
    for (int blk = F.bid; blk < T / 64; blk += F.G) {
        for (int rp = 0; rp < 8; rp += 2) {
            f32x4 v[2][4]; float w1[2] = {0.f, 0.f}, w2[2] = {0.f, 0.f};
#pragma unroll
            for (int u = 0; u < 2; ++u) { const int row = blk * 64 + F.wave * 8 + rp + u;
                if (MOE_IN) { w1[u] = tokw[row * 2]; w2[u] = tokw[row * 2 + 1]; } }
            f32x4 xv[2][4], ya[2][4], yb[2][4];
#pragma unroll
            for (int u = 0; u < 2; ++u) { const int row = blk * 64 + F.wave * 8 + rp + u;
#pragma unroll
                for (int j = 0; j < 4; ++j) { const int c = F.lane * 4 + 256 * j;
                    xv[u][j] = *(const f32x4*)(xin + (size_t)row * D + c);
                    if (MOE_IN) { ya[u][j] = *(const f32x4*)(y + (size_t)(2 * row) * D + c); yb[u][j] = *(const f32x4*)(y + (size_t)(2 * row + 1) * D + c); }
                    else ya[u][j] = *(const f32x4*)(y + (size_t)row * D + c); } }
#pragma unroll
            for (int u = 0; u < 2; ++u)
#pragma unroll
                for (int j = 0; j < 4; ++j) { f32x4 yv; if (MOE_IN) yv = ya[u][j] * w1[u] + yb[u][j] * w2[u]; else yv = ya[u][j]; v[u][j] = xv[u][j] * DN_ALPHA + yv; }
            float mu[2], rstd[2];
#pragma unroll
            for (int u = 0; u < 2; ++u) { float s_ = 0.f;
#pragma unroll
                for (int j = 0; j < 4; ++j) s_ += (v[u][j][0] + v[u][j][1]) + (v[u][j][2] + v[u][j][3]);
                mu[u] = s_; }
            mu[0] = wave_sum(mu[0]) * (1.0f / 1024.0f); mu[1] = wave_sum(mu[1]) * (1.0f / 1024.0f);
#pragma unroll
            for (int u = 0; u < 2; ++u) { float q = 0.f;
#pragma unroll
                for (int j = 0; j < 4; ++j) { const f32x4 d = v[u][j] - mu[u]; q += (d[0] * d[0] + d[1] * d[1]) + (d[2] * d[2] + d[3] * d[3]); }
                rstd[u] = q; }
            rstd[0] = 1.0f / sqrtf(wave_sum(rstd[0]) * (1.0f / 1024.0f) + LN_EPS); rstd[1] = 1.0f / sqrtf(wave_sum(rstd[1]) * (1.0f / 1024.0f) + LN_EPS);
#pragma unroll
            for (int u = 0; u < 2; ++u) { const int row = blk * 64 + F.wave * 8 + rp + u, rr = rp + u;
#pragma unroll
            for (int j = 0; j < 4; ++j) { const int c = F.lane * 4 + 256 * j;
                v[u][j] = (v[u][j] - mu[u]) * rstd[u] * gg[j] + bb[j];
                *(f32x4*)(xout + (size_t)row * D + c) = v[u][j];
                if (!FINAL) { u32x2 w; w.x = cvt_pk_bf16(v[u][j][0], v[u][j][1]); w.y = cvt_pk_bf16(v[u][j][2], v[u][j][3]); *(u32x2*)(xb + (size_t)row * D + c) = w; } }
            if constexpr (NP != 0) {
                float pr[NPA];
#pragma unroll
                for (int p = 0; p < NPA; ++p) pr[p] = 0.f;
#pragma unroll
                for (int j = 0; j < 4; ++j)
#pragma unroll
                    for (int p = 0; p < NPA; ++p) { const f32x4 wv = *(const f32x4*)(wl + p * 1024 + F.lane * 4 + 256 * j);
                        pr[p] += (v[u][j][0] * wv[0] + v[u][j][1] * wv[1]) + (v[u][j][2] * wv[2] + v[u][j][3] * wv[3]); }
                {
                    int np = NPA, msk = 32;
#pragma unroll
                    for (int st = 0; st < (NPA == 16 ? 4 : 3); ++st) { np >>= 1; const bool up = (F.lane & msk) != 0;
#pragma unroll
                        for (int k = 0; k < 8; ++k) if (k < np) { const float keep = up ? pr[k + np] : pr[k], send = up ? pr[k] : pr[k + np]; pr[k] = keep + __shfl_xor(send, msk); }
                        msk >>= 1; }
                    float tot = pr[0];
#pragma unroll
                    for (int o = (NPA == 16 ? 2 : 4); o >= 1; o >>= 1) tot += __shfl_xor(tot, o);
                    if (NPA == 16) { pr[0] = tot; } else { pr[0] = tot; }
                }
                if constexpr (ROUTER) {
                    { const float mine = pr[0];
#pragma unroll
                      for (int p = 0; p < 8; ++p) pr[p] = __shfl(mine, 8 * p); }
                    int e1 = 0; float v1 = pr[0];
#pragma unroll
                    for (int p = 1; p < 8; ++p) if (pr[p] > v1) { v1 = pr[p]; e1 = p; }
                    int e2 = -1; float v2 = -3.0e38f;
#pragma unroll
                    for (int p = 0; p < 8; ++p) if (p != e1 && pr[p] > v2) { v2 = pr[p]; e2 = p; }
                    const float ww2 = 1.0f / (1.0f + expf(v1 - v2)), ww1 = 1.0f - ww2;
                    if (F.lane == 0) { int* te = (int*)(F.ws + WS_META + MT_TOKE); float* tw = (float*)(F.ws + WS_META + MT_TOKW);
                        te[row * 2] = e1; te[row * 2 + 1] = e2; tw[row * 2] = ww1; tw[row * 2 + 1] = ww2;
                        sel[F.wave * 16 + rr * 2] = e1; sel[F.wave * 16 + rr * 2 + 1] = e2; }
                }
                if constexpr (GATES) { if ((F.lane & 3) == 0) { const int p = F.lane >> 2;
                        ((float*)(F.ws + WS_META + MT_GATES))[(size_t)row * 16 + p] = pr[0] + bgate[p]; } }
            }
            }
        }
        if constexpr (ROUTER) {
            __syncthreads();
            if (F.tid < 128) { const int e = sel[F.tid]; int rk = 0; for (int p = 0; p < F.tid; ++p) rk += (sel[p] == e) ? 1 : 0;
                const int row = blk * 64 + (F.tid >> 4) * 8 + ((F.tid & 15) >> 1);
                ((int*)(F.ws + WS_META + MT_RANK))[row * 2 + (F.tid & 1)] = rk; }
            if (F.tid >= 128 && F.tid < 136) { const int e = F.tid - 128; int cn = 0; for (int p = 0; p < 128; ++p) cn += (sel[p] == e) ? 1 : 0;
                ((int*)(F.ws + WS_META + MT_CNTW))[blk * 8 + e] = cn; }
            __syncthreads();
        }
    }
    (void)toke;
}

template <bool FP8>
__device__ __forceinline__ void phase_moe_permute(const Frame& F) {
    int* cl = (int*)F.lds;
    int* tot = cl + 2048; int* toff = cl + 2056; int* base = cl + 2072;
    const int* cntw = (const int*)(F.ws + WS_META + MT_CNTW);
    for (int i = F.tid; i < 2048; i += NTHR) cl[i] = cntw[i];
    __syncthreads();
    if (F.tid < 8) { int s = 0; for (int w = 0; w < 256; ++w) s += cl[w * 8 + F.tid]; tot[F.tid] = s; }
    __syncthreads();
    if (F.tid == 0) { int o = 0; for (int e = 0; e < 8; ++e) { toff[e] = o; o += (tot[e] + 255) >> 8; } toff[8] = o;
        if (F.bid == 0) { int* meta = (int*)(F.ws + WS_META + MT_MOE); for (int e = 0; e < 8; ++e) meta[e] = tot[e]; for (int e = 0; e < 9; ++e) meta[8 + e] = toff[e]; } }
    __syncthreads();
    const int* toke = (const int*)(F.ws + WS_META + MT_TOKE); const int* rank = (const int*)(F.ws + WS_META + MT_RANK);
    int* rowtok = (int*)(F.ws + WS_META + MT_ROWTOK);
    const bf16_t* xb = (const bf16_t*)(F.ws + WS_XB); bf16_t* xp = (bf16_t*)(F.ws + WS_SCR + SC_XP);
    for (int blk = F.bid; blk < T / 64; blk += F.G) {
        __syncthreads();
        if (F.tid < 8) { int s = 0; for (int w = 0; w < blk; ++w) s += cl[w * 8 + F.tid]; base[F.tid] = toff[F.tid] * 256 + s; }
        __syncthreads();
        for (int pp = F.wave; pp < 128; pp += NWAVES) {
            const int tok = blk * 64 + (pp >> 1), k = pp & 1, e = toke[tok * 2 + k], row = base[e] + rank[tok * 2 + k];
            if constexpr (FP8) {
                const u32x4 v0 = *(const u32x4*)(xb + (size_t)tok * D + F.lane * 16), v1 = *(const u32x4*)(xb + (size_t)tok * D + F.lane * 16 + 8);
                u32x4 w; w.x = pack4_fp8(bflo(v0.x), bfhi(v0.x), bflo(v0.y), bfhi(v0.y)); w.y = pack4_fp8(bflo(v0.z), bfhi(v0.z), bflo(v0.w), bfhi(v0.w));
                w.z = pack4_fp8(bflo(v1.x), bfhi(v1.x), bflo(v1.y), bfhi(v1.y)); w.w = pack4_fp8(bflo(v1.z), bfhi(v1.z), bflo(v1.w), bfhi(v1.w));
                *(u32x4*)((char*)xp + (size_t)row * D + F.lane * 16) = w;
            } else {
            const u32x4 v0 = *(const u32x4*)(xb + (size_t)tok * D + F.lane * 8), v1 = *(const u32x4*)(xb + (size_t)tok * D + 512 + F.lane * 8);
            *(u32x4*)(xp + (size_t)row * D + F.lane * 8) = v0; *(u32x4*)(xp + (size_t)row * D + 512 + F.lane * 8) = v1; }
            if (F.lane == 0) rowtok[row] = tok * 2 + k;
        }
    }
}

__device__ __forceinline__ void phase_mla_rows(const Frame& F, const int* positions) {
    const float* lat = (const float*)(F.ws + WS_SCR + SC_LAT);
    bf16_t* cqn = (bf16_t*)(F.ws + WS_SCR + SC_CQN); bf16_t* ckvn = (bf16_t*)(F.ws + WS_SCR + SC_CKVN); bf16_t* kr = (bf16_t*)(F.ws + WS_SCR + SC_KR);
    float* rope = (float*)(F.ws + WS_META + MT_ROPE);
    for (int row = F.bid * NWAVES + F.wave; row < T; row += F.G * NWAVES) {
        const float* lr = lat + (size_t)row * MLA_INP;
        float cq[6], ck[4]; float s1 = 0.f, s2 = 0.f;
#pragma unroll
        for (int j = 0; j < 6; ++j) { cq[j] = lr[F.lane + 64 * j]; s1 += cq[j] * cq[j]; }
#pragma unroll
        for (int j = 0; j < 4; ++j) { ck[j] = lr[MLA_QR + F.lane + 64 * j]; s2 += ck[j] * ck[j]; }
        const float r1 = 1.0f / sqrtf(wave_sum(s1) * (1.0f / MLA_QR) + RMS_EPS), r2 = 1.0f / sqrtf(wave_sum(s2) * (1.0f / MLA_KVR) + RMS_EPS);
#pragma unroll
        for (int j = 0; j < 6; ++j) cqn[(size_t)row * MLA_QR + F.lane + 64 * j] = (bf16_t)(cvt_pk_bf16(cq[j] * r1, 0.f) & 0xffffu);
#pragma unroll
        for (int j = 0; j < 4; ++j) ckvn[(size_t)row * MLA_KVR + F.lane + 64 * j] = (bf16_t)(cvt_pk_bf16(ck[j] * r2, 0.f) & 0xffffu);
        const float kx = lr[MLA_QR + MLA_KVR + F.lane];
        const float ko = __shfl_xor(kx, 32);
        const int i = F.lane & 31;
        const float invf = exp2f(-(float)i * (13.287712379549449f / 32.0f));
        const float ang = (float)positions[row] * invf;
        const double rev = (double)ang * 0.15915494309189535;
        const float fr = (float)(rev - floor(rev));
        const float sn = __builtin_amdgcn_sinf(fr), cs = __builtin_amdgcn_cosf(fr);
        const float out = (F.lane < 32) ? (kx * cs - ko * sn) : (kx * cs + ko * sn);
        kr[(size_t)row * MLA_ROPE + F.lane] = (bf16_t)(cvt_pk_bf16(out, 0.f) & 0xffffu);
        if (F.lane < 32) *(f32x2*)(rope + (size_t)row * 64 + 2 * i) = (f32x2){cs, sn};
    }
}

__device__ __forceinline__ void phase_pool_z(const Frame& F) {
    const float* x = (const float*)(F.ws + WS_X); bf16_t* z = (bf16_t*)(F.ws + WS_SCR + SC_Z);
    const int c = F.tid * 2, half = 1 << (c >> 8);
    for (int blk = F.bid; blk < T / 64; blk += F.G) {
        const int b0 = (blk * 64) / SEQ * SEQ, t0 = blk * 64 - b0;
        f32x2 sum = {0.f, 0.f};
        for (int s = t0 - half; s < t0 + half; ++s) if (s >= 0 && s < SEQ) { const f32x2 v = *(const f32x2*)(x + (size_t)(b0 + s) * D + c); sum += v; }
        for (int t = t0; t < t0 + 64; ++t) {
            const int lo = t - half < 0 ? 0 : t - half, hi = t + half > SEQ ? SEQ : t + half;
            const f32x2 xv = *(const f32x2*)(x + (size_t)(b0 + t) * D + c);
            const float inv = 1.0f / (float)(hi - lo);
            const f32x2 zz = sum * inv - xv;
            *(unsigned*)(z + (size_t)(b0 + t) * D + c) = cvt_pk_bf16(zz[0], zz[1]);
            if (t + half < SEQ) { const f32x2 v = *(const f32x2*)(x + (size_t)(b0 + t + half) * D + c); sum += v; }
            if (t - half >= 0) { const f32x2 v = *(const f32x2*)(x + (size_t)(b0 + t - half) * D + c); sum -= v; }
        }
    }
}

__device__ __forceinline__ void phase_mlstm_prep(const Frame& F, const float* convw) {
    const bf16_t* proj = (const bf16_t*)(F.ws + WS_SCR + SC_PROJ); bf16_t* qkc = (bf16_t*)(F.ws + WS_SCR + SC_QKC);
    const int c = F.tid * 2;
    float w0[5], w1[5];
#pragma unroll
    for (int j = 0; j < 5; ++j) { w0[j] = convw[j * 1024 + c]; w1[j] = convw[j * 1024 + c + 1]; }
    const float ksc = (c >= 512) ? 0.08838834764831845f : 1.0f;
    for (int blk = F.bid; blk < T / 64; blk += F.G) {
        const int b0 = (blk * 64) / SEQ * SEQ, t0 = blk * 64 - b0;
        float a0[5], a1[5];
#pragma unroll
        for (int j = 0; j < 4; ++j) { const int s = t0 - 2 + j; unsigned w = 0u; if (s >= 0 && s < SEQ) w = *(const unsigned*)(proj + (size_t)(b0 + s) * ML_INP + c); a0[j + 1] = bflo(w); a1[j + 1] = bfhi(w); }
        for (int t = t0; t < t0 + 64; ++t) {
#pragma unroll
            for (int j = 0; j < 4; ++j) { a0[j] = a0[j + 1]; a1[j] = a1[j + 1]; }
            { const int s = t + 2; unsigned w = 0u; if (s < SEQ) w = *(const unsigned*)(proj + (size_t)(b0 + s) * ML_INP + c); a0[4] = bflo(w); a1[4] = bfhi(w); }
            float r0 = 0.f, r1 = 0.f;
#pragma unroll
            for (int j = 0; j < 5; ++j) { r0 += a0[j] * w0[j]; r1 += a1[j] * w1[j]; }
            r0 = silu_f(r0) * ksc; r1 = silu_f(r1) * ksc;
            *(unsigned*)(qkc + (size_t)(b0 + t) * D + c) = cvt_pk_bf16(r0, r1);
        }
    }
    const float* gates = (const float*)(F.ws + WS_META + MT_GATES);
    float* gb = (float*)(F.ws + WS_META + MT_GVEC); float* gu = gb + 32 * SEQ; float* gpm = gu + 32 * SEQ; float* gawl = gpm + 32 * SEQ;
    for (int wg = F.bid * NWAVES + F.wave; wg < 32 * 64; wg += F.G * NWAVES) {
        const int chain = wg >> 6, cch = wg & 63, dir = chain >> 4, bb = (chain >> 2) & 3, hd = chain & 3;
        const int pos = cch * 64 + F.lane, tok = dir ? (SEQ - 1 - pos) : pos;
        const size_t row = (size_t)bb * SEQ + tok;
        const float li = gates[row * 16 + dir * 4 + hd], f = gates[row * 16 + 8 + dir * 4 + hd];
        const float lf = fminf(f, 0.f) - log1pf(expf(-fabsf(f)));
        float bsum = lf;
#pragma unroll
        for (int o = 1; o < 64; o <<= 1) { const float n = __shfl_up(bsum, o); if (F.lane >= o) bsum += n; }
        const float u = li - bsum;
        float pm = u;
#pragma unroll
        for (int o = 1; o < 64; o <<= 1) { const float n = __shfl_up(pm, o); if (F.lane >= o) pm = fmaxf(pm, n); }
        const float pm63 = __shfl(pm, 63);
        const size_t o_ = (size_t)chain * SEQ + pos;
        gb[o_] = bsum; gu[o_] = u; gpm[o_] = pm; gawl[o_] = expf(u - pm63);
    }
}

__device__ __forceinline__ void phase_mlstm_combine(const Frame& F, const float* norm_g) {
    const float* hs = (const float*)(F.ws + WS_SCR + SC_HS); const bf16_t* proj = (const bf16_t*)(F.ws + WS_SCR + SC_PROJ); bf16_t* ym = (bf16_t*)(F.ws + WS_SCR + SC_YM);
    for (int row = F.bid * NWAVES + F.wave; row < T; row += F.G * NWAVES) {
#pragma unroll
        for (int hd = 0; hd < 4; ++hd) { const int c = hd * 256 + F.lane * 4;
            const f32x4 h = *(const f32x4*)(hs + (size_t)row * D + c) + *(const f32x4*)(hs + (size_t)T * D + (size_t)row * D + c);
            const float mu = wave_sum((h[0] + h[1]) + (h[2] + h[3])) * (1.0f / 256.0f);
            const f32x4 d = h - mu;
            const float rstd = 1.0f / sqrtf(wave_sum((d[0] * d[0] + d[1] * d[1]) + (d[2] * d[2] + d[3] * d[3])) * (1.0f / 256.0f) + LN_EPS);
            const f32x4 gn = *(const f32x4*)(norm_g + c);
            const u32x2 ow = *(const u32x2*)(proj + (size_t)row * ML_INP + 2048 + c);
            const float o0 = bflo(ow.x), o1 = bfhi(ow.x), o2 = bflo(ow.y), o3 = bfhi(ow.y);
            const float y0 = d[0] * rstd * gn[0] * sigmoid_f(o0), y1 = d[1] * rstd * gn[1] * sigmoid_f(o1), y2 = d[2] * rstd * gn[2] * sigmoid_f(o2), y3 = d[3] * rstd * gn[3] * sigmoid_f(o3);
            *(u32x2*)(ym + (size_t)row * D + c) = (u32x2){cvt_pk_bf16(y0, y1), cvt_pk_bf16(y2, y3)}; }
    }
}

#ifndef MOE0_FP8
#define MOE0_FP8 true
#endif
#ifndef MOE1_FP8
#define MOE1_FP8 true
#endif
__global__ void __launch_bounds__(NTHR, 2) fwd_kernel(Args args) {
    extern __shared__ __attribute__((aligned(16))) unsigned char lds_raw[];
    Frame F;
    F.lds = (char*)lds_raw; F.tid = threadIdx.x; F.lane = F.tid & 63; F.wave = __builtin_amdgcn_readfirstlane(F.tid >> 6); F.G = gridDim.x; F.bid = blockIdx.x; F.ws = args.ws;
    LAS unsigned char* ldsl = (LAS unsigned char*)lds_raw;
    volatile LAS unsigned* MISC = (volatile LAS unsigned*)(ldsl + LDS_MISC);
    if (F.tid < 64) MISC[F.tid] = 0u;
    __syncthreads();
    const int lo = args.ph_lo, hi = args.ph_hi;
    XcdBarrier bar; bar.bar = (unsigned*)(args.ws + WS_CTL) + 4096; bar.x = 0; bar.st = nullptr;
    if (hi - lo > 1) bar = xcd_barrier_post((unsigned*)(args.ws + WS_CTL) + 4096, MISC + 8);
#ifndef EN_MASK
#define EN_MASK 0xffffffffu
#endif
#define EN(b) ((EN_MASK >> (b)) & 1u)
#define IN(k) (lo <= (k) && (k) < hi)
#define SEAM(k) do { if (IN(k) && IN((k) + 1)) xcd_barrier(bar); } while (0)
    int ph = 0;
#define PTRS size_t zoff_ = 0; asm volatile("" : "+s"(zoff_)); unsigned char* ws = args.ws + zoff_; F.ws = ws; unsigned char* scr = ws + WS_SCR; bf16_t* Wb = (bf16_t*)(ws + WS_W); \
    float* X = (float*)(ws + WS_X); bf16_t* XB = (bf16_t*)(ws + WS_XB); float* Y = (float*)(ws + WS_Y); const float* lng = args.in[22]; const float* lnb = args.in[23]; \
    (void)scr; (void)Wb; (void)X; (void)XB; (void)Y; (void)lng; (void)lnb;

    if (EN(0) && IN(ph)) { PTRS phase_convert_small(F, args); }
    SEAM(ph); ++ph;
    if (EN(0) && IN(ph)) { PTRS phase_convert_moe<MOE0_FP8>(F, args, 0); }
    SEAM(ph); ++ph;

#define GEMM_DENSE(EPI, Aptr, lda_, Bptr, ldb_, K_, Mrows, Ncols, epi) do { \
        pg8::Gemm g{(const bf16_t*)(Aptr), (const bf16_t*)(Bptr), (lda_), (ldb_), (K_)}; pg8::DenseOrder S; S.init((Mrows), (Ncols), F.G, F.bid); \
        pg8::gemm_phase<EPI, pg8::DenseOrder, true>(ldsl, g, S, epi); } while (0)

#define MLA_PHASES(j, xres, lnidx, LNMODE, wproj_) do { \
    if (EN(11) && IN(ph)) { PTRS  pg8::EpiF32 E{(float*)(scr + SC_LAT), MLA_INP}; GEMM_DENSE(pg8::EpiF32, XB, D, (char*)Wb + W_DQKV + (size_t)(j) * MLA_INP * D * 2, D, D, T, MLA_INP, E); } \
    SEAM(ph); ++ph; \
    if (EN(2) && IN(ph)) { PTRS phase_mla_rows(F, (const int*)args.in[1]); } \
    SEAM(ph); ++ph; \
    if (EN(12) && IN(ph)) { PTRS  { pg8::EpiBf16 E{(bf16_t*)(scr + SC_Q), MLA_QW}; GEMM_DENSE(pg8::EpiBf16, scr + SC_CQN, MLA_QR, (char*)Wb + W_UQ + (size_t)(j) * MLA_QW * MLA_QR * 2, MLA_QR, MLA_QR, T, MLA_QW, E); } \
                  { pg8::EpiBf16 E{(bf16_t*)(scr + SC_KV), MLA_KVW}; GEMM_DENSE(pg8::EpiBf16, scr + SC_CKVN, MLA_KVR, (char*)Wb + W_UKV + (size_t)(j) * MLA_KVW * MLA_KVR * 2, MLA_KVR, MLA_KVR, T, MLA_KVW, E); } } \
    SEAM(ph); ++ph; \
    if (EN(3) && IN(ph)) { PTRS  const int x8 = F.bid & 7, jj = F.bid >> 3, per = F.G >> 3; \
        for (int lu = jj; lu < 64; lu += per) { const int bh = x8 * 4 + (lu >> 4), qb = lu & 15, b_ = bh >> 3, h_ = bh & 7; const size_t r0 = (size_t)b_ * SEQ + (size_t)qb * 256; \
            att::attn_body((const bf16_t*)(scr + SC_Q) + r0 * MLA_QW + h_ * 192, (const float*)(ws + WS_META + MT_ROPE) + r0 * 64, \
                           (const bf16_t*)(scr + SC_KV) + (size_t)b_ * SEQ * MLA_KVW + h_ * 256, (const bf16_t*)(scr + SC_KV) + (size_t)b_ * SEQ * MLA_KVW + h_ * 256 + 128, \
                           (const bf16_t*)(scr + SC_KR) + (size_t)b_ * SEQ * MLA_ROPE, (bf16_t*)(scr + SC_O) + r0 * D + h_ * 128, SEQ, F.lds); } } \
    SEAM(ph); ++ph; \
    if (EN(13) && IN(ph)) { PTRS  pg8::EpiF32 E{Y, D}; GEMM_DENSE(pg8::EpiF32, scr + SC_O, D, (char*)Wb + W_O + (size_t)(j) * D * D * 2, D, D, T, D, E); } \
    SEAM(ph); ++ph; \
    if (EN(4) && IN(ph)) { PTRS phase_ln<LNMODE>(F, xres, Y, X, XB, lng + (lnidx) * D, lnb + (lnidx) * D, wproj_, nullptr); } \
    SEAM(ph); ++ph; } while (0)

#define DENSE_PHASES(c, lnidx, LNMODE) do { \
    if (EN(14) && IN(ph)) { PTRS  pg8::EpiSwiGLU E{(bf16_t*)(scr + SC_H), DFF}; GEMM_DENSE(pg8::EpiSwiGLU, XB, D, (char*)Wb + W_GU + (size_t)(c) * 2 * DFF * D * 2, D, D, T, 2 * DFF, E); } \
    SEAM(ph); ++ph; \
    if (EN(15) && IN(ph)) { PTRS  pg8::EpiF32 E{Y, D}; GEMM_DENSE(pg8::EpiF32, scr + SC_H, DFF, (char*)Wb + W_DN + (size_t)(c) * D * DFF * 2, DFF, DFF, T, D, E); } \
    SEAM(ph); ++ph; \
    if (EN(4) && IN(ph)) { PTRS phase_ln<LNMODE>(F, X, Y, X, XB, lng + (lnidx) * D, lnb + (lnidx) * D, nullptr, nullptr); } \
    SEAM(ph); ++ph; } while (0)

#define MOE_PHASES(c, lnidx, LNMODE, xout_, wproj_, bgate_, F8) do { \
    if (EN(6) && IN(ph)) { PTRS phase_moe_permute<F8>(F); } \
    SEAM(ph); ++ph; \
    if (EN(7) && IN(ph)) { PTRS  pg8::MoeOrder S; S.build_table((const int*)(ws + WS_META + MT_MOE), (LAS int*)(ldsl + LDS_MISC + 1024), 2 * DFFE, F.G, F.bid); \
        if constexpr (F8) { pg8::Gemm g{(const bf16_t*)(scr + SC_XP), (const bf16_t*)(ws + WS_WMOE + WM_GU), D / 2, D / 2, D / 2}; \
            pg8::EpiSwiGLU8 E{(unsigned char*)(scr + SC_HM), DFFE, 8.0f}; pg8::gemm_phase<pg8::EpiSwiGLU8, pg8::MoeOrder, true, true>(ldsl, g, S, E, 127, 121); } \
        else { pg8::Gemm g{(const bf16_t*)(scr + SC_XP), (const bf16_t*)(ws + WS_WMOE + WM_GU), D, D, D}; \
            pg8::EpiSwiGLU E{(bf16_t*)(scr + SC_HM), DFFE}; pg8::gemm_phase<pg8::EpiSwiGLU, pg8::MoeOrder, true>(ldsl, g, S, E); } } \
    SEAM(ph); ++ph; \
    if (EN(7) && IN(ph)) { PTRS  pg8::MoeOrder S; S.build_table((const int*)(ws + WS_META + MT_MOE), (LAS int*)(ldsl + LDS_MISC + 1024), D, F.G, F.bid); \
        pg8::EpiF32Scatter E{(float*)(scr + SC_Y2), (const int*)(ws + WS_META + MT_ROWTOK)}; \
        if constexpr (F8) { pg8::Gemm g{(const bf16_t*)(scr + SC_HM), (const bf16_t*)(ws + WS_WMOE + WM_DN), DFFE / 2, DFFE / 2, DFFE / 2}; pg8::gemm_phase<pg8::EpiF32Scatter, pg8::MoeOrder, true, true>(ldsl, g, S, E, 124, 119); } \
        else { pg8::Gemm g{(const bf16_t*)(scr + SC_HM), (const bf16_t*)(ws + WS_WMOE + WM_DN), DFFE, DFFE, DFFE}; pg8::gemm_phase<pg8::EpiF32Scatter, pg8::MoeOrder, true>(ldsl, g, S, E); } } \
    SEAM(ph); ++ph; \
    if (EN(4) && IN(ph)) { PTRS phase_ln<LNMODE>(F, X, (const float*)(scr + SC_Y2), xout_, XB, lng + (lnidx) * D, lnb + (lnidx) * D, wproj_, bgate_); } \
    SEAM(ph); ++ph; } while (0)

    MLA_PHASES(0, args.in[0], 0, 0, nullptr);
    DENSE_PHASES(0, 1, 0);
    if (EN(5) && IN(ph)) { PTRS phase_pool_z(F); }
    SEAM(ph); ++ph;
    if (EN(16) && IN(ph)) { PTRS  pg8::Gemm g{(const bf16_t*)(scr + SC_Z), (const bf16_t*)((char*)Wb + W_POOL), D, 256, 256}; pg8::PoolOrder S; S.init(T, D, F.G, F.bid);
        pg8::EpiF32 E{Y, D}; pg8::gemm_phase<pg8::EpiF32, pg8::PoolOrder, true>(ldsl, g, S, E); }
    SEAM(ph); ++ph;
    if (EN(4) && IN(ph)) { PTRS phase_ln<2>(F, X, Y, X, XB, lng + 2 * D, lnb + 2 * D, args.in[18], nullptr); }
    SEAM(ph); ++ph;
    MOE_PHASES(0, 3, 1 | 4, X, args.in[10], args.in[12], MOE0_FP8);
    if (EN(0) && IN(ph)) { PTRS phase_convert_moe<MOE1_FP8>(F, args, 1); }
    SEAM(ph); ++ph;
    if (EN(17) && IN(ph)) { PTRS  pg8::EpiBf16 E{(bf16_t*)(scr + SC_PROJ), ML_INP}; GEMM_DENSE(pg8::EpiBf16, XB, D, (char*)Wb + W_IN, D, D, T, ML_INP, E); }
    SEAM(ph); ++ph;
    if (EN(8) && IN(ph)) { PTRS phase_mlstm_prep(F, args.in[11]); }
    SEAM(ph); ++ph;
    if (EN(9) && IN(ph)) { PTRS  mls::Tensors Tn; Tn.qkc = (const bf16_t*)(scr + SC_QKC); Tn.proj = (const bf16_t*)(scr + SC_PROJ);
        Tn.gvec = (const float*)(ws + WS_META + MT_GVEC); Tn.hs = (float*)(scr + SC_HS);
        for (int u = F.bid; u < 256; u += F.G) { const int x8 = u & 7, jj = u >> 3; mls::scan_unit(Tn, (x8 * 4 + (jj >> 3)) * 8 + (jj & 7), F.lds); } }
    SEAM(ph); ++ph;
    if (EN(10) && IN(ph)) { PTRS phase_mlstm_combine(F, args.in[13]); }
    SEAM(ph); ++ph;
    if (EN(18) && IN(ph)) { PTRS  pg8::EpiF32 E{Y, D}; GEMM_DENSE(pg8::EpiF32, scr + SC_YM, D, (char*)Wb + W_OUT, D, D, T, D, E); }
    SEAM(ph); ++ph;
    if (EN(4) && IN(ph)) { PTRS phase_ln<0>(F, X, Y, X, XB, lng + 4 * D, lnb + 4 * D, nullptr, nullptr); }
    SEAM(ph); ++ph;
    DENSE_PHASES(1, 5, 0);
    MLA_PHASES(1, X, 6, 2, args.in[18] + (size_t)D * NEXP);
    MOE_PHASES(1, 7, 1 | 8, args.out, nullptr, nullptr, MOE1_FP8);
#undef IN
#undef SEAM
}

extern "C" void kernel_launch(void* const* d_in, const int* in_sizes, int n_in, void* d_out, int out_size, void* d_ws, size_t ws_size, hipStream_t stream) {
    static int grid = 0;
    if (grid == 0) {
        if (n_in != 24 || in_sizes[0] != T * D || out_size != T * D || ws_size < WS_END) {
            fprintf(stderr, "kernel_launch: shape mismatch: n_in %d in0 %d out %d ws %zu (need %zu)\n", n_in, n_in > 0 ? in_sizes[0] : -1, out_size, ws_size, (size_t)WS_END); grid = -1; return; }
        int dev = 0, cus = 0, per_cu = 0;
        if (hipGetDevice(&dev) != hipSuccess || hipDeviceGetAttribute(&cus, hipDeviceAttributeMultiprocessorCount, dev) != hipSuccess) { grid = -1; return; }
        if (hipFuncSetAttribute((const void*)fwd_kernel, hipFuncAttributeMaxDynamicSharedMemorySize, LDS_BYTES) != hipSuccess) { fprintf(stderr, "kernel_launch: hipFuncSetAttribute failed\n"); grid = -1; return; }
        if (hipOccupancyMaxActiveBlocksPerMultiprocessor(&per_cu, (const void*)fwd_kernel, NTHR, LDS_BYTES) != hipSuccess || per_cu < 1)
            fprintf(stderr, "kernel_launch: occupancy query reports %d blocks per CU\n", per_cu);
        (void)hipGetLastError();
        grid = cus;
    }
    if (grid < 0) return;
    if (hipMemsetAsync((char*)d_ws + WS_CTL, 0, CTL_ZERO_BYTES, stream) != hipSuccess) { fprintf(stderr, "kernel_launch: memset failed\n"); return; }
    Args a{};
    for (int i = 0; i < 24; ++i) a.in[i] = (const float*)d_in[i];
    a.out = (float*)d_out; a.ws = (unsigned char*)d_ws;
#ifndef MK_ONE_LAUNCH
#define MK_ONE_LAUNCH 1
#endif
    if (MK_ONE_LAUNCH) { a.ph_lo = 0; a.ph_hi = NPH; hipLaunchKernelGGL(fwd_kernel, dim3(grid), dim3(NTHR), LDS_BYTES, stream, a);
#ifdef PROBE_PHASE
        for (int r = 0; r < PROBE_REPS; ++r) { a.ph_lo = PROBE_PHASE; a.ph_hi = PROBE_PHASE + 1; hipLaunchKernelGGL(fwd_kernel, dim3(grid), dim3(NTHR), LDS_BYTES, stream, a); }
#endif
    }
    else for (int p = 0; p < NPH; ++p) { a.ph_lo = p; a.ph_hi = p + 1; hipLaunchKernelGGL(fwd_kernel, dim3(grid), dim3(NTHR), LDS_BYTES, stream, a); }
    const hipError_t le = hipPeekAtLastError();
    if (le != hipSuccess) fprintf(stderr, "kernel_launch: launch failed: %s\n", hipGetErrorName(le));
}
```

```cpp
#include <hip/hip_runtime.h>
#include <cstdio>
#include <cstdint>

#define LAS __attribute__((address_space(3)))
#define GAS __attribute__((address_space(1)))
typedef unsigned short bf16_t;
typedef short bf16x8 __attribute__((ext_vector_type(8)));
typedef short s16x4 __attribute__((ext_vector_type(4)));
typedef float f32x4 __attribute__((ext_vector_type(4)));
typedef float f32x2 __attribute__((ext_vector_type(2)));
typedef float f32x16 __attribute__((ext_vector_type(16)));
typedef unsigned u32x4 __attribute__((ext_vector_type(4)));
typedef unsigned u32x2 __attribute__((ext_vector_type(2)));
typedef GAS unsigned gu32;

constexpr int BATCH = 4, SEQ = 4096, T = BATCH * SEQ, D = 1024;
constexpr float DN_ALPHA = 1.6817928305074290f;
constexpr float LN_EPS = 1e-5f, RMS_EPS = 1e-6f;
constexpr int MLA_H = 8, MLA_QR = 384, MLA_KVR = 256, MLA_NOPE = 128, MLA_ROPE = 64, MLA_V = 128, MLA_IN = 704, MLA_INP = 768;
constexpr int MLA_QW = MLA_H * (MLA_NOPE + MLA_ROPE);
constexpr int MLA_KVW = MLA_H * (MLA_NOPE + MLA_V);
constexpr int ML_H = 4, ML_DK = 128, ML_DV = 256, ML_IN = 3088, ML_INP = 3072;
constexpr int DFF = 2816, NEXP = 8, DFFE = 3584;
constexpr int MOE_MAXT = 136;
constexpr int NWAVES = 8, NTHR = 512;

#ifndef DENSE0_FP8
#define DENSE0_FP8 false
#endif
#ifndef DENSE1_FP8
#define DENSE1_FP8 true
#endif
#ifndef MOE0_FP8
#define MOE0_FP8 true
#endif
#ifndef MOE1_FP8
#define MOE1_FP8 true
#endif
constexpr size_t MiB = 1u << 20;
constexpr size_t WS_CTL = 0, CTL_ZERO_BYTES = 1 * MiB;
constexpr size_t WS_META = 1 * MiB;
constexpr size_t MT_CNTW = 0;
constexpr size_t MT_MOE = 16384;
constexpr size_t MT_TOKE = 32768;
constexpr size_t MT_TOKW = MT_TOKE + (size_t)T * 8;
constexpr size_t MT_RANK = MT_TOKW + (size_t)T * 8;
constexpr size_t MT_ROWTOK = MT_RANK + (size_t)T * 8;
constexpr size_t MT_GATES = 1 * MiB;
constexpr size_t MT_GVEC = 2 * MiB;
constexpr size_t MT_ROPE = 4 * MiB;
static_assert(MT_ROWTOK + (size_t)MOE_MAXT * 256 * 4 <= MT_GATES, "meta map");
constexpr size_t WS_W = 17 * MiB;
constexpr size_t W_DQKV = 0;
constexpr size_t W_UQ = W_DQKV + 2 * (size_t)MLA_INP * D * 2;
constexpr size_t W_UKV = W_UQ + 2 * (size_t)MLA_QW * MLA_QR * 2;
constexpr size_t W_O = W_UKV + 2 * (size_t)MLA_KVW * MLA_KVR * 2;
constexpr size_t W_POOL = W_O + 2 * (size_t)D * D * 2;
constexpr size_t W_IN = W_POOL + 4 * (size_t)256 * 256 * 2;
constexpr size_t W_OUT = W_IN + (size_t)ML_INP * D * 2;
constexpr size_t W_GU = W_OUT + (size_t)D * D * 2;
constexpr size_t W_DN = W_GU + 2 * (size_t)2 * DFF * D * 2;
constexpr size_t W_END = W_DN + 2 * (size_t)D * DFF * 2;
static_assert(W_END <= 55 * MiB, "weights map");
constexpr size_t WS_WMOE = 72 * MiB;
constexpr size_t WM_GU = 0, WM_DN = (size_t)NEXP * 2 * DFFE * D * 2;
static_assert(WM_DN + (size_t)NEXP * D * DFFE * 2 == 168 * MiB, "moe weights map");
constexpr size_t WS_X = 240 * MiB;
constexpr size_t WS_XB = 304 * MiB;
constexpr size_t WS_Y = 336 * MiB;
constexpr size_t WS_XB8 = 368 * MiB;
constexpr size_t WS_SCR = 400 * MiB;
constexpr size_t WS_END = 834 * MiB;
constexpr size_t SC_LAT = 0, SC_CQN = 48 * MiB, SC_CKVN = 60 * MiB, SC_KR = 68 * MiB, SC_Q = 70 * MiB, SC_KV = 118 * MiB, SC_O = 182 * MiB;
constexpr size_t SC_H = 0;
constexpr size_t SC_Z = 0;
constexpr size_t SC_XP = 0, SC_HM = 68 * MiB, SC_Y2 = 306 * MiB;
static_assert(SC_Y2 + (size_t)2 * T * D * 4 == 434 * MiB, "moe scratch");
constexpr size_t SC_PROJ = 0, SC_QKC = 96 * MiB, SC_HS = 128 * MiB, SC_YM = 256 * MiB;

constexpr int LDS_MAIN = 131072;
constexpr int LDS_MISC = LDS_MAIN;
constexpr int LDS_BYTES = 147456;

#define RLX_AGENT __ATOMIC_RELAXED, __HIP_MEMORY_SCOPE_AGENT
__device__ __forceinline__ unsigned cvt_pk_bf16(float lo, float hi) { unsigned r; asm volatile("v_cvt_pk_bf16_f32 %0, %1, %2" : "=v"(r) : "v"(lo), "v"(hi)); return r; }
__device__ __forceinline__ float bf2f(unsigned short b) { return __builtin_bit_cast(float, (unsigned)b << 16); }
__device__ __forceinline__ float bflo(unsigned w) { return __builtin_bit_cast(float, w << 16); }
__device__ __forceinline__ float bfhi(unsigned w) { return __builtin_bit_cast(float, w & 0xffff0000u); }
__device__ __forceinline__ float wave_sum(float v) {
#pragma unroll
    for (int o = 32; o >= 1; o >>= 1) v += __shfl_xor(v, o);
    return v;
}
__device__ __forceinline__ unsigned pack4_fp8(float a, float b, float c, float d) {
    a = __builtin_amdgcn_fmed3f(a, -448.f, 448.f); b = __builtin_amdgcn_fmed3f(b, -448.f, 448.f); c = __builtin_amdgcn_fmed3f(c, -448.f, 448.f); d = __builtin_amdgcn_fmed3f(d, -448.f, 448.f);
    int w = __builtin_amdgcn_cvt_pk_fp8_f32(a, b, 0, false); w = __builtin_amdgcn_cvt_pk_fp8_f32(c, d, w, true); return (unsigned)w; }
__device__ __forceinline__ float fast_exp(float x) { return __builtin_amdgcn_exp2f(x * 1.4426950408889634f); }
__device__ __forceinline__ float fast_rcp(float x) { return __builtin_amdgcn_rcpf(x); }
__device__ __forceinline__ float silu_f(float x) { return x * fast_rcp(1.0f + fast_exp(-x)); }
__device__ __forceinline__ float sigmoid_f(float x) { return fast_rcp(1.0f + fast_exp(-x)); }

namespace pg8 {
constexpr int BM = 256, BK = 64, HALF = 128, HTB = HALF * BK * 2, STAGE_BYTES = 8 * HTB, NXCD = 8, WGM = 8;
__host__ __device__ __forceinline__ int lds_byte(int r, int c) { const int st = (r >> 4) * 2 + (c >> 5), rr = r & 15, cc = c & 31, ob = rr * 64 + cc * 2; return st * 1024 + (ob ^ (((ob >> 9) & 1) << 5)); }
__host__ __device__ __forceinline__ void stage_rc(int b, int& R, int& C) { const int st = b / 1024, sb = b % 1024, swz = sb ^ (((sb >> 9) & 1) << 5); R = (st >> 1) * 16 + swz / 64; C = (st & 1) * 32 + (swz % 64) / 2; }
__host__ __device__ __forceinline__ int perm32(int rho) { const int n = rho >> 4, i = rho & 15; return 8 * (i >> 2) + 4 * n + (i & 3); }

struct Unit { int pm, pn, e, nv; };
struct Gemm { const bf16_t* A; const bf16_t* Bt; int lda, ldb, K; };

struct DenseOrder {
    int nM, nN, nwg, G, c;
    __device__ __forceinline__ void init(int M, int N, int G_, int c_) { nM = M / BM; nN = N / BM; nwg = nM * nN; G = G_; c = c_; }
    __device__ __forceinline__ bool next(int i, Unit& u) const {
        const long L = (long)i * G + c; if (L >= nwg) return false;
        int wgid = (int)L; { const int q = nwg / NXCD, r = nwg % NXCD, xcd = wgid % NXCD, off = wgid / NXCD; wgid = (xcd < r ? xcd * (q + 1) : r * (q + 1) + (xcd - r) * q) + off; }
        const int nig = WGM * nN, gid = wgid / nig, fm = gid * WGM, gsz = (nM - fm) < WGM ? (nM - fm) : WGM;
        u.pm = fm + ((wgid % nig) % gsz); u.pn = (wgid % nig) / gsz; u.e = 0; u.nv = 256; return true;
    }
    __device__ __forceinline__ const char* a_tile(const Unit& u, const Gemm& g) const { return (const char*)g.A + (size_t)u.pm * BM * g.lda * 2; }
    __device__ __forceinline__ const char* b_tile(const Unit& u, const Gemm& g) const { return (const char*)g.Bt + (size_t)u.pn * BM * g.ldb * 2; }
};
struct PoolOrder : DenseOrder {
    __device__ __forceinline__ const char* a_tile(const Unit& u, const Gemm& g) const { return (const char*)g.A + ((size_t)u.pm * BM * g.lda + (size_t)u.pn * 256) * 2; }
    __device__ __forceinline__ const char* b_tile(const Unit& u, const Gemm& g) const { return (const char*)g.Bt + (size_t)u.pn * 256 * 256 * 2; }
};
struct MoeOrder {
    const LAS int* tab; int ntiles, nN, Nexp, G, c;
    __device__ __forceinline__ void build_table(const int* meta, LAS int* tabw, int Nexp_, int G_, int c_) {
        const int tid = threadIdx.x;
        if (tid < MOE_MAXT) {
            int e = 0;
#pragma unroll
            for (int k = 1; k < 8; ++k) e += (tid >= meta[8 + k]) ? 1 : 0;
            const int rem = meta[e] - (tid - meta[8 + e]) * 256;
            tabw[2 * tid] = e; tabw[2 * tid + 1] = rem < 256 ? rem : 256;
        }
        ntiles = __builtin_amdgcn_readfirstlane(meta[16]);
        __syncthreads();
        tab = tabw; Nexp = Nexp_; nN = Nexp_ / BM; G = G_; c = c_;
    }
    __device__ __forceinline__ bool next(int i, Unit& u) const {
        const long L = (long)i * G + c; if (L >= (long)ntiles * nN) return false;
        const int rt = (int)(L / nN); u.pn = (int)(L % nN); u.pm = rt;
        u.e = __builtin_amdgcn_readfirstlane(tab[2 * rt]); u.nv = __builtin_amdgcn_readfirstlane(tab[2 * rt + 1]); return true;
    }
    __device__ __forceinline__ const char* a_tile(const Unit& u, const Gemm& g) const { return (const char*)g.A + (size_t)u.pm * BM * g.lda * 2; }
    __device__ __forceinline__ const char* b_tile(const Unit& u, const Gemm& g) const { return (const char*)g.Bt + ((size_t)u.e * Nexp + (size_t)u.pn * BM) * g.ldb * 2; }
};

struct EpiF32 {
    static constexpr bool PERM = false;
    float* C; int ldc;
    __device__ __forceinline__ void operator()(const f32x4 (&acc)[2][2][4][2], const Unit& u, int wr, int wc, int fr, int fq) const {
        const int row0 = u.pm * BM + wr * 64 + fr, col0 = u.pn * BM + wc * 32 + 4 * fq;
#pragma unroll
        for (int ai = 0; ai < 2; ++ai)
#pragma unroll
            for (int m = 0; m < 4; ++m) { float* rowp = C + (size_t)(row0 + ai * HALF + m * 16) * ldc + col0;
#pragma unroll
                for (int bj = 0; bj < 2; ++bj)
#pragma unroll
                    for (int n = 0; n < 2; ++n) *(f32x4*)(rowp + bj * HALF + n * 16) = acc[ai][bj][m][n]; }
    }
};
struct EpiF32Scatter {
    static constexpr bool PERM = false;
    float* C; const int* rowtok;
    __device__ __forceinline__ void operator()(const f32x4 (&acc)[2][2][4][2], const Unit& u, int wr, int wc, int fr, int fq) const {
        const int col0 = u.pn * BM + wc * 32 + 4 * fq;
#pragma unroll
        for (int ai = 0; ai < 2; ++ai)
#pragma unroll
            for (int m = 0; m < 4; ++m) { const int rl = ai * HALF + wr * 64 + m * 16 + fr;
                if (rl < u.nv) { const int dst = rowtok[u.pm * BM + rl]; float* rowp = C + (size_t)dst * D + col0;
#pragma unroll
                    for (int bj = 0; bj < 2; ++bj)
#pragma unroll
                        for (int n = 0; n < 2; ++n) *(f32x4*)(rowp + bj * HALF + n * 16) = acc[ai][bj][m][n]; } }
    }
};
struct EpiBf16Scatter {
    static constexpr bool PERM = true;
    bf16_t* O; const int* rowtok;
    __device__ __forceinline__ void operator()(const f32x4 (&acc)[2][2][4][2], const Unit& u, int wr, int wc, int fr, int fq) const {
        const int col0 = u.pn * BM + wc * 32 + 8 * fq;
#pragma unroll
        for (int ai = 0; ai < 2; ++ai)
#pragma unroll
            for (int m = 0; m < 4; ++m) { const int rl = ai * HALF + wr * 64 + m * 16 + fr;
                if (rl < u.nv) { const int dst = rowtok[u.pm * BM + rl]; bf16_t* rowp = O + (size_t)dst * D + col0;
#pragma unroll
                    for (int bj = 0; bj < 2; ++bj) { const f32x4 v0 = acc[ai][bj][m][0], v1 = acc[ai][bj][m][1];
                        u32x4 w; w.x = cvt_pk_bf16(v0[0], v0[1]); w.y = cvt_pk_bf16(v0[2], v0[3]); w.z = cvt_pk_bf16(v1[0], v1[1]); w.w = cvt_pk_bf16(v1[2], v1[3]);
                        *(u32x4*)(rowp + bj * HALF) = w; } } }
    }
};
struct EpiBf16 {
    static constexpr bool PERM = true;
    bf16_t* O; int ldc;
    __device__ __forceinline__ void operator()(const f32x4 (&acc)[2][2][4][2], const Unit& u, int wr, int wc, int fr, int fq) const {
        const int row0 = u.pm * BM + wr * 64 + fr, col0 = u.pn * BM + wc * 32 + 8 * fq;
#pragma unroll
        for (int ai = 0; ai < 2; ++ai)
#pragma unroll
            for (int m = 0; m < 4; ++m) { bf16_t* rowp = O + (size_t)(row0 + ai * HALF + m * 16) * ldc + col0;
#pragma unroll
                for (int bj = 0; bj < 2; ++bj) { const f32x4 v0 = acc[ai][bj][m][0], v1 = acc[ai][bj][m][1];
                    u32x4 w; w.x = cvt_pk_bf16(v0[0], v0[1]); w.y = cvt_pk_bf16(v0[2], v0[3]); w.z = cvt_pk_bf16(v1[0], v1[1]); w.w = cvt_pk_bf16(v1[2], v1[3]);
                    *(u32x4*)(rowp + bj * HALF) = w; } }
    }
};
struct EpiSwiGLU {
    static constexpr bool PERM = true;
    bf16_t* O; int ldc;
    __device__ __forceinline__ void operator()(const f32x4 (&acc)[2][2][4][2], const Unit& u, int wr, int wc, int fr, int fq) const {
        const int row0 = u.pm * BM + wr * 64 + fr, col0 = u.pn * HALF + wc * 32 + 8 * fq;
#pragma unroll
        for (int ai = 0; ai < 2; ++ai)
#pragma unroll
            for (int m = 0; m < 4; ++m) { bf16_t* rowp = O + (size_t)(row0 + ai * HALF + m * 16) * ldc + col0;
                float h[8];
#pragma unroll
                for (int n = 0; n < 2; ++n)
#pragma unroll
                    for (int i = 0; i < 4; ++i) h[n * 4 + i] = silu_f(acc[ai][0][m][n][i]) * acc[ai][1][m][n][i];
                u32x4 w; w.x = cvt_pk_bf16(h[0], h[1]); w.y = cvt_pk_bf16(h[2], h[3]); w.z = cvt_pk_bf16(h[4], h[5]); w.w = cvt_pk_bf16(h[6], h[7]);
                *(u32x4*)rowp = w; }
    }
};

struct EpiSwiGLU8 {
    static constexpr bool PERM = true;
    unsigned char* O; int ldc; float oscale;
    __device__ __forceinline__ void operator()(const f32x4 (&acc)[2][2][4][2], const Unit& u, int wr, int wc, int fr, int fq) const {
        const int row0 = u.pm * BM + wr * 64 + fr, col0 = u.pn * HALF + wc * 32 + 8 * fq;
#pragma unroll
        for (int ai = 0; ai < 2; ++ai)
#pragma unroll
            for (int m = 0; m < 4; ++m) { unsigned char* rowp = O + (size_t)(row0 + ai * HALF + m * 16) * ldc + col0;
                float h[8];
#pragma unroll
                for (int n = 0; n < 2; ++n)
#pragma unroll
                    for (int i = 0; i < 4; ++i) h[n * 4 + i] = silu_f(acc[ai][0][m][n][i]) * acc[ai][1][m][n][i] * oscale;
                u32x2 w; w.x = pack4_fp8(h[0], h[1], h[2], h[3]); w.y = pack4_fp8(h[4], h[5], h[6], h[7]);
                *(u32x2*)rowp = w; }
    }
};

typedef int v8i32 __attribute__((ext_vector_type(8)));
template <class Epi, class Sched, bool ALIGN_EPI = true, bool FP8 = false>
__device__ __forceinline__ void gemm_phase(LAS unsigned char* lds, const Gemm g, const Sched& S, const Epi& E, int sclA = 127, int sclB = 127) {
    const int tid = threadIdx.x, wid = __builtin_amdgcn_readfirstlane(tid >> 6), lane = tid & 63, wr = wid >> 2, wc = wid & 3, fr = lane & 15, fq = lane >> 4;
    const int sclA4 = sclA * 0x01010101, sclB4 = sclB * 0x01010101; (void)sclA4; (void)sclB4;
    int K = g.K; asm volatile("" : "+s"(K));
    const int nt = K / BK;
    unsigned voffA[2], voffB[2];
#pragma unroll
    for (int i = 0; i < 2; ++i) { int R, C; stage_rc(tid * 16 + i * 8192, R, C); const int Rb = Epi::PERM ? ((R & ~31) + perm32(R & 31)) : R;
        voffA[i] = (unsigned)(R * g.lda + C) * 2u; voffB[i] = (unsigned)(Rb * g.ldb + C) * 2u; }
    const size_t kstep = (size_t)(BK * 2);
    const size_t hstepA = (size_t)HALF * g.lda * 2, hstepB = (size_t)HALF * g.ldb * 2;
    const unsigned ldsw = (unsigned)wid * 1024u;
    const int aoff = lds_byte(wr * 64 + fr, fq * 8), boff = lds_byte(wc * 32 + fr, fq * 8);
#define PG8_SA(b, h) (((b) * 2 + (h)) * HTB)
#define PG8_SB(b, h) ((4 + (b) * 2 + (h)) * HTB)
#define PG8_STAGE(bufoff, gbase, voff) do { _Pragma("unroll") for (int _i = 0; _i < 2; ++_i) \
        __builtin_amdgcn_global_load_lds((const unsigned*)((const char*)(gbase) + (voff)[_i]), (LAS unsigned*)(lds + (bufoff) + ldsw + _i * 8192), 16, 0, 0); } while (0)
#define PG8_LDA(dst, b, h) do { _Pragma("unroll") for (int m = 0; m < 4; ++m) _Pragma("unroll") for (int k = 0; k < 2; ++k) dst[m][k] = *(const LAS bf16x8*)(lds + PG8_SA(b, h) + aoff + m * 2048 + k * 1024); } while (0)
#define PG8_LDB(dst, b, h) do { _Pragma("unroll") for (int n = 0; n < 2; ++n) _Pragma("unroll") for (int k = 0; k < 2; ++k) dst[n][k] = *(const LAS bf16x8*)(lds + PG8_SB(b, h) + boff + n * 2048 + k * 1024); } while (0)
#define PG8_CAT(x0, x1) __builtin_shufflevector(__builtin_bit_cast(u32x4, x0), __builtin_bit_cast(u32x4, x1), 0, 1, 2, 3, 4, 5, 6, 7)
#define PG8_MMA(ai, bj, At, Bt) do { __builtin_amdgcn_s_setprio(1); \
        if constexpr (FP8) { _Pragma("unroll") for (int m = 0; m < 4; ++m) _Pragma("unroll") for (int n = 0; n < 2; ++n) \
            asm volatile("v_mfma_scale_f32_16x16x128_f8f6f4 %0, %1, %2, %0, %3, %4 op_sel_hi:[0,0,0]" : "+v"(acc[ai][bj][m][n]) \
                : "v"(__builtin_bit_cast(v8i32, PG8_CAT(Bt[n][0], Bt[n][1]))), "v"(__builtin_bit_cast(v8i32, PG8_CAT(At[m][0], At[m][1]))), "v"(sclB4), "v"(sclA4)); } \
        else { _Pragma("unroll") for (int m = 0; m < 4; ++m) _Pragma("unroll") for (int n = 0; n < 2; ++n) _Pragma("unroll") for (int k = 0; k < 2; ++k) \
            acc[ai][bj][m][n] = __builtin_amdgcn_mfma_f32_16x16x32_bf16(Bt[n][k], At[m][k], acc[ai][bj][m][n], 0, 0, 0); } \
        __builtin_amdgcn_s_setprio(0); } while (0)
#define PG8_WAIT_V(n) asm volatile("s_waitcnt vmcnt(" #n ")" ::: "memory")
#define PG8_WAIT_L(n) asm volatile("s_waitcnt lgkmcnt(" #n ")" ::: "memory")
#define PG8_BAR __builtin_amdgcn_s_barrier()
#define PG8_SCHED __builtin_amdgcn_sched_barrier(0)
    Unit cur, nxt; int ui = 0;
    if (!S.next(0, cur)) return;
    f32x4 acc[2][2][4][2];
#pragma unroll
    for (int a = 0; a < 2; ++a)
#pragma unroll
        for (int b = 0; b < 2; ++b)
#pragma unroll
            for (int m = 0; m < 4; ++m)
#pragma unroll
                for (int n = 0; n < 2; ++n) acc[a][b][m][n] = (f32x4){0.f, 0.f, 0.f, 0.f};
    bf16x8 At[4][2], B0[2][2], B1[2][2];
    const char* cA = S.a_tile(cur, g); const char* cB = S.b_tile(cur, g);
    PG8_STAGE(PG8_SB(0, 0), cB, voffB); PG8_STAGE(PG8_SB(0, 1), cB + hstepB, voffB); PG8_STAGE(PG8_SA(0, 0), cA, voffA); PG8_STAGE(PG8_SA(0, 1), cA + hstepA, voffA);
    if (wr == 1) PG8_BAR;
    PG8_WAIT_V(2); PG8_BAR;
    PG8_STAGE(PG8_SB(1, 0), cB + kstep, voffB); PG8_STAGE(PG8_SA(1, 0), cA + kstep, voffA); PG8_STAGE(PG8_SB(1, 1), cB + hstepB + kstep, voffB);
    PG8_WAIT_V(6); PG8_BAR;
    for (;;) {
        const bool has_next = S.next(ui + 1, nxt);
        const char* nA = has_next ? S.a_tile(nxt, g) : cA; const char* nB = has_next ? S.b_tile(nxt, g) : cB;
        for (int t = 0; t < nt; t += 2) {
            const bool last = (t == nt - 2);
            const char* a1 = cA + (size_t)(t + 1) * kstep;
            const char* a2 = last ? nA : cA + (size_t)(t + 2) * kstep; const char* b2 = last ? nB : cB + (size_t)(t + 2) * kstep;
            const char* a3 = a2 + kstep; const char* b3 = b2 + kstep;
            PG8_LDB(B0, 0, 0); PG8_LDB(B1, 0, 1); PG8_SCHED; PG8_LDA(At, 0, 0); PG8_STAGE(PG8_SA(1, 1), a1 + hstepA, voffA);
            PG8_WAIT_V(8); PG8_WAIT_L(0); PG8_BAR; PG8_MMA(0, 0, At, B0); PG8_MMA(0, 1, At, B1); PG8_BAR; PG8_SCHED;
            PG8_LDA(At, 0, 1); PG8_STAGE(PG8_SB(0, 0), b2, voffB); PG8_STAGE(PG8_SB(0, 1), b2 + hstepB, voffB); PG8_STAGE(PG8_SA(0, 0), a2, voffA);
            PG8_WAIT_V(8); PG8_WAIT_L(0); PG8_BAR; PG8_MMA(1, 0, At, B0); PG8_MMA(1, 1, At, B1); PG8_BAR; PG8_SCHED;
            PG8_LDB(B0, 1, 0); PG8_LDB(B1, 1, 1); PG8_SCHED; PG8_LDA(At, 1, 0); PG8_STAGE(PG8_SA(0, 1), a2 + hstepA, voffA);
            PG8_WAIT_V(8); PG8_WAIT_L(0); PG8_BAR; PG8_MMA(0, 0, At, B0); PG8_MMA(0, 1, At, B1); PG8_BAR; PG8_SCHED;
            PG8_LDA(At, 1, 1); PG8_STAGE(PG8_SB(1, 0), b3, voffB); PG8_STAGE(PG8_SB(1, 1), b3 + hstepB, voffB); PG8_STAGE(PG8_SA(1, 0), a3, voffA);
            PG8_WAIT_V(8); PG8_WAIT_L(0); PG8_BAR; PG8_MMA(1, 0, At, B0); PG8_MMA(1, 1, At, B1); PG8_BAR; PG8_SCHED;
        }
        if constexpr (ALIGN_EPI) { if (wr == 0) PG8_BAR; }
        if constexpr (FP8) asm volatile("s_nop 15\n\ts_nop 15" ::: "memory");
        { int ln_ = lane; asm volatile("" : "+v"(ln_));
          E(acc, cur, wr, wc, ln_ & 15, ln_ >> 4); }
        if (!has_next) break;
#pragma unroll
        for (int a = 0; a < 2; ++a)
#pragma unroll
            for (int b = 0; b < 2; ++b)
#pragma unroll
                for (int m = 0; m < 4; ++m)
#pragma unroll
                    for (int n = 0; n < 2; ++n) acc[a][b][m][n] = (f32x4){0.f, 0.f, 0.f, 0.f};
        cur = nxt; cA = nA; cB = nB; ++ui;
        if constexpr (ALIGN_EPI) { if (wr == 1) PG8_BAR; }
    }
    PG8_WAIT_V(0);
    if constexpr (!ALIGN_EPI) { if (wr == 0) PG8_BAR; }
    PG8_BAR;
#undef PG8_SA
#undef PG8_SB
#undef PG8_STAGE
#undef PG8_LDA
#undef PG8_LDB
#undef PG8_MMA
#undef PG8_CAT
#undef PG8_WAIT_V
#undef PG8_WAIT_L
#undef PG8_BAR
#undef PG8_SCHED
}
}

#ifndef ATT_SDEPTH
#define ATT_SDEPTH 1
#endif
namespace att {
constexpr int NW = 8, QBLK = 32, KVBLK = 64;
constexpr float SCALE = 0.07216878364870322f;
constexpr float THR = 8.f;
constexpr int LDQ = MLA_QW, LDK = MLA_KVW, LDKR = MLA_ROPE, LDO = D;
constexpr int SHM_V = KVBLK * 128 * 2, SHM_K = KVBLK * 128 * 2, SHM_KR = KVBLK * 64 * 2;
constexpr int OFF_V = 0, OFF_K = 2 * SHM_V, OFF_KR = OFF_K + 2 * SHM_K, OFF_WS = OFF_KR + 2 * SHM_KR, OFF_QR = OFF_WS + NW * 64 * 4, SHM_ATTN = OFF_QR + NW * 4096;
#define KSWZ(row, colB) ((row) * 256 + ((colB) ^ (((row) & 7) << 4)))
#define KRSWZ(row, colB) ((row) * 128 + ((colB) ^ ((((row) >> 1) & 7) << 4)))
#define SBAR() __builtin_amdgcn_sched_barrier(0)
__device__ __forceinline__ int crow(int r, int hi) { return (r & 3) + 8 * (r >> 2) + 4 * hi; }

__device__ __forceinline__ void partialSM(f32x16& p0, f32x16& p1, float& m_reg, float& mn, float& alpha) {
  constexpr float C = SCALE * 1.4426950408889634f;
  float pmax = p0[0];
#pragma unroll
  for (int r = 1; r < 16; ++r) pmax = fmaxf(pmax, p0[r]);
#pragma unroll
  for (int r = 0; r < 16; ++r) pmax = fmaxf(pmax, p1[r]);
  { auto rr = __builtin_amdgcn_permlane32_swap(__float_as_uint(pmax), __float_as_uint(pmax), false, false);
    pmax = fmaxf(__uint_as_float(rr[0]), __uint_as_float(rr[1])); }
  if (__builtin_expect(__all(pmax - m_reg <= THR / SCALE), 1)) { mn = m_reg; alpha = 1.f; }
  else { mn = fmaxf(m_reg, pmax); alpha = __builtin_amdgcn_exp2f((m_reg - mn) * C); m_reg = mn; }
  float mnC = -mn * C;
#pragma unroll
  for (int r = 0; r < 16; ++r) p0[r] = fmaf(p0[r], C, mnC);
#pragma unroll
  for (int r = 0; r < 16; ++r) p1[r] = fmaf(p1[r], C, mnC);
#pragma unroll
  for (int r = 0; r < 16; ++r) p0[r] = __builtin_amdgcn_exp2f(p0[r]);
}
__device__ __forceinline__ void finishSM(f32x16& p0, f32x16& p1, float alpha, float& l_reg, bf16x8& pa0, bf16x8& pa1, bf16x8& pa2, bf16x8& pa3) {
#pragma unroll
  for (int r = 0; r < 16; ++r) p1[r] = __builtin_amdgcn_exp2f(p1[r]);
  float ps = 0;
#pragma unroll
  for (int r = 0; r < 16; ++r) ps += p0[r];
#pragma unroll
  for (int r = 0; r < 16; ++r) ps += p1[r];
  { auto rr = __builtin_amdgcn_permlane32_swap(__float_as_uint(ps), __float_as_uint(ps), false, false);
    ps = __uint_as_float(rr[0]) + __uint_as_float(rr[1]); }
  l_reg = l_reg * alpha + ps;
#define PK4(P, BASE, OUT) do { unsigned a0 = cvt_pk_bf16(P[BASE + 0], P[BASE + 1]), a1 = cvt_pk_bf16(P[BASE + 2], P[BASE + 3]);   \
    unsigned b0 = cvt_pk_bf16(P[BASE + 4], P[BASE + 5]), b1 = cvt_pk_bf16(P[BASE + 6], P[BASE + 7]);                              \
    auto r0 = __builtin_amdgcn_permlane32_swap(a0, b0, false, false); auto r1 = __builtin_amdgcn_permlane32_swap(a1, b1, false, false); \
    u32x4 w = {r0[0], r1[0], r0[1], r1[1]}; OUT = __builtin_bit_cast(bf16x8, w); } while (0)
  PK4(p0, 0, pa0); PK4(p0, 8, pa1); PK4(p1, 0, pa2); PK4(p1, 8, pa3);
}
__device__ __forceinline__ void qkt(f32x16& p0, f32x16& p1, const char* Ks, const char* Krs, const bf16x8* qr, const char* qrl, int r32, int hi) {
  p0 = f32x16{}; p1 = f32x16{};
#pragma unroll
  for (int d0 = 0; d0 < 8; ++d0) { const int cb = (d0 * 16 + hi * 8) * 2;
    bf16x8 b0 = *reinterpret_cast<const bf16x8*>(Ks + KSWZ(r32, cb));
    bf16x8 b1 = *reinterpret_cast<const bf16x8*>(Ks + KSWZ(32 + r32, cb));
    p0 = __builtin_amdgcn_mfma_f32_32x32x16_bf16(b0, qr[d0], p0, 0, 0, 0);
    p1 = __builtin_amdgcn_mfma_f32_32x32x16_bf16(b1, qr[d0], p1, 0, 0, 0); }
#pragma unroll
  for (int d0 = 0; d0 < 4; ++d0) { const int cb = (d0 * 16 + hi * 8) * 2;
    bf16x8 b0 = *reinterpret_cast<const bf16x8*>(Krs + KRSWZ(r32, cb));
    bf16x8 b1 = *reinterpret_cast<const bf16x8*>(Krs + KRSWZ(32 + r32, cb));
    const bf16x8 qq = *reinterpret_cast<const bf16x8*>(qrl + d0 * 1024);
    p0 = __builtin_amdgcn_mfma_f32_32x32x16_bf16(b0, qq, p0, 0, 0, 0);
    p1 = __builtin_amdgcn_mfma_f32_32x32x16_bf16(b1, qq, p1, 0, 0, 0); }
}
__device__ __forceinline__ int v_st(int k, int c) { const int kk = (k & ~0xC) | ((k & 4) << 1) | ((k & 8) >> 1); return ((kk >> 3) * 4 + (c >> 5)) * 512 + ((kk & 7) * 32 + (c & 31)) * 2; }
__device__ __forceinline__ int v_rd_base(int lane) { return ((lane & 3) << 3) | (((lane >> 2) & 3) << 6) | (((lane >> 4) & 1) << 5) | (((lane >> 5) & 1) << 8); }
constexpr int v_rd_off(int d0, int ks, int half) { return d0 * 512 + ks * 4096 + half * 2048; }
template <int OFF> __device__ __forceinline__ s16x4 tr_read(int vb) {
  s16x4 r; asm volatile("ds_read_b64_tr_b16 %0, %1 offset:%2" : "=&v"(r) : "v"(vb), "i"(OFF) : "memory"); return r;
}
#define PKV(L, H) (bf16x8){L[0], L[1], L[2], L[3], H[0], H[1], H[2], H[3]}
template <int D0> __device__ __forceinline__ void pv_one(f32x16& od, int vb, bf16x8 pa0, bf16x8 pa1, bf16x8 pa2, bf16x8 pa3) {
  const s16x4 l0 = tr_read<v_rd_off(D0, 0, 0)>(vb), h0 = tr_read<v_rd_off(D0, 0, 1)>(vb), l1 = tr_read<v_rd_off(D0, 1, 0)>(vb), h1 = tr_read<v_rd_off(D0, 1, 1)>(vb);
  const s16x4 l2 = tr_read<v_rd_off(D0, 2, 0)>(vb), h2 = tr_read<v_rd_off(D0, 2, 1)>(vb), l3 = tr_read<v_rd_off(D0, 3, 0)>(vb), h3 = tr_read<v_rd_off(D0, 3, 1)>(vb);
  asm volatile("s_waitcnt lgkmcnt(0)" ::: "memory"); SBAR();
  od = __builtin_amdgcn_mfma_f32_32x32x16_bf16(pa0, PKV(l0, h0), od, 0, 0, 0);
  od = __builtin_amdgcn_mfma_f32_32x32x16_bf16(pa1, PKV(l1, h1), od, 0, 0, 0);
  od = __builtin_amdgcn_mfma_f32_32x32x16_bf16(pa2, PKV(l2, h2), od, 0, 0, 0);
  od = __builtin_amdgcn_mfma_f32_32x32x16_bf16(pa3, PKV(l3, h3), od, 0, 0, 0);
}
__device__ __forceinline__ void pv_d0(f32x16* o, int vb, bf16x8 pa0, bf16x8 pa1, bf16x8 pa2, bf16x8 pa3) {
  pv_one<0>(o[0], vb, pa0, pa1, pa2, pa3); pv_one<1>(o[1], vb, pa0, pa1, pa2, pa3); pv_one<2>(o[2], vb, pa0, pa1, pa2, pa3); pv_one<3>(o[3], vb, pa0, pa1, pa2, pa3);
}

__device__ __forceinline__ void attn_body(const bf16_t* __restrict__ Qb, const float* __restrict__ cs, const bf16_t* __restrict__ Kn, const bf16_t* __restrict__ Vh,
                                          const bf16_t* __restrict__ Kr, bf16_t* __restrict__ Ob, int seq, char* lds) {
  int tid = threadIdx.x; asm volatile("" : "+v"(tid));
  const int wid = tid >> 6, lane = tid & 63, r32 = lane & 31, hi = lane >> 5;
  char* V_lds = lds + OFF_V; char* K_lds = lds + OFF_K; char* KR_lds = lds + OFF_KR;
  float* ws = (float*)(lds + OFF_WS) + wid * 64; float* li_l = ws; float* al_l = ws + 32;
  float m_reg = -1e30f, l_reg = 0; f32x16 o[4] = {}; bf16x8 qr[8];
  char* qrl = lds + OFF_QR + wid * 4096 + lane * 16;
  { const int qrow = wid * QBLK + r32;
    const unsigned qoff = (unsigned)(qrow * LDQ + hi * 8) * 2u;
    const char* Qc = (const char*)Qb;
    bf16x8 qro[4];
#pragma unroll
    for (int d0 = 0; d0 < 8; ++d0) qr[d0] = *reinterpret_cast<const bf16x8*>(Qc + qoff + d0 * 32);
#pragma unroll
    for (int d0 = 0; d0 < 4; ++d0) qro[d0] = *reinterpret_cast<const bf16x8*>(Qc + qoff + 256 + d0 * 32);
    const char* csc = (const char*)cs; const unsigned csoff = (unsigned)qrow * 256u;
#pragma unroll
    for (int a = 0; a < 2; ++a) {
      const int i0 = a * 16 + hi * 8;
      bf16x8 x1 = qro[a], x2 = qro[2 + a], y1, y2;
#pragma unroll
      for (int j = 0; j < 8; ++j) {
        const f32x2 c_s = *reinterpret_cast<const f32x2*>(csc + csoff + 8 * (i0 + j));
        const float f1 = bf2f((unsigned short)x1[j]), f2 = bf2f((unsigned short)x2[j]);
        const float g1 = f1 * c_s.x - f2 * c_s.y, g2 = f2 * c_s.x + f1 * c_s.y;
        const unsigned pk = cvt_pk_bf16(g1, g2);
        y1[j] = (short)(pk & 0xffffu); y2[j] = (short)(pk >> 16);
      }
      *reinterpret_cast<bf16x8*>(qrl + a * 1024) = y1; *reinterpret_cast<bf16x8*>(qrl + (2 + a) * 1024) = y2;
    }
  }
  const int sr = tid >> 4, sc = (tid & 15) * 8, vst0 = v_st(sr, sc), vst1 = v_st(32 + sr, sc);
  const int krr = tid >> 3, krc = (tid & 7) * 8;
  const int vb0 = (int)(uintptr_t)V_lds + v_rd_base(lane);
  constexpr int SDEPTH = ATT_SDEPTH;
  struct { bf16x8 vs0, vs1, ks0, ks1, kr0; } sr_[SDEPTH];
  const unsigned vo0 = (unsigned)(sr * LDK + sc) * 2u, vo1 = (unsigned)((32 + sr) * LDK + sc) * 2u, kro = (unsigned)(krr * LDKR + krc) * 2u;
#define SLOAD(i, k0) do { const char* vt_ = (const char*)Vh + (size_t)(k0) * (LDK * 2); const char* kt_ = (const char*)Kn + (size_t)(k0) * (LDK * 2); const char* krt_ = (const char*)Kr + (size_t)(k0) * (LDKR * 2); \
    sr_[i].vs0 = *reinterpret_cast<const bf16x8*>(vt_ + vo0); sr_[i].vs1 = *reinterpret_cast<const bf16x8*>(vt_ + vo1); \
    sr_[i].ks0 = *reinterpret_cast<const bf16x8*>(kt_ + vo0); sr_[i].ks1 = *reinterpret_cast<const bf16x8*>(kt_ + vo1); \
    sr_[i].kr0 = *reinterpret_cast<const bf16x8*>(krt_ + kro); } while (0)
#define SWRITE(b, i) do { *(bf16x8*)(V_lds + (b) * SHM_V + vst0) = sr_[i].vs0;          \
    *(bf16x8*)(V_lds + (b) * SHM_V + vst1) = sr_[i].vs1; const int kc = sc * 2;               \
    *(bf16x8*)(K_lds + (b) * SHM_K + KSWZ(sr, kc)) = sr_[i].ks0;                       \
    *(bf16x8*)(K_lds + (b) * SHM_K + KSWZ(32 + sr, kc)) = sr_[i].ks1;                  \
    *(bf16x8*)(KR_lds + (b) * SHM_KR + KRSWZ(krr, krc * 2)) = sr_[i].kr0; } while (0)
#define SWAIT() do { if constexpr (SDEPTH == 2) asm volatile("s_waitcnt vmcnt(5)" ::: "memory"); else asm volatile("s_waitcnt vmcnt(0)" ::: "memory"); } while (0)
#define RESC(a) do { if (__any((a) < 1.f)) { if (hi == 0) al_l[r32] = (a); asm volatile("s_waitcnt lgkmcnt(0)" ::: "memory"); \
    _Pragma("unroll") for (int d = 0; d < 4; ++d) _Pragma("unroll") for (int r = 0; r < 16; ++r) o[d][r] *= al_l[crow(r, hi)]; } } while (0)
  f32x16 pA0, pA1, pB0, pB1; float mnA, mnB, alA, alB; bf16x8 pa0, pa1, pa2, pa3; const int NT = seq / KVBLK;
  constexpr int SE = 0, SO = SDEPTH - 1;
  SLOAD(SE, 0); asm volatile("s_waitcnt vmcnt(0)" ::: "memory"); SWRITE(0, SE); __syncthreads();
  qkt(pA0, pA1, K_lds, KR_lds, qr, qrl, r32, hi); partialSM(pA0, pA1, m_reg, mnA, alA);
  SLOAD(SO, KVBLK); if constexpr (SDEPTH == 2) { if (2 < NT) SLOAD(SE, 2 * KVBLK); }
  SWAIT(); SWRITE(1, SO); __syncthreads();
  for (int j = 1; j + 1 < NT; j += 2) {
    SBAR(); qkt(pB0, pB1, K_lds + SHM_K, KR_lds + SHM_KR, qr, qrl, r32, hi);
    finishSM(pA0, pA1, alA, l_reg, pa0, pa1, pa2, pa3); SBAR();
    SLOAD(SO, (j + SDEPTH) * KVBLK); SBAR();
    pv_d0(o, vb0, pa0, pa1, pa2, pa3); partialSM(pB0, pB1, m_reg, mnB, alB);
    __syncthreads(); SWAIT(); SWRITE(0, SE);
    RESC(alB); __syncthreads();
    SBAR(); qkt(pA0, pA1, K_lds, KR_lds, qr, qrl, r32, hi);
    finishSM(pB0, pB1, alB, l_reg, pa0, pa1, pa2, pa3); SBAR();
    if (SDEPTH == 1 || j + 3 < NT) SLOAD(SE, (j + 1 + SDEPTH) * KVBLK); SBAR();
    pv_d0(o, vb0 + SHM_V, pa0, pa1, pa2, pa3); partialSM(pA0, pA1, m_reg, mnA, alA);
    __syncthreads(); SWAIT(); SWRITE(1, SO);
    RESC(alA); __syncthreads();
  }
  SBAR(); qkt(pB0, pB1, K_lds + SHM_K, KR_lds + SHM_KR, qr, qrl, r32, hi);
  finishSM(pA0, pA1, alA, l_reg, pa0, pa1, pa2, pa3); SBAR();
  pv_d0(o, vb0, pa0, pa1, pa2, pa3); partialSM(pB0, pB1, m_reg, mnB, alB);
  __syncthreads(); RESC(alB);
  finishSM(pB0, pB1, alB, l_reg, pa0, pa1, pa2, pa3); SBAR();
  pv_d0(o, vb0 + SHM_V, pa0, pa1, pa2, pa3);
  if (hi == 0) li_l[r32] = l_reg; asm volatile("s_waitcnt lgkmcnt(0)" ::: "memory");
  float rli[16];
#pragma unroll
  for (int r = 0; r < 16; ++r) rli[r] = __builtin_amdgcn_rcpf(li_l[crow(r, hi)]);
  __syncthreads();
  int tid2 = threadIdx.x; asm volatile("" : "+v"(tid2));
  const int wid2 = tid2 >> 6, lane2 = tid2 & 63;
  char* ot = lds + wid2 * (32 * 272);
#pragma unroll
  for (int r = 0; r < 16; ++r) { const int orow = crow(r, lane2 >> 5);
#pragma unroll
    for (int d0 = 0; d0 < 4; ++d0) *(bf16_t*)(ot + orow * 272 + (d0 * 32 + (lane2 & 31)) * 2) = (bf16_t)(cvt_pk_bf16(o[d0][r] * rli[r], 0.f) & 0xffffu); }
  asm volatile("s_waitcnt lgkmcnt(0)" ::: "memory");
  char* Oc = (char*)Ob;
#pragma unroll
  for (int i = 0; i < 8; ++i) { const int id = lane2 + 64 * i, row = id >> 4, ch = id & 15;
    const u32x4 v = *(const u32x4*)(ot + row * 272 + ch * 16);
    *(u32x4*)(Oc + (unsigned)((wid2 * QBLK + row) * LDO + ch * 8) * 2u) = v; }
  __syncthreads();
#undef SLOAD
#undef SWRITE
#undef SWAIT
#undef RESC
}
}

namespace mls {
constexpr int OFF_Q = 0, OFF_K = 16384, OFF_VA = 32768, OFF_VB = 49152, OFF_C = 57344, OFF_N = 65536, OFF_VEC = 73728, OFF_CS = 76800, OFF_NS = 93184, LDS_NEED = 109568;
__device__ __forceinline__ unsigned off_b(unsigned row, unsigned ch) { return 256u * row + 16u * (ch ^ (((row & 3) << 2) | ((row >> 2) & 3))); }
__device__ __forceinline__ unsigned off_vb(unsigned row, unsigned ch) { return 1024u * (row >> 3) + 512u * (ch >> 2) + 64u * (row & 7) + 16u * ((ch & 3) ^ ((row >> 2) & 3)); }
__device__ __forceinline__ s16x4 trr(unsigned addr) { s16x4 r; asm volatile("ds_read_b64_tr_b16 %0, %1" : "=&v"(r) : "v"(addr) : "memory"); return r; }

struct Tensors { const bf16_t* qkc; const bf16_t* proj; const float* gvec; float* hs; int variant; };

struct Stg { bf16x8 sqk[6], sv; float sawl, svec[2]; };
__device__ __forceinline__ void scan_unit(const Tensors& Tn, int unit, char* lds) {
  int tid = threadIdx.x; asm volatile("" : "+v"(tid));
  const int wid = __builtin_amdgcn_readfirstlane(tid >> 6), lane = tid & 63, r32 = lane & 31, hi = lane >> 5;
  const int chain = unit >> 3, vs = unit & 7, dir = chain >> 4, bb = (chain >> 2) & 3, hd = chain & 3;
  const unsigned lbase = (unsigned)(uintptr_t)lds;
  float* vec = (float*)(lds + OFF_VEC);
#define QKO(t_, i) ((unsigned)(((dir ? 63 - ((((t_) + 384 * (i)) & 1023) >> 4) : ((((t_) + 384 * (i)) & 1023) >> 4)) * 1024 + (((t_) + 384 * (i)) & 15) * 8) * 2 + (((t_) + 384 * (i)) >= 1024 ? 1024 : 0)))
  const char* gvb = (const char*)Tn.gvec + (size_t)chain * SEQ * 4;
  const char* awsrc = gvb + (size_t)3 * 32 * SEQ * 4;
  Stg sA;
#define TB(c) ((size_t)bb * SEQ + (dir ? (SEQ - 64 * ((c) + 1)) : 64 * (c)))
#define MLOAD(S_, c) do { if (wid >= 2) { const size_t tb_ = TB(c); int ts = tid - 128; asm volatile("" : "+v"(ts)); const int vrow = (ts & 255) >> 2, vch = ts & 3; \
    const unsigned vo = (unsigned)(((dir ? 63 - vrow : vrow) * ML_INP + vch * 8) * 2), awo = (unsigned)vrow * 4u; \
    const char* qb_ = (const char*)Tn.qkc + (tb_ * 1024 + hd * 128) * 2; \
    const char* vb_ = (const char*)Tn.proj + (tb_ * ML_INP + 1024 + hd * 256 + vs * 32) * 2; \
    _Pragma("unroll") for (int i = 0; i < 6; ++i) if (ts + 384 * i < 2048) S_.sqk[i] = *reinterpret_cast<const bf16x8*>(qb_ + QKO(ts, i)); \
    if (ts < 256) { S_.sv = *reinterpret_cast<const bf16x8*>(vb_ + vo); S_.sawl = *reinterpret_cast<const float*>(awsrc + (size_t)(c) * 256 + awo); } \
    else { _Pragma("unroll") for (int j = 0; j < 2; ++j) { const int vi = ts - 256 + 128 * j; if (vi < 192) S_.svec[j] = *reinterpret_cast<const float*>(gvb + (size_t)(c) * 256 + (size_t)((vi >> 6) * 32 * SEQ + (vi & 63)) * 4); } } } } while (0)
#define MWRITE(S_) do { if (wid >= 2) { int ts = tid - 128; asm volatile("" : "+v"(ts)); const int vrow = (ts & 255) >> 2, vch = ts & 3; \
    _Pragma("unroll") for (int i = 0; i < 6; ++i) { const int idx = ts + 384 * i, pi = idx & 1023, row = pi >> 4, ch = pi & 15; \
      if (idx < 2048) *(bf16x8*)(lds + (idx < 1024 ? OFF_Q : OFF_K) + off_b(row, ch)) = S_.sqk[i]; } \
    if (ts < 256) { *(bf16x8*)(lds + OFF_VA + att::v_st(vrow, vch * 8)) = S_.sv; \
      float f[8]; _Pragma("unroll") for (int j = 0; j < 8; ++j) f[j] = bf2f((unsigned short)S_.sv[j]) * S_.sawl; \
      u32x4 w; w.x = cvt_pk_bf16(f[0], f[1]); w.y = cvt_pk_bf16(f[2], f[3]); w.z = cvt_pk_bf16(f[4], f[5]); w.w = cvt_pk_bf16(f[6], f[7]); \
      *(u32x4*)(lds + OFF_VB + off_vb(vrow, vch)) = w; \
      const unsigned a = cvt_pk_bf16(S_.sawl, S_.sawl); u32x4 w2 = {a, a, a, a}; *(u32x4*)(lds + OFF_VB + off_vb(vrow, 4 + vch)) = w2; } \
    else { _Pragma("unroll") for (int j = 0; j < 2; ++j) { const int vi = ts - 256 + 128 * j; if (vi < 192) vec[vi] = S_.svec[j]; } } } } while (0)

  float* cst_l = (float*)(lds + OFF_CS) + (wid & 3) * 1024 + lane; float* nst_l = (float*)(lds + OFF_NS) + (wid & 3) * 1024 + lane;
  float m = 0.f;
  const int blk = wid - 2;
  MLOAD(sA, 0);
  asm volatile("s_waitcnt vmcnt(0)" ::: "memory");
  MWRITE(sA);
  if (wid >= 2 && wid < 6) {
#pragma unroll
    for (int g = 0; g < 4; ++g) { const unsigned a = off_b(r32, 4 * blk + g) + 8 * hi; *(u32x2*)(lds + OFF_C + a) = (u32x2){0u, 0u}; *(u32x2*)(lds + OFF_N + a) = (u32x2){0u, 0u}; }
#pragma unroll
    for (int r = 0; r < 16; ++r) { cst_l[r * 64] = 0.f; nst_l[r * 64] = 0.f; }
  }
  __syncthreads();
  const bf16x8 ones = {(short)0x3F80, (short)0x3F80, (short)0x3F80, (short)0x3F80, (short)0x3F80, (short)0x3F80, (short)0x3F80, (short)0x3F80};
  const int th = wid & 1;
  const unsigned hso = (unsigned)(((dir ? 63 - 32 * th - 4 * hi : 32 * th + 4 * hi) * D + hd * 256 + vs * 32 + r32) * 4);
  const int hstep = dir ? -(D * 4) : (D * 4);
#define CHUNK(c, LD_, WR_) do { \
    if ((c) + 1 < 64 && !(Tn.variant & 4)) MLOAD(LD_, (c) + 1); \
    const float pm63 = vec[128 + 63], bL = vec[63]; \
    const float Mx = fmaxf(m, pm63); \
    if (wid < 2 && !(Tn.variant & 1)) { \
      int ln_ = lane; asm volatile("" : "+v"(ln_)); \
      const int r32 = ln_ & 31, hi = ln_ >> 5; \
      f32x16 qc = {}, qn = {}, p0 = {}, p1 = {}; \
      f32x4 uv[8]; float pmt; \
      { \
          \
        bf16x8 qf[8], cf[4], nf[4]; \
        _Pragma("unroll") for (int ks = 0; ks < 8; ++ks) qf[ks] = *(const bf16x8*)(lds + OFF_Q + off_b(32 * th + r32, 2 * ks + hi)); \
        _Pragma("unroll") for (int hb_ = 0; hb_ < 2; ++hb_) { \
          _Pragma("unroll") for (int k4 = 0; k4 < 4; ++k4) { const int ks = hb_ * 4 + k4; \
            cf[k4] = *(const bf16x8*)(lds + OFF_C + off_b(r32, 2 * ks + hi)); nf[k4] = *(const bf16x8*)(lds + OFF_N + off_b(r32, 2 * ks + hi)); } \
          asm volatile("s_waitcnt lgkmcnt(0)" ::: "memory"); __builtin_amdgcn_sched_barrier(0); \
          _Pragma("unroll") for (int k4 = 0; k4 < 4; ++k4) { const int ks = hb_ * 4 + k4; \
            qc = __builtin_amdgcn_mfma_f32_32x32x16_bf16(qf[ks], cf[k4], qc, 0, 0, 0); \
            qn = __builtin_amdgcn_mfma_f32_32x32x16_bf16(qf[ks], nf[k4], qn, 0, 0, 0); } \
          __builtin_amdgcn_sched_barrier(0); } \
        _Pragma("unroll") for (int hb_ = 0; hb_ < 2; ++hb_) { \
          _Pragma("unroll") for (int k4 = 0; k4 < 4; ++k4) { const int ks = hb_ * 4 + k4; \
            cf[k4] = *(const bf16x8*)(lds + OFF_K + off_b(r32, 2 * ks + hi)); nf[k4] = *(const bf16x8*)(lds + OFF_K + off_b(32 + r32, 2 * ks + hi)); } \
          asm volatile("s_waitcnt lgkmcnt(0)" ::: "memory"); __builtin_amdgcn_sched_barrier(0); \
          _Pragma("unroll") for (int k4 = 0; k4 < 4; ++k4) { const int ks = hb_ * 4 + k4; \
            p0 = __builtin_amdgcn_mfma_f32_32x32x16_bf16(cf[k4], qf[ks], p0, 0, 0, 0); \
            p1 = __builtin_amdgcn_mfma_f32_32x32x16_bf16(nf[k4], qf[ks], p1, 0, 0, 0); } \
          __builtin_amdgcn_sched_barrier(0); } \
      } \
      _Pragma("unroll") for (int g = 0; g < 8; ++g) uv[g] = *(const f32x4*)(vec + 64 + 8 * (g & 3) + 4 * hi + 32 * (g >> 2)); \
      pmt = vec[128 + 32 * th + r32]; \
      asm volatile("s_waitcnt lgkmcnt(0)" ::: "memory"); __builtin_amdgcn_sched_barrier(0); \
      const int t = 32 * th + r32; \
      const float Mt = fmaxf(m, pmt); \
      _Pragma("unroll") for (int r = 0; r < 16; ++r) { const int s0 = att::crow(r, hi), s1 = 32 + s0; \
        float w0 = fast_exp(uv[r >> 2][r & 3] - Mt), w1 = fast_exp(uv[4 + (r >> 2)][r & 3] - Mt); w0 = (s0 <= t) ? w0 : 0.f; w1 = (s1 <= t) ? w1 : 0.f; \
        p0[r] *= w0; p1[r] *= w1; } \
      bf16x8 pa0, pa1, pa2, pa3; \
      PK4(p0, 0, pa0); PK4(p0, 8, pa1); PK4(p1, 0, pa2); PK4(p1, 8, pa3); \
      f32x16 pv = {}, pd = {}; \
      att::pv_one<0>(pv, (int)(lbase + OFF_VA) + att::v_rd_base(ln_), pa0, pa1, pa2, pa3); \
      pd = __builtin_amdgcn_mfma_f32_32x32x16_bf16(pa0, ones, pd, 0, 0, 0); \
      pd = __builtin_amdgcn_mfma_f32_32x32x16_bf16(pa1, ones, pd, 0, 0, 0); \
      pd = __builtin_amdgcn_mfma_f32_32x32x16_bf16(pa2, ones, pd, 0, 0, 0); \
      pd = __builtin_amdgcn_mfma_f32_32x32x16_bf16(pa3, ones, pd, 0, 0, 0); \
      char* hsb = (char*)Tn.hs + ((size_t)dir * T + TB(c)) * (D * 4); \
      f32x4 pmr[4], br[4]; \
      _Pragma("unroll") for (int g = 0; g < 4; ++g) { pmr[g] = *(const f32x4*)(vec + 128 + 32 * th + 4 * hi + 8 * g); br[g] = *(const f32x4*)(vec + 32 * th + 4 * hi + 8 * g); } \
      asm volatile("s_waitcnt lgkmcnt(0)" ::: "memory"); __builtin_amdgcn_sched_barrier(0); \
      _Pragma("unroll") for (int r = 0; r < 16; ++r) { const int rr = (r & 3) + 8 * (r >> 2); \
        const float Mr = fmaxf(m, pmr[r >> 2][r & 3]), gw = fast_exp(m - Mr), en = fast_exp(-(br[r >> 2][r & 3] + Mr)); \
        const float num = gw * qc[r] + pv[r], den = gw * qn[r] + pd[r]; \
        const float h = num * fast_rcp(fmaxf(fabsf(den), en)); \
        *(float*)(hsb + (unsigned)((int)hso + rr * hstep)) = h; } \
    } else if (wid >= 2 && wid < 6 && !(Tn.variant & 2)) { \
      int ln_ = lane; asm volatile("" : "+v"(ln_)); \
      const int hi = ln_ >> 5; \
      f32x16 kv = {}, kn = {}; \
      _Pragma("unroll") for (int ks = 0; ks < 4; ++ks) { \
        const unsigned hb = (ln_ >> 4) & 1, q = (ln_ & 15) >> 2, p = ln_ & 3; \
        const unsigned row0 = 16 * ks + 8 * hi + q; \
        const s16x4 ka = trr(lbase + OFF_K + off_b(row0, 4 * blk + 2 * hb + (p >> 1)) + 8 * (p & 1)); \
        const s16x4 kb = trr(lbase + OFF_K + off_b(row0 + 4, 4 * blk + 2 * hb + (p >> 1)) + 8 * (p & 1)); \
        const s16x4 va = trr(lbase + OFF_VB + off_vb(row0, 2 * hb + (p >> 1)) + 8 * (p & 1)); \
        const s16x4 vb_ = trr(lbase + OFF_VB + off_vb(row0 + 4, 2 * hb + (p >> 1)) + 8 * (p & 1)); \
        const s16x4 aa = trr(lbase + OFF_VB + off_vb(row0, 4 + 2 * hb + (p >> 1)) + 8 * (p & 1)); \
        const s16x4 ab = trr(lbase + OFF_VB + off_vb(row0 + 4, 4 + 2 * hb + (p >> 1)) + 8 * (p & 1)); \
        asm volatile("s_waitcnt lgkmcnt(0)" ::: "memory"); __builtin_amdgcn_sched_barrier(0); \
        const bf16x8 kf = PKV(ka, kb), vf = PKV(va, vb_), af = PKV(aa, ab); \
        kv = __builtin_amdgcn_mfma_f32_32x32x16_bf16(kf, vf, kv, 0, 0, 0); \
        kn = __builtin_amdgcn_mfma_f32_32x32x16_bf16(kf, af, kn, 0, 0, 0); \
      } \
      const float cw = fast_exp(m - Mx), sc = fast_exp(pm63 - Mx); \
      _Pragma("unroll") for (int r = 0; r < 16; ++r) { cst_l[r * 64] = cw * cst_l[r * 64] + sc * kv[r]; nst_l[r * 64] = cw * nst_l[r * 64] + sc * kn[r]; } \
    } \
    m = bL + Mx; \
    if (wid >= 2) asm volatile("s_waitcnt vmcnt(0)" ::: "memory");     \
    __syncthreads(); \
    if ((c) + 1 < 64) { \
      if (!(Tn.variant & 8)) MWRITE(WR_); \
      if (wid >= 2 && wid < 6) { \
        _Pragma("unroll") for (int g = 0; g < 4; ++g) { const unsigned a = off_b(r32, 4 * blk + g) + 8 * hi; \
          *(u32x2*)(lds + OFF_C + a) = (u32x2){cvt_pk_bf16(cst_l[(4 * g) * 64], cst_l[(4 * g + 1) * 64]), cvt_pk_bf16(cst_l[(4 * g + 2) * 64], cst_l[(4 * g + 3) * 64])}; \
          *(u32x2*)(lds + OFF_N + a) = (u32x2){cvt_pk_bf16(nst_l[(4 * g) * 64], nst_l[(4 * g + 1) * 64]), cvt_pk_bf16(nst_l[(4 * g + 2) * 64], nst_l[(4 * g + 3) * 64])}; } \
      } \
    } \
    __syncthreads(); \
  } while (0)
  for (int c = 0; c < 64; ++c) { CHUNK(c, sA, sA); }
#undef CHUNK
#undef TB
#undef MLOAD
#undef MWRITE
#undef QKO
}
}

#define XB_TMO      128
#define XB_XCNT(j)  (256  + 64 * (j))
#define XB_XSUB(j)  (1280 + 64 * (j))
#define XB_XGEN(j)  (2304 + 64 * (j))
#define XB_TOP      3328
#define XB_TOPGEN   3392
#define XCD_BAR_WORDS 3456
#define XB_SPIN_CAP (1u << 18)
__device__ __forceinline__ unsigned xb_ld(unsigned* p)              { return __hip_atomic_load(p, __ATOMIC_RELAXED, __HIP_MEMORY_SCOPE_AGENT); }
__device__ __forceinline__ unsigned xb_add(unsigned* p, unsigned v) { return __hip_atomic_fetch_add(p, v, __ATOMIC_RELAXED, __HIP_MEMORY_SCOPE_AGENT); }
__device__ __forceinline__ unsigned xb_xcc_id() { return (unsigned)__builtin_amdgcn_s_getreg((3 << 11) | 20) & 0xFu; }
#define XB_SPIN(cond, bar) do { unsigned _sp = 0; while (cond) { __builtin_amdgcn_s_sleep(1); \
    if ((++_sp & 255u) == 0u) { if (xb_ld(&(bar)[XB_TMO])) break; if (_sp > XB_SPIN_CAP) { atomicAdd(&(bar)[XB_TMO], 1u); break; } } } } while (0)
struct XcdBarrier { unsigned* bar; unsigned x; volatile LAS unsigned* st; };
__device__ __forceinline__ XcdBarrier xcd_barrier_post(unsigned* bar, volatile LAS unsigned* st) {
    XcdBarrier b; b.bar = bar; b.x = xb_xcc_id(); b.st = st;
    if (threadIdx.x == 0) (void)xb_add(&bar[XB_XCNT(b.x)], 1u);
    return b;
}
__device__ __forceinline__ void xcd_barrier_complete(unsigned* bar, unsigned x, unsigned& nloc, unsigned& nx) {
    const unsigned G = gridDim.x * gridDim.y * gridDim.z;
    unsigned sum, cnt, mine, sp = 0u;
    for (;;) {
        sum = 0u; cnt = 0u; mine = 0u;
#pragma unroll
        for (unsigned j = 0; j < 16; ++j) { const unsigned c = xb_ld(&bar[XB_XCNT(j)]); sum += c; cnt += (c > 0u) ? 1u : 0u; mine = (j == x) ? c : mine; }
        if (sum == G) break;
        __builtin_amdgcn_s_sleep(1);
        if ((++sp & 255u) == 0u) { if (xb_ld(&bar[XB_TMO])) break; if (sp > XB_SPIN_CAP) { atomicAdd(&bar[XB_TMO], 1u); break; } }
    }
    nloc = mine > 0u ? mine : 1u; nx = cnt > 0u ? cnt : 1u;
}
__device__ __forceinline__ void xcd_barrier(const XcdBarrier& b) {
    asm volatile("s_waitcnt vmcnt(0)" ::: "memory");
    __syncthreads();
    if (threadIdx.x == 0) {
        unsigned* bar = b.bar;
        __builtin_amdgcn_s_waitcnt(0);
        unsigned nloc = b.st[0], nx = b.st[1];
        if (nloc == 0u) { xcd_barrier_complete(bar, b.x, nloc, nx); b.st[0] = nloc; b.st[1] = nx; }
        const unsigned old = xb_add(&bar[XB_XSUB(b.x)], 1u);
        const unsigned gen = old / nloc;
        if (old + 1u == (gen + 1u) * nloc) {
            __builtin_amdgcn_fence(__ATOMIC_RELEASE, "agent");
            asm volatile("s_waitcnt vmcnt(0)" ::: "memory");
            const unsigned og = xb_add(&bar[XB_TOP], 1u);
            const unsigned tg = og / nx;
            if (og + 1u == (tg + 1u) * nx) xb_add(&bar[XB_TOPGEN], 1u);
            else XB_SPIN(xb_ld(&bar[XB_TOPGEN]) == tg, bar);
            __builtin_amdgcn_fence(__ATOMIC_ACQUIRE, "agent");
            xb_add(&bar[XB_XGEN(b.x)], 1u);
            asm volatile("s_waitcnt vmcnt(0)" ::: "memory");
        } else {
            XB_SPIN(xb_ld(&bar[XB_XGEN(b.x)]) == gen, bar);
            __builtin_amdgcn_fence(__ATOMIC_ACQUIRE, "agent");
            asm volatile("s_waitcnt vmcnt(0)" ::: "memory");
        }
    }
    __syncthreads();
}

struct Args { const float* in[24]; float* out; unsigned char* ws; int ph_lo, ph_hi, variant, pad; };
constexpr int NPH = 38;
struct Frame {
    char* lds; int tid, lane, wave, G, bid;
    unsigned char* ws;
};

struct CvtJob { const float* src; bf16_t* dst; int K, N, sld; int grp, gstride, goff; const float* sk; const float* sn; float oscale; };
template <bool FP8>
__device__ __forceinline__ void cvt_tiles(const Frame& F, const CvtJob& j, int& rot) {
    constexpr int RP = FP8 ? 16 : 8, KI = 8 * RP, ES = FP8 ? 1 : 2;
    const int tk = j.K / KI, tn = (j.N + 255) / 256, nt = tk * tn;
    int start = F.bid - (rot % F.G); if (start < 0) start += F.G;
    rot += nt;
    if (start >= nt) return;
    const int n4 = F.lane * 4, kq = F.wave;
    f32x4 v[RP], vn[RP];
#define CVT_LOAD(dst, it_) do { const int k0_ = ((it_) / tn) * KI + kq * RP, n0_ = ((it_) % tn) * 256 + n4; \
        if (n0_ < j.N) { _Pragma("unroll") for (int r = 0; r < RP; ++r) dst[r] = *(const f32x4*)(j.src + (size_t)(k0_ + r) * j.sld + n0_); } } while (0)
    CVT_LOAD(v, start);
    int buf = 0;
    for (int it = start; it < nt; it += F.G) {
        const bool has_next = it + F.G < nt;
        if (has_next) CVT_LOAD(vn, it + F.G);
        const int k0 = (it / tn) * KI, n0 = (it % tn) * 256;
        char* img = F.lds + buf * 32768;
        if (n0 + n4 < j.N) {
            if (j.sk) {
#pragma unroll
                for (int r = 0; r < RP; ++r) v[r] = v[r] * j.sk[k0 + kq * RP + r];
            }
            if (j.sn) { const f32x4 sn = *(const f32x4*)(j.sn + n0 + n4);
#pragma unroll
                for (int r = 0; r < RP; ++r) v[r] = v[r] * sn; }
#pragma unroll
            for (int c = 0; c < 4; ++c) {
                u32x4 w;
                if constexpr (FP8) { w.x = pack4_fp8(v[0][c] * j.oscale, v[1][c] * j.oscale, v[2][c] * j.oscale, v[3][c] * j.oscale); w.y = pack4_fp8(v[4][c] * j.oscale, v[5][c] * j.oscale, v[6][c] * j.oscale, v[7][c] * j.oscale);
                                     w.z = pack4_fp8(v[8 % RP][c] * j.oscale, v[9 % RP][c] * j.oscale, v[10 % RP][c] * j.oscale, v[11 % RP][c] * j.oscale); w.w = pack4_fp8(v[12 % RP][c] * j.oscale, v[13 % RP][c] * j.oscale, v[14 % RP][c] * j.oscale, v[15 % RP][c] * j.oscale); }
                else { w.x = cvt_pk_bf16(v[0][c], v[1][c]); w.y = cvt_pk_bf16(v[2][c], v[3][c]); w.z = cvt_pk_bf16(v[4][c], v[5][c]); w.w = cvt_pk_bf16(v[6][c], v[7][c]); }
                *(u32x4*)(img + (n4 + c) * 128 + ((kq ^ (F.lane & 7)) * 16)) = w;
            }
        }
        __syncthreads();
#pragma unroll
        for (int q = 0; q < 4; ++q) { const int id = F.tid + 512 * q, n = id >> 3, kc = id & 7;
            if (n0 + n < j.N) { const u32x4 w = *(const u32x4*)(img + n * 128 + ((kc ^ ((n >> 2) & 7)) * 16));
                const int nn = n0 + n, drow = (nn / j.grp) * j.gstride + j.goff + (nn % j.grp);
                *(u32x4*)((char*)j.dst + ((size_t)drow * j.K + k0) * ES + kc * 16) = w; } }
        buf ^= 1;
        if (has_next) {
#pragma unroll
            for (int r = 0; r < RP; ++r) v[r] = vn[r];
        }
    }
    __syncthreads();
#undef CVT_LOAD
}
__device__ __forceinline__ CvtJob mkjob(const float* src, bf16_t* dst, int K, int N, int sld) { CvtJob j; j.src = src; j.dst = dst; j.K = K; j.N = N; j.sld = sld; j.grp = N; j.gstride = 0; j.goff = 0; j.sk = nullptr; j.sn = nullptr; j.oscale = 1.f; return j; }

__device__ __forceinline__ void phase_convert_small(const Frame& F, const Args& a) {
    bf16_t* W = (bf16_t*)(F.ws + WS_W); int rot = 0;
    for (int j = 0; j < 2; ++j) {
        { CvtJob c = mkjob(a.in[2] + (size_t)j * D * MLA_IN, (bf16_t*)((char*)W + W_DQKV) + (size_t)j * MLA_INP * D, D, MLA_IN, MLA_IN); cvt_tiles<false>(F, c, rot); }
        { CvtJob c = mkjob(a.in[4] + (size_t)j * MLA_QR * MLA_QW, (bf16_t*)((char*)W + W_UQ) + (size_t)j * MLA_QW * MLA_QR, MLA_QR, MLA_QW, MLA_QW); c.sk = a.in[3] + j * MLA_QR; cvt_tiles<false>(F, c, rot); }
        { CvtJob c = mkjob(a.in[6] + (size_t)j * MLA_KVR * MLA_KVW, (bf16_t*)((char*)W + W_UKV) + (size_t)j * MLA_KVW * MLA_KVR, MLA_KVR, MLA_KVW, MLA_KVW); c.sk = a.in[5] + j * MLA_KVR; cvt_tiles<false>(F, c, rot); }
        { CvtJob c = mkjob(a.in[7] + (size_t)j * D * D, (bf16_t*)((char*)W + W_O) + (size_t)j * D * D, D, D, D); cvt_tiles<false>(F, c, rot); }
        { bf16_t* z = (bf16_t*)((char*)W + W_DQKV) + (size_t)j * MLA_INP * D + (size_t)MLA_IN * D;
          for (int i = F.bid * NTHR + F.tid; i < (MLA_INP - MLA_IN) * D / 8; i += F.G * NTHR) *(u32x4*)(z + (size_t)i * 8) = (u32x4){0u, 0u, 0u, 0u}; }
    }
    for (int g = 0; g < 4; ++g) { CvtJob c = mkjob(a.in[8] + (size_t)g * 256 * 256, (bf16_t*)((char*)W + W_POOL) + (size_t)g * 256 * 256, 256, 256, 256); c.sn = a.in[9] + g * 256; cvt_tiles<false>(F, c, rot); }
    { CvtJob c = mkjob(a.in[10], (bf16_t*)((char*)W + W_IN), D, ML_INP, ML_IN); cvt_tiles<false>(F, c, rot); }
    { CvtJob c = mkjob(a.in[14], (bf16_t*)((char*)W + W_OUT), D, D, D); cvt_tiles<false>(F, c, rot); }
    for (int j = 0; j < 2; ++j) {
        const bool f8 = j == 0 ? DENSE0_FP8 : DENSE1_FP8;
        { CvtJob c = mkjob(a.in[15] + (size_t)j * D * DFF, (bf16_t*)((char*)W + W_GU) + (size_t)j * 2 * DFF * D, D, DFF, DFF); c.grp = 128; c.gstride = 256; c.goff = 0; c.oscale = 64.f; if (f8) cvt_tiles<true>(F, c, rot); else cvt_tiles<false>(F, c, rot); }
        { CvtJob c = mkjob(a.in[16] + (size_t)j * D * DFF, (bf16_t*)((char*)W + W_GU) + (size_t)j * 2 * DFF * D, D, DFF, DFF); c.grp = 128; c.gstride = 256; c.goff = 128; c.oscale = 64.f; if (f8) cvt_tiles<true>(F, c, rot); else cvt_tiles<false>(F, c, rot); }
        { CvtJob c = mkjob(a.in[17] + (size_t)j * DFF * D, (bf16_t*)((char*)W + W_DN) + (size_t)j * D * DFF, DFF, D, D); c.oscale = 256.f; if (f8) cvt_tiles<true>(F, c, rot); else cvt_tiles<false>(F, c, rot); }
    }
    { const float* x = a.in[0]; bf16_t* xb = (bf16_t*)(F.ws + WS_XB);
      for (size_t i = (size_t)F.bid * NTHR + F.tid; i < (size_t)T * D / 8; i += (size_t)F.G * NTHR) {
          const f32x4 v0 = *(const f32x4*)(x + i * 8), v1 = *(const f32x4*)(x + i * 8 + 4);
          u32x4 w; w.x = cvt_pk_bf16(v0[0], v0[1]); w.y = cvt_pk_bf16(v0[2], v0[3]); w.z = cvt_pk_bf16(v1[0], v1[1]); w.w = cvt_pk_bf16(v1[2], v1[3]);
          *(u32x4*)(xb + i * 8) = w; } }
}
template <bool FP8>
__device__ __forceinline__ void phase_convert_moe(const Frame& F, const Args& a, int c) {
    constexpr int ES = FP8 ? 1 : 2;
    char* GU = (char*)(F.ws + WS_WMOE + WM_GU); char* DN = (char*)(F.ws + WS_WMOE + WM_DN); int rot = 0;
    for (int e = 0; e < NEXP; ++e) {
        const size_t eo = ((size_t)c * NEXP + e) * (size_t)D * DFFE;
        { CvtJob j = mkjob(a.in[19] + eo, (bf16_t*)(GU + (size_t)e * 2 * DFFE * D * ES), D, DFFE, DFFE); j.grp = 128; j.gstride = 256; j.goff = 0; j.oscale = 64.f; cvt_tiles<FP8>(F, j, rot); }
        { CvtJob j = mkjob(a.in[20] + eo, (bf16_t*)(GU + (size_t)e * 2 * DFFE * D * ES), D, DFFE, DFFE); j.grp = 128; j.gstride = 256; j.goff = 128; j.oscale = 64.f; cvt_tiles<FP8>(F, j, rot); }
        { CvtJob j = mkjob(a.in[21] + eo, (bf16_t*)(DN + (size_t)e * D * DFFE * ES), DFFE, D, D); j.oscale = 256.f; cvt_tiles<FP8>(F, j, rot); }
    }
}

template <int MODE>
__device__ __forceinline__ void phase_ln(const Frame& F, const float* xin, const bf16_t* y, float* xout, bf16_t* xb, const float* g, const float* b,
                                         const float* wproj  , const float* bgate) {
    constexpr bool MOE_IN = MODE & 1, ROUTER = (MODE & 2) != 0, GATES = (MODE & 4) != 0, FINAL = (MODE & 8) != 0, F8OUT = (MODE & 16) != 0;
    unsigned char* xb8 = (unsigned char*)(F.ws + WS_XB8);
    constexpr int NP = ROUTER ? 8 : (GATES ? 16 : 0); constexpr int NPA = NP ? NP : 4;
    float* wl = (float*)F.lds;
    int* sel = (int*)(F.lds + 65536);
    const int* toke = (const int*)(F.ws + WS_META + MT_TOKE); const float* tokw = (const float*)(F.ws + WS_META + MT_TOKW);
    if constexpr (NP != 0) {
        for (int i = F.tid; i < 1024 * NPA; i += NTHR) { const int c = i / NPA, p = i % NPA; wl[p * 1024 + c] = ROUTER ? wproj[c * 8 + p] : wproj[(size_t)c * ML_IN + ML_INP + p]; }
        __syncthreads();
    }
    f32x4 gg[4], bb[4];
#pragma unroll
    for (int j = 0; j < 4; ++j) { gg[j] = *(const f32x4*)(g + F.lane * 4 + 256 * j); bb[j] = *(const f32x4*)(b + F.lane * 4 + 256 * j); }
    for (int blk = F.bid; blk < T / 64; blk += F.G) {
        for (int rp = 0; rp < 8; rp += 2) {
            f32x4 v[2][4]; float w1[2] = {0.f, 0.f}, w2[2] = {0.f, 0.f};
#pragma unroll
            for (int u = 0; u < 2; ++u) { const int row = blk * 64 + F.wave * 8 + rp + u;
                if (MOE_IN) { w1[u] = tokw[row * 2]; w2[u] = tokw[row * 2 + 1]; } }
            f32x4 xv[2][4]; u32x2 ya[2][4], yb[2][4];
#pragma unroll
            for (int u = 0; u < 2; ++u) { const int row = blk * 64 + F.wave * 8 + rp + u;
#pragma unroll
                for (int j = 0; j < 4; ++j) { const int c = F.lane * 4 + 256 * j;
                    xv[u][j] = *(const f32x4*)(xin + (size_t)row * D + c);
                    if (MOE_IN) { ya[u][j] = *(const u32x2*)(y + (size_t)(2 * row) * D + c); yb[u][j] = *(const u32x2*)(y + (size_t)(2 * row + 1) * D + c); }
                    else ya[u][j] = *(const u32x2*)(y + (size_t)row * D + c); } }
#pragma unroll
            for (int u = 0; u < 2; ++u)
#pragma unroll
                for (int j = 0; j < 4; ++j) { const f32x4 fa = {bflo(ya[u][j].x), bfhi(ya[u][j].x), bflo(ya[u][j].y), bfhi(ya[u][j].y)}; f32x4 yv;
                    if (MOE_IN) { const f32x4 fb = {bflo(yb[u][j].x), bfhi(yb[u][j].x), bflo(yb[u][j].y), bfhi(yb[u][j].y)}; yv = fa * w1[u] + fb * w2[u]; } else yv = fa;
                    v[u][j] = xv[u][j] * DN_ALPHA + yv; }
            float mu[2], rstd[2];
#pragma unroll
            for (int u = 0; u < 2; ++u) { float s_ = 0.f;
#pragma unroll
                for (int j = 0; j < 4; ++j) s_ += (v[u][j][0] + v[u][j][1]) + (v[u][j][2] + v[u][j][3]);
                mu[u] = s_; }
            mu[0] = wave_sum(mu[0]) * (1.0f / 1024.0f); mu[1] = wave_sum(mu[1]) * (1.0f / 1024.0f);
#pragma unroll
            for (int u = 0; u < 2; ++u) { float q = 0.f;
#pragma unroll
                for (int j = 0; j < 4; ++j) { const f32x4 d = v[u][j] - mu[u]; q += (d[0] * d[0] + d[1] * d[1]) + (d[2] * d[2] + d[3] * d[3]); }
                rstd[u] = q; }
            rstd[0] = 1.0f / sqrtf(wave_sum(rstd[0]) * (1.0f / 1024.0f) + LN_EPS); rstd[1] = 1.0f / sqrtf(wave_sum(rstd[1]) * (1.0f / 1024.0f) + LN_EPS);
#pragma unroll
            for (int u = 0; u < 2; ++u) { const int row = blk * 64 + F.wave * 8 + rp + u, rr = rp + u;
#pragma unroll
            for (int j = 0; j < 4; ++j) { const int c = F.lane * 4 + 256 * j;
                v[u][j] = (v[u][j] - mu[u]) * rstd[u] * gg[j] + bb[j];
                *(f32x4*)(xout + (size_t)row * D + c) = v[u][j];
                if (!FINAL) { u32x2 w; w.x = cvt_pk_bf16(v[u][j][0], v[u][j][1]); w.y = cvt_pk_bf16(v[u][j][2], v[u][j][3]); *(u32x2*)(xb + (size_t)row * D + c) = w; }
                if (F8OUT) *(unsigned*)(xb8 + (size_t)row * D + c) = pack4_fp8(v[u][j][0], v[u][j][1], v[u][j][2], v[u][j][3]); }
            if constexpr (NP != 0) {
                float pr[NPA];
#pragma unroll
                for (int p = 0; p < NPA; ++p) pr[p] = 0.f;
#pragma unroll
                for (int j = 0; j < 4; ++j)
#pragma unroll
                    for (int p = 0; p < NPA; ++p) { const f32x4 wv = *(const f32x4*)(wl + p * 1024 + F.lane * 4 + 256 * j);
                        pr[p] += (v[u][j][0] * wv[0] + v[u][j][1] * wv[1]) + (v[u][j][2] * wv[2] + v[u][j][3] * wv[3]); }
                {
                    int np = NPA, msk = 32;
#pragma unroll
                    for (int st = 0; st < (NPA == 16 ? 4 : 3); ++st) { np >>= 1; const bool up = (F.lane & msk) != 0;
#pragma unroll
                        for (int k = 0; k < 8; ++k) if (k < np) { const float keep = up ? pr[k + np] : pr[k], send = up ? pr[k] : pr[k + np]; pr[k] = keep + __shfl_xor(send, msk); }
                        msk >>= 1; }
                    float tot = pr[0];
#pragma unroll
                    for (int o = (NPA == 16 ? 2 : 4); o >= 1; o >>= 1) tot += __shfl_xor(tot, o);
                    if (NPA == 16) { pr[0] = tot; } else { pr[0] = tot; }
                }
                if constexpr (ROUTER) {
                    { const float mine = pr[0];
#pragma unroll
                      for (int p = 0; p < 8; ++p) pr[p] = __shfl(mine, 8 * p); }
                    int e1 = 0; float v1 = pr[0];
#pragma unroll
                    for (int p = 1; p < 8; ++p) if (pr[p] > v1) { v1 = pr[p]; e1 = p; }
                    int e2 = -1; float v2 = -3.0e38f;
#pragma unroll
                    for (int p = 0; p < 8; ++p) if (p != e1 && pr[p] > v2) { v2 = pr[p]; e2 = p; }
                    const float ww2 = 1.0f / (1.0f + expf(v1 - v2)), ww1 = 1.0f - ww2;
                    if (F.lane == 0) { int* te = (int*)(F.ws + WS_META + MT_TOKE); float* tw = (float*)(F.ws + WS_META + MT_TOKW);
                        te[row * 2] = e1; te[row * 2 + 1] = e2; tw[row * 2] = ww1; tw[row * 2 + 1] = ww2;
                        sel[F.wave * 16 + rr * 2] = e1; sel[F.wave * 16 + rr * 2 + 1] = e2; }
                }
                if constexpr (GATES) { if ((F.lane & 3) == 0) { const int p = F.lane >> 2;
                        ((float*)(F.ws + WS_META + MT_GATES))[(size_t)row * 16 + p] = pr[0] + bgate[p]; } }
            }
            }
        }
        if constexpr (ROUTER) {
            __syncthreads();
            if (F.tid < 128) { const int e = sel[F.tid]; int rk = 0; for (int p = 0; p < F.tid; ++p) rk += (sel[p] == e) ? 1 : 0;
                const int row = blk * 64 + (F.tid >> 4) * 8 + ((F.tid & 15) >> 1);
                ((int*)(F.ws + WS_META + MT_RANK))[row * 2 + (F.tid & 1)] = rk; }
            if (F.tid >= 128 && F.tid < 136) { const int e = F.tid - 128; int cn = 0; for (int p = 0; p < 128; ++p) cn += (sel[p] == e) ? 1 : 0;
                ((int*)(F.ws + WS_META + MT_CNTW))[blk * 8 + e] = cn; }
            __syncthreads();
        }
    }
    (void)toke;
}

template <bool FP8>
__device__ __forceinline__ void phase_moe_permute(const Frame& F) {
    int* cl = (int*)F.lds;
    int* tot = cl + 2048; int* toff = cl + 2056; int* base = cl + 2072;
    const int* cntw = (const int*)(F.ws + WS_META + MT_CNTW);
    for (int i = F.tid; i < 2048; i += NTHR) cl[i] = cntw[i];
    __syncthreads();
    if (F.tid < 8) { int s = 0; for (int w = 0; w < 256; ++w) s += cl[w * 8 + F.tid]; tot[F.tid] = s; }
    __syncthreads();
    if (F.tid == 0) { int o = 0; for (int e = 0; e < 8; ++e) { toff[e] = o; o += (tot[e] + 255) >> 8; } toff[8] = o;
        if (F.bid == 0) { int* meta = (int*)(F.ws + WS_META + MT_MOE); for (int e = 0; e < 8; ++e) meta[e] = tot[e]; for (int e = 0; e < 9; ++e) meta[8 + e] = toff[e]; } }
    __syncthreads();
    const int* toke = (const int*)(F.ws + WS_META + MT_TOKE); const int* rank = (const int*)(F.ws + WS_META + MT_RANK);
    int* rowtok = (int*)(F.ws + WS_META + MT_ROWTOK);
    const bf16_t* xb = (const bf16_t*)(F.ws + WS_XB); bf16_t* xp = (bf16_t*)(F.ws + WS_SCR + SC_XP);
    for (int blk = F.bid; blk < T / 64; blk += F.G) {
        __syncthreads();
        if (F.tid < 8) { int s = 0; for (int w = 0; w < blk; ++w) s += cl[w * 8 + F.tid]; base[F.tid] = toff[F.tid] * 256 + s; }
        __syncthreads();
        for (int pp = F.wave; pp < 128; pp += NWAVES) {
            const int tok = blk * 64 + (pp >> 1), k = pp & 1, e = toke[tok * 2 + k], row = base[e] + rank[tok * 2 + k];
            if constexpr (FP8) {
                const u32x4 v0 = *(const u32x4*)(xb + (size_t)tok * D + F.lane * 16), v1 = *(const u32x4*)(xb + (size_t)tok * D + F.lane * 16 + 8);
                u32x4 w; w.x = pack4_fp8(bflo(v0.x), bfhi(v0.x), bflo(v0.y), bfhi(v0.y)); w.y = pack4_fp8(bflo(v0.z), bfhi(v0.z), bflo(v0.w), bfhi(v0.w));
                w.z = pack4_fp8(bflo(v1.x), bfhi(v1.x), bflo(v1.y), bfhi(v1.y)); w.w = pack4_fp8(bflo(v1.z), bfhi(v1.z), bflo(v1.w), bfhi(v1.w));
                *(u32x4*)((char*)xp + (size_t)row * D + F.lane * 16) = w;
            } else {
            const u32x4 v0 = *(const u32x4*)(xb + (size_t)tok * D + F.lane * 8), v1 = *(const u32x4*)(xb + (size_t)tok * D + 512 + F.lane * 8);
            *(u32x4*)(xp + (size_t)row * D + F.lane * 8) = v0; *(u32x4*)(xp + (size_t)row * D + 512 + F.lane * 8) = v1; }
            if (F.lane == 0) rowtok[row] = tok * 2 + k;
        }
    }
}

__device__ __forceinline__ void phase_mla_rows(const Frame& F, const int* positions) {
    const float* lat = (const float*)(F.ws + WS_SCR + SC_LAT);
    bf16_t* cqn = (bf16_t*)(F.ws + WS_SCR + SC_CQN); bf16_t* ckvn = (bf16_t*)(F.ws + WS_SCR + SC_CKVN); bf16_t* kr = (bf16_t*)(F.ws + WS_SCR + SC_KR);
    float* rope = (float*)(F.ws + WS_META + MT_ROPE);
    for (int row = F.bid * NWAVES + F.wave; row < T; row += F.G * NWAVES) {
        const float* lr = lat + (size_t)row * MLA_INP;
        float cq[6], ck[4]; float s1 = 0.f, s2 = 0.f;
#pragma unroll
        for (int j = 0; j < 6; ++j) { cq[j] = lr[F.lane + 64 * j]; s1 += cq[j] * cq[j]; }
#pragma unroll
        for (int j = 0; j < 4; ++j) { ck[j] = lr[MLA_QR + F.lane + 64 * j]; s2 += ck[j] * ck[j]; }
        const float r1 = 1.0f / sqrtf(wave_sum(s1) * (1.0f / MLA_QR) + RMS_EPS), r2 = 1.0f / sqrtf(wave_sum(s2) * (1.0f / MLA_KVR) + RMS_EPS);
#pragma unroll
        for (int j = 0; j < 6; ++j) cqn[(size_t)row * MLA_QR + F.lane + 64 * j] = (bf16_t)(cvt_pk_bf16(cq[j] * r1, 0.f) & 0xffffu);
#pragma unroll
        for (int j = 0; j < 4; ++j) ckvn[(size_t)row * MLA_KVR + F.lane + 64 * j] = (bf16_t)(cvt_pk_bf16(ck[j] * r2, 0.f) & 0xffffu);
        const float kx = lr[MLA_QR + MLA_KVR + F.lane];
        const float ko = __shfl_xor(kx, 32);
        const int i = F.lane & 31;
        const float invf = exp2f(-(float)i * (13.287712379549449f / 32.0f));
        const float ang = (float)positions[row] * invf;
        const double rev = (double)ang * 0.15915494309189535;
        const float fr = (float)(rev - floor(rev));
        const float sn = __builtin_amdgcn_sinf(fr), cs = __builtin_amdgcn_cosf(fr);
        const float out = (F.lane < 32) ? (kx * cs - ko * sn) : (kx * cs + ko * sn);
        kr[(size_t)row * MLA_ROPE + F.lane] = (bf16_t)(cvt_pk_bf16(out, 0.f) & 0xffffu);
        if (F.lane < 32) *(f32x2*)(rope + (size_t)row * 64 + 2 * i) = (f32x2){cs, sn};
    }
}

__device__ __forceinline__ void phase_pool_z(const Frame& F) {
    const float* x = (const float*)(F.ws + WS_X); bf16_t* z = (bf16_t*)(F.ws + WS_SCR + SC_Z);
    const int c = F.tid * 2, half = 1 << (c >> 8);
    for (int blk = F.bid; blk < T / 64; blk += F.G) {
        const int b0 = (blk * 64) / SEQ * SEQ, t0 = blk * 64 - b0;
        f32x2 sum = {0.f, 0.f};
        for (int s = t0 - half; s < t0 + half; ++s) if (s >= 0 && s < SEQ) { const f32x2 v = *(const f32x2*)(x + (size_t)(b0 + s) * D + c); sum += v; }
        for (int t = t0; t < t0 + 64; ++t) {
            const int lo = t - half < 0 ? 0 : t - half, hi = t + half > SEQ ? SEQ : t + half;
            const f32x2 xv = *(const f32x2*)(x + (size_t)(b0 + t) * D + c);
            const float inv = 1.0f / (float)(hi - lo);
            const f32x2 zz = sum * inv - xv;
            *(unsigned*)(z + (size_t)(b0 + t) * D + c) = cvt_pk_bf16(zz[0], zz[1]);
            if (t + half < SEQ) { const f32x2 v = *(const f32x2*)(x + (size_t)(b0 + t + half) * D + c); sum += v; }
            if (t - half >= 0) { const f32x2 v = *(const f32x2*)(x + (size_t)(b0 + t - half) * D + c); sum -= v; }
        }
    }
}

__device__ __forceinline__ void phase_mlstm_prep(const Frame& F, const float* convw) {
    const bf16_t* proj = (const bf16_t*)(F.ws + WS_SCR + SC_PROJ); bf16_t* qkc = (bf16_t*)(F.ws + WS_SCR + SC_QKC);
    const int c = F.tid * 2;
    float w0[5], w1[5];
#pragma unroll
    for (int j = 0; j < 5; ++j) { w0[j] = convw[j * 1024 + c]; w1[j] = convw[j * 1024 + c + 1]; }
    const float ksc = (c >= 512) ? 0.08838834764831845f : 1.0f;
    for (int blk = F.bid; blk < T / 64; blk += F.G) {
        const int b0 = (blk * 64) / SEQ * SEQ, t0 = blk * 64 - b0;
        float a0[5], a1[5];
#pragma unroll
        for (int j = 0; j < 4; ++j) { const int s = t0 - 2 + j; unsigned w = 0u; if (s >= 0 && s < SEQ) w = *(const unsigned*)(proj + (size_t)(b0 + s) * ML_INP + c); a0[j + 1] = bflo(w); a1[j + 1] = bfhi(w); }
        for (int t = t0; t < t0 + 64; ++t) {
#pragma unroll
            for (int j = 0; j < 4; ++j) { a0[j] = a0[j + 1]; a1[j] = a1[j + 1]; }
            { const int s = t + 2; unsigned w = 0u; if (s < SEQ) w = *(const unsigned*)(proj + (size_t)(b0 + s) * ML_INP + c); a0[4] = bflo(w); a1[4] = bfhi(w); }
            float r0 = 0.f, r1 = 0.f;
#pragma unroll
            for (int j = 0; j < 5; ++j) { r0 += a0[j] * w0[j]; r1 += a1[j] * w1[j]; }
            r0 = silu_f(r0) * ksc; r1 = silu_f(r1) * ksc;
            *(unsigned*)(qkc + (size_t)(b0 + t) * D + c) = cvt_pk_bf16(r0, r1);
        }
    }
    const float* gates = (const float*)(F.ws + WS_META + MT_GATES);
    float* gb = (float*)(F.ws + WS_META + MT_GVEC); float* gu = gb + 32 * SEQ; float* gpm = gu + 32 * SEQ; float* gawl = gpm + 32 * SEQ;
    for (int wg = F.bid * NWAVES + F.wave; wg < 32 * 64; wg += F.G * NWAVES) {
        const int chain = wg >> 6, cch = wg & 63, dir = chain >> 4, bb = (chain >> 2) & 3, hd = chain & 3;
        const int pos = cch * 64 + F.lane, tok = dir ? (SEQ - 1 - pos) : pos;
        const size_t row = (size_t)bb * SEQ + tok;
        const float li = gates[row * 16 + dir * 4 + hd], f = gates[row * 16 + 8 + dir * 4 + hd];
        const float lf = fminf(f, 0.f) - log1pf(expf(-fabsf(f)));
        float bsum = lf;
#pragma unroll
        for (int o = 1; o < 64; o <<= 1) { const float n = __shfl_up(bsum, o); if (F.lane >= o) bsum += n; }
        const float u = li - bsum;
        float pm = u;
#pragma unroll
        for (int o = 1; o < 64; o <<= 1) { const float n = __shfl_up(pm, o); if (F.lane >= o) pm = fmaxf(pm, n); }
        const float pm63 = __shfl(pm, 63);
        const size_t o_ = (size_t)chain * SEQ + pos;
        gb[o_] = bsum; gu[o_] = u; gpm[o_] = pm; gawl[o_] = expf(u - pm63);
    }
}

__device__ __forceinline__ void phase_mlstm_combine(const Frame& F, const float* norm_g) {
    const float* hs = (const float*)(F.ws + WS_SCR + SC_HS); const bf16_t* proj = (const bf16_t*)(F.ws + WS_SCR + SC_PROJ); bf16_t* ym = (bf16_t*)(F.ws + WS_SCR + SC_YM);
    for (int row = F.bid * NWAVES + F.wave; row < T; row += F.G * NWAVES) {
#pragma unroll
        for (int hd = 0; hd < 4; ++hd) { const int c = hd * 256 + F.lane * 4;
            const f32x4 h = *(const f32x4*)(hs + (size_t)row * D + c) + *(const f32x4*)(hs + (size_t)T * D + (size_t)row * D + c);
            const float mu = wave_sum((h[0] + h[1]) + (h[2] + h[3])) * (1.0f / 256.0f);
            const f32x4 d = h - mu;
            const float rstd = 1.0f / sqrtf(wave_sum((d[0] * d[0] + d[1] * d[1]) + (d[2] * d[2] + d[3] * d[3])) * (1.0f / 256.0f) + LN_EPS);
            const f32x4 gn = *(const f32x4*)(norm_g + c);
            const u32x2 ow = *(const u32x2*)(proj + (size_t)row * ML_INP + 2048 + c);
            const float o0 = bflo(ow.x), o1 = bfhi(ow.x), o2 = bflo(ow.y), o3 = bfhi(ow.y);
            const float y0 = d[0] * rstd * gn[0] * sigmoid_f(o0), y1 = d[1] * rstd * gn[1] * sigmoid_f(o1), y2 = d[2] * rstd * gn[2] * sigmoid_f(o2), y3 = d[3] * rstd * gn[3] * sigmoid_f(o3);
            *(u32x2*)(ym + (size_t)row * D + c) = (u32x2){cvt_pk_bf16(y0, y1), cvt_pk_bf16(y2, y3)}; }
    }
}

__global__ void __launch_bounds__(NTHR, 2) fwd_kernel(Args args) {
    extern __shared__ __attribute__((aligned(16))) unsigned char lds_raw[];
    Frame F;
    F.lds = (char*)lds_raw; F.tid = threadIdx.x; F.lane = F.tid & 63; F.wave = __builtin_amdgcn_readfirstlane(F.tid >> 6); F.G = gridDim.x; F.bid = blockIdx.x; F.ws = args.ws;
    LAS unsigned char* ldsl = (LAS unsigned char*)lds_raw;
    volatile LAS unsigned* MISC = (volatile LAS unsigned*)(ldsl + LDS_MISC);
    if (F.tid < 64) MISC[F.tid] = 0u;
    __syncthreads();
    const int lo = args.ph_lo, hi = args.ph_hi;
    XcdBarrier bar; bar.bar = (unsigned*)(args.ws + WS_CTL) + 4096; bar.x = 0; bar.st = nullptr;
    if (hi - lo > 1) bar = xcd_barrier_post((unsigned*)(args.ws + WS_CTL) + 4096, MISC + 8);
#ifndef EN_MASK
#define EN_MASK 0xffffffffu
#endif
#define EN(b) ((EN_MASK >> (b)) & 1u)
#define IN(k) (lo <= (k) && (k) < hi)
#define SEAM(k) do { if (IN(k) && IN((k) + 1)) xcd_barrier(bar); } while (0)
    int ph = 0;
#define PTRS size_t zoff_ = 0; asm volatile("" : "+s"(zoff_)); unsigned char* ws = args.ws + zoff_; F.ws = ws; unsigned char* scr = ws + WS_SCR; bf16_t* Wb = (bf16_t*)(ws + WS_W); \
    float* X = (float*)(ws + WS_X); bf16_t* XB = (bf16_t*)(ws + WS_XB); bf16_t* Y = (bf16_t*)(ws + WS_Y); const float* lng = args.in[22]; const float* lnb = args.in[23]; \
    (void)scr; (void)Wb; (void)X; (void)XB; (void)Y; (void)lng; (void)lnb;

    if (EN(0) && IN(ph)) { PTRS phase_convert_small(F, args); }
    SEAM(ph); ++ph;
    if (EN(0) && IN(ph)) { PTRS phase_convert_moe<MOE0_FP8>(F, args, 0); }
    SEAM(ph); ++ph;

#define GEMM_DENSE(EPI, Aptr, lda_, Bptr, ldb_, K_, Mrows, Ncols, epi) do { \
        pg8::Gemm g{(const bf16_t*)(Aptr), (const bf16_t*)(Bptr), (lda_), (ldb_), (K_)}; pg8::DenseOrder S; S.init((Mrows), (Ncols), F.G, F.bid); \
        pg8::gemm_phase<EPI, pg8::DenseOrder, true>(ldsl, g, S, epi); } while (0)

#define MLA_PHASES(j, xres, lnidx, LNMODE, wproj_) do { \
    if (EN(11) && IN(ph)) { PTRS  pg8::EpiF32 E{(float*)(scr + SC_LAT), MLA_INP}; GEMM_DENSE(pg8::EpiF32, XB, D, (char*)Wb + W_DQKV + (size_t)(j) * MLA_INP * D * 2, D, D, T, MLA_INP, E); } \
    SEAM(ph); ++ph; \
    if (EN(2) && IN(ph)) { PTRS phase_mla_rows(F, (const int*)args.in[1]); } \
    SEAM(ph); ++ph; \
    if (EN(12) && IN(ph)) { PTRS  { pg8::EpiBf16 E{(bf16_t*)(scr + SC_Q), MLA_QW}; GEMM_DENSE(pg8::EpiBf16, scr + SC_CQN, MLA_QR, (char*)Wb + W_UQ + (size_t)(j) * MLA_QW * MLA_QR * 2, MLA_QR, MLA_QR, T, MLA_QW, E); } \
                  { pg8::EpiBf16 E{(bf16_t*)(scr + SC_KV), MLA_KVW}; GEMM_DENSE(pg8::EpiBf16, scr + SC_CKVN, MLA_KVR, (char*)Wb + W_UKV + (size_t)(j) * MLA_KVW * MLA_KVR * 2, MLA_KVR, MLA_KVR, T, MLA_KVW, E); } } \
    SEAM(ph); ++ph; \
    if (EN(3) && IN(ph)) { PTRS  const int x8 = F.bid & 7, jj = F.bid >> 3, per = F.G >> 3; \
        for (int lu = jj; lu < 64; lu += per) { const int bh = x8 * 4 + (lu >> 4), qb = lu & 15, b_ = bh >> 3, h_ = bh & 7; const size_t r0 = (size_t)b_ * SEQ + (size_t)qb * 256; \
            att::attn_body((const bf16_t*)(scr + SC_Q) + r0 * MLA_QW + h_ * 192, (const float*)(ws + WS_META + MT_ROPE) + r0 * 64, \
                           (const bf16_t*)(scr + SC_KV) + (size_t)b_ * SEQ * MLA_KVW + h_ * 256, (const bf16_t*)(scr + SC_KV) + (size_t)b_ * SEQ * MLA_KVW + h_ * 256 + 128, \
                           (const bf16_t*)(scr + SC_KR) + (size_t)b_ * SEQ * MLA_ROPE, (bf16_t*)(scr + SC_O) + r0 * D + h_ * 128, SEQ, F.lds); } } \
    SEAM(ph); ++ph; \
    if (EN(13) && IN(ph)) { PTRS  pg8::EpiBf16 E{Y, D}; GEMM_DENSE(pg8::EpiBf16, scr + SC_O, D, (char*)Wb + W_O + (size_t)(j) * D * D * 2, D, D, T, D, E); } \
    SEAM(ph); ++ph; \
    if (EN(4) && IN(ph)) { PTRS phase_ln<LNMODE>(F, xres, Y, X, XB, lng + (lnidx) * D, lnb + (lnidx) * D, wproj_, nullptr); } \
    SEAM(ph); ++ph; } while (0)

#define DENSE_PHASES(c, lnidx, LNMODE, F8) do { \
    if (EN(14) && IN(ph)) { PTRS  pg8::DenseOrder S; S.init(T, 2 * DFF, F.G, F.bid); \
        if constexpr (F8) { pg8::Gemm g{(const bf16_t*)(ws + WS_XB8), (const bf16_t*)((char*)Wb + W_GU + (size_t)(c) * 2 * DFF * D * 2), D / 2, D / 2, D / 2}; \
            pg8::EpiSwiGLU8 E{(unsigned char*)(scr + SC_H), DFF, 8.0f}; pg8::gemm_phase<pg8::EpiSwiGLU8, pg8::DenseOrder, true, true>(ldsl, g, S, E, 127, 121); } \
        else { pg8::Gemm g{(const bf16_t*)XB, (const bf16_t*)((char*)Wb + W_GU + (size_t)(c) * 2 * DFF * D * 2), D, D, D}; \
            pg8::EpiSwiGLU E{(bf16_t*)(scr + SC_H), DFF}; pg8::gemm_phase<pg8::EpiSwiGLU, pg8::DenseOrder, true>(ldsl, g, S, E); } } \
    SEAM(ph); ++ph; \
    if (EN(15) && IN(ph)) { PTRS  pg8::DenseOrder S; S.init(T, D, F.G, F.bid); pg8::EpiBf16 E{Y, D}; \
        if constexpr (F8) { pg8::Gemm g{(const bf16_t*)(scr + SC_H), (const bf16_t*)((char*)Wb + W_DN + (size_t)(c) * D * DFF * 2), DFF / 2, DFF / 2, DFF / 2}; \
            pg8::gemm_phase<pg8::EpiBf16, pg8::DenseOrder, true, true>(ldsl, g, S, E, 124, 119); } \
        else { pg8::Gemm g{(const bf16_t*)(scr + SC_H), (const bf16_t*)((char*)Wb + W_DN + (size_t)(c) * D * DFF * 2), DFF, DFF, DFF}; \
            pg8::gemm_phase<pg8::EpiBf16, pg8::DenseOrder, true>(ldsl, g, S, E); } } \
    SEAM(ph); ++ph; \
    if (EN(4) && IN(ph)) { PTRS phase_ln<LNMODE>(F, X, Y, X, XB, lng + (lnidx) * D, lnb + (lnidx) * D, nullptr, nullptr); } \
    SEAM(ph); ++ph; } while (0)

#define MOE_PHASES(c, lnidx, LNMODE, xout_, wproj_, bgate_, F8) do { \
    if (EN(6) && IN(ph)) { PTRS phase_moe_permute<F8>(F); } \
    SEAM(ph); ++ph; \
    if (EN(7) && IN(ph)) { PTRS  pg8::MoeOrder S; S.build_table((const int*)(ws + WS_META + MT_MOE), (LAS int*)(ldsl + LDS_MISC + 1024), 2 * DFFE, F.G, F.bid); \
        if constexpr (F8) { pg8::Gemm g{(const bf16_t*)(scr + SC_XP), (const bf16_t*)(ws + WS_WMOE + WM_GU), D / 2, D / 2, D / 2}; \
            pg8::EpiSwiGLU8 E{(unsigned char*)(scr + SC_HM), DFFE, 8.0f}; pg8::gemm_phase<pg8::EpiSwiGLU8, pg8::MoeOrder, true, true>(ldsl, g, S, E, 127, 121); } \
        else { pg8::Gemm g{(const bf16_t*)(scr + SC_XP), (const bf16_t*)(ws + WS_WMOE + WM_GU), D, D, D}; \
            pg8::EpiSwiGLU E{(bf16_t*)(scr + SC_HM), DFFE}; pg8::gemm_phase<pg8::EpiSwiGLU, pg8::MoeOrder, true>(ldsl, g, S, E); } } \
    SEAM(ph); ++ph; \
    if (EN(7) && IN(ph)) { PTRS  pg8::MoeOrder S; S.build_table((const int*)(ws + WS_META + MT_MOE), (LAS int*)(ldsl + LDS_MISC + 1024), D, F.G, F.bid); \
        pg8::EpiBf16Scatter E{(bf16_t*)(scr + SC_Y2), (const int*)(ws + WS_META + MT_ROWTOK)}; \
        if constexpr (F8) { pg8::Gemm g{(const bf16_t*)(scr + SC_HM), (const bf16_t*)(ws + WS_WMOE + WM_DN), DFFE / 2, DFFE / 2, DFFE / 2}; pg8::gemm_phase<pg8::EpiBf16Scatter, pg8::MoeOrder, true, true>(ldsl, g, S, E, 124, 119); } \
        else { pg8::Gemm g{(const bf16_t*)(scr + SC_HM), (const bf16_t*)(ws + WS_WMOE + WM_DN), DFFE, DFFE, DFFE}; pg8::gemm_phase<pg8::EpiBf16Scatter, pg8::MoeOrder, true>(ldsl, g, S, E); } } \
    SEAM(ph); ++ph; \
    if (EN(4) && IN(ph)) { PTRS phase_ln<LNMODE>(F, X, (const bf16_t*)(scr + SC_Y2), xout_, XB, lng + (lnidx) * D, lnb + (lnidx) * D, wproj_, bgate_); } \
    SEAM(ph); ++ph; } while (0)

    MLA_PHASES(0, args.in[0], 0, (DENSE0_FP8 ? 16 : 0), nullptr);
    DENSE_PHASES(0, 1, 0, DENSE0_FP8);
    if (EN(5) && IN(ph)) { PTRS phase_pool_z(F); }
    SEAM(ph); ++ph;
    if (EN(16) && IN(ph)) { PTRS  pg8::Gemm g{(const bf16_t*)(scr + SC_Z), (const bf16_t*)((char*)Wb + W_POOL), D, 256, 256}; pg8::PoolOrder S; S.init(T, D, F.G, F.bid);
        pg8::EpiBf16 E{Y, D}; pg8::gemm_phase<pg8::EpiBf16, pg8::PoolOrder, true>(ldsl, g, S, E); }
    SEAM(ph); ++ph;
    if (EN(4) && IN(ph)) { PTRS phase_ln<2>(F, X, Y, X, XB, lng + 2 * D, lnb + 2 * D, args.in[18], nullptr); }
    SEAM(ph); ++ph;
    MOE_PHASES(0, 3, 1 | 4, X, args.in[10], args.in[12], MOE0_FP8);
    if (EN(0) && IN(ph)) { PTRS phase_convert_moe<MOE1_FP8>(F, args, 1); }
    SEAM(ph); ++ph;
    if (EN(17) && IN(ph)) { PTRS  pg8::EpiBf16 E{(bf16_t*)(scr + SC_PROJ), ML_INP}; GEMM_DENSE(pg8::EpiBf16, XB, D, (char*)Wb + W_IN, D, D, T, ML_INP, E); }
    SEAM(ph); ++ph;
    if (EN(8) && IN(ph)) { PTRS phase_mlstm_prep(F, args.in[11]); }
    SEAM(ph); ++ph;
    if (EN(9) && IN(ph)) { PTRS  mls::Tensors Tn; Tn.qkc = (const bf16_t*)(scr + SC_QKC); Tn.proj = (const bf16_t*)(scr + SC_PROJ);
        Tn.gvec = (const float*)(ws + WS_META + MT_GVEC); Tn.hs = (float*)(scr + SC_HS); Tn.variant = args.variant;
        for (int u = F.bid; u < 256; u += F.G) { const int x8 = u & 7, jj = u >> 3; mls::scan_unit(Tn, (x8 * 4 + (jj >> 3)) * 8 + (jj & 7), F.lds); } }
    SEAM(ph); ++ph;
    if (EN(10) && IN(ph)) { PTRS phase_mlstm_combine(F, args.in[13]); }
    SEAM(ph); ++ph;
    if (EN(18) && IN(ph)) { PTRS  pg8::EpiBf16 E{Y, D}; GEMM_DENSE(pg8::EpiBf16, scr + SC_YM, D, (char*)Wb + W_OUT, D, D, T, D, E); }
    SEAM(ph); ++ph;
    if (EN(4) && IN(ph)) { PTRS phase_ln<(DENSE1_FP8 ? 16 : 0)>(F, X, Y, X, XB, lng + 4 * D, lnb + 4 * D, nullptr, nullptr); }
    SEAM(ph); ++ph;
    DENSE_PHASES(1, 5, 0, DENSE1_FP8);
    MLA_PHASES(1, X, 6, 2, args.in[18] + (size_t)D * NEXP);
    MOE_PHASES(1, 7, 1 | 8, args.out, nullptr, nullptr, MOE1_FP8);
#undef IN
#undef SEAM
}

extern "C" void kernel_launch(void* const* d_in, const int* in_sizes, int n_in, void* d_out, int out_size, void* d_ws, size_t ws_size, hipStream_t stream) {
    static int grid = 0;
    if (grid == 0) {
        if (n_in != 24 || in_sizes[0] != T * D || out_size != T * D || ws_size < WS_END) {
            fprintf(stderr, "kernel_launch: shape mismatch: n_in %d in0 %d out %d ws %zu (need %zu)\n", n_in, n_in > 0 ? in_sizes[0] : -1, out_size, ws_size, (size_t)WS_END); grid = -1; return; }
        int dev = 0, cus = 0, per_cu = 0;
        if (hipGetDevice(&dev) != hipSuccess || hipDeviceGetAttribute(&cus, hipDeviceAttributeMultiprocessorCount, dev) != hipSuccess) { grid = -1; return; }
        if (hipFuncSetAttribute((const void*)fwd_kernel, hipFuncAttributeMaxDynamicSharedMemorySize, LDS_BYTES) != hipSuccess) { fprintf(stderr, "kernel_launch: hipFuncSetAttribute failed\n"); grid = -1; return; }
        if (hipOccupancyMaxActiveBlocksPerMultiprocessor(&per_cu, (const void*)fwd_kernel, NTHR, LDS_BYTES) != hipSuccess || per_cu < 1)
            fprintf(stderr, "kernel_launch: occupancy query reports %d blocks per CU\n", per_cu);
        (void)hipGetLastError();
        grid = cus;
    }
    if (grid < 0) return;
    if (hipMemsetAsync((char*)d_ws + WS_CTL, 0, CTL_ZERO_BYTES, stream) != hipSuccess) { fprintf(stderr, "kernel_launch: memset failed\n"); return; }
    Args a{};
    for (int i = 0; i < 24; ++i) a.in[i] = (const float*)d_in[i];
    a.out = (float*)d_out; a.ws = (unsigned char*)d_ws;
#ifndef MK_ONE_LAUNCH
#define MK_ONE_LAUNCH 1
#endif
    if (MK_ONE_LAUNCH) { a.ph_lo = 0; a.ph_hi = NPH; hipLaunchKernelGGL(fwd_kernel, dim3(grid), dim3(NTHR), LDS_BYTES, stream, a);
#ifdef PROBE_PHASE
#ifndef PROBE_VARIANT
#define PROBE_VARIANT 0
#endif
        for (int r = 0; r < PROBE_REPS; ++r) { a.ph_lo = PROBE_PHASE; a.ph_hi = PROBE_PHASE + 1; a.variant = PROBE_VARIANT; hipLaunchKernelGGL(fwd_kernel, dim3(grid), dim3(NTHR), LDS_BYTES, stream, a); }
#endif
    }
    else for (int p = 0; p < NPH; ++p) { a.ph_lo = p; a.ph_hi = p + 1; hipLaunchKernelGGL(fwd_kernel, dim3(grid), dim3(NTHR), LDS_BYTES, stream, a); }
    const hipError_t le = hipPeekAtLastError();
    if (le != hipSuccess) fprintf(stderr, "kernel_launch: launch failed: %s\n", hipGetErrorName(le));
}
```

```cpp
#include <hip/hip_runtime.h>
#include <cstdio>
#include <cstdint>

#define LAS __attribute__((address_space(3)))
#define GAS __attribute__((address_space(1)))
typedef unsigned short bf16_t;
typedef short bf16x8 __attribute__((ext_vector_type(8)));
typedef short s16x4 __attribute__((ext_vector_type(4)));
typedef float f32x4 __attribute__((ext_vector_type(4)));
typedef float f32x2 __attribute__((ext_vector_type(2)));
typedef float f32x16 __attribute__((ext_vector_type(16)));
typedef unsigned u32x4 __attribute__((ext_vector_type(4)));
typedef unsigned u32x2 __attribute__((ext_vector_type(2)));
typedef GAS unsigned gu32;

constexpr int BATCH = 4, SEQ = 4096, T = BATCH * SEQ, D = 1024;
constexpr float DN_ALPHA = 1.6817928305074290f;
constexpr float LN_EPS = 1e-5f, RMS_EPS = 1e-6f;
constexpr int MLA_H = 8, MLA_QR = 384, MLA_KVR = 256, MLA_NOPE = 128, MLA_ROPE = 64, MLA_V = 128, MLA_IN = 704, MLA_INP = 768;
constexpr int MLA_QW = MLA_H * (MLA_NOPE + MLA_ROPE);
constexpr int MLA_KVW = MLA_H * (MLA_NOPE + MLA_V);
constexpr int ML_H = 4, ML_DK = 128, ML_DV = 256, ML_IN = 3088, ML_INP = 3072;
constexpr int DFF = 2816, NEXP = 8, DFFE = 3584;
constexpr int MOE_MAXT = 136;
constexpr int NWAVES = 8, NTHR = 512;

#ifndef DENSE0_FP8
#define DENSE0_FP8 false
#endif
#ifndef DENSE1_FP8
#define DENSE1_FP8 true
#endif
#ifndef MOE0_FP8
#define MOE0_FP8 true
#endif
#ifndef MOE1_FP8
#define MOE1_FP8 true
#endif
constexpr size_t MiB = 1u << 20;
constexpr size_t WS_CTL = 0, CTL_ZERO_BYTES = 1 * MiB;
constexpr size_t WS_META = 1 * MiB;
constexpr size_t MT_CNTW = 0;
constexpr size_t MT_MOE = 16384;
constexpr size_t MT_TOKE = 32768;
constexpr size_t MT_TOKW = MT_TOKE + (size_t)T * 8;
constexpr size_t MT_RANK = MT_TOKW + (size_t)T * 8;
constexpr size_t MT_ROWTOK = MT_RANK + (size_t)T * 8;
constexpr size_t MT_GATES = 1 * MiB;
constexpr size_t MT_GVEC = 2 * MiB;
constexpr size_t MT_ROPE = 4 * MiB;
static_assert(MT_ROWTOK + (size_t)MOE_MAXT * 256 * 4 <= MT_GATES, "meta map");
constexpr size_t WS_W = 17 * MiB;
constexpr size_t W_DQKV = 0;
constexpr size_t W_UQ = W_DQKV + 2 * (size_t)MLA_INP * D * 2;
constexpr size_t W_UKV = W_UQ + 2 * (size_t)MLA_QW * MLA_QR * 2;
constexpr size_t W_O = W_UKV + 2 * (size_t)MLA_KVW * MLA_KVR * 2;
constexpr size_t W_POOL = W_O + 2 * (size_t)D * D * 2;
constexpr size_t W_IN = W_POOL + 4 * (size_t)256 * 256 * 2;
constexpr size_t W_OUT = W_IN + (size_t)ML_INP * D * 2;
constexpr size_t W_GU = W_OUT + (size_t)D * D * 2;
constexpr size_t W_DN = W_GU + 2 * (size_t)2 * DFF * D * 2;
constexpr size_t W_END = W_DN + 2 * (size_t)D * DFF * 2;
static_assert(W_END <= 55 * MiB, "weights map");
constexpr size_t WS_WMOE = 72 * MiB;
constexpr size_t WM_GU = 0, WM_DN = (size_t)NEXP * 2 * DFFE * D * 2;
static_assert(WM_DN + (size_t)NEXP * D * DFFE * 2 == 168 * MiB, "moe weights map");
constexpr size_t WS_X = 240 * MiB;
constexpr size_t WS_XB = 304 * MiB;
constexpr size_t WS_Y = 336 * MiB;
constexpr size_t WS_XB8 = 368 * MiB;
constexpr size_t WS_SCR = 400 * MiB;
constexpr size_t WS_END = 834 * MiB;
constexpr size_t SC_LAT = 0, SC_CQN = 48 * MiB, SC_CKVN = 60 * MiB, SC_KR = 68 * MiB, SC_Q = 70 * MiB, SC_KV = 118 * MiB, SC_O = 182 * MiB;
constexpr size_t SC_H = 0;
constexpr size_t SC_Z = 0;
constexpr size_t SC_XP = 0, SC_HM = 68 * MiB, SC_Y2 = 306 * MiB;
static_assert(SC_Y2 + (size_t)2 * T * D * 4 == 434 * MiB, "moe scratch");
constexpr size_t SC_PROJ = 0, SC_QKC = 96 * MiB, SC_HS = 128 * MiB, SC_YM = 256 * MiB;

constexpr int LDS_MAIN = 159744;
constexpr int LDS_MISC = LDS_MAIN;
constexpr int LDS_BYTES = 163840;

#define RLX_AGENT __ATOMIC_RELAXED, __HIP_MEMORY_SCOPE_AGENT
__device__ __forceinline__ unsigned cvt_pk_bf16(float lo, float hi) { unsigned r; asm volatile("v_cvt_pk_bf16_f32 %0, %1, %2" : "=v"(r) : "v"(lo), "v"(hi)); return r; }
__device__ __forceinline__ float bf2f(unsigned short b) { return __builtin_bit_cast(float, (unsigned)b << 16); }
__device__ __forceinline__ float bflo(unsigned w) { return __builtin_bit_cast(float, w << 16); }
__device__ __forceinline__ float bfhi(unsigned w) { return __builtin_bit_cast(float, w & 0xffff0000u); }
__device__ __forceinline__ float wave_sum(float v) {
#pragma unroll
    for (int o = 32; o >= 1; o >>= 1) v += __shfl_xor(v, o);
    return v;
}
__device__ __forceinline__ unsigned pack4_fp8(float a, float b, float c, float d) {
    a = __builtin_amdgcn_fmed3f(a, -448.f, 448.f); b = __builtin_amdgcn_fmed3f(b, -448.f, 448.f); c = __builtin_amdgcn_fmed3f(c, -448.f, 448.f); d = __builtin_amdgcn_fmed3f(d, -448.f, 448.f);
    int w = __builtin_amdgcn_cvt_pk_fp8_f32(a, b, 0, false); w = __builtin_amdgcn_cvt_pk_fp8_f32(c, d, w, true); return (unsigned)w; }
__device__ __forceinline__ float fast_exp(float x) { return __builtin_amdgcn_exp2f(x * 1.4426950408889634f); }
__device__ __forceinline__ float fast_rcp(float x) { return __builtin_amdgcn_rcpf(x); }
__device__ __forceinline__ float silu_f(float x) { return x * fast_rcp(1.0f + fast_exp(-x)); }
__device__ __forceinline__ float sigmoid_f(float x) { return fast_rcp(1.0f + fast_exp(-x)); }

namespace pg8 {
constexpr int BM = 256, BK = 64, HALF = 128, HTB = HALF * BK * 2, STAGE_BYTES = 8 * HTB, NXCD = 8, WGM = 8;
__host__ __device__ __forceinline__ int lds_byte(int r, int c) { const int st = (r >> 4) * 2 + (c >> 5), rr = r & 15, cc = c & 31, ob = rr * 64 + cc * 2; return st * 1024 + (ob ^ (((ob >> 9) & 1) << 5)); }
__host__ __device__ __forceinline__ void stage_rc(int b, int& R, int& C) { const int st = b / 1024, sb = b % 1024, swz = sb ^ (((sb >> 9) & 1) << 5); R = (st >> 1) * 16 + swz / 64; C = (st & 1) * 32 + (swz % 64) / 2; }
__host__ __device__ __forceinline__ int perm32(int rho) { const int n = rho >> 4, i = rho & 15; return 8 * (i >> 2) + 4 * n + (i & 3); }

struct Unit { int pm, pn, e, nv; };
struct Gemm { const bf16_t* A; const bf16_t* Bt; int lda, ldb, K; };

struct DenseOrder {
    int nM, nN, nwg, G, c;
    __device__ __forceinline__ void init(int M, int N, int G_, int c_) { nM = M / BM; nN = N / BM; nwg = nM * nN; G = G_; c = c_; }
    __device__ __forceinline__ bool next(int i, Unit& u) const {
        const long L = (long)i * G + c; if (L >= nwg) return false;
        int wgid = (int)L; { const int q = nwg / NXCD, r = nwg % NXCD, xcd = wgid % NXCD, off = wgid / NXCD; wgid = (xcd < r ? xcd * (q + 1) : r * (q + 1) + (xcd - r) * q) + off; }
        const int nig = WGM * nN, gid = wgid / nig, fm = gid * WGM, gsz = (nM - fm) < WGM ? (nM - fm) : WGM;
        u.pm = fm + ((wgid % nig) % gsz); u.pn = (wgid % nig) / gsz; u.e = 0; u.nv = 256; return true;
    }
    __device__ __forceinline__ const char* a_tile(const Unit& u, const Gemm& g) const { return (const char*)g.A + (size_t)u.pm * BM * g.lda * 2; }
    __device__ __forceinline__ const char* b_tile(const Unit& u, const Gemm& g) const { return (const char*)g.Bt + (size_t)u.pn * BM * g.ldb * 2; }
};
struct PoolOrder : DenseOrder {
    __device__ __forceinline__ const char* a_tile(const Unit& u, const Gemm& g) const { return (const char*)g.A + ((size_t)u.pm * BM * g.lda + (size_t)u.pn * 256) * 2; }
    __device__ __forceinline__ const char* b_tile(const Unit& u, const Gemm& g) const { return (const char*)g.Bt + (size_t)u.pn * 256 * 256 * 2; }
};
struct MoeOrder {
    const LAS int* tab; int ntiles, nN, Nexp, G, c;
    __device__ __forceinline__ void build_table(const int* meta, LAS int* tabw, int Nexp_, int G_, int c_) {
        const int tid = threadIdx.x;
        if (tid < MOE_MAXT) {
            int e = 0;
#pragma unroll
            for (int k = 1; k < 8; ++k) e += (tid >= meta[8 + k]) ? 1 : 0;
            const int rem = meta[e] - (tid - meta[8 + e]) * 256;
            tabw[2 * tid] = e; tabw[2 * tid + 1] = rem < 256 ? rem : 256;
        }
        ntiles = __builtin_amdgcn_readfirstlane(meta[16]);
        __syncthreads();
        tab = tabw; Nexp = Nexp_; nN = Nexp_ / BM; G = G_; c = c_;
    }
    __device__ __forceinline__ bool next(int i, Unit& u) const {
        const long L = (long)i * G + c; if (L >= (long)ntiles * nN) return false;
        const int rt = (int)(L / nN); u.pn = (int)(L % nN); u.pm = rt;
        u.e = __builtin_amdgcn_readfirstlane(tab[2 * rt]); u.nv = __builtin_amdgcn_readfirstlane(tab[2 * rt + 1]); return true;
    }
    __device__ __forceinline__ const char* a_tile(const Unit& u, const Gemm& g) const { return (const char*)g.A + (size_t)u.pm * BM * g.lda * 2; }
    __device__ __forceinline__ const char* b_tile(const Unit& u, const Gemm& g) const { return (const char*)g.Bt + ((size_t)u.e * Nexp + (size_t)u.pn * BM) * g.ldb * 2; }
};

struct EpiF32 {
    static constexpr bool PERM = false;
    float* C; int ldc;
    __device__ __forceinline__ void operator()(const f32x4 (&acc)[2][2][4][2], const Unit& u, int wr, int wc, int fr, int fq) const {
        const int row0 = u.pm * BM + wr * 64 + fr, col0 = u.pn * BM + wc * 32 + 4 * fq;
#pragma unroll
        for (int ai = 0; ai < 2; ++ai)
#pragma unroll
            for (int m = 0; m < 4; ++m) { float* rowp = C + (size_t)(row0 + ai * HALF + m * 16) * ldc + col0;
#pragma unroll
                for (int bj = 0; bj < 2; ++bj)
#pragma unroll
                    for (int n = 0; n < 2; ++n) *(f32x4*)(rowp + bj * HALF + n * 16) = acc[ai][bj][m][n]; }
    }
};
struct EpiF32Scatter {
    static constexpr bool PERM = false;
    float* C; const int* rowtok;
    __device__ __forceinline__ void operator()(const f32x4 (&acc)[2][2][4][2], const Unit& u, int wr, int wc, int fr, int fq) const {
        const int col0 = u.pn * BM + wc * 32 + 4 * fq;
#pragma unroll
        for (int ai = 0; ai < 2; ++ai)
#pragma unroll
            for (int m = 0; m < 4; ++m) { const int rl = ai * HALF + wr * 64 + m * 16 + fr;
                if (rl < u.nv) { const int dst = rowtok[u.pm * BM + rl]; float* rowp = C + (size_t)dst * D + col0;
#pragma unroll
                    for (int bj = 0; bj < 2; ++bj)
#pragma unroll
                        for (int n = 0; n < 2; ++n) *(f32x4*)(rowp + bj * HALF + n * 16) = acc[ai][bj][m][n]; } }
    }
};
struct EpiBf16Scatter {
    static constexpr bool PERM = true;
    bf16_t* O; const int* rowtok;
    __device__ __forceinline__ void operator()(const f32x4 (&acc)[2][2][4][2], const Unit& u, int wr, int wc, int fr, int fq) const {
        const int col0 = u.pn * BM + wc * 32 + 8 * fq;
#pragma unroll
        for (int ai = 0; ai < 2; ++ai)
#pragma unroll
            for (int m = 0; m < 4; ++m) { const int rl = ai * HALF + wr * 64 + m * 16 + fr;
                if (rl < u.nv) { const int dst = rowtok[u.pm * BM + rl]; bf16_t* rowp = O + (size_t)dst * D + col0;
#pragma unroll
                    for (int bj = 0; bj < 2; ++bj) { const f32x4 v0 = acc[ai][bj][m][0], v1 = acc[ai][bj][m][1];
                        u32x4 w; w.x = cvt_pk_bf16(v0[0], v0[1]); w.y = cvt_pk_bf16(v0[2], v0[3]); w.z = cvt_pk_bf16(v1[0], v1[1]); w.w = cvt_pk_bf16(v1[2], v1[3]);
                        *(u32x4*)(rowp + bj * HALF) = w; } } }
    }
};
struct EpiBf16 {
    static constexpr bool PERM = true;
    bf16_t* O; int ldc;
    __device__ __forceinline__ void operator()(const f32x4 (&acc)[2][2][4][2], const Unit& u, int wr, int wc, int fr, int fq) const {
        const int row0 = u.pm * BM + wr * 64 + fr, col0 = u.pn * BM + wc * 32 + 8 * fq;
#pragma unroll
        for (int ai = 0; ai < 2; ++ai)
#pragma unroll
            for (int m = 0; m < 4; ++m) { bf16_t* rowp = O + (size_t)(row0 + ai * HALF + m * 16) * ldc + col0;
#pragma unroll
                for (int bj = 0; bj < 2; ++bj) { const f32x4 v0 = acc[ai][bj][m][0], v1 = acc[ai][bj][m][1];
                    u32x4 w; w.x = cvt_pk_bf16(v0[0], v0[1]); w.y = cvt_pk_bf16(v0[2], v0[3]); w.z = cvt_pk_bf16(v1[0], v1[1]); w.w = cvt_pk_bf16(v1[2], v1[3]);
                    *(u32x4*)(rowp + bj * HALF) = w; } }
    }
};
struct EpiSwiGLU {
    static constexpr bool PERM = true;
    bf16_t* O; int ldc;
    __device__ __forceinline__ void operator()(const f32x4 (&acc)[2][2][4][2], const Unit& u, int wr, int wc, int fr, int fq) const {
        const int row0 = u.pm * BM + wr * 64 + fr, col0 = u.pn * HALF + wc * 32 + 8 * fq;
#pragma unroll
        for (int ai = 0; ai < 2; ++ai)
#pragma unroll
            for (int m = 0; m < 4; ++m) { bf16_t* rowp = O + (size_t)(row0 + ai * HALF + m * 16) * ldc + col0;
                float h[8];
#pragma unroll
                for (int n = 0; n < 2; ++n)
#pragma unroll
                    for (int i = 0; i < 4; ++i) h[n * 4 + i] = silu_f(acc[ai][0][m][n][i]) * acc[ai][1][m][n][i];
                u32x4 w; w.x = cvt_pk_bf16(h[0], h[1]); w.y = cvt_pk_bf16(h[2], h[3]); w.z = cvt_pk_bf16(h[4], h[5]); w.w = cvt_pk_bf16(h[6], h[7]);
                *(u32x4*)rowp = w; }
    }
};

struct EpiSwiGLU8 {
    static constexpr bool PERM = true;
    unsigned char* O; int ldc; float oscale;
    __device__ __forceinline__ void operator()(const f32x4 (&acc)[2][2][4][2], const Unit& u, int wr, int wc, int fr, int fq) const {
        const int row0 = u.pm * BM + wr * 64 + fr, col0 = u.pn * HALF + wc * 32 + 8 * fq;
#pragma unroll
        for (int ai = 0; ai < 2; ++ai)
#pragma unroll
            for (int m = 0; m < 4; ++m) { unsigned char* rowp = O + (size_t)(row0 + ai * HALF + m * 16) * ldc + col0;
                float h[8];
#pragma unroll
                for (int n = 0; n < 2; ++n)
#pragma unroll
                    for (int i = 0; i < 4; ++i) h[n * 4 + i] = silu_f(acc[ai][0][m][n][i]) * acc[ai][1][m][n][i] * oscale;
                u32x2 w; w.x = pack4_fp8(h[0], h[1], h[2], h[3]); w.y = pack4_fp8(h[4], h[5], h[6], h[7]);
                *(u32x2*)rowp = w; }
    }
};

typedef int v8i32 __attribute__((ext_vector_type(8)));
template <class Epi, class Sched, bool ALIGN_EPI = true, bool FP8 = false>
__device__ __forceinline__ void gemm_phase(LAS unsigned char* lds, const Gemm g, const Sched& S, const Epi& E, int sclA = 127, int sclB = 127) {
    const int tid = threadIdx.x, wid = __builtin_amdgcn_readfirstlane(tid >> 6), lane = tid & 63, wr = wid >> 2, wc = wid & 3, fr = lane & 15, fq = lane >> 4;
    const int sclA4 = sclA * 0x01010101, sclB4 = sclB * 0x01010101; (void)sclA4; (void)sclB4;
    int K = g.K; asm volatile("" : "+s"(K));
    const int nt = K / BK;
    unsigned voffA[2], voffB[2];
#pragma unroll
    for (int i = 0; i < 2; ++i) { int R, C; stage_rc(tid * 16 + i * 8192, R, C); const int Rb = Epi::PERM ? ((R & ~31) + perm32(R & 31)) : R;
        voffA[i] = (unsigned)(R * g.lda + C) * 2u; voffB[i] = (unsigned)(Rb * g.ldb + C) * 2u; }
    const size_t kstep = (size_t)(BK * 2);
    const size_t hstepA = (size_t)HALF * g.lda * 2, hstepB = (size_t)HALF * g.ldb * 2;
    const unsigned ldsw = (unsigned)wid * 1024u;
    const int aoff = lds_byte(wr * 64 + fr, fq * 8), boff = lds_byte(wc * 32 + fr, fq * 8);
#define PG8_SA(b, h) (((b) * 2 + (h)) * HTB)
#define PG8_SB(b, h) ((4 + (b) * 2 + (h)) * HTB)
#define PG8_STAGE(bufoff, gbase, voff) do { _Pragma("unroll") for (int _i = 0; _i < 2; ++_i) \
        __builtin_amdgcn_global_load_lds((const unsigned*)((const char*)(gbase) + (voff)[_i]), (LAS unsigned*)(lds + (bufoff) + ldsw + _i * 8192), 16, 0, 0); } while (0)
#define PG8_LDA(dst, b, h) do { _Pragma("unroll") for (int m = 0; m < 4; ++m) _Pragma("unroll") for (int k = 0; k < 2; ++k) dst[m][k] = *(const LAS bf16x8*)(lds + PG8_SA(b, h) + aoff + m * 2048 + k * 1024); } while (0)
#define PG8_LDB(dst, b, h) do { _Pragma("unroll") for (int n = 0; n < 2; ++n) _Pragma("unroll") for (int k = 0; k < 2; ++k) dst[n][k] = *(const LAS bf16x8*)(lds + PG8_SB(b, h) + boff + n * 2048 + k * 1024); } while (0)
#define PG8_CAT(x0, x1) __builtin_shufflevector(__builtin_bit_cast(u32x4, x0), __builtin_bit_cast(u32x4, x1), 0, 1, 2, 3, 4, 5, 6, 7)
#define PG8_MMA(ai, bj, At, Bt) do { __builtin_amdgcn_s_setprio(1); \
        if constexpr (FP8) { _Pragma("unroll") for (int m = 0; m < 4; ++m) _Pragma("unroll") for (int n = 0; n < 2; ++n) \
            asm volatile("v_mfma_scale_f32_16x16x128_f8f6f4 %0, %1, %2, %0, %3, %4 op_sel_hi:[0,0,0]" : "+v"(acc[ai][bj][m][n]) \
                : "v"(__builtin_bit_cast(v8i32, PG8_CAT(Bt[n][0], Bt[n][1]))), "v"(__builtin_bit_cast(v8i32, PG8_CAT(At[m][0], At[m][1]))), "v"(sclB4), "v"(sclA4)); } \
        else { _Pragma("unroll") for (int m = 0; m < 4; ++m) _Pragma("unroll") for (int n = 0; n < 2; ++n) _Pragma("unroll") for (int k = 0; k < 2; ++k) \
            acc[ai][bj][m][n] = __builtin_amdgcn_mfma_f32_16x16x32_bf16(Bt[n][k], At[m][k], acc[ai][bj][m][n], 0, 0, 0); } \
        __builtin_amdgcn_s_setprio(0); } while (0)
#define PG8_WAIT_V(n) asm volatile("s_waitcnt vmcnt(" #n ")" ::: "memory")
#define PG8_WAIT_L(n) asm volatile("s_waitcnt lgkmcnt(" #n ")" ::: "memory")
#define PG8_BAR __builtin_amdgcn_s_barrier()
#define PG8_SCHED __builtin_amdgcn_sched_barrier(0)
    Unit cur, nxt; int ui = 0;
    if (!S.next(0, cur)) return;
    f32x4 acc[2][2][4][2];
#pragma unroll
    for (int a = 0; a < 2; ++a)
#pragma unroll
        for (int b = 0; b < 2; ++b)
#pragma unroll
            for (int m = 0; m < 4; ++m)
#pragma unroll
                for (int n = 0; n < 2; ++n) acc[a][b][m][n] = (f32x4){0.f, 0.f, 0.f, 0.f};
    bf16x8 At[4][2], B0[2][2], B1[2][2];
    const char* cA = S.a_tile(cur, g); const char* cB = S.b_tile(cur, g);
    PG8_STAGE(PG8_SB(0, 0), cB, voffB); PG8_STAGE(PG8_SB(0, 1), cB + hstepB, voffB); PG8_STAGE(PG8_SA(0, 0), cA, voffA); PG8_STAGE(PG8_SA(0, 1), cA + hstepA, voffA);
    if (wr == 1) PG8_BAR;
    PG8_WAIT_V(2); PG8_BAR;
    PG8_STAGE(PG8_SB(1, 0), cB + kstep, voffB); PG8_STAGE(PG8_SA(1, 0), cA + kstep, voffA); PG8_STAGE(PG8_SB(1, 1), cB + hstepB + kstep, voffB);
    PG8_WAIT_V(6); PG8_BAR;
    for (;;) {
        const bool has_next = S.next(ui + 1, nxt);
        const char* nA = has_next ? S.a_tile(nxt, g) : cA; const char* nB = has_next ? S.b_tile(nxt, g) : cB;
        for (int t = 0; t < nt; t += 2) {
            const bool last = (t == nt - 2);
            const char* a1 = cA + (size_t)(t + 1) * kstep;
            const char* a2 = last ? nA : cA + (size_t)(t + 2) * kstep; const char* b2 = last ? nB : cB + (size_t)(t + 2) * kstep;
            const char* a3 = a2 + kstep; const char* b3 = b2 + kstep;
            PG8_LDB(B0, 0, 0); PG8_LDB(B1, 0, 1); PG8_SCHED; PG8_LDA(At, 0, 0); PG8_STAGE(PG8_SA(1, 1), a1 + hstepA, voffA);
            PG8_WAIT_V(8); PG8_WAIT_L(0); PG8_BAR; PG8_MMA(0, 0, At, B0); PG8_MMA(0, 1, At, B1); PG8_BAR; PG8_SCHED;
            PG8_LDA(At, 0, 1); PG8_STAGE(PG8_SB(0, 0), b2, voffB); PG8_STAGE(PG8_SB(0, 1), b2 + hstepB, voffB); PG8_STAGE(PG8_SA(0, 0), a2, voffA);
            PG8_WAIT_V(8); PG8_WAIT_L(0); PG8_BAR; PG8_MMA(1, 0, At, B0); PG8_MMA(1, 1, At, B1); PG8_BAR; PG8_SCHED;
            PG8_LDB(B0, 1, 0); PG8_LDB(B1, 1, 1); PG8_SCHED; PG8_LDA(At, 1, 0); PG8_STAGE(PG8_SA(0, 1), a2 + hstepA, voffA);
            PG8_WAIT_V(8); PG8_WAIT_L(0); PG8_BAR; PG8_MMA(0, 0, At, B0); PG8_MMA(0, 1, At, B1); PG8_BAR; PG8_SCHED;
            PG8_LDA(At, 1, 1); PG8_STAGE(PG8_SB(1, 0), b3, voffB); PG8_STAGE(PG8_SB(1, 1), b3 + hstepB, voffB); PG8_STAGE(PG8_SA(1, 0), a3, voffA);
            PG8_WAIT_V(8); PG8_WAIT_L(0); PG8_BAR; PG8_MMA(1, 0, At, B0); PG8_MMA(1, 1, At, B1); PG8_BAR; PG8_SCHED;
        }
        if constexpr (ALIGN_EPI) { if (wr == 0) PG8_BAR; }
        if constexpr (FP8) asm volatile("s_nop 15\n\ts_nop 15" ::: "memory");
        { int ln_ = lane; asm volatile("" : "+v"(ln_));
          E(acc, cur, wr, wc, ln_ & 15, ln_ >> 4); }
        if (!has_next) break;
#pragma unroll
        for (int a = 0; a < 2; ++a)
#pragma unroll
            for (int b = 0; b < 2; ++b)
#pragma unroll
                for (int m = 0; m < 4; ++m)
#pragma unroll
                    for (int n = 0; n < 2; ++n) acc[a][b][m][n] = (f32x4){0.f, 0.f, 0.f, 0.f};
        cur = nxt; cA = nA; cB = nB; ++ui;
        if constexpr (ALIGN_EPI) { if (wr == 1) PG8_BAR; }
    }
    PG8_WAIT_V(0);
    if constexpr (!ALIGN_EPI) { if (wr == 0) PG8_BAR; }
    PG8_BAR;
#undef PG8_SA
#undef PG8_SB
#undef PG8_STAGE
#undef PG8_LDA
#undef PG8_LDB
#undef PG8_MMA
#undef PG8_CAT
#undef PG8_WAIT_V
#undef PG8_WAIT_L
#undef PG8_BAR
#undef PG8_SCHED
}
}

#ifndef ATT_SDEPTH
#define ATT_SDEPTH 1
#endif
namespace att {
constexpr int NW = 8, QBLK = 32, KVBLK = 64;
constexpr float SCALE = 0.07216878364870322f;
constexpr float THR = 8.f;
constexpr int LDQ = MLA_QW, LDK = MLA_KVW, LDKR = MLA_ROPE, LDO = D;
constexpr int SHM_V = KVBLK * 128 * 2, SHM_K = KVBLK * 128 * 2, SHM_KR = KVBLK * 64 * 2;
constexpr int NBUF = 3;
constexpr int OFF_V = 0, OFF_K = NBUF * SHM_V, OFF_KR = OFF_K + NBUF * SHM_K, OFF_WS = OFF_KR + NBUF * SHM_KR, OFF_QR = OFF_WS + NW * 64 * 4, SHM_ATTN = OFF_QR + NW * 4096;
static_assert(SHM_ATTN <= LDS_MAIN, "attention LDS");
#define KSWZ(row, colB) ((row) * 256 + ((colB) ^ (((row) & 7) << 4)))
#define KRSWZ(row, colB) ((row) * 128 + ((colB) ^ ((((row) >> 1) & 7) << 4)))
#define SBAR() __builtin_amdgcn_sched_barrier(0)
__device__ __forceinline__ int crow(int r, int hi) { return (r & 3) + 8 * (r >> 2) + 4 * hi; }

__device__ __forceinline__ void partialSM(f32x16& p0, f32x16& p1, float& m_reg, float& mn, float& alpha) {
  constexpr float C = SCALE * 1.4426950408889634f;
  float pmax = p0[0];
#pragma unroll
  for (int r = 1; r < 16; ++r) pmax = fmaxf(pmax, p0[r]);
#pragma unroll
  for (int r = 0; r < 16; ++r) pmax = fmaxf(pmax, p1[r]);
  { auto rr = __builtin_amdgcn_permlane32_swap(__float_as_uint(pmax), __float_as_uint(pmax), false, false);
    pmax = fmaxf(__uint_as_float(rr[0]), __uint_as_float(rr[1])); }
  if (__builtin_expect(__all(pmax - m_reg <= THR / SCALE), 1)) { mn = m_reg; alpha = 1.f; }
  else { mn = fmaxf(m_reg, pmax); alpha = __builtin_amdgcn_exp2f((m_reg - mn) * C); m_reg = mn; }
  float mnC = -mn * C;
#pragma unroll
  for (int r = 0; r < 16; ++r) p0[r] = fmaf(p0[r], C, mnC);
#pragma unroll
  for (int r = 0; r < 16; ++r) p1[r] = fmaf(p1[r], C, mnC);
#pragma unroll
  for (int r = 0; r < 16; ++r) p0[r] = __builtin_amdgcn_exp2f(p0[r]);
}
__device__ __forceinline__ void finishSM(f32x16& p0, f32x16& p1, float alpha, float& l_reg, bf16x8& pa0, bf16x8& pa1, bf16x8& pa2, bf16x8& pa3) {
#pragma unroll
  for (int r = 0; r < 16; ++r) p1[r] = __builtin_amdgcn_exp2f(p1[r]);
  float ps = 0;
#pragma unroll
  for (int r = 0; r < 16; ++r) ps += p0[r];
#pragma unroll
  for (int r = 0; r < 16; ++r) ps += p1[r];
  { auto rr = __builtin_amdgcn_permlane32_swap(__float_as_uint(ps), __float_as_uint(ps), false, false);
    ps = __uint_as_float(rr[0]) + __uint_as_float(rr[1]); }
  l_reg = l_reg * alpha + ps;
#define PK4(P, BASE, OUT) do { unsigned a0 = cvt_pk_bf16(P[BASE + 0], P[BASE + 1]), a1 = cvt_pk_bf16(P[BASE + 2], P[BASE + 3]);   \
    unsigned b0 = cvt_pk_bf16(P[BASE + 4], P[BASE + 5]), b1 = cvt_pk_bf16(P[BASE + 6], P[BASE + 7]);                              \
    auto r0 = __builtin_amdgcn_permlane32_swap(a0, b0, false, false); auto r1 = __builtin_amdgcn_permlane32_swap(a1, b1, false, false); \
    u32x4 w = {r0[0], r1[0], r0[1], r1[1]}; OUT = __builtin_bit_cast(bf16x8, w); } while (0)
  PK4(p0, 0, pa0); PK4(p0, 8, pa1); PK4(p1, 0, pa2); PK4(p1, 8, pa3);
}
__device__ __forceinline__ void qkt(f32x16& p0, f32x16& p1, const char* Ks, const char* Krs, const bf16x8* qr, const char* qrl, int r32, int hi) {
  p0 = f32x16{}; p1 = f32x16{};
#pragma unroll
  for (int d0 = 0; d0 < 8; ++d0) { const int cb = (d0 * 16 + hi * 8) * 2;
    bf16x8 b0 = *reinterpret_cast<const bf16x8*>(Ks + KSWZ(r32, cb));
    bf16x8 b1 = *reinterpret_cast<const bf16x8*>(Ks + KSWZ(32 + r32, cb));
    p0 = __builtin_amdgcn_mfma_f32_32x32x16_bf16(b0, qr[d0], p0, 0, 0, 0);
    p1 = __builtin_amdgcn_mfma_f32_32x32x16_bf16(b1, qr[d0], p1, 0, 0, 0); }
#pragma unroll
  for (int d0 = 0; d0 < 4; ++d0) { const int cb = (d0 * 16 + hi * 8) * 2;
    bf16x8 b0 = *reinterpret_cast<const bf16x8*>(Krs + KRSWZ(r32, cb));
    bf16x8 b1 = *reinterpret_cast<const bf16x8*>(Krs + KRSWZ(32 + r32, cb));
    const bf16x8 qq = *reinterpret_cast<const bf16x8*>(qrl + d0 * 1024);
    p0 = __builtin_amdgcn_mfma_f32_32x32x16_bf16(b0, qq, p0, 0, 0, 0);
    p1 = __builtin_amdgcn_mfma_f32_32x32x16_bf16(b1, qq, p1, 0, 0, 0); }
}
__device__ __forceinline__ int v_st(int k, int c) { const int kk = (k & ~0xC) | ((k & 4) << 1) | ((k & 8) >> 1); return ((kk >> 3) * 4 + (c >> 5)) * 512 + ((kk & 7) * 32 + (c & 31)) * 2; }
__device__ __forceinline__ int v_rd_base(int lane) { return ((lane & 3) << 3) | (((lane >> 2) & 3) << 6) | (((lane >> 4) & 1) << 5) | (((lane >> 5) & 1) << 8); }
constexpr int v_rd_off(int d0, int ks, int half) { return d0 * 512 + ks * 4096 + half * 2048; }
template <int OFF> __device__ __forceinline__ s16x4 tr_read(int vb) {
  s16x4 r; asm volatile("ds_read_b64_tr_b16 %0, %1 offset:%2" : "=&v"(r) : "v"(vb), "i"(OFF) : "memory"); return r;
}
#define PKV(L, H) (bf16x8){L[0], L[1], L[2], L[3], H[0], H[1], H[2], H[3]}
template <int D0> __device__ __forceinline__ void pv_one(f32x16& od, int vb, bf16x8 pa0, bf16x8 pa1, bf16x8 pa2, bf16x8 pa3) {
  const s16x4 l0 = tr_read<v_rd_off(D0, 0, 0)>(vb), h0 = tr_read<v_rd_off(D0, 0, 1)>(vb), l1 = tr_read<v_rd_off(D0, 1, 0)>(vb), h1 = tr_read<v_rd_off(D0, 1, 1)>(vb);
  const s16x4 l2 = tr_read<v_rd_off(D0, 2, 0)>(vb), h2 = tr_read<v_rd_off(D0, 2, 1)>(vb), l3 = tr_read<v_rd_off(D0, 3, 0)>(vb), h3 = tr_read<v_rd_off(D0, 3, 1)>(vb);
  asm volatile("s_waitcnt lgkmcnt(0)" ::: "memory"); SBAR();
  od = __builtin_amdgcn_mfma_f32_32x32x16_bf16(pa0, PKV(l0, h0), od, 0, 0, 0);
  od = __builtin_amdgcn_mfma_f32_32x32x16_bf16(pa1, PKV(l1, h1), od, 0, 0, 0);
  od = __builtin_amdgcn_mfma_f32_32x32x16_bf16(pa2, PKV(l2, h2), od, 0, 0, 0);
  od = __builtin_amdgcn_mfma_f32_32x32x16_bf16(pa3, PKV(l3, h3), od, 0, 0, 0);
}
__device__ __forceinline__ void pv_d0(f32x16* o, int vb, bf16x8 pa0, bf16x8 pa1, bf16x8 pa2, bf16x8 pa3) {
  pv_one<0>(o[0], vb, pa0, pa1, pa2, pa3); pv_one<1>(o[1], vb, pa0, pa1, pa2, pa3); pv_one<2>(o[2], vb, pa0, pa1, pa2, pa3); pv_one<3>(o[3], vb, pa0, pa1, pa2, pa3);
}

__device__ __forceinline__ void attn_body(const bf16_t* __restrict__ Qb, const float* __restrict__ cs, const bf16_t* __restrict__ Kn, const bf16_t* __restrict__ Vh,
                                          const bf16_t* __restrict__ Kr, bf16_t* __restrict__ Ob, int seq, char* lds) {
  int tid = threadIdx.x; asm volatile("" : "+v"(tid));
  const int wid = tid >> 6, lane = tid & 63, r32 = lane & 31, hi = lane >> 5;
  char* V_lds = lds + OFF_V; char* K_lds = lds + OFF_K; char* KR_lds = lds + OFF_KR;
  float* ws = (float*)(lds + OFF_WS) + wid * 64; float* li_l = ws; float* al_l = ws + 32;
  float m_reg = -1e30f, l_reg = 0; f32x16 o[4] = {}; bf16x8 qr[8];
  char* qrl = lds + OFF_QR + wid * 4096 + lane * 16;
  { const int qrow = wid * QBLK + r32;
    const unsigned qoff = (unsigned)(qrow * LDQ + hi * 8) * 2u;
    const char* Qc = (const char*)Qb;
    bf16x8 qro[4];
#pragma unroll
    for (int d0 = 0; d0 < 8; ++d0) qr[d0] = *reinterpret_cast<const bf16x8*>(Qc + qoff + d0 * 32);
#pragma unroll
    for (int d0 = 0; d0 < 4; ++d0) qro[d0] = *reinterpret_cast<const bf16x8*>(Qc + qoff + 256 + d0 * 32);
    const char* csc = (const char*)cs; const unsigned csoff = (unsigned)qrow * 256u;
#pragma unroll
    for (int a = 0; a < 2; ++a) {
      const int i0 = a * 16 + hi * 8;
      bf16x8 x1 = qro[a], x2 = qro[2 + a], y1, y2;
#pragma unroll
      for (int j = 0; j < 8; ++j) {
        const f32x2 c_s = *reinterpret_cast<const f32x2*>(csc + csoff + 8 * (i0 + j));
        const float f1 = bf2f((unsigned short)x1[j]), f2 = bf2f((unsigned short)x2[j]);
        const float g1 = f1 * c_s.x - f2 * c_s.y, g2 = f2 * c_s.x + f1 * c_s.y;
        const unsigned pk = cvt_pk_bf16(g1, g2);
        y1[j] = (short)(pk & 0xffffu); y2[j] = (short)(pk >> 16);
      }
      *reinterpret_cast<bf16x8*>(qrl + a * 1024) = y1; *reinterpret_cast<bf16x8*>(qrl + (2 + a) * 1024) = y2;
    }
  }
  const int sr = tid >> 4, sc = (tid & 15) * 8, vst0 = v_st(sr, sc), vst1 = v_st(32 + sr, sc);
  const int krr = tid >> 3, krc = (tid & 7) * 8;
  const int vb0 = (int)(uintptr_t)V_lds + v_rd_base(lane);
  constexpr int SDEPTH = 1;
  struct { bf16x8 vs0, vs1, ks0, ks1, kr0; } sr_[SDEPTH];
  const unsigned vo0 = (unsigned)(sr * LDK + sc) * 2u, vo1 = (unsigned)((32 + sr) * LDK + sc) * 2u, kro = (unsigned)(krr * LDKR + krc) * 2u;
#define SLOAD(i, k0) do { const char* vt_ = (const char*)Vh + (size_t)(k0) * (LDK * 2); const char* kt_ = (const char*)Kn + (size_t)(k0) * (LDK * 2); const char* krt_ = (const char*)Kr + (size_t)(k0) * (LDKR * 2); \
    sr_[i].vs0 = *reinterpret_cast<const bf16x8*>(vt_ + vo0); sr_[i].vs1 = *reinterpret_cast<const bf16x8*>(vt_ + vo1); \
    sr_[i].ks0 = *reinterpret_cast<const bf16x8*>(kt_ + vo0); sr_[i].ks1 = *reinterpret_cast<const bf16x8*>(kt_ + vo1); \
    sr_[i].kr0 = *reinterpret_cast<const bf16x8*>(krt_ + kro); } while (0)
#define SWRITE(b, i) do { *(bf16x8*)(V_lds + (b) * SHM_V + vst0) = sr_[i].vs0;          \
    *(bf16x8*)(V_lds + (b) * SHM_V + vst1) = sr_[i].vs1; const int kc = sc * 2;               \
    *(bf16x8*)(K_lds + (b) * SHM_K + KSWZ(sr, kc)) = sr_[i].ks0;                       \
    *(bf16x8*)(K_lds + (b) * SHM_K + KSWZ(32 + sr, kc)) = sr_[i].ks1;                  \
    *(bf16x8*)(KR_lds + (b) * SHM_KR + KRSWZ(krr, krc * 2)) = sr_[i].kr0; } while (0)
#define SWAIT() do { if constexpr (SDEPTH == 2) asm volatile("s_waitcnt vmcnt(5)" ::: "memory"); else asm volatile("s_waitcnt vmcnt(0)" ::: "memory"); } while (0)
#define RESC(a) do { if (__any((a) < 1.f)) { if (hi == 0) al_l[r32] = (a); asm volatile("s_waitcnt lgkmcnt(0)" ::: "memory"); \
    _Pragma("unroll") for (int d = 0; d < 4; ++d) _Pragma("unroll") for (int r = 0; r < 16; ++r) o[d][r] *= al_l[crow(r, hi)]; } } while (0)
  f32x16 pA0, pA1, pB0, pB1; float mnA, mnB, alA, alB; bf16x8 pa0, pa1, pa2, pa3; const int NT = seq / KVBLK;
  static_assert(SDEPTH == 1, "the three-buffer loop below stages one tile ahead");
  SLOAD(0, 0); asm volatile("s_waitcnt vmcnt(0)" ::: "memory"); SWRITE(0, 0); __syncthreads();
  qkt(pA0, pA1, K_lds, KR_lds, qr, qrl, r32, hi); partialSM(pA0, pA1, m_reg, mnA, alA);
  SLOAD(0, KVBLK);
  SWAIT(); SWRITE(1, 0); __syncthreads();
  int bj = 1;
  for (int j = 1; j + 1 < NT; j += 2) {
    const int b0 = bj, bp = (bj == 2) ? 0 : bj + 1, bm = (bj == 0) ? 2 : bj - 1;
    SBAR(); qkt(pB0, pB1, K_lds + b0 * SHM_K, KR_lds + b0 * SHM_KR, qr, qrl, r32, hi);
    finishSM(pA0, pA1, alA, l_reg, pa0, pa1, pa2, pa3); SBAR();
    SLOAD(0, (j + 1) * KVBLK); SBAR();
    pv_d0(o, vb0 + bm * SHM_V, pa0, pa1, pa2, pa3); partialSM(pB0, pB1, m_reg, mnB, alB);
    SWAIT(); SWRITE(bp, 0);
    RESC(alB); __syncthreads();
    SBAR(); qkt(pA0, pA1, K_lds + bp * SHM_K, KR_lds + bp * SHM_KR, qr, qrl, r32, hi);
    finishSM(pB0, pB1, alB, l_reg, pa0, pa1, pa2, pa3); SBAR();
    SLOAD(0, (j + 2) * KVBLK); SBAR();
    pv_d0(o, vb0 + b0 * SHM_V, pa0, pa1, pa2, pa3); partialSM(pA0, pA1, m_reg, mnA, alA);
    SWAIT(); SWRITE(bm, 0);
    RESC(alA); __syncthreads();
    bj = bm;
  }
  { const int b0 = bj, bm = (bj == 0) ? 2 : bj - 1;
    SBAR(); qkt(pB0, pB1, K_lds + b0 * SHM_K, KR_lds + b0 * SHM_KR, qr, qrl, r32, hi);
    finishSM(pA0, pA1, alA, l_reg, pa0, pa1, pa2, pa3); SBAR();
    pv_d0(o, vb0 + bm * SHM_V, pa0, pa1, pa2, pa3); partialSM(pB0, pB1, m_reg, mnB, alB);
    RESC(alB);
    finishSM(pB0, pB1, alB, l_reg, pa0, pa1, pa2, pa3); SBAR();
    pv_d0(o, vb0 + b0 * SHM_V, pa0, pa1, pa2, pa3); }
  if (hi == 0) li_l[r32] = l_reg; asm volatile("s_waitcnt lgkmcnt(0)" ::: "memory");
  float rli[16];
#pragma unroll
  for (int r = 0; r < 16; ++r) rli[r] = __builtin_amdgcn_rcpf(li_l[crow(r, hi)]);
  __syncthreads();
  int tid2 = threadIdx.x; asm volatile("" : "+v"(tid2));
  const int wid2 = tid2 >> 6, lane2 = tid2 & 63;
  char* ot = lds + wid2 * (32 * 272);
#pragma unroll
  for (int r = 0; r < 16; ++r) { const int orow = crow(r, lane2 >> 5);
#pragma unroll
    for (int d0 = 0; d0 < 4; ++d0) *(bf16_t*)(ot + orow * 272 + (d0 * 32 + (lane2 & 31)) * 2) = (bf16_t)(cvt_pk_bf16(o[d0][r] * rli[r], 0.f) & 0xffffu); }
  asm volatile("s_waitcnt lgkmcnt(0)" ::: "memory");
  char* Oc = (char*)Ob;
#pragma unroll
  for (int i = 0; i < 8; ++i) { const int id = lane2 + 64 * i, row = id >> 4, ch = id & 15;
    const u32x4 v = *(const u32x4*)(ot + row * 272 + ch * 16);
    *(u32x4*)(Oc + (unsigned)((wid2 * QBLK + row) * LDO + ch * 8) * 2u) = v; }
  __syncthreads();
#undef SLOAD
#undef SWRITE
#undef SWAIT
#undef RESC
}
}

namespace mls {
constexpr int OFF_Q = 0, OFF_K = 16384, OFF_VA = 32768, OFF_VB = 49152, OFF_C = 57344, OFF_N = 65536, OFF_VEC = 73728, OFF_CS = 76800, OFF_NS = 93184, LDS_NEED = 109568;
__device__ __forceinline__ unsigned off_b(unsigned row, unsigned ch) { return 256u * row + 16u * (ch ^ (((row & 3) << 2) | ((row >> 2) & 3))); }
__device__ __forceinline__ unsigned off_vb(unsigned row, unsigned ch) { return 1024u * (row >> 3) + 512u * (ch >> 2) + 64u * (row & 7) + 16u * ((ch & 3) ^ ((row >> 2) & 3)); }
__device__ __forceinline__ s16x4 trr(unsigned addr) { s16x4 r; asm volatile("ds_read_b64_tr_b16 %0, %1" : "=&v"(r) : "v"(addr) : "memory"); return r; }

struct Tensors { const bf16_t* qkc; const bf16_t* proj; const float* gvec; float* hs; int variant; };

struct Stg { bf16x8 sqk[6], sv; float sawl, svec[2]; };
__device__ __forceinline__ void scan_unit(const Tensors& Tn, int unit, char* lds) {
  int tid = threadIdx.x; asm volatile("" : "+v"(tid));
  const int wid = __builtin_amdgcn_readfirstlane(tid >> 6), lane = tid & 63, r32 = lane & 31, hi = lane >> 5;
  const int chain = unit >> 3, vs = unit & 7, dir = chain >> 4, bb = (chain >> 2) & 3, hd = chain & 3;
  const unsigned lbase = (unsigned)(uintptr_t)lds;
  float* vec = (float*)(lds + OFF_VEC);
#define QKO(t_, i) ((unsigned)(((dir ? 63 - ((((t_) + 384 * (i)) & 1023) >> 4) : ((((t_) + 384 * (i)) & 1023) >> 4)) * 1024 + (((t_) + 384 * (i)) & 15) * 8) * 2 + (((t_) + 384 * (i)) >= 1024 ? 1024 : 0)))
  const char* gvb = (const char*)Tn.gvec + (size_t)chain * SEQ * 4;
  const char* awsrc = gvb + (size_t)3 * 32 * SEQ * 4;
  Stg sA;
#define TB(c) ((size_t)bb * SEQ + (dir ? (SEQ - 64 * ((c) + 1)) : 64 * (c)))
#define MLOAD(S_, c) do { if (wid >= 2) { const size_t tb_ = TB(c); int ts = tid - 128; asm volatile("" : "+v"(ts)); const int vrow = (ts & 255) >> 2, vch = ts & 3; \
    const unsigned vo = (unsigned)(((dir ? 63 - vrow : vrow) * ML_INP + vch * 8) * 2), awo = (unsigned)vrow * 4u; \
    const char* qb_ = (const char*)Tn.qkc + (tb_ * 1024 + hd * 128) * 2; \
    const char* vb_ = (const char*)Tn.proj + (tb_ * ML_INP + 1024 + hd * 256 + vs * 32) * 2; \
    _Pragma("unroll") for (int i = 0; i < 6; ++i) if (ts + 384 * i < 2048) S_.sqk[i] = *reinterpret_cast<const bf16x8*>(qb_ + QKO(ts, i)); \
    if (ts < 256) { S_.sv = *reinterpret_cast<const bf16x8*>(vb_ + vo); S_.sawl = *reinterpret_cast<const float*>(awsrc + (size_t)(c) * 256 + awo); } \
    else { _Pragma("unroll") for (int j = 0; j < 2; ++j) { const int vi = ts - 256 + 128 * j; if (vi < 192) S_.svec[j] = *reinterpret_cast<const float*>(gvb + (size_t)(c) * 256 + (size_t)((vi >> 6) * 32 * SEQ + (vi & 63)) * 4); } } } } while (0)
#define MWRITE(S_) do { if (wid >= 2) { int ts = tid - 128; asm volatile("" : "+v"(ts)); const int vrow = (ts & 255) >> 2, vch = ts & 3; \
    _Pragma("unroll") for (int i = 0; i < 6; ++i) { const int idx = ts + 384 * i, pi = idx & 1023, row = pi >> 4, ch = pi & 15; \
      if (idx < 2048) *(bf16x8*)(lds + (idx < 1024 ? OFF_Q : OFF_K) + off_b(row, ch)) = S_.sqk[i]; } \
    if (ts < 256) { *(bf16x8*)(lds + OFF_VA + att::v_st(vrow, vch * 8)) = S_.sv; \
      float f[8]; _Pragma("unroll") for (int j = 0; j < 8; ++j) f[j] = bf2f((unsigned short)S_.sv[j]) * S_.sawl; \
      u32x4 w; w.x = cvt_pk_bf16(f[0], f[1]); w.y = cvt_pk_bf16(f[2], f[3]); w.z = cvt_pk_bf16(f[4], f[5]); w.w = cvt_pk_bf16(f[6], f[7]); \
      *(u32x4*)(lds + OFF_VB + off_vb(vrow, vch)) = w; \
      const unsigned a = cvt_pk_bf16(S_.sawl, S_.sawl); u32x4 w2 = {a, a, a, a}; *(u32x4*)(lds + OFF_VB + off_vb(vrow, 4 + vch)) = w2; } \
    else { _Pragma("unroll") for (int j = 0; j < 2; ++j) { const int vi = ts - 256 + 128 * j; if (vi < 192) vec[vi] = S_.svec[j]; } } } } while (0)

  float* cst_l = (float*)(lds + OFF_CS) + (wid & 3) * 1024 + lane; float* nst_l = (float*)(lds + OFF_NS) + (wid & 3) * 1024 + lane;
  float m = 0.f;
  const int blk = wid - 2;
  MLOAD(sA, 0);
  asm volatile("s_waitcnt vmcnt(0)" ::: "memory");
  MWRITE(sA);
  if (wid >= 2 && wid < 6) {
#pragma unroll
    for (int g = 0; g < 4; ++g) { const unsigned a = off_b(r32, 4 * blk + g) + 8 * hi; *(u32x2*)(lds + OFF_C + a) = (u32x2){0u, 0u}; *(u32x2*)(lds + OFF_N + a) = (u32x2){0u, 0u}; }
#pragma unroll
    for (int r = 0; r < 16; ++r) { cst_l[r * 64] = 0.f; nst_l[r * 64] = 0.f; }
  }
  __syncthreads();
  const bf16x8 ones = {(short)0x3F80, (short)0x3F80, (short)0x3F80, (short)0x3F80, (short)0x3F80, (short)0x3F80, (short)0x3F80, (short)0x3F80};
  const int th = wid & 1;
  const unsigned hso = (unsigned)(((dir ? 63 - 32 * th - 4 * hi : 32 * th + 4 * hi) * D + hd * 256 + vs * 32 + r32) * 4);
  const int hstep = dir ? -(D * 4) : (D * 4);
#define CHUNK(c, LD_, WR_) do { \
    if ((c) + 1 < 64 && !(Tn.variant & 4)) MLOAD(LD_, (c) + 1); \
    const float pm63 = vec[128 + 63], bL = vec[63]; \
    const float Mx = fmaxf(m, pm63); \
    if (wid < 2 && !(Tn.variant & 1)) { \
      int ln_ = lane; asm volatile("" : "+v"(ln_)); \
      const int r32 = ln_ & 31, hi = ln_ >> 5; \
      f32x16 qc = {}, qn = {}, p0 = {}, p1 = {}; \
      f32x4 uv[8]; float pmt; \
      { \
          \
        bf16x8 qf[8], cf[4], nf[4]; \
        _Pragma("unroll") for (int ks = 0; ks < 8; ++ks) qf[ks] = *(const bf16x8*)(lds + OFF_Q + off_b(32 * th + r32, 2 * ks + hi)); \
        _Pragma("unroll") for (int hb_ = 0; hb_ < 2; ++hb_) { \
          _Pragma("unroll") for (int k4 = 0; k4 < 4; ++k4) { const int ks = hb_ * 4 + k4; \
            cf[k4] = *(const bf16x8*)(lds + OFF_C + off_b(r32, 2 * ks + hi)); nf[k4] = *(const bf16x8*)(lds + OFF_N + off_b(r32, 2 * ks + hi)); } \
          asm volatile("s_waitcnt lgkmcnt(0)" ::: "memory"); __builtin_amdgcn_sched_barrier(0); \
          _Pragma("unroll") for (int k4 = 0; k4 < 4; ++k4) { const int ks = hb_ * 4 + k4; \
            qc = __builtin_amdgcn_mfma_f32_32x32x16_bf16(qf[ks], cf[k4], qc, 0, 0, 0); \
            qn = __builtin_amdgcn_mfma_f32_32x32x16_bf16(qf[ks], nf[k4], qn, 0, 0, 0); } \
          __builtin_amdgcn_sched_barrier(0); } \
        _Pragma("unroll") for (int hb_ = 0; hb_ < 2; ++hb_) { \
          _Pragma("unroll") for (int k4 = 0; k4 < 4; ++k4) { const int ks = hb_ * 4 + k4; \
            cf[k4] = *(const bf16x8*)(lds + OFF_K + off_b(r32, 2 * ks + hi)); nf[k4] = *(const bf16x8*)(lds + OFF_K + off_b(32 + r32, 2 * ks + hi)); } \
          asm volatile("s_waitcnt lgkmcnt(0)" ::: "memory"); __builtin_amdgcn_sched_barrier(0); \
          _Pragma("unroll") for (int k4 = 0; k4 < 4; ++k4) { const int ks = hb_ * 4 + k4; \
            p0 = __builtin_amdgcn_mfma_f32_32x32x16_bf16(cf[k4], qf[ks], p0, 0, 0, 0); \
            p1 = __builtin_amdgcn_mfma_f32_32x32x16_bf16(nf[k4], qf[ks], p1, 0, 0, 0); } \
          __builtin_amdgcn_sched_barrier(0); } \
      } \
      _Pragma("unroll") for (int g = 0; g < 8; ++g) uv[g] = *(const f32x4*)(vec + 64 + 8 * (g & 3) + 4 * hi + 32 * (g >> 2)); \
      pmt = vec[128 + 32 * th + r32]; \
      asm volatile("s_waitcnt lgkmcnt(0)" ::: "memory"); __builtin_amdgcn_sched_barrier(0); \
      const int t = 32 * th + r32; \
      const float Mt = fmaxf(m, pmt); \
      _Pragma("unroll") for (int r = 0; r < 16; ++r) { const int s0 = att::crow(r, hi), s1 = 32 + s0; \
        float w0 = fast_exp(uv[r >> 2][r & 3] - Mt), w1 = fast_exp(uv[4 + (r >> 2)][r & 3] - Mt); w0 = (s0 <= t) ? w0 : 0.f; w1 = (s1 <= t) ? w1 : 0.f; \
        p0[r] *= w0; p1[r] *= w1; } \
      bf16x8 pa0, pa1, pa2, pa3; \
      PK4(p0, 0, pa0); PK4(p0, 8, pa1); PK4(p1, 0, pa2); PK4(p1, 8, pa3); \
      f32x16 pv = {}, pd = {}; \
      att::pv_one<0>(pv, (int)(lbase + OFF_VA) + att::v_rd_base(ln_), pa0, pa1, pa2, pa3); \
      pd = __builtin_amdgcn_mfma_f32_32x32x16_bf16(pa0, ones, pd, 0, 0, 0); \
      pd = __builtin_amdgcn_mfma_f32_32x32x16_bf16(pa1, ones, pd, 0, 0, 0); \
      pd = __builtin_amdgcn_mfma_f32_32x32x16_bf16(pa2, ones, pd, 0, 0, 0); \
      pd = __builtin_amdgcn_mfma_f32_32x32x16_bf16(pa3, ones, pd, 0, 0, 0); \
      char* hsb = (char*)Tn.hs + ((size_t)dir * T + TB(c)) * (D * 4); \
      f32x4 pmr[4], br[4]; \
      _Pragma("unroll") for (int g = 0; g < 4; ++g) { pmr[g] = *(const f32x4*)(vec + 128 + 32 * th + 4 * hi + 8 * g); br[g] = *(const f32x4*)(vec + 32 * th + 4 * hi + 8 * g); } \
      asm volatile("s_waitcnt lgkmcnt(0)" ::: "memory"); __builtin_amdgcn_sched_barrier(0); \
      _Pragma("unroll") for (int r = 0; r < 16; ++r) { const int rr = (r & 3) + 8 * (r >> 2); \
        const float Mr = fmaxf(m, pmr[r >> 2][r & 3]), gw = fast_exp(m - Mr), en = fast_exp(-(br[r >> 2][r & 3] + Mr)); \
        const float num = gw * qc[r] + pv[r], den = gw * qn[r] + pd[r]; \
        const float h = num * fast_rcp(fmaxf(fabsf(den), en)); \
        *(float*)(hsb + (unsigned)((int)hso + rr * hstep)) = h; } \
    } else if (wid >= 2 && wid < 6 && !(Tn.variant & 2)) { \
      int ln_ = lane; asm volatile("" : "+v"(ln_)); \
      const int hi = ln_ >> 5; \
      f32x16 kv = {}, kn = {}; \
      _Pragma("unroll") for (int ks = 0; ks < 4; ++ks) { \
        const unsigned hb = (ln_ >> 4) & 1, q = (ln_ & 15) >> 2, p = ln_ & 3; \
        const unsigned row0 = 16 * ks + 8 * hi + q; \
        const s16x4 ka = trr(lbase + OFF_K + off_b(row0, 4 * blk + 2 * hb + (p >> 1)) + 8 * (p & 1)); \
        const s16x4 kb = trr(lbase + OFF_K + off_b(row0 + 4, 4 * blk + 2 * hb + (p >> 1)) + 8 * (p & 1)); \
        const s16x4 va = trr(lbase + OFF_VB + off_vb(row0, 2 * hb + (p >> 1)) + 8 * (p & 1)); \
        const s16x4 vb_ = trr(lbase + OFF_VB + off_vb(row0 + 4, 2 * hb + (p >> 1)) + 8 * (p & 1)); \
        const s16x4 aa = trr(lbase + OFF_VB + off_vb(row0, 4 + 2 * hb + (p >> 1)) + 8 * (p & 1)); \
        const s16x4 ab = trr(lbase + OFF_VB + off_vb(row0 + 4, 4 + 2 * hb + (p >> 1)) + 8 * (p & 1)); \
        asm volatile("s_waitcnt lgkmcnt(0)" ::: "memory"); __builtin_amdgcn_sched_barrier(0); \
        const bf16x8 kf = PKV(ka, kb), vf = PKV(va, vb_), af = PKV(aa, ab); \
        kv = __builtin_amdgcn_mfma_f32_32x32x16_bf16(kf, vf, kv, 0, 0, 0); \
        kn = __builtin_amdgcn_mfma_f32_32x32x16_bf16(kf, af, kn, 0, 0, 0); \
      } \
      const float cw = fast_exp(m - Mx), sc = fast_exp(pm63 - Mx); \
      _Pragma("unroll") for (int r = 0; r < 16; ++r) { cst_l[r * 64] = cw * cst_l[r * 64] + sc * kv[r]; nst_l[r * 64] = cw * nst_l[r * 64] + sc * kn[r]; } \
    } \
    m = bL + Mx; \
    if (wid >= 2) asm volatile("s_waitcnt vmcnt(0)" ::: "memory");     \
    __syncthreads(); \
    if ((c) + 1 < 64) { \
      if (!(Tn.variant & 8)) MWRITE(WR_); \
      if (wid >= 2 && wid < 6) { \
        _Pragma("unroll") for (int g = 0; g < 4; ++g) { const unsigned a = off_b(r32, 4 * blk + g) + 8 * hi; \
          *(u32x2*)(lds + OFF_C + a) = (u32x2){cvt_pk_bf16(cst_l[(4 * g) * 64], cst_l[(4 * g + 1) * 64]), cvt_pk_bf16(cst_l[(4 * g + 2) * 64], cst_l[(4 * g + 3) * 64])}; \
          *(u32x2*)(lds + OFF_N + a) = (u32x2){cvt_pk_bf16(nst_l[(4 * g) * 64], nst_l[(4 * g + 1) * 64]), cvt_pk_bf16(nst_l[(4 * g + 2) * 64], nst_l[(4 * g + 3) * 64])}; } \
      } \
    } \
    __syncthreads(); \
  } while (0)
  for (int c = 0; c < 64; ++c) { CHUNK(c, sA, sA); }
#undef CHUNK
#undef TB
#undef MLOAD
#undef MWRITE
#undef QKO
}
}

#define XB_TMO      128
#define XB_XCNT(j)  (256  + 64 * (j))
#define XB_XSUB(j)  (1280 + 64 * (j))
#define XB_XGEN(j)  (2304 + 64 * (j))
#define XB_TOP      3328
#define XB_TOPGEN   3392
#define XCD_BAR_WORDS 3456
#define XB_SPIN_CAP (1u << 18)
__device__ __forceinline__ unsigned xb_ld(unsigned* p)              { return __hip_atomic_load(p, __ATOMIC_RELAXED, __HIP_MEMORY_SCOPE_AGENT); }
__device__ __forceinline__ unsigned xb_add(unsigned* p, unsigned v) { return __hip_atomic_fetch_add(p, v, __ATOMIC_RELAXED, __HIP_MEMORY_SCOPE_AGENT); }
__device__ __forceinline__ unsigned xb_xcc_id() { return (unsigned)__builtin_amdgcn_s_getreg((3 << 11) | 20) & 0xFu; }
#define XB_SPIN(cond, bar) do { unsigned _sp = 0; while (cond) { __builtin_amdgcn_s_sleep(1); \
    if ((++_sp & 255u) == 0u) { if (xb_ld(&(bar)[XB_TMO])) break; if (_sp > XB_SPIN_CAP) { atomicAdd(&(bar)[XB_TMO], 1u); break; } } } } while (0)
struct XcdBarrier { unsigned* bar; unsigned x; volatile LAS unsigned* st; };
__device__ __forceinline__ XcdBarrier xcd_barrier_post(unsigned* bar, volatile LAS unsigned* st) {
    XcdBarrier b; b.bar = bar; b.x = xb_xcc_id(); b.st = st;
    if (threadIdx.x == 0) (void)xb_add(&bar[XB_XCNT(b.x)], 1u);
    return b;
}
__device__ __forceinline__ void xcd_barrier_complete(unsigned* bar, unsigned x, unsigned& nloc, unsigned& nx) {
    const unsigned G = gridDim.x * gridDim.y * gridDim.z;
    unsigned sum, cnt, mine, sp = 0u;
    for (;;) {
        sum = 0u; cnt = 0u; mine = 0u;
#pragma unroll
        for (unsigned j = 0; j < 16; ++j) { const unsigned c = xb_ld(&bar[XB_XCNT(j)]); sum += c; cnt += (c > 0u) ? 1u : 0u; mine = (j == x) ? c : mine; }
        if (sum == G) break;
        __builtin_amdgcn_s_sleep(1);
        if ((++sp & 255u) == 0u) { if (xb_ld(&bar[XB_TMO])) break; if (sp > XB_SPIN_CAP) { atomicAdd(&bar[XB_TMO], 1u); break; } }
    }
    nloc = mine > 0u ? mine : 1u; nx = cnt > 0u ? cnt : 1u;
}
__device__ __forceinline__ void xcd_barrier(const XcdBarrier& b) {
    asm volatile("s_waitcnt vmcnt(0)" ::: "memory");
    __syncthreads();
    if (threadIdx.x == 0) {
        unsigned* bar = b.bar;
        __builtin_amdgcn_s_waitcnt(0);
        unsigned nloc = b.st[0], nx = b.st[1];
        if (nloc == 0u) { xcd_barrier_complete(bar, b.x, nloc, nx); b.st[0] = nloc; b.st[1] = nx; }
        const unsigned old = xb_add(&bar[XB_XSUB(b.x)], 1u);
        const unsigned gen = old / nloc;
        if (old + 1u == (gen + 1u) * nloc) {
            __builtin_amdgcn_fence(__ATOMIC_RELEASE, "agent");
            asm volatile("s_waitcnt vmcnt(0)" ::: "memory");
            const unsigned og = xb_add(&bar[XB_TOP], 1u);
            const unsigned tg = og / nx;
            if (og + 1u == (tg + 1u) * nx) xb_add(&bar[XB_TOPGEN], 1u);
            else XB_SPIN(xb_ld(&bar[XB_TOPGEN]) == tg, bar);
            __builtin_amdgcn_fence(__ATOMIC_ACQUIRE, "agent");
            xb_add(&bar[XB_XGEN(b.x)], 1u);
            asm volatile("s_waitcnt vmcnt(0)" ::: "memory");
        } else {
            XB_SPIN(xb_ld(&bar[XB_XGEN(b.x)]) == gen, bar);
            __builtin_amdgcn_fence(__ATOMIC_ACQUIRE, "agent");
            asm volatile("s_waitcnt vmcnt(0)" ::: "memory");
        }
    }
    __syncthreads();
}

struct Args { const float* in[24]; float* out; unsigned char* ws; int ph_lo, ph_hi, variant, pad; };
constexpr int NPH = 38;
struct Frame {
    char* lds; int tid, lane, wave, G, bid;
    unsigned char* ws;
};

struct CvtJob { const float* src; bf16_t* dst; int K, N, sld; int grp, gstride, goff; const float* sk; const float* sn; float oscale; };
template <bool FP8>
__device__ __forceinline__ void cvt_tiles(const Frame& F, const CvtJob& j, int& rot) {
    constexpr int RP = FP8 ? 16 : 8, KI = 8 * RP, ES = FP8 ? 1 : 2;
    const int tk = j.K / KI, tn = (j.N + 255) / 256, nt = tk * tn;
    int start = F.bid - (rot % F.G); if (start < 0) start += F.G;
    rot += nt;
    if (start >= nt) return;
    const int n4 = F.lane * 4, kq = F.wave;
    f32x4 v[RP], vn[RP];
#define CVT_LOAD(dst, it_) do { const int k0_ = ((it_) / tn) * KI + kq * RP, n0_ = ((it_) % tn) * 256 + n4; \
        if (n0_ < j.N) { _Pragma("unroll") for (int r = 0; r < RP; ++r) dst[r] = *(const f32x4*)(j.src + (size_t)(k0_ + r) * j.sld + n0_); } } while (0)
    CVT_LOAD(v, start);
    int buf = 0;
    for (int it = start; it < nt; it += F.G) {
        const bool has_next = it + F.G < nt;
        if (has_next) CVT_LOAD(vn, it + F.G);
        const int k0 = (it / tn) * KI, n0 = (it % tn) * 256;
        char* img = F.lds + buf * 32768;
        if (n0 + n4 < j.N) {
            if (j.sk) {
#pragma unroll
                for (int r = 0; r < RP; ++r) v[r] = v[r] * j.sk[k0 + kq * RP + r];
            }
            if (j.sn) { const f32x4 sn = *(const f32x4*)(j.sn + n0 + n4);
#pragma unroll
                for (int r = 0; r < RP; ++r) v[r] = v[r] * sn; }
#pragma unroll
            for (int c = 0; c < 4; ++c) {
                u32x4 w;
                if constexpr (FP8) { w.x = pack4_fp8(v[0][c] * j.oscale, v[1][c] * j.oscale, v[2][c] * j.oscale, v[3][c] * j.oscale); w.y = pack4_fp8(v[4][c] * j.oscale, v[5][c] * j.oscale, v[6][c] * j.oscale, v[7][c] * j.oscale);
                                     w.z = pack4_fp8(v[8 % RP][c] * j.oscale, v[9 % RP][c] * j.oscale, v[10 % RP][c] * j.oscale, v[11 % RP][c] * j.oscale); w.w = pack4_fp8(v[12 % RP][c] * j.oscale, v[13 % RP][c] * j.oscale, v[14 % RP][c] * j.oscale, v[15 % RP][c] * j.oscale); }
                else { w.x = cvt_pk_bf16(v[0][c], v[1][c]); w.y = cvt_pk_bf16(v[2][c], v[3][c]); w.z = cvt_pk_bf16(v[4][c], v[5][c]); w.w = cvt_pk_bf16(v[6][c], v[7][c]); }
                *(u32x4*)(img + (n4 + c) * 128 + ((kq ^ (F.lane & 7)) * 16)) = w;
            }
        }
        __syncthreads();
#pragma unroll
        for (int q = 0; q < 4; ++q) { const int id = F.tid + 512 * q, n = id >> 3, kc = id & 7;
            if (n0 + n < j.N) { const u32x4 w = *(const u32x4*)(img + n * 128 + ((kc ^ ((n >> 2) & 7)) * 16));
                const int nn = n0 + n, drow = (nn / j.grp) * j.gstride + j.goff + (nn % j.grp);
                *(u32x4*)((char*)j.dst + ((size_t)drow * j.K + k0) * ES + kc * 16) = w; } }
        buf ^= 1;
        if (has_next) {
#pragma unroll
            for (int r = 0; r < RP; ++r) v[r] = vn[r];
        }
    }
    __syncthreads();
#undef CVT_LOAD
}
__device__ __forceinline__ CvtJob mkjob(const float* src, bf16_t* dst, int K, int N, int sld) { CvtJob j; j.src = src; j.dst = dst; j.K = K; j.N = N; j.sld = sld; j.grp = N; j.gstride = 0; j.goff = 0; j.sk = nullptr; j.sn = nullptr; j.oscale = 1.f; return j; }

__device__ __forceinline__ void phase_convert_small(const Frame& F, const Args& a) {
    bf16_t* W = (bf16_t*)(F.ws + WS_W); int rot = 0;
    for (int j = 0; j < 2; ++j) {
        { CvtJob c = mkjob(a.in[2] + (size_t)j * D * MLA_IN, (bf16_t*)((char*)W + W_DQKV) + (size_t)j * MLA_INP * D, D, MLA_IN, MLA_IN); cvt_tiles<false>(F, c, rot); }
        { CvtJob c = mkjob(a.in[4] + (size_t)j * MLA_QR * MLA_QW, (bf16_t*)((char*)W + W_UQ) + (size_t)j * MLA_QW * MLA_QR, MLA_QR, MLA_QW, MLA_QW); c.sk = a.in[3] + j * MLA_QR; cvt_tiles<false>(F, c, rot); }
        { CvtJob c = mkjob(a.in[6] + (size_t)j * MLA_KVR * MLA_KVW, (bf16_t*)((char*)W + W_UKV) + (size_t)j * MLA_KVW * MLA_KVR, MLA_KVR, MLA_KVW, MLA_KVW); c.sk = a.in[5] + j * MLA_KVR; cvt_tiles<false>(F, c, rot); }
        { CvtJob c = mkjob(a.in[7] + (size_t)j * D * D, (bf16_t*)((char*)W + W_O) + (size_t)j * D * D, D, D, D); cvt_tiles<false>(F, c, rot); }
        { bf16_t* z = (bf16_t*)((char*)W + W_DQKV) + (size_t)j * MLA_INP * D + (size_t)MLA_IN * D;
          for (int i = F.bid * NTHR + F.tid; i < (MLA_INP - MLA_IN) * D / 8; i += F.G * NTHR) *(u32x4*)(z + (size_t)i * 8) = (u32x4){0u, 0u, 0u, 0u}; }
    }
    for (int g = 0; g < 4; ++g) { CvtJob c = mkjob(a.in[8] + (size_t)g * 256 * 256, (bf16_t*)((char*)W + W_POOL) + (size_t)g * 256 * 256, 256, 256, 256); c.sn = a.in[9] + g * 256; cvt_tiles<false>(F, c, rot); }
    { CvtJob c = mkjob(a.in[10], (bf16_t*)((char*)W + W_IN), D, ML_INP, ML_IN); cvt_tiles<false>(F, c, rot); }
    { CvtJob c = mkjob(a.in[14], (bf16_t*)((char*)W + W_OUT), D, D, D); cvt_tiles<false>(F, c, rot); }
    for (int j = 0; j < 2; ++j) {
        const bool f8 = j == 0 ? DENSE0_FP8 : DENSE1_FP8;
        { CvtJob c = mkjob(a.in[15] + (size_t)j * D * DFF, (bf16_t*)((char*)W + W_GU) + (size_t)j * 2 * DFF * D, D, DFF, DFF); c.grp = 128; c.gstride = 256; c.goff = 0; c.oscale = 64.f; if (f8) cvt_tiles<true>(F, c, rot); else cvt_tiles<false>(F, c, rot); }
        { CvtJob c = mkjob(a.in[16] + (size_t)j * D * DFF, (bf16_t*)((char*)W + W_GU) + (size_t)j * 2 * DFF * D, D, DFF, DFF); c.grp = 128; c.gstride = 256; c.goff = 128; c.oscale = 64.f; if (f8) cvt_tiles<true>(F, c, rot); else cvt_tiles<false>(F, c, rot); }
        { CvtJob c = mkjob(a.in[17] + (size_t)j * DFF * D, (bf16_t*)((char*)W + W_DN) + (size_t)j * D * DFF, DFF, D, D); c.oscale = 256.f; if (f8) cvt_tiles<true>(F, c, rot); else cvt_tiles<false>(F, c, rot); }
    }
    { const float* x = a.in[0]; bf16_t* xb = (bf16_t*)(F.ws + WS_XB);
      for (size_t i = (size_t)F.bid * NTHR + F.tid; i < (size_t)T * D / 8; i += (size_t)F.G * NTHR) {
          const f32x4 v0 = *(const f32x4*)(x + i * 8), v1 = *(const f32x4*)(x + i * 8 + 4);
          u32x4 w; w.x = cvt_pk_bf16(v0[0], v0[1]); w.y = cvt_pk_bf16(v0[2], v0[3]); w.z = cvt_pk_bf16(v1[0], v1[1]); w.w = cvt_pk_bf16(v1[2], v1[3]);
          *(u32x4*)(xb + i * 8) = w; } }
}
template <bool FP8>
__device__ __forceinline__ void phase_convert_moe(const Frame& F, const Args& a, int c) {
    constexpr int ES = FP8 ? 1 : 2;
    char* GU = (char*)(F.ws + WS_WMOE + WM_GU); char* DN = (char*)(F.ws + WS_WMOE + WM_DN); int rot = 0;
    for (int e = 0; e < NEXP; ++e) {
        const size_t eo = ((size_t)c * NEXP + e) * (size_t)D * DFFE;
        { CvtJob j = mkjob(a.in[19] + eo, (bf16_t*)(GU + (size_t)e * 2 * DFFE * D * ES), D, DFFE, DFFE); j.grp = 128; j.gstride = 256; j.goff = 0; j.oscale = 64.f; cvt_tiles<FP8>(F, j, rot); }
        { CvtJob j = mkjob(a.in[20] + eo, (bf16_t*)(GU + (size_t)e * 2 * DFFE * D * ES), D, DFFE, DFFE); j.grp = 128; j.gstride = 256; j.goff = 128; j.oscale = 64.f; cvt_tiles<FP8>(F, j, rot); }
        { CvtJob j = mkjob(a.in[21] + eo, (bf16_t*)(DN + (size_t)e * D * DFFE * ES), DFFE, D, D); j.oscale = 256.f; cvt_tiles<FP8>(F, j, rot); }
    }
}

template <int MODE>
__device__ __forceinline__ void phase_ln(const Frame& F, const float* xin, const bf16_t* y, float* xout, bf16_t* xb, const float* g, const float* b,
                                         const float* wproj  , const float* bgate) {
    constexpr bool MOE_IN = MODE & 1, ROUTER = (MODE & 2) != 0, GATES = (MODE & 4) != 0, FINAL = (MODE & 8) != 0, F8OUT = (MODE & 16) != 0;
    unsigned char* xb8 = (unsigned char*)(F.ws + WS_XB8);
    constexpr int NP = ROUTER ? 8 : (GATES ? 16 : 0); constexpr int NPA = NP ? NP : 4;
    float* wl = (float*)F.lds;
    int* sel = (int*)(F.lds + 65536);
    const int* toke = (const int*)(F.ws + WS_META + MT_TOKE); const float* tokw = (const float*)(F.ws + WS_META + MT_TOKW);
    if constexpr (NP != 0) {
        for (int i = F.tid; i < 1024 * NPA; i += NTHR) { const int c = i / NPA, p = i % NPA; wl[p * 1024 + c] = ROUTER ? wproj[c * 8 + p] : wproj[(size_t)c * ML_IN + ML_INP + p]; }
        __syncthreads();
    }
    f32x4 gg[4], bb[4];
#pragma unroll
    for (int j = 0; j < 4; ++j) { gg[j] = *(const f32x4*)(g + F.lane * 4 + 256 * j); bb[j] = *(const f32x4*)(b + F.lane * 4 + 256 * j); }
    for (int blk = F.bid; blk < T / 64; blk += F.G) {
        for (int rp = 0; rp < 8; rp += 2) {
            f32x4 v[2][4]; float w1[2] = {0.f, 0.f}, w2[2] = {0.f, 0.f};
#pragma unroll
            for (int u = 0; u < 2; ++u) { const int row = blk * 64 + F.wave * 8 + rp + u;
                if (MOE_IN) { w1[u] = tokw[row * 2]; w2[u] = tokw[row * 2 + 1]; } }
            f32x4 xv[2][4]; u32x2 ya[2][4], yb[2][4];
#pragma unroll
            for (int u = 0; u < 2; ++u) { const int row = blk * 64 + F.wave * 8 + rp + u;
#pragma unroll
                for (int j = 0; j < 4; ++j) { const int c = F.lane * 4 + 256 * j;
                    xv[u][j] = *(const f32x4*)(xin + (size_t)row * D + c);
                    if (MOE_IN) { ya[u][j] = *(const u32x2*)(y + (size_t)(2 * row) * D + c); yb[u][j] = *(const u32x2*)(y + (size_t)(2 * row + 1) * D + c); }
                    else ya[u][j] = *(const u32x2*)(y + (size_t)row * D + c); } }
#pragma unroll
            for (int u = 0; u < 2; ++u)
#pragma unroll
                for (int j = 0; j < 4; ++j) { const f32x4 fa = {bflo(ya[u][j].x), bfhi(ya[u][j].x), bflo(ya[u][j].y), bfhi(ya[u][j].y)}; f32x4 yv;
                    if (MOE_IN) { const f32x4 fb = {bflo(yb[u][j].x), bfhi(yb[u][j].x), bflo(yb[u][j].y), bfhi(yb[u][j].y)}; yv = fa * w1[u] + fb * w2[u]; } else yv = fa;
                    v[u][j] = xv[u][j] * DN_ALPHA + yv; }
            float mu[2], rstd[2];
#pragma unroll
            for (int u = 0; u < 2; ++u) { float s_ = 0.f;
#pragma unroll
                for (int j = 0; j < 4; ++j) s_ += (v[u][j][0] + v[u][j][1]) + (v[u][j][2] + v[u][j][3]);
                mu[u] = s_; }
            mu[0] = wave_sum(mu[0]) * (1.0f / 1024.0f); mu[1] = wave_sum(mu[1]) * (1.0f / 1024.0f);
#pragma unroll
            for (int u = 0; u < 2; ++u) { float q = 0.f;
#pragma unroll
                for (int j = 0; j < 4; ++j) { const f32x4 d = v[u][j] - mu[u]; q += (d[0] * d[0] + d[1] * d[1]) + (d[2] * d[2] + d[3] * d[3]); }
                rstd[u] = q; }
            rstd[0] = 1.0f / sqrtf(wave_sum(rstd[0]) * (1.0f / 1024.0f) + LN_EPS); rstd[1] = 1.0f / sqrtf(wave_sum(rstd[1]) * (1.0f / 1024.0f) + LN_EPS);
#pragma unroll
            for (int u = 0; u < 2; ++u) { const int row = blk * 64 + F.wave * 8 + rp + u, rr = rp + u;
#pragma unroll
            for (int j = 0; j < 4; ++j) { const int c = F.lane * 4 + 256 * j;
                v[u][j] = (v[u][j] - mu[u]) * rstd[u] * gg[j] + bb[j];
                *(f32x4*)(xout + (size_t)row * D + c) = v[u][j];
                if (!FINAL) { u32x2 w; w.x = cvt_pk_bf16(v[u][j][0], v[u][j][1]); w.y = cvt_pk_bf16(v[u][j][2], v[u][j][3]); *(u32x2*)(xb + (size_t)row * D + c) = w; }
                if (F8OUT) *(unsigned*)(xb8 + (size_t)row * D + c) = pack4_fp8(v[u][j][0], v[u][j][1], v[u][j][2], v[u][j][3]); }
            if constexpr (NP != 0) {
                float pr[NPA];
#pragma unroll
                for (int p = 0; p < NPA; ++p) pr[p] = 0.f;
#pragma unroll
                for (int j = 0; j < 4; ++j)
#pragma unroll
                    for (int p = 0; p < NPA; ++p) { const f32x4 wv = *(const f32x4*)(wl + p * 1024 + F.lane * 4 + 256 * j);
                        pr[p] += (v[u][j][0] * wv[0] + v[u][j][1] * wv[1]) + (v[u][j][2] * wv[2] + v[u][j][3] * wv[3]); }
                {
                    int np = NPA, msk = 32;
#pragma unroll
                    for (int st = 0; st < (NPA == 16 ? 4 : 3); ++st) { np >>= 1; const bool up = (F.lane & msk) != 0;
#pragma unroll
                        for (int k = 0; k < 8; ++k) if (k < np) { const float keep = up ? pr[k + np] : pr[k], send = up ? pr[k] : pr[k + np]; pr[k] = keep + __shfl_xor(send, msk); }
                        msk >>= 1; }
                    float tot = pr[0];
#pragma unroll
                    for (int o = (NPA == 16 ? 2 : 4); o >= 1; o >>= 1) tot += __shfl_xor(tot, o);
                    if (NPA == 16) { pr[0] = tot; } else { pr[0] = tot; }
                }
                if constexpr (ROUTER) {
                    { const float mine = pr[0];
#pragma unroll
                      for (int p = 0; p < 8; ++p) pr[p] = __shfl(mine, 8 * p); }
                    int e1 = 0; float v1 = pr[0];
#pragma unroll
                    for (int p = 1; p < 8; ++p) if (pr[p] > v1) { v1 = pr[p]; e1 = p; }
                    int e2 = -1; float v2 = -3.0e38f;
#pragma unroll
                    for (int p = 0; p < 8; ++p) if (p != e1 && pr[p] > v2) { v2 = pr[p]; e2 = p; }
                    const float ww2 = 1.0f / (1.0f + expf(v1 - v2)), ww1 = 1.0f - ww2;
                    if (F.lane == 0) { int* te = (int*)(F.ws + WS_META + MT_TOKE); float* tw = (float*)(F.ws + WS_META + MT_TOKW);
                        te[row * 2] = e1; te[row * 2 + 1] = e2; tw[row * 2] = ww1; tw[row * 2 + 1] = ww2;
                        sel[F.wave * 16 + rr * 2] = e1; sel[F.wave * 16 + rr * 2 + 1] = e2; }
                }
                if constexpr (GATES) { if ((F.lane & 3) == 0) { const int p = F.lane >> 2;
                        ((float*)(F.ws + WS_META + MT_GATES))[(size_t)row * 16 + p] = pr[0] + bgate[p]; } }
            }
            }
        }
        if constexpr (ROUTER) {
            __syncthreads();
            if (F.tid < 128) { const int e = sel[F.tid]; int rk = 0; for (int p = 0; p < F.tid; ++p) rk += (sel[p] == e) ? 1 : 0;
                const int row = blk * 64 + (F.tid >> 4) * 8 + ((F.tid & 15) >> 1);
                ((int*)(F.ws + WS_META + MT_RANK))[row * 2 + (F.tid & 1)] = rk; }
            if (F.tid >= 128 && F.tid < 136) { const int e = F.tid - 128; int cn = 0; for (int p = 0; p < 128; ++p) cn += (sel[p] == e) ? 1 : 0;
                ((int*)(F.ws + WS_META + MT_CNTW))[blk * 8 + e] = cn; }
            __syncthreads();
        }
    }
    (void)toke;
}

template <bool FP8>
__device__ __forceinline__ void phase_moe_permute(const Frame& F) {
    int* cl = (int*)F.lds;
    int* tot = cl + 2048; int* toff = cl + 2056; int* base = cl + 2072;
    const int* cntw = (const int*)(F.ws + WS_META + MT_CNTW);
    for (int i = F.tid; i < 2048; i += NTHR) cl[i] = cntw[i];
    __syncthreads();
    if (F.tid < 8) { int s = 0; for (int w = 0; w < 256; ++w) s += cl[w * 8 + F.tid]; tot[F.tid] = s; }
    __syncthreads();
    if (F.tid == 0) { int o = 0; for (int e = 0; e < 8; ++e) { toff[e] = o; o += (tot[e] + 255) >> 8; } toff[8] = o;
        if (F.bid == 0) { int* meta = (int*)(F.ws + WS_META + MT_MOE); for (int e = 0; e < 8; ++e) meta[e] = tot[e]; for (int e = 0; e < 9; ++e) meta[8 + e] = toff[e]; } }
    __syncthreads();
    const int* toke = (const int*)(F.ws + WS_META + MT_TOKE); const int* rank = (const int*)(F.ws + WS_META + MT_RANK);
    int* rowtok = (int*)(F.ws + WS_META + MT_ROWTOK);
    const bf16_t* xb = (const bf16_t*)(F.ws + WS_XB); bf16_t* xp = (bf16_t*)(F.ws + WS_SCR + SC_XP);
    for (int blk = F.bid; blk < T / 64; blk += F.G) {
        __syncthreads();
        if (F.tid < 8) { int s = 0; for (int w = 0; w < blk; ++w) s += cl[w * 8 + F.tid]; base[F.tid] = toff[F.tid] * 256 + s; }
        __syncthreads();
        for (int g = 0; g < 16; g += 4) {
            int tok[4], kk[4], row[4]; u32x4 v0[4], v1[4];
#pragma unroll
            for (int u = 0; u < 4; ++u) { const int pp = F.wave + NWAVES * (g + u); tok[u] = blk * 64 + (pp >> 1); kk[u] = pp & 1;
                row[u] = base[toke[tok[u] * 2 + kk[u]]] + rank[tok[u] * 2 + kk[u]]; }
#pragma unroll
            for (int u = 0; u < 4; ++u) {
                if constexpr (FP8) { v0[u] = *(const u32x4*)(xb + (size_t)tok[u] * D + F.lane * 16); v1[u] = *(const u32x4*)(xb + (size_t)tok[u] * D + F.lane * 16 + 8); }
                else { v0[u] = *(const u32x4*)(xb + (size_t)tok[u] * D + F.lane * 8); v1[u] = *(const u32x4*)(xb + (size_t)tok[u] * D + 512 + F.lane * 8); } }
#pragma unroll
            for (int u = 0; u < 4; ++u) {
                if constexpr (FP8) {
                    u32x4 w; w.x = pack4_fp8(bflo(v0[u].x), bfhi(v0[u].x), bflo(v0[u].y), bfhi(v0[u].y)); w.y = pack4_fp8(bflo(v0[u].z), bfhi(v0[u].z), bflo(v0[u].w), bfhi(v0[u].w));
                    w.z = pack4_fp8(bflo(v1[u].x), bfhi(v1[u].x), bflo(v1[u].y), bfhi(v1[u].y)); w.w = pack4_fp8(bflo(v1[u].z), bfhi(v1[u].z), bflo(v1[u].w), bfhi(v1[u].w));
                    *(u32x4*)((char*)xp + (size_t)row[u] * D + F.lane * 16) = w;
                } else { *(u32x4*)(xp + (size_t)row[u] * D + F.lane * 8) = v0[u]; *(u32x4*)(xp + (size_t)row[u] * D + 512 + F.lane * 8) = v1[u]; }
                if (F.lane == 0) rowtok[row[u]] = tok[u] * 2 + kk[u]; }
        }
    }
}

__device__ __forceinline__ void phase_mla_rows(const Frame& F, const int* positions) {
    const float* lat = (const float*)(F.ws + WS_SCR + SC_LAT);
    bf16_t* cqn = (bf16_t*)(F.ws + WS_SCR + SC_CQN); bf16_t* ckvn = (bf16_t*)(F.ws + WS_SCR + SC_CKVN); bf16_t* kr = (bf16_t*)(F.ws + WS_SCR + SC_KR);
    float* rope = (float*)(F.ws + WS_META + MT_ROPE);
    const int l = F.lane; const bool lo32 = l < 32, isk = (l >= 32 && l < 48);
    const int fq0 = 4 * ((l - 32) & 7);
    float invf[4];
#pragma unroll
    for (int i = 0; i < 4; ++i) invf[i] = exp2f(-(float)(fq0 + i) * (13.287712379549449f / 32.0f));
    for (int row0 = (F.bid * NWAVES + F.wave) * 2; row0 < T; row0 += F.G * NWAVES * 2) {
        f32x4 c0[2], c1[2], c2[2]; int pos[2];
#pragma unroll
        for (int u = 0; u < 2; ++u) { const float* lr = lat + (size_t)(row0 + u) * MLA_INP;
            c0[u] = *(const f32x4*)(lr + 4 * l); c1[u] = *(const f32x4*)(lr + 256 + 4 * l); c2[u] = *(const f32x4*)(lr + 512 + 4 * l); pos[u] = positions[row0 + u]; }
#pragma unroll
        for (int u = 0; u < 2; ++u) { const int row = row0 + u;
            const float q0 = (c0[u][0] * c0[u][0] + c0[u][1] * c0[u][1]) + (c0[u][2] * c0[u][2] + c0[u][3] * c0[u][3]);
            const float q1 = (c1[u][0] * c1[u][0] + c1[u][1] * c1[u][1]) + (c1[u][2] * c1[u][2] + c1[u][3] * c1[u][3]);
            const float q2 = (c2[u][0] * c2[u][0] + c2[u][1] * c2[u][1]) + (c2[u][2] * c2[u][2] + c2[u][3] * c2[u][3]);
            const float r1 = 1.0f / sqrtf(wave_sum(q0 + (lo32 ? q1 : 0.f)) * (1.0f / MLA_QR) + RMS_EPS);
            const float r2 = 1.0f / sqrtf(wave_sum((lo32 ? 0.f : q1) + (lo32 ? q2 : 0.f)) * (1.0f / MLA_KVR) + RMS_EPS);
            { const f32x4 v = c0[u] * r1; *(u32x2*)(cqn + (size_t)row * MLA_QR + 4 * l) = (u32x2){cvt_pk_bf16(v[0], v[1]), cvt_pk_bf16(v[2], v[3])}; }
            if (lo32) { const f32x4 v = c1[u] * r1; *(u32x2*)(cqn + (size_t)row * MLA_QR + 256 + 4 * l) = (u32x2){cvt_pk_bf16(v[0], v[1]), cvt_pk_bf16(v[2], v[3])};
                        const f32x4 w = c2[u] * r2; *(u32x2*)(ckvn + (size_t)row * MLA_KVR + 128 + 4 * l) = (u32x2){cvt_pk_bf16(w[0], w[1]), cvt_pk_bf16(w[2], w[3])}; }
            else { const f32x4 v = c1[u] * r2; *(u32x2*)(ckvn + (size_t)row * MLA_KVR + 4 * (l - 32)) = (u32x2){cvt_pk_bf16(v[0], v[1]), cvt_pk_bf16(v[2], v[3])}; }
            f32x4 ko; ko[0] = __shfl_xor(c2[u][0], 8); ko[1] = __shfl_xor(c2[u][1], 8); ko[2] = __shfl_xor(c2[u][2], 8); ko[3] = __shfl_xor(c2[u][3], 8);
            if (isk) { float o4[4], cs4[4], sn4[4];
#pragma unroll
                for (int i = 0; i < 4; ++i) { const float ang = (float)pos[u] * invf[i];
                    const double rev = (double)ang * 0.15915494309189535; const float fr = (float)(rev - floor(rev));
                    sn4[i] = __builtin_amdgcn_sinf(fr); cs4[i] = __builtin_amdgcn_cosf(fr);
                    o4[i] = (l < 40) ? (c2[u][i] * cs4[i] - ko[i] * sn4[i]) : (c2[u][i] * cs4[i] + ko[i] * sn4[i]); }
                *(u32x2*)(kr + (size_t)row * MLA_ROPE + 4 * (l - 32)) = (u32x2){cvt_pk_bf16(o4[0], o4[1]), cvt_pk_bf16(o4[2], o4[3])};
                if (l < 40) { float* rp = rope + (size_t)row * 64 + 2 * fq0; *(f32x4*)rp = (f32x4){cs4[0], sn4[0], cs4[1], sn4[1]}; *(f32x4*)(rp + 4) = (f32x4){cs4[2], sn4[2], cs4[3], sn4[3]}; } }
        }
    }
}

template <int H>
__device__ __forceinline__ void pool_group(const float* xb0, bf16_t* zb0, int t0, int c) {
    f32x4 val[8 + 2 * H];
#pragma unroll
    for (int i = 0; i < 8 + 2 * H; ++i) { const int t = t0 + i - H; val[i] = (t >= 0 && t < SEQ) ? *(const f32x4*)(xb0 + (size_t)t * D + c) : (f32x4){0.f, 0.f, 0.f, 0.f}; }
    f32x4 sum = val[0];
#pragma unroll
    for (int i = 1; i < 2 * H; ++i) sum += val[i];
#pragma unroll
    for (int k = 0; k < 8; ++k) { const int t = t0 + k, lo = t - H < 0 ? 0 : t - H, hi = t + H > SEQ ? SEQ : t + H;
        const f32x4 zz = sum * (1.0f / (float)(hi - lo)) - val[k + H];
        *(u32x2*)(zb0 + (size_t)t * D + c) = (u32x2){cvt_pk_bf16(zz[0], zz[1]), cvt_pk_bf16(zz[2], zz[3])};
        if (k < 7) sum += val[k + 2 * H] - val[k]; }
}
__device__ __forceinline__ void phase_pool_z(const Frame& F) {
    const float* x = (const float*)(F.ws + WS_X); bf16_t* z = (bf16_t*)(F.ws + WS_SCR + SC_Z);
    for (int w = F.bid * NWAVES + F.wave; w < T / 8; w += F.G * NWAVES) {
        const int row0 = w * 8, b0 = row0 / SEQ * SEQ, t0 = row0 - b0;
        const float* xb0 = x + (size_t)b0 * D; bf16_t* zb0 = z + (size_t)b0 * D;
        pool_group<1>(xb0, zb0, t0, F.lane * 4);
        pool_group<2>(xb0, zb0, t0, F.lane * 4 + 256);
        pool_group<4>(xb0, zb0, t0, F.lane * 4 + 512);
        pool_group<8>(xb0, zb0, t0, F.lane * 4 + 768);
    }
}

__device__ __forceinline__ void phase_mlstm_prep(const Frame& F, const float* convw) {
    const bf16_t* proj = (const bf16_t*)(F.ws + WS_SCR + SC_PROJ); bf16_t* qkc = (bf16_t*)(F.ws + WS_SCR + SC_QKC);
    for (int w = F.bid * NWAVES + F.wave; w < T / 8; w += F.G * NWAVES) {
        const int row0 = w * 8, b0 = row0 / SEQ * SEQ, t0 = row0 - b0;
#pragma unroll
        for (int j = 0; j < 2; ++j) {
            const int c = F.lane * 8 + 512 * j;
            u32x4 rw[12];
#pragma unroll
            for (int i = 0; i < 12; ++i) { const int t = t0 + i - 2; rw[i] = (t >= 0 && t < SEQ) ? *(const u32x4*)(proj + (size_t)(b0 + t) * ML_INP + c) : (u32x4){0u, 0u, 0u, 0u}; }
            f32x4 wa[5], wb[5];
#pragma unroll
            for (int k = 0; k < 5; ++k) { wa[k] = *(const f32x4*)(convw + k * 1024 + c); wb[k] = *(const f32x4*)(convw + k * 1024 + c + 4); }
            const float ksc = j ? 0.08838834764831845f : 1.0f;
#pragma unroll
            for (int r = 0; r < 8; ++r) {
                f32x4 a0 = {0.f, 0.f, 0.f, 0.f}, a1 = {0.f, 0.f, 0.f, 0.f};
#pragma unroll
                for (int k = 0; k < 5; ++k) { const u32x4 v = rw[r + k];
                    a0 += (f32x4){bflo(v.x), bfhi(v.x), bflo(v.y), bfhi(v.y)} * wa[k]; a1 += (f32x4){bflo(v.z), bfhi(v.z), bflo(v.w), bfhi(v.w)} * wb[k]; }
                u32x4 o; o.x = cvt_pk_bf16(silu_f(a0[0]) * ksc, silu_f(a0[1]) * ksc); o.y = cvt_pk_bf16(silu_f(a0[2]) * ksc, silu_f(a0[3]) * ksc);
                o.z = cvt_pk_bf16(silu_f(a1[0]) * ksc, silu_f(a1[1]) * ksc); o.w = cvt_pk_bf16(silu_f(a1[2]) * ksc, silu_f(a1[3]) * ksc);
                *(u32x4*)(qkc + (size_t)(b0 + t0 + r) * D + c) = o;
            }
        }
    }
    const float* gates = (const float*)(F.ws + WS_META + MT_GATES);
    float* gb = (float*)(F.ws + WS_META + MT_GVEC); float* gu = gb + 32 * SEQ; float* gpm = gu + 32 * SEQ; float* gawl = gpm + 32 * SEQ;
    for (int wg = F.bid * NWAVES + F.wave; wg < 32 * 64; wg += F.G * NWAVES) {
        const int chain = wg >> 6, cch = wg & 63, dir = chain >> 4, bb = (chain >> 2) & 3, hd = chain & 3;
        const int pos = cch * 64 + F.lane, tok = dir ? (SEQ - 1 - pos) : pos;
        const size_t row = (size_t)bb * SEQ + tok;
        const float li = gates[row * 16 + dir * 4 + hd], f = gates[row * 16 + 8 + dir * 4 + hd];
        const float lf = fminf(f, 0.f) - log1pf(expf(-fabsf(f)));
        float bsum = lf;
#pragma unroll
        for (int o = 1; o < 64; o <<= 1) { const float n = __shfl_up(bsum, o); if (F.lane >= o) bsum += n; }
        const float u = li - bsum;
        float pm = u;
#pragma unroll
        for (int o = 1; o < 64; o <<= 1) { const float n = __shfl_up(pm, o); if (F.lane >= o) pm = fmaxf(pm, n); }
        const float pm63 = __shfl(pm, 63);
        const size_t o_ = (size_t)chain * SEQ + pos;
        gb[o_] = bsum; gu[o_] = u; gpm[o_] = pm; gawl[o_] = expf(u - pm63);
    }
}

__device__ __forceinline__ void phase_mlstm_combine(const Frame& F, const float* norm_g) {
    const float* hs = (const float*)(F.ws + WS_SCR + SC_HS); const bf16_t* proj = (const bf16_t*)(F.ws + WS_SCR + SC_PROJ); bf16_t* ym = (bf16_t*)(F.ws + WS_SCR + SC_YM);
    f32x4 gn[4];
#pragma unroll
    for (int hd = 0; hd < 4; ++hd) gn[hd] = *(const f32x4*)(norm_g + hd * 256 + F.lane * 4);
    for (int row0 = (F.bid * NWAVES + F.wave) * 2; row0 < T; row0 += F.G * NWAVES * 2) {
        f32x4 ha[2][4], hb[2][4]; u32x2 ow[2][4];
#pragma unroll
        for (int u = 0; u < 2; ++u)
#pragma unroll
            for (int hd = 0; hd < 4; ++hd) { const size_t o = (size_t)(row0 + u) * D + hd * 256 + F.lane * 4;
                ha[u][hd] = *(const f32x4*)(hs + o); hb[u][hd] = *(const f32x4*)(hs + (size_t)T * D + o); ow[u][hd] = *(const u32x2*)(proj + (size_t)(row0 + u) * ML_INP + 2048 + hd * 256 + F.lane * 4); }
#pragma unroll
        for (int u = 0; u < 2; ++u)
#pragma unroll
            for (int hd = 0; hd < 4; ++hd) { const f32x4 h = ha[u][hd] + hb[u][hd];
                const float mu = wave_sum((h[0] + h[1]) + (h[2] + h[3])) * (1.0f / 256.0f);
                const f32x4 d = h - mu;
                const float rstd = 1.0f / sqrtf(wave_sum((d[0] * d[0] + d[1] * d[1]) + (d[2] * d[2] + d[3] * d[3])) * (1.0f / 256.0f) + LN_EPS);
                const float o0 = bflo(ow[u][hd].x), o1 = bfhi(ow[u][hd].x), o2 = bflo(ow[u][hd].y), o3 = bfhi(ow[u][hd].y);
                const float y0 = d[0] * rstd * gn[hd][0] * sigmoid_f(o0), y1 = d[1] * rstd * gn[hd][1] * sigmoid_f(o1), y2 = d[2] * rstd * gn[hd][2] * sigmoid_f(o2), y3 = d[3] * rstd * gn[hd][3] * sigmoid_f(o3);
                *(u32x2*)(ym + (size_t)(row0 + u) * D + hd * 256 + F.lane * 4) = (u32x2){cvt_pk_bf16(y0, y1), cvt_pk_bf16(y2, y3)}; }
    }
}

__global__ void __launch_bounds__(NTHR, 2) fwd_kernel(Args args) {
    extern __shared__ __attribute__((aligned(16))) unsigned char lds_raw[];
    Frame F;
    F.lds = (char*)lds_raw; F.tid = threadIdx.x; F.lane = F.tid & 63; F.wave = __builtin_amdgcn_readfirstlane(F.tid >> 6); F.G = gridDim.x; F.bid = blockIdx.x; F.ws = args.ws;
    LAS unsigned char* ldsl = (LAS unsigned char*)lds_raw;
    volatile LAS unsigned* MISC = (volatile LAS unsigned*)(ldsl + LDS_MISC);
    if (F.tid < 64) MISC[F.tid] = 0u;
    __syncthreads();
    const int lo = args.ph_lo, hi = args.ph_hi;
    XcdBarrier bar; bar.bar = (unsigned*)(args.ws + WS_CTL) + 4096; bar.x = 0; bar.st = nullptr;
    if (hi - lo > 1) bar = xcd_barrier_post((unsigned*)(args.ws + WS_CTL) + 4096, MISC + 8);
#ifndef EN_MASK
#define EN_MASK 0xffffffffu
#endif
#define EN(b) ((EN_MASK >> (b)) & 1u)
#define IN(k) (lo <= (k) && (k) < hi)
#define SEAM(k) do { if (IN(k) && IN((k) + 1)) xcd_barrier(bar); } while (0)
    int ph = 0;
#define PTRS size_t zoff_ = 0; asm volatile("" : "+s"(zoff_)); unsigned char* ws = args.ws + zoff_; F.ws = ws; unsigned char* scr = ws + WS_SCR; bf16_t* Wb = (bf16_t*)(ws + WS_W); \
    float* X = (float*)(ws + WS_X); bf16_t* XB = (bf16_t*)(ws + WS_XB); bf16_t* Y = (bf16_t*)(ws + WS_Y); const float* lng = args.in[22]; const float* lnb = args.in[23]; \
    (void)scr; (void)Wb; (void)X; (void)XB; (void)Y; (void)lng; (void)lnb;

    if (EN(0) && IN(ph)) { PTRS phase_convert_small(F, args); }
    SEAM(ph); ++ph;
    if (EN(0) && IN(ph)) { PTRS phase_convert_moe<MOE0_FP8>(F, args, 0); }
    SEAM(ph); ++ph;

#define GEMM_DENSE(EPI, Aptr, lda_, Bptr, ldb_, K_, Mrows, Ncols, epi) do { \
        pg8::Gemm g{(const bf16_t*)(Aptr), (const bf16_t*)(Bptr), (lda_), (ldb_), (K_)}; pg8::DenseOrder S; S.init((Mrows), (Ncols), F.G, F.bid); \
        pg8::gemm_phase<EPI, pg8::DenseOrder, true>(ldsl, g, S, epi); } while (0)

#define MLA_PHASES(j, xres, lnidx, LNMODE, wproj_) do { \
    if (EN(11) && IN(ph)) { PTRS  pg8::EpiF32 E{(float*)(scr + SC_LAT), MLA_INP}; GEMM_DENSE(pg8::EpiF32, XB, D, (char*)Wb + W_DQKV + (size_t)(j) * MLA_INP * D * 2, D, D, T, MLA_INP, E); } \
    SEAM(ph); ++ph; \
    if (EN(2) && IN(ph)) { PTRS phase_mla_rows(F, (const int*)args.in[1]); } \
    SEAM(ph); ++ph; \
    if (EN(12) && IN(ph)) { PTRS  { pg8::EpiBf16 E{(bf16_t*)(scr + SC_Q), MLA_QW}; GEMM_DENSE(pg8::EpiBf16, scr + SC_CQN, MLA_QR, (char*)Wb + W_UQ + (size_t)(j) * MLA_QW * MLA_QR * 2, MLA_QR, MLA_QR, T, MLA_QW, E); } \
                  { pg8::EpiBf16 E{(bf16_t*)(scr + SC_KV), MLA_KVW}; GEMM_DENSE(pg8::EpiBf16, scr + SC_CKVN, MLA_KVR, (char*)Wb + W_UKV + (size_t)(j) * MLA_KVW * MLA_KVR * 2, MLA_KVR, MLA_KVR, T, MLA_KVW, E); } } \
    SEAM(ph); ++ph; \
    if (EN(3) && IN(ph)) { PTRS  const int x8 = F.bid & 7, jj = F.bid >> 3, per = F.G >> 3; \
        for (int lu = jj; lu < 64; lu += per) { const int bh = x8 * 4 + (lu >> 4), qb = lu & 15, b_ = bh >> 3, h_ = bh & 7; const size_t r0 = (size_t)b_ * SEQ + (size_t)qb * 256; \
            att::attn_body((const bf16_t*)(scr + SC_Q) + r0 * MLA_QW + h_ * 192, (const float*)(ws + WS_META + MT_ROPE) + r0 * 64, \
                           (const bf16_t*)(scr + SC_KV) + (size_t)b_ * SEQ * MLA_KVW + h_ * 256, (const bf16_t*)(scr + SC_KV) + (size_t)b_ * SEQ * MLA_KVW + h_ * 256 + 128, \
                           (const bf16_t*)(scr + SC_KR) + (size_t)b_ * SEQ * MLA_ROPE, (bf16_t*)(scr + SC_O) + r0 * D + h_ * 128, SEQ, F.lds); } } \
    SEAM(ph); ++ph; \
    if (EN(13) && IN(ph)) { PTRS  pg8::EpiBf16 E{Y, D}; GEMM_DENSE(pg8::EpiBf16, scr + SC_O, D, (char*)Wb + W_O + (size_t)(j) * D * D * 2, D, D, T, D, E); } \
    SEAM(ph); ++ph; \
    if (EN(4) && IN(ph)) { PTRS phase_ln<LNMODE>(F, xres, Y, X, XB, lng + (lnidx) * D, lnb + (lnidx) * D, wproj_, nullptr); } \
    SEAM(ph); ++ph; } while (0)

#define DENSE_PHASES(c, lnidx, LNMODE, F8) do { \
    if (EN(14) && IN(ph)) { PTRS  pg8::DenseOrder S; S.init(T, 2 * DFF, F.G, F.bid); \
        if constexpr (F8) { pg8::Gemm g{(const bf16_t*)(ws + WS_XB8), (const bf16_t*)((char*)Wb + W_GU + (size_t)(c) * 2 * DFF * D * 2), D / 2, D / 2, D / 2}; \
            pg8::EpiSwiGLU8 E{(unsigned char*)(scr + SC_H), DFF, 8.0f}; pg8::gemm_phase<pg8::EpiSwiGLU8, pg8::DenseOrder, true, true>(ldsl, g, S, E, 127, 121); } \
        else { pg8::Gemm g{(const bf16_t*)XB, (const bf16_t*)((char*)Wb + W_GU + (size_t)(c) * 2 * DFF * D * 2), D, D, D}; \
            pg8::EpiSwiGLU E{(bf16_t*)(scr + SC_H), DFF}; pg8::gemm_phase<pg8::EpiSwiGLU, pg8::DenseOrder, true>(ldsl, g, S, E); } } \
    SEAM(ph); ++ph; \
    if (EN(15) && IN(ph)) { PTRS  pg8::DenseOrder S; S.init(T, D, F.G, F.bid); pg8::EpiBf16 E{Y, D}; \
        if constexpr (F8) { pg8::Gemm g{(const bf16_t*)(scr + SC_H), (const bf16_t*)((char*)Wb + W_DN + (size_t)(c) * D * DFF * 2), DFF / 2, DFF / 2, DFF / 2}; \
            pg8::gemm_phase<pg8::EpiBf16, pg8::DenseOrder, true, true>(ldsl, g, S, E, 124, 119); } \
        else { pg8::Gemm g{(const bf16_t*)(scr + SC_H), (const bf16_t*)((char*)Wb + W_DN + (size_t)(c) * D * DFF * 2), DFF, DFF, DFF}; \
            pg8::gemm_phase<pg8::EpiBf16, pg8::DenseOrder, true>(ldsl, g, S, E); } } \
    SEAM(ph); ++ph; \
    if (EN(4) && IN(ph)) { PTRS phase_ln<LNMODE>(F, X, Y, X, XB, lng + (lnidx) * D, lnb + (lnidx) * D, nullptr, nullptr); } \
    SEAM(ph); ++ph; } while (0)

#define MOE_PHASES(c, lnidx, LNMODE, xout_, wproj_, bgate_, F8) do { \
    if (EN(6) && IN(ph)) { PTRS phase_moe_permute<F8>(F); } \
    SEAM(ph); ++ph; \
    if (EN(7) && IN(ph)) { PTRS  pg8::MoeOrder S; S.build_table((const int*)(ws + WS_META + MT_MOE), (LAS int*)(ldsl + LDS_MISC + 1024), 2 * DFFE, F.G, F.bid); \
        if constexpr (F8) { pg8::Gemm g{(const bf16_t*)(scr + SC_XP), (const bf16_t*)(ws + WS_WMOE + WM_GU), D / 2, D / 2, D / 2}; \
            pg8::EpiSwiGLU8 E{(unsigned char*)(scr + SC_HM), DFFE, 8.0f}; pg8::gemm_phase<pg8::EpiSwiGLU8, pg8::MoeOrder, true, true>(ldsl, g, S, E, 127, 121); } \
        else { pg8::Gemm g{(const bf16_t*)(scr + SC_XP), (const bf16_t*)(ws + WS_WMOE + WM_GU), D, D, D}; \
            pg8::EpiSwiGLU E{(bf16_t*)(scr + SC_HM), DFFE}; pg8::gemm_phase<pg8::EpiSwiGLU, pg8::MoeOrder, true>(ldsl, g, S, E); } } \
    SEAM(ph); ++ph; \
    if (EN(7) && IN(ph)) { PTRS  pg8::MoeOrder S; S.build_table((const int*)(ws + WS_META + MT_MOE), (LAS int*)(ldsl + LDS_MISC + 1024), D, F.G, F.bid); \
        pg8::EpiBf16Scatter E{(bf16_t*)(scr + SC_Y2), (const int*)(ws + WS_META + MT_ROWTOK)}; \
        if constexpr (F8) { pg8::Gemm g{(const bf16_t*)(scr + SC_HM), (const bf16_t*)(ws + WS_WMOE + WM_DN), DFFE / 2, DFFE / 2, DFFE / 2}; pg8::gemm_phase<pg8::EpiBf16Scatter, pg8::MoeOrder, true, true>(ldsl, g, S, E, 124, 119); } \
        else { pg8::Gemm g{(const bf16_t*)(scr + SC_HM), (const bf16_t*)(ws + WS_WMOE + WM_DN), DFFE, DFFE, DFFE}; pg8::gemm_phase<pg8::EpiBf16Scatter, pg8::MoeOrder, true>(ldsl, g, S, E); } } \
    SEAM(ph); ++ph; \
    if (EN(4) && IN(ph)) { PTRS phase_ln<LNMODE>(F, X, (const bf16_t*)(scr + SC_Y2), xout_, XB, lng + (lnidx) * D, lnb + (lnidx) * D, wproj_, bgate_); } \
    SEAM(ph); ++ph; } while (0)

    MLA_PHASES(0, args.in[0], 0, (DENSE0_FP8 ? 16 : 0), nullptr);
    DENSE_PHASES(0, 1, 0, DENSE0_FP8);
    if (EN(5) && IN(ph)) { PTRS phase_pool_z(F); }
    SEAM(ph); ++ph;
    if (EN(16) && IN(ph)) { PTRS  pg8::Gemm g{(const bf16_t*)(scr + SC_Z), (const bf16_t*)((char*)Wb + W_POOL), D, 256, 256}; pg8::PoolOrder S; S.init(T, D, F.G, F.bid);
        pg8::EpiBf16 E{Y, D}; pg8::gemm_phase<pg8::EpiBf16, pg8::PoolOrder, true>(ldsl, g, S, E); }
    SEAM(ph); ++ph;
    if (EN(4) && IN(ph)) { PTRS phase_ln<2>(F, X, Y, X, XB, lng + 2 * D, lnb + 2 * D, args.in[18], nullptr); }
    SEAM(ph); ++ph;
    MOE_PHASES(0, 3, 1 | 4, X, args.in[10], args.in[12], MOE0_FP8);
    if (EN(0) && IN(ph)) { PTRS phase_convert_moe<MOE1_FP8>(F, args, 1); }
    SEAM(ph); ++ph;
    if (EN(17) && IN(ph)) { PTRS  pg8::EpiBf16 E{(bf16_t*)(scr + SC_PROJ), ML_INP}; GEMM_DENSE(pg8::EpiBf16, XB, D, (char*)Wb + W_IN, D, D, T, ML_INP, E); }
    SEAM(ph); ++ph;
    if (EN(8) && IN(ph)) { PTRS phase_mlstm_prep(F, args.in[11]); }
    SEAM(ph); ++ph;
    if (EN(9) && IN(ph)) { PTRS  mls::Tensors Tn; Tn.qkc = (const bf16_t*)(scr + SC_QKC); Tn.proj = (const bf16_t*)(scr + SC_PROJ);
        Tn.gvec = (const float*)(ws + WS_META + MT_GVEC); Tn.hs = (float*)(scr + SC_HS); Tn.variant = args.variant;
        for (int u = F.bid; u < 256; u += F.G) { const int x8 = u & 7, jj = u >> 3; mls::scan_unit(Tn, (x8 * 4 + (jj >> 3)) * 8 + (jj & 7), F.lds); } }
    SEAM(ph); ++ph;
    if (EN(10) && IN(ph)) { PTRS phase_mlstm_combine(F, args.in[13]); }
    SEAM(ph); ++ph;
    if (EN(18) && IN(ph)) { PTRS  pg8::EpiBf16 E{Y, D}; GEMM_DENSE(pg8::EpiBf16, scr + SC_YM, D, (char*)Wb + W_OUT, D, D, T, D, E); }
    SEAM(ph); ++ph;
    if (EN(4) && IN(ph)) { PTRS phase_ln<(DENSE1_FP8 ? 16 : 0)>(F, X, Y, X, XB, lng + 4 * D, lnb + 4 * D, nullptr, nullptr); }
    SEAM(ph); ++ph;
    DENSE_PHASES(1, 5, 0, DENSE1_FP8);
    MLA_PHASES(1, X, 6, 2, args.in[18] + (size_t)D * NEXP);
    MOE_PHASES(1, 7, 1 | 8, args.out, nullptr, nullptr, MOE1_FP8);
#undef IN
#undef SEAM
}

extern "C" void kernel_launch(void* const* d_in, const int* in_sizes, int n_in, void* d_out, int out_size, void* d_ws, size_t ws_size, hipStream_t stream) {
    static int grid = 0;
    if (grid == 0) {
        if (n_in != 24 || in_sizes[0] != T * D || out_size != T * D || ws_size < WS_END) {
            fprintf(stderr, "kernel_launch: shape mismatch: n_in %d in0 %d out %d ws %zu (need %zu)\n", n_in, n_in > 0 ? in_sizes[0] : -1, out_size, ws_size, (size_t)WS_END); grid = -1; return; }
        int dev = 0, cus = 0, per_cu = 0;
        if (hipGetDevice(&dev) != hipSuccess || hipDeviceGetAttribute(&cus, hipDeviceAttributeMultiprocessorCount, dev) != hipSuccess) { grid = -1; return; }
        if (hipFuncSetAttribute((const void*)fwd_kernel, hipFuncAttributeMaxDynamicSharedMemorySize, LDS_BYTES) != hipSuccess) { fprintf(stderr, "kernel_launch: hipFuncSetAttribute failed\n"); grid = -1; return; }
        if (hipOccupancyMaxActiveBlocksPerMultiprocessor(&per_cu, (const void*)fwd_kernel, NTHR, LDS_BYTES) != hipSuccess || per_cu < 1)
            fprintf(stderr, "kernel_launch: occupancy query reports %d blocks per CU\n", per_cu);
        (void)hipGetLastError();
        grid = cus;
    }
    if (grid < 0) return;
    if (hipMemsetAsync((char*)d_ws + WS_CTL, 0, CTL_ZERO_BYTES, stream) != hipSuccess) { fprintf(stderr, "kernel_launch: memset failed\n"); return; }
    Args a{};
    for (int i = 0; i < 24; ++i) a.in[i] = (const float*)d_in[i];
    a.out = (float*)d_out; a.ws = (unsigned char*)d_ws;
#ifndef MK_ONE_LAUNCH
#define MK_ONE_LAUNCH 1
#endif
    if (MK_ONE_LAUNCH) { a.ph_lo = 0; a.ph_hi = NPH; hipLaunchKernelGGL(fwd_kernel, dim3(grid), dim3(NTHR), LDS_BYTES, stream, a);
#ifdef PROBE_PHASE
#ifndef PROBE_VARIANT
#define PROBE_VARIANT 0
#endif
        for (int r = 0; r < PROBE_REPS; ++r) { a.ph_lo = PROBE_PHASE; a.ph_hi = PROBE_PHASE + 1; a.variant = PROBE_VARIANT; hipLaunchKernelGGL(fwd_kernel, dim3(grid), dim3(NTHR), LDS_BYTES, stream, a); }
#endif
    }
    else for (int p = 0; p < NPH; ++p) { a.ph_lo = p; a.ph_hi = p + 1; hipLaunchKernelGGL(fwd_kernel, dim3(grid), dim3(NTHR), LDS_BYTES, stream, a); }
    const hipError_t le = hipPeekAtLastError();
    if (le != hipSuccess) fprintf(stderr, "kernel_launch: launch failed: %s\n", hipGetErrorName(le));
}
```
